# Optimizing an MI355X kernel written in HIP

```python
import math
import jax
import jax.numpy as jnp
from jax import lax
import numpy as np

D_MODEL = 1024
BATCH = 4
SEQ = 4096
DEPTH = 4

CTX_LEN = 256
GRID_W = 64

A_HEADS = 4
A_HEAD_DIM = 64
A_WIDTH = A_HEADS * 2 * A_HEAD_DIM

G_HEADS = 4
G_KEY_DIM = 128
G_VAL_DIM = 128
G_QK_WIDTH = G_HEADS * G_KEY_DIM
G_V_WIDTH = G_HEADS * G_VAL_DIM
CONV_K = 5
CHUNK = 64

N_EXPERTS = 16
N_GROUPS = 4
EXPERTS_PER_GROUP = N_EXPERTS // N_GROUPS
TOP_K = 2
GROUP_SCORE_TOPK = 2
D_EXPERT = 512
MOE_BLOCK = 256

Q_BLOCK = 128
ROPE_BASE = 10000.0
EPS = 1e-6

IN_SIZES = (A_WIDTH, A_WIDTH, A_WIDTH, 2 * G_QK_WIDTH + G_V_WIDTH, G_V_WIDTH, 2 * G_HEADS, 2 * G_HEADS, 2 * D_MODEL)
IN_OFFSETS = tuple(sum(IN_SIZES[:i + 1]) for i in range(len(IN_SIZES) - 1))
N_IN = sum(IN_SIZES)

kernel_name = 'hybrid_diffattn_gdn_moe_dit'


def layer_norm(x, g, b):
    xf = x.astype(jnp.float32)
    mu = jnp.mean(xf, axis=-1, keepdims=True)
    var = jnp.mean(jnp.square(xf - mu), axis=-1, keepdims=True)
    return ((xf - mu) * lax.rsqrt(var + EPS)).astype(x.dtype) * g + b


def rms_norm(x, g):
    xf = x.astype(jnp.float32)
    return (xf * lax.rsqrt(jnp.mean(jnp.square(xf), axis=-1, keepdims=True) + EPS)).astype(x.dtype) * g


def l2_normalize(x):
    xf = x.astype(jnp.float32)
    return (xf * lax.rsqrt(jnp.sum(jnp.square(xf), axis=-1, keepdims=True) + EPS)).astype(x.dtype)


def modulate(x, shift, scale):
    return x * (1.0 + scale) + shift


def split_in(p):
    return jnp.split(p, IN_OFFSETS, axis=-1)


def axial_rope(n_tokens, dim):
    rows = n_tokens // GRID_W
    row = jnp.repeat(jnp.arange(rows, dtype=jnp.float32), GRID_W)
    col = jnp.tile(jnp.arange(GRID_W, dtype=jnp.float32), rows)
    n_freq = dim // 4
    inv = ROPE_BASE ** (-jnp.arange(n_freq, dtype=jnp.float32) / n_freq)
    ang = jnp.stack([row[:, None] * inv, col[:, None] * inv], axis=1)
    return jnp.cos(ang), jnp.sin(ang)


def rope_2d(x, cos, sin):
    xs = x.reshape(x.shape[:-1] + (2, 2, -1))
    c = cos[:, None, None, :, :]
    s = sin[:, None, None, :, :]
    x1 = xs[..., 0, :]
    x2 = xs[..., 1, :]
    out = jnp.stack([x1 * c - x2 * s, x2 * c + x1 * s], axis=-2)
    return out.reshape(x.shape)


def diff_attend(q, k, v, lam):
    s = jnp.einsum('bqhnd,bkhnd->bnhqk', q, k).astype(jnp.float32) * (A_HEAD_DIM ** -0.5)
    p = jax.nn.softmax(s, axis=-1)
    p = p[:, 0] - lam * p[:, 1]
    return jnp.einsum('bhqk,bkhe->bqhe', p.astype(v.dtype), v)


def short_conv(x, w):
    return lax.conv_general_dilated(x, w[:, None, :], window_strides=(1,),
                                    padding=[(CONV_K // 2, CONV_K // 2)],
                                    dimension_numbers=('NWC', 'WIO', 'NWC'),
                                    feature_group_count=x.shape[-1])


def gated_delta_rule(q, k, v, g, beta, state):
    B, L, H, DK = q.shape
    DV = v.shape[-1]
    n = L // CHUNK
    f32 = jnp.float32

    def chunk4(t):
        return t.astype(f32).reshape(B, n, CHUNK, H, t.shape[-1]).transpose(1, 0, 3, 2, 4)

    def chunk3(t):
        return t.astype(f32).reshape(B, n, CHUNK, H).transpose(1, 0, 3, 2)

    qc = chunk4(q) * (DK ** -0.5)
    kc = chunk4(k)
    vc = chunk4(v)
    bc = chunk3(beta)
    gcum = jnp.cumsum(chunk3(g), axis=-1)
    idx = jnp.arange(CHUNK)
    causal = idx[:, None] >= idx[None, :]
    strict = idx[:, None] > idx[None, :]
    decay = jnp.exp(jnp.where(causal, gcum[..., :, None] - gcum[..., None, :], -jnp.inf))
    kb = kc * bc[..., None]
    a_mat = jnp.where(strict, jnp.einsum('nbhid,nbhjd->nbhij', kb, kc) * decay, 0.0)
    rhs = jnp.concatenate([vc * bc[..., None], kb * jnp.exp(gcum)[..., None]], axis=-1)
    sol = lax.linalg.triangular_solve(a_mat + jnp.eye(CHUNK, dtype=f32), rhs, left_side=True,
                                      lower=True, unit_diagonal=True)
    u, w = sol[..., :DV], sol[..., DV:]
    qk = jnp.where(causal, jnp.einsum('nbhid,nbhjd->nbhij', qc, kc) * decay, 0.0)
    q_dec = qc * jnp.exp(gcum)[..., None]
    k_dec = kc * jnp.exp(gcum[..., -1:] - gcum)[..., None]
    g_last = jnp.exp(gcum[..., -1])

    def step(s, xs):
        q_d, k_d, u_n, w_n, qk_n, gl = xs
        v_new = u_n - jnp.einsum('bhcd,bhde->bhce', w_n, s)
        o = jnp.einsum('bhcd,bhde->bhce', q_d, s) + jnp.einsum('bhij,bhje->bhie', qk_n, v_new)
        s = s * gl[..., None, None] + jnp.einsum('bhcd,bhce->bhde', k_d, v_new)
        return s, o

    s_final, o = lax.scan(step, state.astype(f32), (q_dec, k_dec, u, w, qk, g_last))
    o = o.transpose(1, 0, 3, 2, 4).reshape(B, L, H, DV)
    return o, s_final


def token_mixer(h_lat, h_ctx, cos, sin, lam_init, ctx_out, w_in, conv_w, lam_q1, lam_k1, lam_q2, lam_k2,
                subln_g, a_log, dt_bias, onorm_g, w_pa, w_pb, w_o):
    B, S, _ = h_lat.shape
    qa_l, ka_l, va_l, qkv_l, z_l, a_l, b_l, gate_l = split_in(h_lat @ w_in)
    qa_c, ka_c, va_c, qkv_c, z_c, a_c, b_c, gate_c = split_in(h_ctx @ w_in)

    def heads_a(t):
        return t.reshape(t.shape[:2] + (A_HEADS, 2, A_HEAD_DIM))

    def heads_v(t):
        return t.reshape(t.shape[:2] + (A_HEADS, 2 * A_HEAD_DIM))

    def subln(o):
        return (rms_norm(o, subln_g) * (1.0 - lam_init)).reshape(o.shape[:2] + (A_WIDTH,))

    lam = (jnp.exp(jnp.sum(lam_q1 * lam_k1).astype(jnp.float32))
           - jnp.exp(jnp.sum(lam_q2 * lam_k2).astype(jnp.float32)) + lam_init)
    qa_l = rope_2d(heads_a(qa_l), cos, sin)
    k_ctx = heads_a(ka_c)
    v_ctx = heads_v(va_c)
    k_all = jnp.concatenate([k_ctx, rope_2d(heads_a(ka_l), cos, sin)], axis=1)
    v_all = jnp.concatenate([v_ctx, heads_v(va_l)], axis=1)
    q_blocks = qa_l.reshape((B, S // Q_BLOCK, Q_BLOCK) + qa_l.shape[2:]).swapaxes(0, 1)
    oa_l = lax.map(lambda qb: diff_attend(qb, k_all, v_all, lam), q_blocks)
    ya_l = subln(oa_l.swapaxes(0, 1).reshape(B, S, A_HEADS, 2 * A_HEAD_DIM))

    def gdn_branch(qkv, z, a, b, states):
        L = qkv.shape[1]
        qkv = jax.nn.silu(short_conv(qkv, conv_w))
        q, k, v = jnp.split(qkv, [G_QK_WIDTH, 2 * G_QK_WIDTH], axis=-1)
        q = l2_normalize(q.reshape(B, L, G_HEADS, G_KEY_DIM))
        k = l2_normalize(k.reshape(B, L, G_HEADS, G_KEY_DIM))
        v = v.reshape(B, L, G_HEADS, G_VAL_DIM)
        g = -jnp.exp(a_log.astype(jnp.float32)) * jax.nn.softplus(
            a.reshape(B, L, 2, G_HEADS).astype(jnp.float32) + dt_bias.astype(jnp.float32))
        beta = jax.nn.sigmoid(b.reshape(B, L, 2, G_HEADS).astype(jnp.float32))
        flip = lambda t: jnp.flip(t, axis=1)
        o_f, s_f = gated_delta_rule(q, k, v, g[:, :, 0], beta[:, :, 0], states[0])
        o_b, s_b = gated_delta_rule(flip(q), flip(k), flip(v), flip(g[:, :, 1]), flip(beta[:, :, 1]), states[1])
        o = (o_f + flip(o_b)).astype(z.dtype)
        y = rms_norm(o, onorm_g) * jax.nn.silu(z.reshape(B, L, G_HEADS, G_VAL_DIM))
        return y.reshape(B, L, G_V_WIDTH), (s_f, s_b)

    zeros = jnp.zeros((B, G_HEADS, G_KEY_DIM, G_VAL_DIM), jnp.float32)
    yb_c, ctx_states = gdn_branch(qkv_c, z_c, a_c, b_c, (zeros, zeros))
    yb_l, _ = gdn_branch(qkv_l, z_l, a_l, b_l, ctx_states)

    def merge(ya, yb, gates):
        g_a, g_b = jnp.split(jax.nn.sigmoid(gates), 2, axis=-1)
        return (g_a * (ya @ w_pa) + g_b * (yb @ w_pb)) @ w_o

    y_lat = merge(ya_l, yb_l, gate_l)
    if not ctx_out:
        return y_lat, None
    ya_c = subln(diff_attend(heads_a(qa_c), k_ctx, v_ctx, lam))
    y_ctx = merge(ya_c, yb_c, gate_c)
    return y_lat, y_ctx


def moe_ffn(h, router_w, router_b, w1, w3, w2):
    T, D = h.shape
    scores = jax.nn.sigmoid((h @ router_w).astype(jnp.float32))
    sel = (scores + router_b.astype(jnp.float32)).reshape(T, N_GROUPS, EXPERTS_PER_GROUP)
    group_score = jnp.sum(lax.top_k(sel, GROUP_SCORE_TOPK)[0], axis=-1)
    best = jnp.argmax(group_score, axis=-1).astype(jnp.int32)
    in_group = jnp.take_along_axis(sel, best[:, None, None], axis=1)[:, 0]
    _, local = lax.top_k(in_group, TOP_K)
    expert_idx = best[:, None] * EXPERTS_PER_GROUP + local
    w = jnp.take_along_axis(scores, expert_idx, axis=1)
    w = w / jnp.sum(w, axis=-1, keepdims=True)

    n_assign = T * TOP_K
    flat_e = expert_idx.reshape(-1)
    order = jnp.argsort(flat_e)
    sorted_e = flat_e[order]
    counts = jnp.bincount(flat_e, length=N_EXPERTS)
    padded = (counts + MOE_BLOCK - 1) // MOE_BLOCK * MOE_BLOCK
    pad_end = jnp.cumsum(padded)
    pad_start = pad_end - padded
    start = jnp.cumsum(counts) - counts
    dest_sorted = pad_start[sorted_e] + jnp.arange(n_assign) - start[sorted_e]
    dest = jnp.zeros_like(dest_sorted).at[order].set(dest_sorted)
    n_blocks = -(-n_assign // MOE_BLOCK) + N_EXPERTS
    tok = jnp.arange(n_assign, dtype=jnp.int32) // TOP_K
    slot_tok = jnp.full((n_blocks * MOE_BLOCK,), T, jnp.int32).at[dest].set(tok)
    h_pad = jnp.concatenate([h, jnp.zeros((1, D), h.dtype)], axis=0)
    xs = h_pad[slot_tok].reshape(n_blocks, MOE_BLOCK, D)
    block_e = jnp.minimum(jnp.searchsorted(pad_end, jnp.arange(n_blocks) * MOE_BLOCK, side='right'),
                          N_EXPERTS - 1)

    def expert_block(args):
        xb, e = args
        return (jax.nn.silu(xb @ w1[e]) * (xb @ w3[e])) @ w2[e]

    ys = lax.map(expert_block, (xs, block_e)).reshape(-1, D)
    y = ys[dest].reshape(T, TOP_K, D)
    return jnp.einsum('tk,tkd->td', w.astype(h.dtype), y)


def setup_inputs(seed: int = 0) -> dict:
    key = jax.random.key(seed)
    ks = jax.random.split(key, 32)
    f32 = jnp.float32
    beta_dn = (8.0 * DEPTH) ** -0.25

    def nrm(k, shape, scale):
        return jax.random.normal(k, shape, f32) * scale

    def gain(k, shape):
        return 1.0 + 0.02 * jax.random.normal(k, shape, f32)

    dt = jnp.exp(jax.random.uniform(ks[12], (DEPTH, 2, G_HEADS), f32, math.log(1e-3), math.log(1e-1)))
    return {
        'x': nrm(ks[0], (BATCH, SEQ, D_MODEL), 1.0),
        'c': nrm(ks[1], (BATCH, D_MODEL), 1.0),
        'ctx': nrm(ks[2], (BATCH, CTX_LEN, D_MODEL), 1.0),
        'c_ctx': nrm(ks[3], (D_MODEL,), 1.0),
        'mod_w': nrm(ks[4], (DEPTH, D_MODEL, 6 * D_MODEL), 0.5 * D_MODEL ** -0.5),
        'mod_b': nrm(ks[5], (DEPTH, 6 * D_MODEL), 0.02),
        'w_in': nrm(ks[6], (DEPTH, D_MODEL, N_IN), D_MODEL ** -0.5),
        'conv_w': nrm(ks[7], (DEPTH, CONV_K, 2 * G_QK_WIDTH + G_V_WIDTH), CONV_K ** -0.5),
        'lam_q1': nrm(ks[8], (DEPTH, A_HEAD_DIM), 0.1),
        'lam_k1': nrm(ks[9], (DEPTH, A_HEAD_DIM), 0.1),
        'lam_q2': nrm(ks[10], (DEPTH, A_HEAD_DIM), 0.1),
        'lam_k2': nrm(ks[11], (DEPTH, A_HEAD_DIM), 0.1),
        'subln_g': gain(ks[13], (DEPTH, 2 * A_HEAD_DIM)),
        'a_log': jnp.log(jax.random.uniform(ks[14], (DEPTH, 2, G_HEADS), f32, 1.0, 16.0)),
        'dt_bias': dt + jnp.log(-jnp.expm1(-dt)),
        'onorm_g': gain(ks[15], (DEPTH, G_VAL_DIM)),
        'w_pa': nrm(ks[16], (DEPTH, A_WIDTH, D_MODEL), beta_dn * A_WIDTH ** -0.5),
        'w_pb': nrm(ks[17], (DEPTH, G_V_WIDTH, D_MODEL), beta_dn * G_V_WIDTH ** -0.5),
        'w_o': nrm(ks[18], (DEPTH, D_MODEL, D_MODEL), beta_dn * D_MODEL ** -0.5),
        'ln1_g': gain(ks[19], (DEPTH, D_MODEL)),
        'ln1_b': nrm(ks[20], (DEPTH, D_MODEL), 0.02),
        'router_w': nrm(ks[21], (D_MODEL, N_EXPERTS), D_MODEL ** -0.5),
        'router_b': nrm(ks[22], (N_EXPERTS,), 0.01),
        'w_exp1': nrm(ks[23], (DEPTH, N_EXPERTS, D_MODEL, D_EXPERT), D_MODEL ** -0.5),
        'w_exp3': nrm(ks[24], (DEPTH, N_EXPERTS, D_MODEL, D_EXPERT), D_MODEL ** -0.5),
        'w_exp2': nrm(ks[25], (DEPTH, N_EXPERTS, D_EXPERT, D_MODEL), beta_dn * D_EXPERT ** -0.5),
        'ln2_g': gain(ks[26], (DEPTH, D_MODEL)),
        'ln2_b': nrm(ks[27], (DEPTH, D_MODEL), 0.02),
    }


def reference(x, c, ctx, c_ctx, mod_w, mod_b, w_in, conv_w, lam_q1, lam_k1, lam_q2, lam_k2, subln_g,
              a_log, dt_bias, onorm_g, w_pa, w_pb, w_o, ln1_g, ln1_b, router_w, router_b,
              w_exp1, w_exp3, w_exp2, ln2_g, ln2_b):
    B, S, D = x.shape
    n_ctx = ctx.shape[1]
    alpha = (2.0 * DEPTH) ** 0.25
    cos, sin = axial_rope(S, A_HEAD_DIM)
    cos, sin = cos.astype(x.dtype), sin.astype(x.dtype)
    xc = ctx
    for l in range(DEPTH):
        last = l == DEPTH - 1
        lam_init = 0.8 - 0.6 * math.exp(-0.3 * l)
        m_lat = jnp.split(jax.nn.silu(c) @ mod_w[l] + mod_b[l], 6, axis=-1)
        m_ctx = jnp.split(jax.nn.silu(c_ctx) @ mod_w[l] + mod_b[l], 6, axis=-1)

        h_lat = modulate(x, m_lat[0][:, None], m_lat[1][:, None])
        h_ctx = modulate(xc, m_ctx[0], m_ctx[1])
        y_lat, y_ctx = token_mixer(h_lat, h_ctx, cos, sin, lam_init, not last, w_in[l], conv_w[l],
                                   lam_q1[l], lam_k1[l], lam_q2[l], lam_k2[l], subln_g[l], a_log[l],
                                   dt_bias[l], onorm_g[l], w_pa[l], w_pb[l], w_o[l])
        x = layer_norm(alpha * x + m_lat[2][:, None] * y_lat, ln1_g[l], ln1_b[l])

        h_lat = modulate(x, m_lat[3][:, None], m_lat[4][:, None])
        if last:
            y_lat = moe_ffn(h_lat.reshape(-1, D), router_w, router_b,
                            w_exp1[l], w_exp3[l], w_exp2[l]).reshape(B, S, D)
        else:
            xc = layer_norm(alpha * xc + m_ctx[2] * y_ctx, ln1_g[l], ln1_b[l])
            h_ctx = modulate(xc, m_ctx[3], m_ctx[4])
            tokens = jnp.concatenate([h_ctx.reshape(-1, D), h_lat.reshape(-1, D)], axis=0)
            y = moe_ffn(tokens, router_w, router_b, w_exp1[l], w_exp3[l], w_exp2[l])
            y_ctx = y[:B * n_ctx].reshape(B, n_ctx, D)
            y_lat = y[B * n_ctx:].reshape(B, S, D)
            xc = layer_norm(alpha * xc + m_ctx[5] * y_ctx, ln2_g[l], ln2_b[l])
        x = layer_norm(alpha * x + m_lat[5][:, None] * y_lat, ln2_g[l], ln2_b[l])
    return x
```

```cpp
#include <hip/hip_runtime.h>
#include <cstdio>
#include <cstdint>

#define DI __device__ __forceinline__
typedef unsigned short bf16_t;
typedef short bf16x8 __attribute__((ext_vector_type(8)));
typedef float f32x4 __attribute__((ext_vector_type(4)));
typedef float f32x2 __attribute__((ext_vector_type(2)));
typedef float f32x16 __attribute__((ext_vector_type(16)));
typedef unsigned u32x4 __attribute__((ext_vector_type(4)));
typedef unsigned u32x2 __attribute__((ext_vector_type(2)));
typedef __bf16 bf16x2_t __attribute__((ext_vector_type(2)));

constexpr int D = 1024, NB = 4, SEQ = 4096, CTX = 256, DEPTH = 4;
constexpr int NCTX = NB * CTX;
constexpr int TT = NCTX + NB * SEQ;
constexpr int N_IN = 5648, NPROJ = 5632;
constexpr int NE = 16;
constexpr float EPS = 1e-6f;
constexpr float ALPHA = 1.681792830507429f;
constexpr float QSCALE = 0.125f * 1.4426950408889634f;
constexpr int NASSIGN = TT * 2;
constexpr int NSLOT = NASSIGN + NE * 256;

constexpr size_t MiB = 1u << 20;
constexpr size_t WS_CTL = 0;
constexpr size_t WS_MODS = 1 * MiB;
constexpr size_t WS_ROPE = 2 * MiB;
constexpr size_t WS_META = 2 * MiB + 65536;
constexpr size_t WS_ROUTE_E = 3 * MiB;
constexpr size_t WS_ROUTE_W = 3 * MiB + 262144;
constexpr size_t WS_DEST = 3 * MiB + 524288;
constexpr size_t WS_SLOTA = 3 * MiB + 786432;
constexpr size_t WS_AB = 4 * MiB;
constexpr size_t WS_GL = 6 * MiB;
constexpr size_t WS_WIN = 8 * MiB;
constexpr size_t WS_WPAB = 20 * MiB;
constexpr size_t WS_WO = 22 * MiB;
constexpr size_t WS_W13 = 24 * MiB;
constexpr size_t WS_W2 = 56 * MiB;
constexpr size_t WS_X = 72 * MiB;
constexpr size_t WS_H = 140 * MiB;
constexpr size_t WS_QA = 174 * MiB;
constexpr size_t WS_KA = 191 * MiB;
constexpr size_t WS_VA = 208 * MiB;
constexpr size_t WS_QKV = 225 * MiB;
constexpr size_t WS_Z = 276 * MiB;
constexpr size_t WS_SG = 293 * MiB;
constexpr size_t WS_GPRE = 361 * MiB;
constexpr size_t WS_OF = 514 * MiB;
constexpr size_t WS_OB = 531 * MiB;
constexpr size_t WS_YAB = 548 * MiB;
constexpr size_t WS_M = 582 * MiB;
constexpr size_t WS_END = 616 * MiB;
constexpr size_t WS_XS = 174 * MiB;
constexpr size_t WS_ACT = 250 * MiB;
constexpr size_t WS_YS = 288 * MiB;
constexpr size_t WS_ON = 361 * MiB;
constexpr size_t WS_CONVO = 361 * MiB;

DI float bf2f(bf16_t v) { return __uint_as_float(((unsigned)v) << 16); }
DI unsigned pk2(float lo, float hi) { f32x2 v = {lo, hi}; bf16x2_t b = __builtin_convertvector(v, bf16x2_t); return __builtin_bit_cast(unsigned, b); }
DI bf16_t f2bf(float f) { return (bf16_t)(pk2(f, 0.f) & 0xffffu); }
DI float sigmoidf_(float x) { return __builtin_amdgcn_rcpf(1.f + __builtin_amdgcn_exp2f(-1.4426950408889634f * x)); }
DI float siluf_(float x) { return x * __builtin_amdgcn_rcpf(1.f + __builtin_amdgcn_exp2f(-1.4426950408889634f * x)); }
DI float softplusf_(float x) { return fmaxf(x, 0.f) + log1pf(__expf(-fabsf(x))); }
template <int CTRL> DI float dppmov(float v) { return __uint_as_float(__builtin_amdgcn_update_dpp(0u, __float_as_uint(v), CTRL, 0xf, 0xf, true)); }
DI float xor32(float x, bool hi32) { auto rr = __builtin_amdgcn_permlane32_swap(__float_as_uint(x), __float_as_uint(x), false, false); return __uint_as_float(hi32 ? rr[0] : rr[1]); }
DI float xor16(float x, bool odd16) { auto rr = __builtin_amdgcn_permlane16_swap(__float_as_uint(x), __float_as_uint(x), false, false); return __uint_as_float(odd16 ? rr[0] : rr[1]); }
DI float wave_sum(float v) {
    v += dppmov<0xB1>(v); v += dppmov<0x4E>(v); v += dppmov<0x124>(v); v += dppmov<0x128>(v);
    { auto rr = __builtin_amdgcn_permlane16_swap(__float_as_uint(v), __float_as_uint(v), false, false); v = __uint_as_float(rr[0]) + __uint_as_float(rr[1]); }
    { auto rr = __builtin_amdgcn_permlane32_swap(__float_as_uint(v), __float_as_uint(v), false, false); v = __uint_as_float(rr[0]) + __uint_as_float(rr[1]); }
    return v;
}
DI int jj16_of_lane(int lane) { return ((lane >> 5) & 1) * 8 + ((lane >> 4) & 1) * 4 + ((lane >> 3) & 1) * 2 + ((lane >> 2) & 1); }
DI int lane_of_jj16(int jj) { return 32 * (jj >> 3) + 16 * ((jj >> 2) & 1) + 8 * ((jj >> 1) & 1) + 4 * (jj & 1); }
DI float reduce16(const float (&p)[16], int lane) {
    const bool b5 = lane & 32, b4 = lane & 16, b3 = lane & 8, b2 = lane & 4;
    float q8[8], q4[4], q2[2];
#pragma unroll
    for (int j = 0; j < 8; ++j) { const float keep = b5 ? p[j + 8] : p[j], send = b5 ? p[j] : p[j + 8]; q8[j] = keep + xor32(send, b5); }
#pragma unroll
    for (int j = 0; j < 4; ++j) { const float keep = b4 ? q8[j + 4] : q8[j], send = b4 ? q8[j] : q8[j + 4]; q4[j] = keep + xor16(send, b4); }
#pragma unroll
    for (int j = 0; j < 2; ++j) { const float keep = b3 ? q4[j + 2] : q4[j], send = b3 ? q4[j] : q4[j + 2]; q2[j] = keep + dppmov<0x128>(send); }
    float q1;
    { const float keep = b2 ? q2[1] : q2[0], send = b2 ? q2[0] : q2[1]; const float pa = dppmov<0x124>(send), pb = dppmov<0x12C>(send); q1 = keep + (b2 ? pa : pb); }
    q1 += dppmov<0x4E>(q1); q1 += dppmov<0xB1>(q1);
    return q1;
}
DI int mod_set(int row) { return row < NCTX ? 4 : ((row - NCTX) >> 12); }
DI float lam_init_of(int l) { return 0.8f - 0.6f * __expf(-0.3f * (float)l); }

DI int tidx() { int t = threadIdx.x; asm volatile("" : "+v"(t)); return t; }

struct Args {
    const float* in[28];
    float* out;
    unsigned char* ws;
    int lo, hi, layer, pad;
};


namespace pg8 {
#define PG8_LAS __attribute__((address_space(3)))
typedef unsigned short bf16_t;
typedef short bf16x8 __attribute__((ext_vector_type(8)));
typedef float f32x4 __attribute__((ext_vector_type(4)));
typedef unsigned u32x4 __attribute__((ext_vector_type(4)));
constexpr int BM = 256, BK = 64, HALF = 128, HTB = HALF * BK * 2  , STAGE_BYTES = 8 * HTB, NXCD = 8, WGM = 8;

__host__ __device__ __forceinline__ int lds_byte(int r, int c) { const int st = (r >> 4) * 2 + (c >> 5), rr = r & 15, cc = c & 31, ob = rr * 64 + cc * 2; return st * 1024 + (ob ^ (((ob >> 9) & 1) << 5)); }
__host__ __device__ __forceinline__ void stage_rc(int b, int& R, int& C) { const int st = b / 1024, sb = b % 1024, swz = sb ^ (((sb >> 9) & 1) << 5); R = (st >> 1) * 16 + swz / 64; C = (st & 1) * 32 + (swz % 64) / 2; }
__host__ __device__ __forceinline__ int perm32(int rho) { const int n = rho >> 4, i = rho & 15; return 8 * (i >> 2) + 4 * n + (i & 3); }

struct Unit { int pm, pn; };
struct Gemm { const bf16_t* A; const bf16_t* Bt; int M, N, K; };

struct StaticOrder {
    int nM, nN, nwg, G, c;
    __host__ __device__ void init(int M, int N, int G_, int c_) { nM = M / BM; nN = N / BM; nwg = nM * nN; G = G_; c = c_; }
    __host__ __device__ bool next(int i, Unit& u) const {
        const long L = (long)i * G + c; if (L >= nwg) return false;
        int wgid = (int)L; { const int q = nwg / NXCD, r = nwg % NXCD, xcd = wgid % NXCD, off = wgid / NXCD; wgid = (xcd < r ? xcd * (q + 1) : r * (q + 1) + (xcd - r) * q) + off; }
        const int nig = WGM * nN, gid = wgid / nig, fm = gid * WGM, gsz = (nM - fm) < WGM ? (nM - fm) : WGM;
        u.pm = fm + ((wgid % nig) % gsz); u.pn = (wgid % nig) / gsz; return true;
    }
    __device__ __forceinline__ void a_ready(const Unit&) const {}
    __device__ __forceinline__ void done(const Unit&) const {}
};

template <class Epi, class Sched, bool ALIGN_EPI = false, bool SP2 = false>
__device__ __forceinline__ void gemm_phase(PG8_LAS unsigned char* lds, const Gemm g, const Sched& S, const Epi& E) {
    const int tid = tidx(), wid = __builtin_amdgcn_readfirstlane(tid >> 6), lane = tid & 63, wr = wid >> 2, wc = wid & 3, fr = lane & 15, fq = lane >> 4;
    const int K = g.K, nt = K / BK;
    unsigned voffA[2], voffB[2];
#pragma unroll
    for (int i = 0; i < 2; ++i) { int R, C; stage_rc(tid * 16 + i * 8192, R, C); const int Rb = Epi::PERM ? ((R & ~31) + perm32(R & 31)) : R;
        voffA[i] = (unsigned)(R * K + C) * 2u; voffB[i] = (unsigned)(Rb * K + C) * 2u; }
    const size_t kstep = (size_t)(BK * 2);
    const size_t hstep = (size_t)HALF * K * 2;
    const size_t tstep = 2 * hstep;
    const unsigned ldsw = (unsigned)wid * 1024u;
    const int aoff = lds_byte(wr * 64 + fr, fq * 8), boff = lds_byte(wc * 32 + fr, fq * 8);
#define PG8_SA(b, h) (((b) * 2 + (h)) * HTB)
#define PG8_SB(b, h) ((4 + (b) * 2 + (h)) * HTB)
#define PG8_STAGE(bufoff, gbase, voff) do { _Pragma("unroll") for (int _i = 0; _i < 2; ++_i) \
        __builtin_amdgcn_global_load_lds((const unsigned*)((const char*)(gbase) + (voff)[_i]), (PG8_LAS unsigned*)(lds + (bufoff) + ldsw + _i * 8192), 16, 0, 0); } while (0)
#define PG8_LDA(dst, b, h) do { _Pragma("unroll") for (int m = 0; m < 4; ++m) _Pragma("unroll") for (int k = 0; k < 2; ++k) dst[m][k] = *(const PG8_LAS bf16x8*)(lds + PG8_SA(b, h) + aoff + m * 2048 + k * 1024); } while (0)
#define PG8_LDB(dst, b, h) do { _Pragma("unroll") for (int n = 0; n < 2; ++n) _Pragma("unroll") for (int k = 0; k < 2; ++k) dst[n][k] = *(const PG8_LAS bf16x8*)(lds + PG8_SB(b, h) + boff + n * 2048 + k * 1024); } while (0)
#define PG8_MMA(ai, bj, At, Bt) do { __builtin_amdgcn_s_setprio(1); _Pragma("unroll") for (int m = 0; m < 4; ++m) _Pragma("unroll") for (int n = 0; n < 2; ++n) _Pragma("unroll") for (int k = 0; k < 2; ++k) \
        acc[ai][bj][m][n] = __builtin_amdgcn_mfma_f32_16x16x32_bf16(Bt[n][k], At[m][k], acc[ai][bj][m][n], 0, 0, 0); __builtin_amdgcn_s_setprio(0); } while (0)
#define PG8_WAIT_V(n) asm volatile("s_waitcnt vmcnt(" #n ")" ::: "memory")
#define PG8_WAIT_L(n) asm volatile("s_waitcnt lgkmcnt(" #n ")" ::: "memory")
#define PG8_BAR __builtin_amdgcn_s_barrier()
#define PG8_SCHED __builtin_amdgcn_sched_barrier(0)
    Unit cur, nxt; int ui = 0;
    if (!S.next(0, cur)) return;
    f32x4 acc[2][2][4][2];
#pragma unroll
    for (int a = 0; a < 2; ++a)
#pragma unroll
        for (int b = 0; b < 2; ++b)
#pragma unroll
            for (int m = 0; m < 4; ++m)
#pragma unroll
                for (int n = 0; n < 2; ++n) acc[a][b][m][n] = (f32x4){0.f, 0.f, 0.f, 0.f};
    bf16x8 At[4][2], B0[2][2], B1[2][2];
    const char* cA = (const char*)g.A + (size_t)cur.pm * tstep; const char* cB = (const char*)g.Bt + (size_t)cur.pn * tstep;
    S.a_ready(cur);
    if constexpr (SP2) {
        PG8_STAGE(PG8_SB(0, 0), cB, voffB); PG8_STAGE(PG8_SB(0, 1), cB + hstep, voffB); PG8_STAGE(PG8_SA(0, 0), cA, voffA); PG8_STAGE(PG8_SA(0, 1), cA + hstep, voffA);
        if (wr == 1) PG8_BAR;
        PG8_WAIT_V(2); PG8_BAR;
        PG8_STAGE(PG8_SB(1, 0), cB + kstep, voffB); PG8_STAGE(PG8_SA(1, 0), cA + kstep, voffA); PG8_STAGE(PG8_SB(1, 1), cB + hstep + kstep, voffB);
        PG8_WAIT_V(6); PG8_BAR;
    } else {
        PG8_STAGE(PG8_SB(0, 0), cB, voffB); PG8_STAGE(PG8_SA(0, 0), cA, voffA); PG8_STAGE(PG8_SB(0, 1), cB + hstep, voffB); PG8_STAGE(PG8_SA(0, 1), cA + hstep, voffA);
        if (wr == 1) PG8_BAR;
        PG8_WAIT_V(4); PG8_BAR;
        PG8_STAGE(PG8_SB(1, 0), cB + kstep, voffB); PG8_STAGE(PG8_SA(1, 0), cA + kstep, voffA); PG8_STAGE(PG8_SB(1, 1), cB + hstep + kstep, voffB);
        PG8_WAIT_V(6); PG8_BAR;
    }
    for (;;) {
        const bool has_next = S.next(ui + 1, nxt);
        const char* nA = has_next ? (const char*)g.A + (size_t)nxt.pm * tstep : cA; const char* nB = has_next ? (const char*)g.Bt + (size_t)nxt.pn * tstep : cB;
        for (int t = 0; t < nt; t += 2) {
            const bool last = (t == nt - 2);
            const char* a1 = cA + (size_t)(t + 1) * kstep;
            const char* a2 = last ? nA : cA + (size_t)(t + 2) * kstep; const char* b2 = last ? nB : cB + (size_t)(t + 2) * kstep;
            const char* a3 = a2 + kstep; const char* b3 = b2 + kstep;
            if (last && has_next) S.a_ready(nxt);
            if constexpr (SP2) {
            PG8_LDB(B0, 0, 0); PG8_LDB(B1, 0, 1); PG8_SCHED; PG8_LDA(At, 0, 0); PG8_STAGE(PG8_SA(1, 1), a1 + hstep, voffA);
            PG8_WAIT_V(8); PG8_WAIT_L(0); PG8_BAR; PG8_MMA(0, 0, At, B0); PG8_MMA(0, 1, At, B1); PG8_BAR; PG8_SCHED;
            PG8_LDA(At, 0, 1); PG8_STAGE(PG8_SB(0, 0), b2, voffB); PG8_STAGE(PG8_SB(0, 1), b2 + hstep, voffB); PG8_STAGE(PG8_SA(0, 0), a2, voffA);
            PG8_WAIT_V(8); PG8_WAIT_L(0); PG8_BAR; PG8_MMA(1, 0, At, B0); PG8_MMA(1, 1, At, B1); PG8_BAR; PG8_SCHED;
            PG8_LDB(B0, 1, 0); PG8_LDB(B1, 1, 1); PG8_SCHED; PG8_LDA(At, 1, 0); PG8_STAGE(PG8_SA(0, 1), a2 + hstep, voffA);
            PG8_WAIT_V(8); PG8_WAIT_L(0); PG8_BAR; PG8_MMA(0, 0, At, B0); PG8_MMA(0, 1, At, B1); PG8_BAR; PG8_SCHED;
            PG8_LDA(At, 1, 1); PG8_STAGE(PG8_SB(1, 0), b3, voffB); PG8_STAGE(PG8_SB(1, 1), b3 + hstep, voffB); PG8_STAGE(PG8_SA(1, 0), a3, voffA);
            PG8_WAIT_V(8); PG8_WAIT_L(0); PG8_BAR; PG8_MMA(1, 0, At, B0); PG8_MMA(1, 1, At, B1); PG8_BAR; PG8_SCHED;
            } else {
            PG8_LDB(B0, 0, 0); PG8_SCHED; PG8_LDA(At, 0, 0); PG8_STAGE(PG8_SA(1, 1), a1 + hstep, voffA);
            PG8_WAIT_L(8); PG8_BAR; PG8_WAIT_L(0); PG8_MMA(0, 0, At, B0); PG8_BAR; PG8_SCHED;
            PG8_LDB(B1, 0, 1); PG8_STAGE(PG8_SB(0, 0), b2, voffB);
            PG8_BAR; PG8_WAIT_L(0); PG8_MMA(0, 1, At, B1); PG8_BAR;
            PG8_LDA(At, 0, 1); PG8_STAGE(PG8_SA(0, 0), a2, voffA);
            PG8_BAR; PG8_WAIT_L(0); PG8_MMA(1, 0, At, B0); PG8_BAR; PG8_SCHED;
            PG8_STAGE(PG8_SB(0, 1), b2 + hstep, voffB);
            PG8_WAIT_V(6); PG8_BAR; PG8_MMA(1, 1, At, B1); PG8_BAR;
            PG8_LDB(B0, 1, 0); PG8_SCHED; PG8_LDA(At, 1, 0); PG8_STAGE(PG8_SA(0, 1), a2 + hstep, voffA);
            PG8_WAIT_L(8); PG8_BAR; PG8_WAIT_L(0); PG8_MMA(0, 0, At, B0); PG8_BAR; PG8_SCHED;
            PG8_LDB(B1, 1, 1); PG8_STAGE(PG8_SB(1, 0), b3, voffB);
            PG8_BAR; PG8_WAIT_L(0); PG8_MMA(0, 1, At, B1); PG8_BAR;
            PG8_LDA(At, 1, 1); PG8_STAGE(PG8_SA(1, 0), a3, voffA);
            PG8_BAR; PG8_WAIT_L(0); PG8_MMA(1, 0, At, B0); PG8_BAR; PG8_SCHED;
            PG8_STAGE(PG8_SB(1, 1), b3 + hstep, voffB);
            PG8_WAIT_V(6); PG8_BAR; PG8_MMA(1, 1, At, B1); PG8_BAR;
            }
        }
        if constexpr (ALIGN_EPI) { if (wr == 0) PG8_BAR; }
        if constexpr (!Epi::AFTER_DRAIN) { E(acc, cur, wr, wc, fr, fq); S.done(cur); }
        if (!has_next) break;
#pragma unroll
        for (int a = 0; a < 2; ++a)
#pragma unroll
            for (int b = 0; b < 2; ++b)
#pragma unroll
                for (int m = 0; m < 4; ++m)
#pragma unroll
                    for (int n = 0; n < 2; ++n) acc[a][b][m][n] = (f32x4){0.f, 0.f, 0.f, 0.f};
        cur = nxt; cA = nA; cB = nB; ++ui;
        if constexpr (ALIGN_EPI) { if (wr == 1) PG8_BAR; }
    }
    PG8_WAIT_V(0);
    if constexpr (!ALIGN_EPI) { if (wr == 0) PG8_BAR; }
    PG8_BAR;
    if constexpr (Epi::AFTER_DRAIN) { E.fused(acc, cur, wr, wc, fr, fq, lds, wid, lane); S.done(cur); }
#undef PG8_SA
#undef PG8_SB
#undef PG8_STAGE
#undef PG8_LDA
#undef PG8_LDB
#undef PG8_MMA
#undef PG8_WAIT_V
#undef PG8_WAIT_L
#undef PG8_BAR
#undef PG8_SCHED
}
}

#define LAS __attribute__((address_space(3)))
constexpr int LDS_BYTES = 147456;
constexpr int LDS_MISC = 131072 + 8192;

DI void ph_mods(const Args& a, unsigned char* lds) {
    float (*sc)[1024] = (float (*)[1024])lds;
    float (*red)[5][128] = (float (*)[5][128])(lds + 20480);
    const float* c = a.in[1]; const float* cctx = a.in[3]; const float* mod_w = a.in[4]; const float* mod_b = a.in[5];
    float* mods = (float*)(a.ws + WS_MODS);
    const int tid = tidx(), lane = tid & 63, wid = tid >> 6;
    for (int i = tid; i < 5 * 1024; i += 512) { int s = i >> 10, k = i & 1023; float v = s < 4 ? c[s * 1024 + k] : cctx[k]; sc[s][k] = siluf_(v); }
    __syncthreads();
    for (int item = blockIdx.x; item < DEPTH * 48; item += gridDim.x) {
        const int l = item / 48, c0 = (item % 48) * 128;
        const int half = lane >> 5, cg = lane & 31;
        f32x4 acc[5];
#pragma unroll
        for (int s = 0; s < 5; ++s) acc[s] = (f32x4){0.f, 0.f, 0.f, 0.f};
        const float* wp = mod_w + (size_t)l * 1024 * 6144 + c0 + 4 * cg;
#pragma unroll 4
        for (int kk = 0; kk < 64; ++kk) {
            const int k = wid * 128 + 2 * kk + half;
            const f32x4 w = *(const f32x4*)(wp + (size_t)k * 6144);
#pragma unroll
            for (int s = 0; s < 5; ++s) acc[s] += w * sc[s][k];
        }
#pragma unroll
        for (int s = 0; s < 5; ++s) {
#pragma unroll
            for (int j = 0; j < 4; ++j) { float v = acc[s][j]; v += __shfl_xor(v, 32); acc[s][j] = v; }
            if (half == 0) {
#pragma unroll
                for (int j = 0; j < 4; ++j) red[wid][s][4 * cg + j] = acc[s][j];
            }
        }
        __syncthreads();
        for (int i = tid; i < 5 * 128; i += 512) {
            const int s = i >> 7, cc = i & 127; float v = 0.f;
#pragma unroll
            for (int w = 0; w < 8; ++w) v += red[w][s][cc];
            mods[((size_t)l * 5 + s) * 6144 + c0 + cc] = v + mod_b[l * 6144 + c0 + cc];
        }
        __syncthreads();
    }
    if (blockIdx.x == gridDim.x - 1) {
        float* rope = (float*)(a.ws + WS_ROPE);
        for (int i = tid; i < 64 * 16; i += 512) {
            const int pos = i >> 4, f = i & 15;
            const float inv = powf(10000.0f, -(float)f / 16.0f);
            const float ang = (float)pos * inv;
            rope[2 * i] = cosf(ang); rope[2 * i + 1] = sinf(ang);
        }
    }
}

DI void row_ln(f32x4 (&v)[4], const float* g, const float* b, int lane) {
    float s = 0.f;
#pragma unroll
    for (int j = 0; j < 4; ++j) s += (v[j][0] + v[j][1]) + (v[j][2] + v[j][3]);
    const float mean = wave_sum(s) * (1.f / 1024.f);
    float q = 0.f;
#pragma unroll
    for (int j = 0; j < 4; ++j) { v[j] = v[j] - mean; q += (v[j][0] * v[j][0] + v[j][1] * v[j][1]) + (v[j][2] * v[j][2] + v[j][3] * v[j][3]); }
    const float rstd = rsqrtf(wave_sum(q) * (1.f / 1024.f) + EPS);
#pragma unroll
    for (int j = 0; j < 4; ++j) {
        const f32x4 gg = *(const f32x4*)(g + 256 * j + 4 * lane), bb = *(const f32x4*)(b + 256 * j + 4 * lane);
        v[j] = v[j] * rstd * gg + bb;
    }
}
DI void row_ln_r(f32x4 (&v)[4], const f32x4 (&gg)[4], const f32x4 (&bb)[4]) {
    float s = 0.f;
#pragma unroll
    for (int j = 0; j < 4; ++j) s += (v[j][0] + v[j][1]) + (v[j][2] + v[j][3]);
    const float mean = wave_sum(s) * (1.f / 1024.f);
    float q = 0.f;
#pragma unroll
    for (int j = 0; j < 4; ++j) { v[j] = v[j] - mean; q += (v[j][0] * v[j][0] + v[j][1] * v[j][1]) + (v[j][2] * v[j][2] + v[j][3] * v[j][3]); }
    const float rstd = rsqrtf(wave_sum(q) * (1.f / 1024.f) + EPS);
#pragma unroll
    for (int j = 0; j < 4; ++j) v[j] = v[j] * rstd * gg[j] + bb[j];
}
DI void row_modulate(f32x4 (&h)[4], const f32x4 (&x)[4], const float* shift, const float* scale, int lane) {
#pragma unroll
    for (int j = 0; j < 4; ++j) {
        const f32x4 sh = *(const f32x4*)(shift + 256 * j + 4 * lane), scl = *(const f32x4*)(scale + 256 * j + 4 * lane);
        h[j] = x[j] * (1.f + scl) + sh;
    }
}
DI void row_store_bf16(bf16_t* dst, const f32x4 (&h)[4], int lane) {
#pragma unroll
    for (int j = 0; j < 4; ++j) { u32x2 w; w.x = pk2(h[j][0], h[j][1]); w.y = pk2(h[j][2], h[j][3]); *(u32x2*)(dst + 256 * j + 4 * lane) = w; }
}
DI float row_gemv16(const f32x4 (&h)[4], const float* WT, int lane) {
    float p[16];
#pragma unroll
    for (int jj = 0; jj < 16; ++jj) {
        float acc = 0.f;
#pragma unroll
        for (int j = 0; j < 4; ++j) { const f32x4 w = *(const f32x4*)(WT + jj * 1024 + 256 * j + 4 * lane); acc += (h[j][0] * w[0] + h[j][1] * w[1]) + (h[j][2] * w[2] + h[j][3] * w[3]); }
        asm volatile("" : "+v"(acc));
        p[jj] = acc;
    }
    return reduce16(p, lane);
}
DI void stage_wt16(float* WT, const float* W, int ld, int col0, int tid) {
    for (int c = tid; c < 1024; c += 512) {
        const float* p = W + (size_t)c * ld + col0;
#pragma unroll
        for (int q = 0; q < 4; ++q) { const f32x4 w = *(const f32x4*)(p + 4 * q);
#pragma unroll
            for (int i = 0; i < 4; ++i) WT[(4 * q + i) * 1024 + c] = w[i]; }
    }
}

DI void ph_prep0(const Args& a, unsigned char* lds) {
    float* WT = (float*)lds;
    const int tid = tidx(), lane = tid & 63, wid = tid >> 6;
    stage_wt16(WT, a.in[6], N_IN, 3584, tid);
    __syncthreads();
    const float* mods = (const float*)(a.ws + WS_MODS);
    float* X = (float*)(a.ws + WS_X); bf16_t* H = (bf16_t*)(a.ws + WS_H); float* AB = (float*)(a.ws + WS_AB);
    const int rstride = gridDim.x * 8;
    f32x4 xn[4];
    { const int row = blockIdx.x * 8 + wid; const float* src = row < NCTX ? a.in[2] + (size_t)row * 1024 : a.in[0] + (size_t)(row - NCTX) * 1024;
#pragma unroll
      for (int j = 0; j < 4; ++j) xn[j] = *(const f32x4*)(src + 256 * j + 4 * lane); }
#pragma unroll 1
    for (int row = blockIdx.x * 8 + wid; row < TT; row += rstride) {
        f32x4 x[4], h[4];
#pragma unroll
        for (int j = 0; j < 4; ++j) x[j] = xn[j];
        { const int rn = row + rstride; if (rn < TT) { const float* src = rn < NCTX ? a.in[2] + (size_t)rn * 1024 : a.in[0] + (size_t)(rn - NCTX) * 1024;
#pragma unroll
            for (int j = 0; j < 4; ++j) xn[j] = *(const f32x4*)(src + 256 * j + 4 * lane); } }
#pragma unroll
        for (int j = 0; j < 4; ++j) *(f32x4*)(X + (size_t)row * 1024 + 256 * j + 4 * lane) = x[j];
        const float* m = mods + (size_t)(0 * 5 + mod_set(row)) * 6144;
        row_modulate(h, x, m, m + 1024, lane);
        row_store_bf16(H + (size_t)row * 1024, h, lane);
        { const float abv = row_gemv16(h, WT, lane); if ((lane & 3) == 0) AB[(size_t)row * 16 + jj16_of_lane(lane)] = abv; }
    }
    __syncthreads();
}

DI void ph_yb(const Args& a, int l) {
    const int tid = tidx(), lane = tid & 63, wid = tid >> 6;
    const bf16_t* OF = (const bf16_t*)(a.ws + WS_OF); const bf16_t* OB = (const bf16_t*)(a.ws + WS_OB); const bf16_t* Z = (const bf16_t*)(a.ws + WS_Z);
    bf16_t* YB = (bf16_t*)(a.ws + WS_YAB) + (size_t)TT * 512;
    const float* ogp = a.in[15] + l * 128 + ((8 * lane) & 127);
    float og[8];
#pragma unroll
    for (int i = 0; i < 8; ++i) og[i] = ogp[i];
    const int rstride = gridDim.x * 8;
    int row0 = blockIdx.x * 8 + wid; if (l == DEPTH - 1) { while (row0 < NCTX) row0 += rstride; }
    u32x4 fn = (u32x4){0u, 0u, 0u, 0u}, bn = fn, zn = fn;
    if (row0 < TT) { const size_t o0 = (size_t)row0 * 512 + 8 * lane; fn = *(const u32x4*)(OF + o0); bn = *(const u32x4*)(OB + o0); zn = *(const u32x4*)(Z + o0); }
#pragma unroll 1
    for (int row = row0; row < TT; row += rstride) {
        const size_t off = (size_t)row * 512 + 8 * lane;
        const u32x4 f = fn, b = bn, z = zn;
        if (row + rstride < TT) { const size_t o1 = (size_t)(row + rstride) * 512 + 8 * lane; fn = *(const u32x4*)(OF + o1); bn = *(const u32x4*)(OB + o1); zn = *(const u32x4*)(Z + o1); }
        float o[8]; float ss = 0.f;
#pragma unroll
        for (int i = 0; i < 4; ++i) {
            o[2 * i] = __uint_as_float(f[i] << 16) + __uint_as_float(b[i] << 16);
            o[2 * i + 1] = __uint_as_float(f[i] & 0xffff0000u) + __uint_as_float(b[i] & 0xffff0000u);
            ss += o[2 * i] * o[2 * i] + o[2 * i + 1] * o[2 * i + 1];
        }
        ss += dppmov<0xB1>(ss); ss += dppmov<0x4E>(ss); ss += dppmov<0x124>(ss); ss += dppmov<0x128>(ss);
        const float r = rsqrtf(ss * (1.f / 128.f) + EPS);
        u32x4 w;
#pragma unroll
        for (int i = 0; i < 4; ++i) {
            const float z0 = __uint_as_float(z[i] << 16), z1 = __uint_as_float(z[i] & 0xffff0000u);
            const float y0 = o[2 * i] * r * og[2 * i] * siluf_(z0), y1 = o[2 * i + 1] * r * og[2 * i + 1] * siluf_(z1);
            w[i] = pk2(y0, y1);
        }
        *(u32x4*)(YB + off) = w;
    }
}

constexpr int LOCAL_ASSIGN = 9 * 8 * 2;
DI void ph_ln1_router(const Args& a, int l, unsigned char* lds, int rd = 0) {
    float* WT = (float*)lds;
    int* le = (int*)(lds + 65536);
    const int tid = tidx(), lane = tid & 63, wid = tid >> 6;
    stage_wt16(WT, a.in[21], 16, 0, tid);
    if (tid < LOCAL_ASSIGN) le[tid] = -1;
    __syncthreads();
    const float* mods = (const float*)(a.ws + WS_MODS);
    const float* X = (const float*)(a.ws + WS_X); float* XO = rd ? (float*)(a.ws + WS_GPRE) : (float*)(a.ws + WS_X); bf16_t* H = rd ? (bf16_t*)(a.ws + WS_GPRE + 72 * MiB) : (bf16_t*)(a.ws + WS_H);
    int* RE = rd ? (int*)(a.ws + WS_GPRE + 110 * MiB) : (int*)(a.ws + WS_ROUTE_E); float* RW = rd ? (float*)(a.ws + WS_GPRE + 111 * MiB) : (float*)(a.ws + WS_ROUTE_W);
    const float* g = a.in[19] + l * 1024; const float* bb = a.in[20] + l * 1024; const float* rb = a.in[22];
    const int kfirst = (l == DEPTH - 1 && (int)(blockIdx.x * 8 + wid) < NCTX) ? 1 : 0;
    f32x4 lg4[4], lb4[4];
#pragma unroll
    for (int j = 0; j < 4; ++j) { lg4[j] = *(const f32x4*)(g + 256 * j + 4 * lane); lb4[j] = *(const f32x4*)(bb + 256 * j + 4 * lane); }
    f32x4 xn[4];
    { const int row = blockIdx.x * 8 + wid + 2048 * kfirst;
#pragma unroll
      for (int j = 0; j < 4; ++j) xn[j] = *(const f32x4*)(X + (size_t)row * 1024 + 256 * j + 4 * lane); }
#pragma unroll 1
    for (int k = kfirst; k < 9; ++k) {
        const int row = blockIdx.x * 8 + wid + 2048 * k;
        if (row >= TT) break;
        f32x4 x[4], h[4], msh[4], msc[4];
#pragma unroll
        for (int j = 0; j < 4; ++j) x[j] = xn[j];
        const float* m = mods + (size_t)(l * 5 + mod_set(row)) * 6144;
#pragma unroll
        for (int j = 0; j < 4; ++j) { msh[j] = *(const f32x4*)(m + 3 * 1024 + 256 * j + 4 * lane); msc[j] = *(const f32x4*)(m + 4 * 1024 + 256 * j + 4 * lane); }
        if (row + 2048 < TT) {
#pragma unroll
            for (int j = 0; j < 4; ++j) xn[j] = *(const f32x4*)(X + (size_t)(row + 2048) * 1024 + 256 * j + 4 * lane);
        }
        row_ln_r(x, lg4, lb4);
#pragma unroll
        for (int j = 0; j < 4; ++j) h[j] = x[j] * (1.f + msc[j]) + msh[j];
        row_store_bf16(H + (size_t)row * 1024, h, lane);
        if (rd >= 2) continue;
        const float lgv = row_gemv16(h, WT, lane);
        float sc[16], sel[16];
#pragma unroll
        for (int e = 0; e < 16; ++e) { const float lg = __uint_as_float(__builtin_amdgcn_readlane(__float_as_uint(lgv), lane_of_jj16(e))); sc[e] = __builtin_amdgcn_rcpf(1.f + __builtin_amdgcn_exp2f(-1.4426950408889634f * lg)); sel[e] = sc[e] + rb[e]; }
        float best_gs = -1e30f; int best = 0;
#pragma unroll
        for (int gI = 0; gI < 4; ++gI) {
            const float v0 = sel[4 * gI], v1 = sel[4 * gI + 1], v2 = sel[4 * gI + 2], v3 = sel[4 * gI + 3];
            const float mx = fmaxf(fmaxf(v0, v1), fmaxf(v2, v3));
            float second;
            if (v0 == mx) second = fmaxf(v1, fmaxf(v2, v3));
            else if (v1 == mx) second = fmaxf(v0, fmaxf(v2, v3));
            else if (v2 == mx) second = fmaxf(fmaxf(v0, v1), v3);
            else second = fmaxf(fmaxf(v0, v1), v2);
            const float gs = mx + second;
            if (gs > best_gs) { best_gs = gs; best = gI; }
        }
        float i0 = 0.f, i1 = 0.f, i2 = 0.f, i3 = 0.f, s0 = 0.f, s1 = 0.f, s2 = 0.f, s3 = 0.f;
#pragma unroll
        for (int gI = 0; gI < 4; ++gI) if (gI == best) { i0 = sel[4 * gI]; i1 = sel[4 * gI + 1]; i2 = sel[4 * gI + 2]; i3 = sel[4 * gI + 3]; s0 = sc[4 * gI]; s1 = sc[4 * gI + 1]; s2 = sc[4 * gI + 2]; s3 = sc[4 * gI + 3]; }
        int a0 = 0; float m0 = i0, w0 = s0;
        if (i1 > m0) { a0 = 1; m0 = i1; w0 = s1; }
        if (i2 > m0) { a0 = 2; m0 = i2; w0 = s2; }
        if (i3 > m0) { a0 = 3; m0 = i3; w0 = s3; }
        int a1 = -1; float m1 = -1e30f, w1 = 0.f;
        if (a0 != 0 && i0 > m1) { a1 = 0; m1 = i0; w1 = s0; }
        if (a0 != 1 && i1 > m1) { a1 = 1; m1 = i1; w1 = s1; }
        if (a0 != 2 && i2 > m1) { a1 = 2; m1 = i2; w1 = s2; }
        if (a0 != 3 && i3 > m1) { a1 = 3; m1 = i3; w1 = s3; }
        if (lane == 0) {
            const float inv = 1.f / (w0 + w1);
            RE[2 * row] = best * 4 + a0; RE[2 * row + 1] = best * 4 + a1;
            RW[2 * row] = w0 * inv; RW[2 * row + 1] = w1 * inv;
            le[(k * 8 + wid) * 2] = best * 4 + a0; le[(k * 8 + wid) * 2 + 1] = best * 4 + a1;
        }
    }
    __syncthreads();
    if (tid < 16) {
        int cnt = 0;
        for (int i = 0; i < LOCAL_ASSIGN; ++i) cnt += (le[i] == tid) ? 1 : 0;
        ((int*)(a.ws + (rd ? WS_GPRE + 112 * MiB : WS_META)))[blockIdx.x * 16 + tid] = cnt;
    }
    __syncthreads();
}

constexpr int META_NT = 4096, META_TE = 4096 + 16;
DI void ph_slot(const Args& a, int l, unsigned char* lds) {
    int* bc = (int*)lds;
    int* tot = (int*)(lds + 16384);
    int* ls = (int*)(lds + 16384 + 1024);
    const int tid = tidx(), lane = tid & 63, wid = tid >> 6;
    const int* meta = (const int*)(a.ws + WS_META);
    int* metaw = (int*)(a.ws + WS_META);
    const int G = gridDim.x;
    for (int i = tid; i < G * 16; i += 512) bc[i] = meta[i];
    if (tid < LOCAL_ASSIGN) ls[tid] = -1;
    __syncthreads();
    {
        int* part = (int*)(lds + 16384 + 4096);
        const int e = tid & 15, pr = tid >> 4; int t = 0, before = 0;
#pragma unroll
        for (int q = 0; q < 8; ++q) { const int b = pr * 8 + q; if (b < G) { const int c = bc[b * 16 + e]; t += c; if (b < (int)blockIdx.x) before += c; } }
        part[pr * 16 + e] = t; part[512 + pr * 16 + e] = before;
        __syncthreads();
        if (tid < 16) { int tt = 0, bb = 0;
#pragma unroll
            for (int q = 0; q < 32; ++q) { tt += part[q * 16 + tid]; bb += part[512 + q * 16 + tid]; }
            tot[tid] = tt; tot[16 + tid] = bb; }
    }
    __syncthreads();
    if (tid == 0) {
        int ps = 0, nt = 0;
#pragma unroll 1
        for (int e = 0; e < 16; ++e) {
            tot[32 + e] = ps; tot[64 + e] = nt; const int tiles = (tot[e] + 255) >> 8;
            nt += tiles; ps += tiles * 256;
        }
        tot[48] = ps; tot[80] = nt;
    }
    __syncthreads();
    if (blockIdx.x == 0) {
        const int nt = tot[80];
        if (tid == 0) metaw[META_NT] = nt;
        if (tid < nt) { int e = 0;
#pragma unroll 1
            for (int q = 1; q < 16; ++q) e += (tot[64 + q] <= tid) ? 1 : 0;
            metaw[META_TE + tid] = e; }
    }
    const int* RE = (const int*)(a.ws + WS_ROUTE_E);
    int* DEST = (int*)(a.ws + WS_DEST); int* SLOTA = (int*)(a.ws + WS_SLOTA);
    int* le2 = (int*)(lds + 16384 + 2048);
    int my_row = -1, my_kk = 0;
    if (tid < LOCAL_ASSIGN) {
        const int row = blockIdx.x * 8 + ((tid >> 1) & 7) + 2048 * (tid >> 4); my_kk = tid & 1;
        int e = -1;
        if (row < TT && !(l == DEPTH - 1 && row < NCTX)) { e = RE[2 * row + my_kk]; my_row = row; }
        le2[tid] = e;
    }
    __syncthreads();
    if (tid < 16) {
        int pos = tot[32 + tid] + tot[16 + tid];
        for (int li = 0; li < LOCAL_ASSIGN; ++li) if (le2[li] == tid) { ls[li] = pos; ++pos; }
    }
    __syncthreads();
    if (tid < LOCAL_ASSIGN && my_row >= 0) { const int pos = ls[tid]; DEST[2 * my_row + my_kk] = pos; SLOTA[pos] = 2 * my_row + my_kk; }
    if (blockIdx.x < 16) {
        const int e = blockIdx.x; const int s0 = tot[32 + e] + tot[e], s1 = tot[32 + e] + (((tot[e] + 255) >> 8) << 8);
        for (int s = s0 + tid; s < s1; s += 512) SLOTA[s] = -1;
    }
    __syncthreads();
    const bf16_t* H = (const bf16_t*)(a.ws + WS_H); bf16_t* XS = (bf16_t*)(a.ws + WS_XS);
#pragma unroll 1
    for (int b0 = 0; b0 < 18; b0 += 6) {
        u32x4 r0[6], r1[6]; int sl[6];
#pragma unroll
        for (int q = 0; q < 6; ++q) {
            const int li = wid + 8 * (b0 + q); sl[q] = ls[li];
            const int row = blockIdx.x * 8 + ((li >> 1) & 7) + 2048 * (li >> 4);
            if (sl[q] >= 0) { const u32x4* sp = (const u32x4*)(H + (size_t)row * 1024); r0[q] = sp[lane]; r1[q] = sp[lane + 64]; }
        }
#pragma unroll
        for (int q = 0; q < 6; ++q) if (sl[q] >= 0) { u32x4* d = (u32x4*)(XS + (size_t)sl[q] * 1024); d[lane] = r0[q]; d[lane + 64] = r1[q]; }
    }
    __syncthreads();
}

DI void ph_combine_ln2(const Args& a, int l, unsigned char* lds, int rd = 0) {
    float* WT = (float*)lds;
    const bool last = (l == DEPTH - 1);
    const int tid = tidx(), lane = tid & 63, wid = tid >> 6;
    if (!last) { stage_wt16(WT, a.in[6] + (size_t)(l + 1) * 1024 * N_IN, N_IN, 3584, tid); }
    __syncthreads();
    const float* mods = (const float*)(a.ws + WS_MODS);
    const float* X = (const float*)(a.ws + WS_X); float* XO = rd ? (float*)(a.ws + WS_GPRE) : (float*)(a.ws + WS_X); bf16_t* H = rd ? (bf16_t*)(a.ws + WS_GPRE + 72 * MiB) : (bf16_t*)(a.ws + WS_H); float* AB = rd ? (float*)(a.ws + WS_GPRE + 110 * MiB) : (float*)(a.ws + WS_AB);
    float* OUT = rd ? (float*)(a.ws + WS_GPRE) : a.out;
    const bf16_t* YS = (const bf16_t*)(a.ws + WS_YS); const float* RW = (const float*)(a.ws + WS_ROUTE_W);
    const float* g = a.in[26] + l * 1024; const float* bb = a.in[27] + l * 1024;
    const int rstride = gridDim.x * 8;
    int row0 = blockIdx.x * 8 + wid; if (last) { while (row0 < NCTX) row0 += rstride; }
    f32x4 xn[4]; u32x2 yn0[4], yn1[4]; float wn0 = 0.f, wn1 = 0.f;
    if (row0 < TT) {
        wn0 = RW[2 * row0]; wn1 = RW[2 * row0 + 1];
#pragma unroll
        for (int j = 0; j < 4; ++j) { const int c = 256 * j + 4 * lane; xn[j] = *(const f32x4*)(X + (size_t)row0 * 1024 + c);
            yn0[j] = *(const u32x2*)(YS + (size_t)(2 * row0) * 1024 + c); yn1[j] = *(const u32x2*)(YS + (size_t)(2 * row0 + 1) * 1024 + c); }
    }
    f32x4 lg4[4], lb4[4], l1g[4], l1b[4];
#pragma unroll
    for (int j = 0; j < 4; ++j) { lg4[j] = *(const f32x4*)(g + 256 * j + 4 * lane); lb4[j] = *(const f32x4*)(bb + 256 * j + 4 * lane);
        l1g[j] = *(const f32x4*)(a.in[19] + l * 1024 + 256 * j + 4 * lane); l1b[j] = *(const f32x4*)(a.in[20] + l * 1024 + 256 * j + 4 * lane); }
#pragma unroll 1
    for (int row = row0; row < TT; row += rstride) {
        const float w0 = wn0, w1 = wn1;
        const float* m = mods + (size_t)(l * 5 + mod_set(row)) * 6144;
        const float* mn = mods + (size_t)((last ? l : l + 1) * 5 + mod_set(row)) * 6144;
        f32x4 x[4], h[4], gt[4], msh[4], msc[4]; u32x2 ya[4], yb[4];
#pragma unroll
        for (int j = 0; j < 4; ++j) { x[j] = xn[j]; ya[j] = yn0[j]; yb[j] = yn1[j]; }
#pragma unroll
        for (int j = 0; j < 4; ++j) { const int c = 256 * j + 4 * lane; gt[j] = *(const f32x4*)(m + 5 * 1024 + c); msh[j] = *(const f32x4*)(mn + c); msc[j] = *(const f32x4*)(mn + 1024 + c); }
        { const int rn = row + rstride;
          if (rn < TT) {
            wn0 = RW[2 * rn]; wn1 = RW[2 * rn + 1];
#pragma unroll
            for (int j = 0; j < 4; ++j) { const int c = 256 * j + 4 * lane; xn[j] = *(const f32x4*)(X + (size_t)rn * 1024 + c);
                yn0[j] = *(const u32x2*)(YS + (size_t)(2 * rn) * 1024 + c); yn1[j] = *(const u32x2*)(YS + (size_t)(2 * rn + 1) * 1024 + c); }
          } }
        row_ln_r(x, l1g, l1b);
#pragma unroll
        for (int j = 0; j < 4; ++j) {
            const u32x2 y0 = ya[j], y1 = yb[j];
            f32x4 y;
            y[0] = w0 * __uint_as_float(y0.x << 16) + w1 * __uint_as_float(y1.x << 16);
            y[1] = w0 * __uint_as_float(y0.x & 0xffff0000u) + w1 * __uint_as_float(y1.x & 0xffff0000u);
            y[2] = w0 * __uint_as_float(y0.y << 16) + w1 * __uint_as_float(y1.y << 16);
            y[3] = w0 * __uint_as_float(y0.y & 0xffff0000u) + w1 * __uint_as_float(y1.y & 0xffff0000u);
            x[j] = ALPHA * x[j] + gt[j] * y;
        }
        row_ln_r(x, lg4, lb4);
        if (last) {
#pragma unroll
            for (int j = 0; j < 4; ++j) *(f32x4*)(OUT + (size_t)(row - NCTX) * 1024 + 256 * j + 4 * lane) = x[j];
        } else {
#pragma unroll
            for (int j = 0; j < 4; ++j) *(f32x4*)(XO + (size_t)row * 1024 + 256 * j + 4 * lane) = x[j];
#pragma unroll
            for (int j = 0; j < 4; ++j) h[j] = x[j] * (1.f + msc[j]) + msh[j];
            row_store_bf16(H + (size_t)row * 1024, h, lane);
            { const float abv = row_gemv16(h, WT, lane); if ((lane & 3) == 0) AB[(size_t)row * 16 + jj16_of_lane(lane)] = abv; }
        }
    }
    __syncthreads();
}

DI void transpose_item(const float* W, int ldw, int K, int ncols, bf16_t* WT, int item, float* scr, int lane) {
    const int nblk = ncols >> 5, kb = item / nblk, nb = item - kb * nblk, k0 = 64 * kb, n0 = 32 * nb;
#pragma unroll 8
    for (int i = 0; i < 32; ++i) { const int kk = 2 * i + (lane >> 5); scr[kk * 33 + (lane & 31)] = W[(size_t)(k0 + kk) * ldw + n0 + (lane & 31)]; }
    asm volatile("s_waitcnt lgkmcnt(0)" ::: "memory");
    const int c = lane & 7;
#pragma unroll
    for (int j = 0; j < 4; ++j) { const int n = (lane >> 3) + 8 * j; const float* s = scr + (8 * c) * 33 + n;
        u32x4 o; o.x = pk2(s[0 * 33], s[1 * 33]); o.y = pk2(s[2 * 33], s[3 * 33]); o.z = pk2(s[4 * 33], s[5 * 33]); o.w = pk2(s[6 * 33], s[7 * 33]);
        *(u32x4*)(WT + (size_t)(n0 + n) * K + k0 + 8 * c) = o; }
    asm volatile("s_waitcnt lgkmcnt(0)" ::: "memory");
}
constexpr int CV_A = 2816, CV_B = 13312;
DI void convert_A(const Args& a, int l, int item, float* scr, int lane) {
    const float* w = a.in[6] + (size_t)l * 1024 * N_IN; bf16_t* wt = (bf16_t*)(a.ws + WS_WIN);
    if (item < 1792) transpose_item(w, N_IN, 1024, 3584, wt, item, scr, lane);
    else transpose_item(w + 3600, N_IN, 1024, 2048, wt + (size_t)3584 * 1024, item - 1792, scr, lane);
}
DI void convert_B(const Args& a, int l, int item, float* scr, int lane) {
    if (item < 256) { transpose_item(a.in[16] + (size_t)l * 512 * 1024, 1024, 512, 1024, (bf16_t*)(a.ws + WS_WPAB), item, scr, lane); return; }
    item -= 256;
    if (item < 256) { transpose_item(a.in[17] + (size_t)l * 512 * 1024, 1024, 512, 1024, (bf16_t*)(a.ws + WS_WPAB) + (size_t)1024 * 512, item, scr, lane); return; }
    item -= 256;
    if (item < 512) { transpose_item(a.in[18] + (size_t)l * 1024 * 1024, 1024, 1024, 1024, (bf16_t*)(a.ws + WS_WO), item, scr, lane); return; }
    item -= 512;
    if (item < 8192) {
        const int job = item >> 6, it = item & 63; const int e = job >> 3, t = (job >> 1) & 3, which = job & 1;
        const float* w = (which ? a.in[24] : a.in[23]) + ((size_t)l * 16 + e) * 1024 * 512 + 128 * t;
        transpose_item(w, 512, 1024, 128, (bf16_t*)(a.ws + WS_W13) + ((size_t)e * 1024 + 256 * t + 128 * which) * 1024, it, scr, lane); return;
    }
    item -= 8192;
    { const int e = item >> 8, it = item & 255;
      transpose_item(a.in[25] + ((size_t)l * 16 + e) * 512 * 1024, 1024, 512, 1024, (bf16_t*)(a.ws + WS_W2) + (size_t)e * 1024 * 512, it, scr, lane); }
}
DI void convert_run(const Args& a, int lA, int lB, int rank, int nw, float* scr, int lane) {
    const int nA = (lA >= 0 && lA < DEPTH) ? CV_A : 0, nB = (lB >= 0 && lB < DEPTH) ? CV_B : 0;
#pragma unroll 1
    for (int it = rank; it < nA + nB; it += nw) { if (it < nA) convert_A(a, lA, it, scr, lane); else convert_B(a, lB, it - nA, scr, lane); }
}

#define XB_TMO      128
#define XB_XCNT(j)  (256  + 64 * (j))
#define XB_XSUB(j)  (1280 + 64 * (j))
#define XB_XGEN(j)  (2304 + 64 * (j))
#define XB_TOP      3328
#define XB_TOPGEN   3392
#define XCD_BAR_WORDS 3456
#define XB_SPIN_CAP (1u << 18)

__device__ __forceinline__ unsigned xb_ld(unsigned* p)              { return __hip_atomic_load(p, __ATOMIC_RELAXED, __HIP_MEMORY_SCOPE_AGENT); }
__device__ __forceinline__ unsigned xb_add(unsigned* p, unsigned v) { return __hip_atomic_fetch_add(p, v, __ATOMIC_RELAXED, __HIP_MEMORY_SCOPE_AGENT); }
__device__ __forceinline__ unsigned xb_xcc_id() { return (unsigned)__builtin_amdgcn_s_getreg((3 << 11) | 20) & 0xFu; }
#define XB_SPIN(cond, bar) do { unsigned _sp = 0; while (cond) { __builtin_amdgcn_s_sleep(1); \
    if ((++_sp & 255u) == 0u) { if (xb_ld(&(bar)[XB_TMO])) break; if (_sp > XB_SPIN_CAP) { atomicAdd(&(bar)[XB_TMO], 1u); break; } } } } while (0)

struct XcdBarrier {
    unsigned* bar; unsigned x;
    volatile LAS unsigned* st;
};

__device__ __forceinline__ XcdBarrier xcd_barrier_post(unsigned* bar, volatile LAS unsigned* st) {
    XcdBarrier b; b.bar = bar; b.x = xb_xcc_id(); b.st = st;
    if (tidx() == 0) (void)xb_add(&bar[XB_XCNT(b.x)], 1u);
    return b;
}
__device__ __forceinline__ void xcd_barrier_complete(unsigned* bar, unsigned x, unsigned& nloc, unsigned& nx) {
    const unsigned G = gridDim.x * gridDim.y * gridDim.z;
    unsigned sum, cnt, mine, sp = 0u;
    for (;;) {
        sum = 0u; cnt = 0u; mine = 0u;
#pragma unroll
        for (unsigned j = 0; j < 16; ++j) { const unsigned c = xb_ld(&bar[XB_XCNT(j)]); sum += c; cnt += (c > 0u) ? 1u : 0u; mine = (j == x) ? c : mine; }
        if (sum == G) break;
        __builtin_amdgcn_s_sleep(1);
        if ((++sp & 255u) == 0u) { if (xb_ld(&bar[XB_TMO])) break; if (sp > XB_SPIN_CAP) { atomicAdd(&bar[XB_TMO], 1u); break; } }
    }
    nloc = mine > 0u ? mine : 1u; nx = cnt > 0u ? cnt : 1u;
}

__device__ __forceinline__ void xcd_barrier(const XcdBarrier& b) {
    asm volatile("s_waitcnt vmcnt(0)" ::: "memory");
    __syncthreads();
    if (tidx() == 0) {
        unsigned* bar = b.bar;
        __builtin_amdgcn_s_waitcnt(0);
        unsigned nloc = b.st[0], nx = b.st[1];
        if (nloc == 0u) { xcd_barrier_complete(bar, b.x, nloc, nx); b.st[0] = nloc; b.st[1] = nx; }
        const unsigned old = xb_add(&bar[XB_XSUB(b.x)], 1u);
        const unsigned gen = old / nloc;
        if (old + 1u == (gen + 1u) * nloc) {
            __builtin_amdgcn_fence(__ATOMIC_RELEASE, "agent");
            asm volatile("s_waitcnt vmcnt(0)" ::: "memory");
            const unsigned og = xb_add(&bar[XB_TOP], 1u);
            const unsigned tg = og / nx;
            if (og + 1u == (tg + 1u) * nx) xb_add(&bar[XB_TOPGEN], 1u);
            else XB_SPIN(xb_ld(&bar[XB_TOPGEN]) == tg, bar);
            __builtin_amdgcn_fence(__ATOMIC_ACQUIRE, "agent");
            xb_add(&bar[XB_XGEN(b.x)], 1u);
            asm volatile("s_waitcnt vmcnt(0)" ::: "memory");
        } else {
            XB_SPIN(xb_ld(&bar[XB_XGEN(b.x)]) == gen, bar);
            __builtin_amdgcn_fence(__ATOMIC_ACQUIRE, "agent");
            asm volatile("s_waitcnt vmcnt(0)" ::: "memory");
        }
    }
    __syncthreads();
}

constexpr int CW_PANEL = 16384;
DI unsigned* panel_word(unsigned char* ws, int l, int kind, int p) { return (unsigned*)(ws + WS_CTL) + CW_PANEL + ((l * 2 + kind) * 160 + p) * 64; }
DI void store16_wt(void* p, u32x4 v) { asm volatile("global_store_dwordx4 %0, %1, off sc1\n\ts_nop 1" :: "v"(p), "v"(v) : "memory"); }
DI void panel_publish(unsigned* w) {
    asm volatile("s_waitcnt vmcnt(0)" ::: "memory");
    if ((tidx() & 63) == 0) __hip_atomic_fetch_add(w, 1u, __ATOMIC_RELAXED, __HIP_MEMORY_SCOPE_AGENT);
}
DI void panel_wait(unsigned* w, unsigned need) {
    if (tidx() < 64) {
        unsigned spins = 0;
        while ((unsigned)__builtin_amdgcn_readfirstlane(__hip_atomic_load(w, __ATOMIC_RELAXED, __HIP_MEMORY_SCOPE_AGENT)) < need) { __builtin_amdgcn_s_sleep(2); if (++spins > (1u << 22)) break; }
        __builtin_amdgcn_fence(__ATOMIC_ACQUIRE, "agent");
        asm volatile("s_waitcnt vmcnt(0)" ::: "memory");
    }
    asm volatile("" ::: "memory"); __builtin_amdgcn_s_barrier(); asm volatile("" ::: "memory");
}
DI int unit_set(int pm) { return pm < 4 ? 4 : ((pm - 4) >> 4); }
struct EpiInproj {
    static constexpr bool PERM = true, AFTER_DRAIN = false;
    unsigned char* ws;
    DI void operator()(const f32x4 (&acc)[2][2][4][2], const pg8::Unit& u, int wr, int wc, int fr, int fq) const {
        const int pn = u.pn; bf16_t* dst; int ld, colt, mode;
        if (pn < 2) { dst = (bf16_t*)(ws + WS_QA); ld = 512; colt = pn * 256; mode = 1; }
        else if (pn < 4) { dst = (bf16_t*)(ws + WS_KA); ld = 512; colt = (pn - 2) * 256; mode = 2; }
        else if (pn < 6) { dst = (bf16_t*)(ws + WS_VA); ld = 512; colt = (pn - 4) * 256; mode = 0; }
        else if (pn < 12) { dst = (bf16_t*)(ws + WS_QKV); ld = 1536; colt = (pn - 6) * 256; mode = 0; }
        else if (pn < 14) { dst = (bf16_t*)(ws + WS_Z); ld = 512; colt = (pn - 12) * 256; mode = 0; }
        else { dst = (bf16_t*)(ws + WS_SG); ld = 2048; colt = (pn - 14) * 256; mode = 3; }
        const bool rope = (mode == 1 || mode == 2) && u.pm >= 4;
        const float qs = (mode == 1) ? QSCALE : 1.f;
        const float* rtab = (const float*)(ws + WS_ROPE);
        const int row0 = u.pm * 256 + wr * 64 + fr;
        const float sgn = (fq >> 1) ? 1.f : -1.f;
        f32x4 csn[2][2];
        if (rope) {
            const int t = (row0 - NCTX) & 4095; const int pos = (wc & 1) ? (t & 63) : (t >> 6);
            const float* rp = rtab + (pos * 16 + 8 * (fq & 1)) * 2;
#pragma unroll
            for (int n = 0; n < 2; ++n) { csn[n][0] = *(const f32x4*)(rp + 8 * n); csn[n][1] = *(const f32x4*)(rp + 8 * n + 4); }
        }
#pragma unroll
        for (int s = 0; s < 8; ++s) {
            const int ai = s >> 2, m = s & 3;
            const int row = row0 + ai * 128 + m * 16;
            f32x4 cs[2][2];
            if (rope) {
#pragma unroll
                for (int n = 0; n < 2; ++n) { cs[n][0] = csn[n][0]; cs[n][1] = csn[n][1]; }
                if (s < 7) {
                    const int r1 = row0 + ((s + 1) >> 2) * 128 + ((s + 1) & 3) * 16;
                    const int t = (r1 - NCTX) & 4095; const int pos = (wc & 1) ? (t & 63) : (t >> 6);
                    const float* rp = rtab + (pos * 16 + 8 * (fq & 1)) * 2;
#pragma unroll
                    for (int n = 0; n < 2; ++n) { csn[n][0] = *(const f32x4*)(rp + 8 * n); csn[n][1] = *(const f32x4*)(rp + 8 * n + 4); }
                }
            }
#pragma unroll
            for (int bj = 0; bj < 2; ++bj) {
                f32x4 v[2] = {acc[ai][bj][m][0], acc[ai][bj][m][1]};
                if (rope) {
#pragma unroll
                    for (int n = 0; n < 2; ++n)
#pragma unroll
                        for (int j = 0; j < 4; ++j) {
                            const float x = v[n][j], xp = xor32(x, fq >> 1);
                            const float c = cs[n][j >> 1][(j & 1) * 2], sv = cs[n][j >> 1][(j & 1) * 2 + 1];
                            v[n][j] = x * c + sgn * xp * sv;
                        }
                }
                if (mode == 3) {
#pragma unroll
                    for (int n = 0; n < 2; ++n)
#pragma unroll
                        for (int j = 0; j < 4; ++j) v[n][j] = sigmoidf_(v[n][j]);
                }
                u32x4 w; w.x = pk2(v[0][0] * qs, v[0][1] * qs); w.y = pk2(v[0][2] * qs, v[0][3] * qs); w.z = pk2(v[1][0] * qs, v[1][1] * qs); w.w = pk2(v[1][2] * qs, v[1][3] * qs);
                *(u32x4*)(dst + (size_t)row * ld + colt + bj * 128 + wc * 32 + 8 * fq) = w;
            }
        }
    }
};
struct EpiMerge1 {
    static constexpr bool PERM = true, AFTER_DRAIN = false;
    unsigned char* ws;
    DI void operator()(const f32x4 (&acc)[2][2][4][2], const pg8::Unit& u, int wr, int wc, int fr, int fq) const {
        const int which = u.pm >= 68 ? 1 : 0; const int pm = u.pm - 68 * which, pn = u.pn - 4 * which;
        const bf16_t* SG = (const bf16_t*)(ws + WS_SG); bf16_t* M = (bf16_t*)(ws + WS_M); bf16_t* MP = (bf16_t*)(ws + WS_GPRE);
        const int row0 = pm * 256 + wr * 64 + fr, colb = pn * 256 + wc * 32 + 8 * fq;
        u32x4 gn[2], on[2], gc[2], oc[2];
#pragma unroll
        for (int bj = 0; bj < 2; ++bj) { gn[bj] = *(const u32x4*)(SG + (size_t)row0 * 2048 + which * 1024 + colb + bj * 128); on[bj] = (u32x4){0u, 0u, 0u, 0u};
            if (which) on[bj] = *(const u32x4*)(MP + (size_t)row0 * 1024 + colb + bj * 128); }
#pragma unroll
        for (int s = 0; s < 8; ++s) {
            const int ai = s >> 2, m = s & 3, row = row0 + ai * 128 + m * 16;
#pragma unroll
            for (int bj = 0; bj < 2; ++bj) { gc[bj] = gn[bj]; oc[bj] = on[bj]; }
            if (s < 7) { const int r1 = row0 + ((s + 1) >> 2) * 128 + ((s + 1) & 3) * 16;
#pragma unroll
                for (int bj = 0; bj < 2; ++bj) { gn[bj] = *(const u32x4*)(SG + (size_t)r1 * 2048 + which * 1024 + colb + bj * 128);
                    if (which) on[bj] = *(const u32x4*)(MP + (size_t)r1 * 1024 + colb + bj * 128); } }
#pragma unroll
            for (int bj = 0; bj < 2; ++bj) {
                float v[8];
#pragma unroll
                for (int i = 0; i < 4; ++i) {
                    v[2 * i] = __uint_as_float(gc[bj][i] << 16) * acc[ai][bj][m][i >> 1][(i & 1) * 2] + __uint_as_float(oc[bj][i] << 16);
                    v[2 * i + 1] = __uint_as_float(gc[bj][i] & 0xffff0000u) * acc[ai][bj][m][i >> 1][(i & 1) * 2 + 1] + __uint_as_float(oc[bj][i] & 0xffff0000u);
                }
                u32x4 w; w.x = pk2(v[0], v[1]); w.y = pk2(v[2], v[3]); w.z = pk2(v[4], v[5]); w.w = pk2(v[6], v[7]);
                if (which) store16_wt(M + (size_t)row * 1024 + colb + bj * 128, w); else *(u32x4*)(MP + (size_t)row * 1024 + colb + bj * 128) = w;
            }
        }
    }
};
struct SchedMerge1 {
    int G, c, pm0; unsigned char* ws; int l;
    DI bool next(int i, pg8::Unit& u) const {
        const int tl = (i >> 1) * G + c; if (tl >= (68 - pm0) * 4) return false;
        const int which = i & 1; u.pm = pm0 + (tl >> 2) + 68 * which; u.pn = (tl & 3) + 4 * which; return true;
    }
    DI void a_ready(const pg8::Unit&) const {}
    DI void done(const pg8::Unit& u) const { if (u.pm >= 68) panel_publish(panel_word(ws, l, 0, u.pm - 68)); }
};
struct SchedWoWait {
    int G, c, pm0; unsigned char* ws; int l;
    DI bool next(int i, pg8::Unit& u) const {
        int tl;
        if (i == 0) tl = c; else if (i == 1 && c >= 16 && c < 32) tl = G + (c - 16); else return false;
        if (tl >= (68 - pm0) * 4) return false;
        u.pm = pm0 + (tl >> 2); u.pn = tl & 3; return true;
    }
    DI void a_ready(const pg8::Unit& u) const { panel_wait(panel_word(ws, l, 0, u.pm), 32u); }
    DI void done(const pg8::Unit&) const {}
};
struct SchedRows {
    int G, c, pm0, nN;
    DI bool next(int i, pg8::Unit& u) const { const int tl = i * G + c; if (tl >= (68 - pm0) * nN) return false; u.pm = pm0 + tl / nN; u.pn = tl % nN; return true; }
    DI void a_ready(const pg8::Unit&) const {}
    DI void done(const pg8::Unit&) const {}
};
struct EpiWo {
    static constexpr bool PERM = false, AFTER_DRAIN = false;
    unsigned char* ws; int l; int rd;
    DI void operator()(const f32x4 (&acc)[2][2][4][2], const pg8::Unit& u, int wr, int wc, int fr, int fq) const {
        const float* X = (const float*)(ws + WS_X); float* XO = rd ? (float*)(ws + WS_GPRE) : (float*)(ws + WS_X);
        const float* mg = (const float*)(ws + WS_MODS) + (size_t)(l * 5 + unit_set(u.pm)) * 6144 + 2 * 1024;
        const int row0 = u.pm * 256 + wr * 64 + fr, col0 = u.pn * 256 + wc * 32 + 4 * fq;
        f32x4 gv[2][2];
#pragma unroll
        for (int bj = 0; bj < 2; ++bj)
#pragma unroll
            for (int n = 0; n < 2; ++n) gv[bj][n] = *(const f32x4*)(mg + col0 + bj * 128 + n * 16);
        f32x4 xc[2][2], xn[2][2];
        { const float* rowp = X + (size_t)row0 * 1024 + col0;
#pragma unroll
          for (int bj = 0; bj < 2; ++bj)
#pragma unroll
              for (int n = 0; n < 2; ++n) xn[bj][n] = *(const f32x4*)(rowp + bj * 128 + n * 16); }
#pragma unroll
        for (int s = 0; s < 8; ++s) {
            const int ai = s >> 2, m = s & 3;
#pragma unroll
            for (int bj = 0; bj < 2; ++bj)
#pragma unroll
                for (int n = 0; n < 2; ++n) xc[bj][n] = xn[bj][n];
            if (s < 7) { const int ai1 = (s + 1) >> 2, m1 = (s + 1) & 3; const float* rp = X + (size_t)(row0 + ai1 * 128 + m1 * 16) * 1024 + col0;
#pragma unroll
                for (int bj = 0; bj < 2; ++bj)
#pragma unroll
                    for (int n = 0; n < 2; ++n) xn[bj][n] = *(const f32x4*)(rp + bj * 128 + n * 16); }
            float* rowp = XO + (size_t)(row0 + ai * 128 + m * 16) * 1024 + col0;
#pragma unroll
            for (int bj = 0; bj < 2; ++bj)
#pragma unroll
                for (int n = 0; n < 2; ++n) *(f32x4*)(rowp + bj * 128 + n * 16) = ALPHA * xc[bj][n] + gv[bj][n] * acc[ai][bj][m][n];
        }
    }
};
struct SchedMoe {
    int G, c, ntiles; const int* tile_e; unsigned char* ws; int l, mode;
    DI bool next(int i, pg8::Unit& u) const {
        int x;
        if (mode != 2 || G != 256) x = i * G + c;
        else {
            if (c < 64) { if (i > 0) return false; x = c; }
            else if (c < 192) { if (i > 2) return false; x = c + 128 * i; }
            else x = 448 + (c - 192) + 64 * i;
        }
        if (x >= ntiles * 4) return false;
        u.pm = x >> 2; u.pn = tile_e[x >> 2] * 4 + (x & 3); return true;
    }
    DI void a_ready(const pg8::Unit& u) const { if (mode == 2) panel_wait(panel_word(ws, l, 1, u.pm), 32u); }
    DI void done(const pg8::Unit& u) const { if (mode == 1) panel_publish(panel_word(ws, l, 1, u.pm)); }
};
struct EpiUp {
    static constexpr bool PERM = true, AFTER_DRAIN = false;
    unsigned char* ws;
    DI void operator()(const f32x4 (&acc)[2][2][4][2], const pg8::Unit& u, int wr, int wc, int fr, int fq) const {
        bf16_t* ACT = (bf16_t*)(ws + WS_ACT);
        const int j = u.pn & 3; const int row0 = u.pm * 256 + wr * 64 + fr; const int col = j * 128 + wc * 32 + 8 * fq;
#pragma unroll
        for (int ai = 0; ai < 2; ++ai)
#pragma unroll
            for (int m = 0; m < 4; ++m) {
                float v[8];
#pragma unroll
                for (int n = 0; n < 2; ++n)
#pragma unroll
                    for (int i = 0; i < 4; ++i) v[4 * n + i] = siluf_(acc[ai][0][m][n][i]) * acc[ai][1][m][n][i];
                u32x4 w; w.x = pk2(v[0], v[1]); w.y = pk2(v[2], v[3]); w.z = pk2(v[4], v[5]); w.w = pk2(v[6], v[7]);
                store16_wt(ACT + (size_t)(row0 + ai * 128 + m * 16) * 512 + col, w);
            }
    }
};
struct EpiDown {
    static constexpr bool PERM = true, AFTER_DRAIN = false;
    unsigned char* ws;
    DI void operator()(const f32x4 (&acc)[2][2][4][2], const pg8::Unit& u, int wr, int wc, int fr, int fq) const {
        bf16_t* YS = (bf16_t*)(ws + WS_YS); const int* SLOTA = (const int*)(ws + WS_SLOTA);
        const int j = u.pn & 3; const int row0 = u.pm * 256 + wr * 64 + fr;
        int asv[2][4];
#pragma unroll
        for (int ai = 0; ai < 2; ++ai)
#pragma unroll
            for (int m = 0; m < 4; ++m) asv[ai][m] = SLOTA[row0 + ai * 128 + m * 16];
#pragma unroll
        for (int ai = 0; ai < 2; ++ai)
#pragma unroll
            for (int m = 0; m < 4; ++m) {
                const int as = asv[ai][m];
                if (as >= 0) {
#pragma unroll
                    for (int bj = 0; bj < 2; ++bj) {
                        const f32x4 v0 = acc[ai][bj][m][0], v1 = acc[ai][bj][m][1];
                        u32x4 w; w.x = pk2(v0[0], v0[1]); w.y = pk2(v0[2], v0[3]); w.z = pk2(v1[0], v1[1]); w.w = pk2(v1[2], v1[3]);
                        *(u32x4*)(YS + (size_t)as * 1024 + j * 256 + bj * 128 + wc * 32 + 8 * fq) = w;
                    }
                }
            }
    }
};

typedef short s16x4 __attribute__((ext_vector_type(4)));
#define MFMA32(a, b, c) __builtin_amdgcn_mfma_f32_32x32x16_bf16((a), (b), (c), 0, 0, 0)
DI int crow(int i, int hl) { return (i & 3) + 8 * (i >> 2) + 4 * hl; }
DI bf16x8 pack8(const f32x16& x, int s) {
    u32x4 p; p.x = pk2(x[8 * s], x[8 * s + 1]); p.y = pk2(x[8 * s + 2], x[8 * s + 3]); p.z = pk2(x[8 * s + 4], x[8 * s + 5]); p.w = pk2(x[8 * s + 6], x[8 * s + 7]);
    return __builtin_bit_cast(bf16x8, p);
}
DI s16x4 tr_read(const LAS unsigned char* p) { return __builtin_bit_cast(s16x4, __builtin_amdgcn_ds_read_tr16_b64_v4i16((LAS s16x4*)p)); }
constexpr int AT_KB = 9216, AT_VB = 16384, AT_K0 = 0, AT_V0 = 2 * AT_KB, AT_ST = 65536;

struct AttnIt { const bf16_t* kp; const bf16_t* vp; int kc0, kl0, nT; unsigned kdst, vdst0, kread, vread; };
template <int FAKE> DI void attn_iter(int t, const AttnIt& g, LAS unsigned char* lds, unsigned kA, unsigned kB, unsigned vA, unsigned vB, u32x4& rk, u32x4& rv0, u32x4& rv1,
                  f32x16 (&st)[2], f32x16 (&sn)[2], f32x16 (&o)[4], float& mrun, float& lrun, const bf16x8 (&qf)[4]) {
    const int kc0 = g.kc0, kl0 = g.kl0, nT = g.nT;
#define KROW(t_) ((t_) < 4 ? kc0 + 64 * (t_) : kl0 + 64 * ((t_) - 4))
    *(LAS u32x4*)(lds + kB + g.kdst) = rk; *(LAS u32x4*)(lds + vB + g.vdst0) = rv0; *(LAS u32x4*)(lds + vB + g.vdst0 + 2048) = rv1;
    { const int tk = (t + 3 < nT) ? t + 3 : nT - 1, tv = (t + 2 < nT) ? t + 2 : nT - 1;
      const int krk = KROW(tk), krv = KROW(tv);
      if (FAKE != 4) { rk = *(const u32x4*)(g.kp + (size_t)krk * 512); rv0 = *(const u32x4*)(g.vp + (size_t)krv * 512); rv1 = *(const u32x4*)(g.vp + (size_t)(krv + 32) * 512); } }
#undef KROW
    const LAS unsigned char* kb = lds + kA + g.kread;
    const LAS unsigned char* vb = lds + vA + g.vread;
    bf16x8 kf[4];
#pragma unroll
    for (int x = 0; x < 4; ++x) kf[x] = *(const LAS bf16x8*)(kb + (x & 1) * 32 * 144 + (x >> 1) * 32);
    s16x4 lo[2][2], hi[2][2];
#pragma unroll
    for (int k2 = 0; k2 < 2; ++k2) { lo[0][k2] = tr_read(vb + k2 * 4096); hi[0][k2] = tr_read(vb + k2 * 4096 + 512); }
    float mx = fmaxf(fmaxf(st[0][0], st[0][1]), st[0][2]);
#pragma unroll
    for (int i = 3; i < 15; i += 2) mx = fmaxf(fmaxf(mx, st[0][i]), st[0][i + 1]);
    mx = fmaxf(mx, st[0][15]);
#pragma unroll
    for (int i = 0; i < 16; i += 2) mx = fmaxf(fmaxf(mx, st[1][i]), st[1][i + 1]);
    { auto rr = __builtin_amdgcn_permlane32_swap(__float_as_uint(mx), __float_as_uint(mx), false, false); mx = fmaxf(__uint_as_float(rr[0]), __uint_as_float(rr[1])); }
    const float mnew = fmaxf(mrun, mx), alpha = __builtin_amdgcn_exp2f(mrun - mnew);
    mrun = mnew;
    float ps = 0.f;
    __builtin_amdgcn_sched_barrier(0);
#pragma unroll
    for (int x = 0; x < 8; ++x) {
        if (FAKE == 5) { sn[x & 1] = st[x & 1]; } else
        if (x < 2) { f32x16 z;
#pragma unroll
            for (int i = 0; i < 16; ++i) z[i] = 0.f;
            sn[x & 1] = MFMA32(kf[x & 3], qf[x >> 1], z); }
        else sn[x & 1] = MFMA32(kf[x & 3], qf[x >> 1], sn[x & 1]);
        if (x < 4) kf[x] = *(const LAS bf16x8*)(kb + (x & 1) * 32 * 144 + ((x + 4) >> 1) * 32);
#pragma unroll
        for (int e = 0; e < 4; ++e) { const int i = 4 * (x & 3) + e, kt = x >> 2; const float p = FAKE == 2 ? (st[kt][i] - mnew) : __builtin_amdgcn_exp2f(st[kt][i] - mnew); st[kt][i] = p; ps += p; }
        __builtin_amdgcn_sched_barrier(0);
    }
    lrun = lrun * alpha + ps;
    bf16x8 pb[4];
#pragma unroll
    for (int ks = 0; ks < 4; ++ks) pb[ks] = pack8(st[ks >> 1], ks & 1);
#pragma unroll
    for (int i = 0; i < 16; ++i) { if (FAKE != 7) { o[0][i] *= alpha; o[1][i] *= alpha; } }
    __builtin_amdgcn_sched_barrier(0);
#pragma unroll
    for (int u = 0; u < (FAKE == 3 ? 0 : 8); ++u) {
        const int ks = u >> 1, dp = u & 1;
        if (u < 7) {
            const int ks1 = (u + 1) >> 1, dp1 = (u + 1) & 1;
#pragma unroll
            for (int k2 = 0; k2 < 2; ++k2) { lo[(u + 1) & 1][k2] = tr_read(vb + (2 * dp1 + k2) * 4096 + ks1 * 1024); hi[(u + 1) & 1][k2] = tr_read(vb + (2 * dp1 + k2) * 4096 + ks1 * 1024 + 512); }
        }
#pragma unroll
        for (int k2 = 0; k2 < 2; ++k2) {
            const int d = 2 * dp + k2;
            const bf16x8 vf = (bf16x8){lo[u & 1][k2][0], lo[u & 1][k2][1], lo[u & 1][k2][2], lo[u & 1][k2][3], hi[u & 1][k2][0], hi[u & 1][k2][1], hi[u & 1][k2][2], hi[u & 1][k2][3]};
            o[d] = MFMA32(vf, pb[ks], o[d]);
            if (u == 0 && FAKE != 7) {
#pragma unroll
                for (int e = 0; e < 16; ++e) o[2 + k2][e] *= alpha;
            }
        }
        __builtin_amdgcn_sched_barrier(0);
    }
    if (FAKE != 6) __syncthreads();
}
constexpr int AT3_K = 0, AT3_V = 3 * AT_KB;
template <int FAKE> DI void attn_unit(const Args& a, int l, int h, int qrow0, int nT, int kc0, int kl0, float lam, LAS unsigned char* lds) {
    const int tid = tidx(), lane = tid & 63, wid = tid >> 6, r = lane & 31, hl = lane >> 5;
    const bf16_t* QA = (const bf16_t*)(a.ws + WS_QA); const bf16_t* KA = (const bf16_t*)(a.ws + WS_KA); const bf16_t* VA = (const bf16_t*)(a.ws + WS_VA);
    const int qrow = qrow0 + 32 * wid + r;
    const int kkey = tid >> 3, kch = tid & 7;
    const unsigned kdst = (unsigned)(kkey * 144 + kch * 16);
    const int vkey0 = tid >> 4, vch = tid & 15;
    const unsigned vdst0 = (unsigned)((vch >> 2) * 4096 + vkey0 * 64 + (vch & 3) * 16);
    const unsigned kread = (unsigned)(r * 144 + hl * 16);
    const unsigned vread = (unsigned)(((lane >> 4) & 1) * 32 + (lane & 3) * 8 + (4 * hl + ((lane & 15) >> 2)) * 64);
#define KROW(t_) ((t_) < 4 ? kc0 + 64 * (t_) : kl0 + 64 * ((t_) - 4))
#pragma unroll 1
    for (int comp = 0; comp < 2; ++comp) {
        bf16x8 qf[4];
#pragma unroll
        for (int s = 0; s < 4; ++s) qf[s] = *(const bf16x8*)(QA + (size_t)qrow * 512 + h * 128 + comp * 64 + 16 * s + 8 * hl);
        f32x16 o[4];
#pragma unroll
        for (int d = 0; d < 4; ++d)
#pragma unroll
            for (int i = 0; i < 16; ++i) o[d][i] = 0.f;
        float mrun = -1e30f, lrun = 0.f;
        const bf16_t* kp = KA + (size_t)kkey * 512 + h * 128 + comp * 64 + kch * 8;
        const bf16_t* vp = VA + (size_t)vkey0 * 512 + h * 128 + vch * 8;
        u32x4 rk, rv0, rv1;
        {
            const int kr0 = KROW(0), kr1 = KROW(1), kr2 = KROW(2);
            const u32x4 k0 = *(const u32x4*)(kp + (size_t)kr0 * 512), k1 = *(const u32x4*)(kp + (size_t)kr1 * 512);
            const u32x4 v0 = *(const u32x4*)(vp + (size_t)kr0 * 512), v1 = *(const u32x4*)(vp + (size_t)(kr0 + 32) * 512);
            rk = *(const u32x4*)(kp + (size_t)kr2 * 512); rv0 = *(const u32x4*)(vp + (size_t)kr1 * 512); rv1 = *(const u32x4*)(vp + (size_t)(kr1 + 32) * 512);
            *(LAS u32x4*)(lds + AT3_K + kdst) = k0; *(LAS u32x4*)(lds + AT3_K + AT_KB + kdst) = k1;
            *(LAS u32x4*)(lds + AT3_V + vdst0) = v0; *(LAS u32x4*)(lds + AT3_V + vdst0 + 2048) = v1;
        }
        __syncthreads();
        f32x16 st[2];
#pragma unroll
        for (int kt = 0; kt < 2; ++kt) {
#pragma unroll
            for (int i = 0; i < 16; ++i) st[kt][i] = 0.f;
#pragma unroll
            for (int s = 0; s < 4; ++s) st[kt] = MFMA32(*(const LAS bf16x8*)(lds + AT3_K + kread + kt * 32 * 144 + s * 32), qf[s], st[kt]);
        }
        unsigned kA = AT3_K + AT_KB, kB = AT3_K + 2 * AT_KB, kC = AT3_K;
        unsigned vA = AT3_V, vB = AT3_V + AT_VB, vC = AT3_V + 2 * AT_VB;
        const AttnIt geo{kp, vp, kc0, kl0, nT, kdst, vdst0, kread, vread};
        f32x16 sn[2];
#pragma unroll 1
        for (int t = 0; t < nT; t += 2) {
            attn_iter<FAKE>(t, geo, lds, kA, kB, vA, vB, rk, rv0, rv1, st, sn, o, mrun, lrun, qf);
            attn_iter<FAKE>(t + 1, geo, lds, kB, kC, vB, vC, rk, rv0, rv1, sn, st, o, mrun, lrun, qf);
            { const unsigned tk_ = kC; kC = kB; kB = kA; kA = tk_; const unsigned tv_ = vC; vC = vB; vB = vA; vA = tv_; }
        }
        const float ltot = lrun + __shfl_xor(lrun, 32);
        const float inv = 1.f / ltot;
        const int tid2 = tidx(), lane2 = tid2 & 63, wid2 = tid2 >> 6, hl2 = lane2 >> 5;
        const int qrow2 = qrow0 + 32 * wid2 + (lane2 & 31);
        unsigned char* stash = a.ws + WS_M + (size_t)blockIdx.x * 65536 + wid2 * 8192 + lane2 * 16;
        if (comp == 0) {
#pragma unroll
            for (int d = 0; d < 4; ++d) {
                u32x4 w0, w1;
                w0.x = pk2(o[d][0] * inv, o[d][1] * inv); w0.y = pk2(o[d][2] * inv, o[d][3] * inv); w0.z = pk2(o[d][4] * inv, o[d][5] * inv); w0.w = pk2(o[d][6] * inv, o[d][7] * inv);
                w1.x = pk2(o[d][8] * inv, o[d][9] * inv); w1.y = pk2(o[d][10] * inv, o[d][11] * inv); w1.z = pk2(o[d][12] * inv, o[d][13] * inv); w1.w = pk2(o[d][14] * inv, o[d][15] * inv);
                *(u32x4*)(stash + (2 * d) * 1024) = w0; *(u32x4*)(stash + (2 * d + 1) * 1024) = w1;
            }
        } else {
            bf16_t* YA = FAKE ? (bf16_t*)(a.ws + WS_GPRE) : (bf16_t*)(a.ws + WS_YAB);
            int l2_ = l; asm volatile("" : "+v"(l2_));
            const float li = lam_init_of(l2_);
            float ss = 0.f;
#pragma unroll
            for (int d = 0; d < 4; ++d) {
                const u32x4 on0 = *(const u32x4*)(stash + (2 * d) * 1024), on1s = *(const u32x4*)(stash + (2 * d + 1) * 1024);
#pragma unroll
                for (int k = 0; k < 4; ++k) {
                    const unsigned wa = on0[k], wb = on1s[k];
                    const float a0 = __uint_as_float(wa << 16), a1 = __uint_as_float(wa & 0xffff0000u), b0 = __uint_as_float(wb << 16), b1 = __uint_as_float(wb & 0xffff0000u);
                    o[d][2 * k] = a0 - lam * o[d][2 * k] * inv; o[d][2 * k + 1] = a1 - lam * o[d][2 * k + 1] * inv;
                    o[d][8 + 2 * k] = b0 - lam * o[d][8 + 2 * k] * inv; o[d][8 + 2 * k + 1] = b1 - lam * o[d][8 + 2 * k + 1] * inv;
                    ss += o[d][2 * k] * o[d][2 * k] + o[d][2 * k + 1] * o[d][2 * k + 1] + o[d][8 + 2 * k] * o[d][8 + 2 * k] + o[d][8 + 2 * k + 1] * o[d][8 + 2 * k + 1];
                }
            }
            ss += __shfl_xor(ss, 32);
            const float rs = rsqrtf(ss * (1.f / 128.f) + EPS) * (1.f - li);
            const float* sg = a.in[12] + l * 128;
#pragma unroll
            for (int d = 0; d < 4; ++d)
#pragma unroll
                for (int ig = 0; ig < 4; ++ig) {
                    const int dv0 = 32 * d + 8 * ig + 4 * hl2;
                    const f32x4 g4 = *(const f32x4*)(sg + dv0);
                    u32x2 w; w.x = pk2(o[d][4 * ig] * rs * g4[0], o[d][4 * ig + 1] * rs * g4[1]); w.y = pk2(o[d][4 * ig + 2] * rs * g4[2], o[d][4 * ig + 3] * rs * g4[3]);
                    *(u32x2*)(YA + (size_t)qrow2 * 512 + h * 128 + dv0) = w;
                }
        }
    }
#undef KROW
}
template <int FAKE> DI void ph_attn(const Args& a, int l, LAS unsigned char* lds) {
    const int ln_ = tidx() & 63;
    const float s1 = wave_sum(a.in[8][l * 64 + ln_] * a.in[9][l * 64 + ln_]), s2 = wave_sum(a.in[10][l * 64 + ln_] * a.in[11][l * 64 + ln_]);
    int l3_ = l; asm volatile("" : "+v"(l3_));
    const float lam = expf(s1) - expf(s2) + lam_init_of(l3_);
    const int G = gridDim.x, bx = blockIdx.x;
    const int vcu = (G % 8 == 0) ? (bx % 8) * (G / 8) + bx / 8 : bx;
    for (int u = vcu; u < 256; u += G) {
        const int bh = u >> 4, qt = u & 15, b = bh >> 2, h = bh & 3;
        attn_unit<FAKE>(a, l, h, NCTX + b * SEQ + qt * 256, 68, b * CTX, NCTX + b * SEQ, lam, lds);
    }
    if (l < DEPTH - 1) {
        if (G >= 80) { if (bx >= 64 && bx < 80) { const int u = bx - 64, b = u >> 2, h = u & 3; attn_unit<FAKE>(a, l, h, b * CTX, 4, b * CTX, 0, lam, lds); } }
        else for (int u = vcu; u < 16; u += G) { const int b = u >> 2, h = u & 3; attn_unit<FAKE>(a, l, h, b * CTX, 4, b * CTX, 0, lam, lds); }
    }
}

constexpr int GP_WN = 0, GP_QD = 8192, GP_KDT = 16384, GP_QK = 24576, GP_U = 28672, GP_REC = 36864;
DI int swap23(int p) { return (p & ~12) | ((p & 4) << 1) | ((p & 8) >> 1); }
DI int chunk_index(int dir, int b, int h, int cc) { return ((dir * 4 + b) * 4 + h) * 68 + cc; }
constexpr int G1_XS = 71680, G1_XST = 832, G1_WS = 71680 + 68 * 832;
constexpr int G1_QS = 0, G1_KS = 17408, G1_VS = 34816  , G1_GS = 71680, G1_QKS = 88064, G1_AT = 104448  , G1_SM = LDS_MISC + 256;
DI float* g1_sm(unsigned char* lds, int dir, int kind) { return (float*)(lds + G1_SM) + (dir * 5 + kind) * 64; }

#ifndef G1REP1
#define G1REP1 1
#endif
#ifndef G1REP6
#define G1REP6 1
#endif
#ifndef G1REP7
#define G1REP7 1
#endif
DI void g1_task(const Args& a, int l, int b, int h, int cc, unsigned char* lds, int cut = 0) {
    const int tid = tidx(), lane = tid & 63, wid = tid >> 6, r = lane & 31, hl = lane >> 5;
    const int s0 = cc < 4 ? b * CTX : NCTX + b * SEQ, len = cc < 4 ? CTX : SEQ, t0 = cc < 4 ? cc * 64 : (cc - 4) * 64;
    const bf16_t* QKV = (const bf16_t*)(a.ws + WS_QKV);
    const float* cw = a.in[7] + (size_t)l * 5 * 1536;
    if (wid < 2) {
        const int dir = wid, row = s0 + t0 + lane;
        const float* AB = (const float*)(a.ws + WS_AB);
        const float nal = -expf(a.in[13][l * 8 + dir * 4 + h]), dtb = a.in[14][l * 8 + dir * 4 + h];
        const float g = nal * softplusf_(AB[(size_t)row * 16 + dir * 4 + h] + dtb);
        const float beta = sigmoidf_(AB[(size_t)row * 16 + 8 + dir * 4 + h]);
        float c = g;
        if (dir == 0) {
#pragma unroll
            for (int o = 1; o < 64; o <<= 1) { const float v = __shfl_up(c, o); if (lane >= o) c += v; }
        } else {
#pragma unroll
            for (int o = 1; o < 64; o <<= 1) { const float v = __shfl_down(c, o); if (lane + o < 64) c += v; }
        }
        const float glref = __shfl(c, dir == 0 ? 63 : 0);
        const float eg = __expf(c);
        g1_sm(lds, dir, 0)[lane] = c; g1_sm(lds, dir, 1)[lane] = beta; g1_sm(lds, dir, 2)[lane] = beta * eg; g1_sm(lds, dir, 3)[lane] = __expf(glref - c); g1_sm(lds, dir, 4)[lane] = eg;
        if (lane == 0) ((float*)(a.ws + WS_GL))[chunk_index(dir, b, h, cc)] = __expf(glref);
    }
#pragma unroll 1
    for (int rep1_ = 0; rep1_ < G1REP1; ++rep1_) {
    {
        unsigned char* xs = lds + G1_XS; float* wsm = (float*)(lds + G1_WS);
        u32x4 xv[7];
#pragma unroll
        for (int it = 0; it < 7; ++it) {
            const int p = tid + 512 * it; const int pc = p < 68 * 48 ? p : 68 * 48 - 1;
            const int rr = pc / 48, q = pc - rr * 48, part = q >> 4, c8 = q & 15;
            const int tt = t0 + rr - 2; const int ttc = tt < 0 ? 0 : (tt >= len ? len - 1 : tt);
            xv[it] = *(const u32x4*)(QKV + (size_t)(s0 + ttc) * 1536 + part * 512 + h * 128 + c8 * 8);
            if (tt != ttc) xv[it] = (u32x4){0u, 0u, 0u, 0u};
        }
#pragma unroll
        for (int it = 0; it < 7; ++it) {
            const int p = tid + 512 * it;
            if (p < 68 * 48) { const int rr = p / 48, q = p - rr * 48, part = q >> 4, c8 = q & 15; *(u32x4*)(xs + rr * G1_XST + part * 256 + c8 * 16) = xv[it]; }
        }
        if (tid < 480) { const int j = tid / 96, q = tid - j * 96, part = q >> 5, c4 = q & 31;
            *(f32x4*)(wsm + j * 384 + part * 128 + c4 * 4) = *(const f32x4*)(cw + j * 1536 + part * 512 + h * 128 + c4 * 4); }
    }
    __syncthreads();
    if (cut == 3) return;
    {
        const int i = tid >> 3, sub = tid & 7;
        const unsigned char* xs = lds + G1_XS; const float* wsm = (const float*)(lds + G1_WS);
#pragma unroll
        for (int part = 0; part < 3; ++part) {
            float val[16];
#pragma unroll
            for (int cg = 0; cg < 2; ++cg) {
                const int d = cg * 64 + sub * 8;
                float acc[8];
#pragma unroll
                for (int e = 0; e < 8; ++e) acc[e] = 0.f;
#pragma unroll
                for (int j = 0; j < 5; ++j) {
                    {
                        const u32x4 x = *(const u32x4*)(xs + (i + j) * G1_XST + part * 256 + d * 2);
                        const f32x4 w0 = *(const f32x4*)(wsm + j * 384 + part * 128 + d), w1 = *(const f32x4*)(wsm + j * 384 + part * 128 + d + 4);
                        acc[0] += w0[0] * __uint_as_float(x[0] << 16); acc[1] += w0[1] * __uint_as_float(x[0] & 0xffff0000u);
                        acc[2] += w0[2] * __uint_as_float(x[1] << 16); acc[3] += w0[3] * __uint_as_float(x[1] & 0xffff0000u);
                        acc[4] += w1[0] * __uint_as_float(x[2] << 16); acc[5] += w1[1] * __uint_as_float(x[2] & 0xffff0000u);
                        acc[6] += w1[2] * __uint_as_float(x[3] << 16); acc[7] += w1[3] * __uint_as_float(x[3] & 0xffff0000u);
                    }
                }
#pragma unroll
                for (int e = 0; e < 8; ++e) val[cg * 8 + e] = (cut == 5) ? acc[e] : siluf_(acc[e]);
            }
            float scale = 1.f;
            if (part < 2) {
                float ss = 0.f;
#pragma unroll
                for (int e = 0; e < 16; ++e) ss += val[e] * val[e];
                ss += dppmov<0xB1>(ss); ss += dppmov<0x4E>(ss); { const float o4 = (lane & 4) ? dppmov<0x124>(ss) : dppmov<0x12C>(ss); ss += o4; }
                scale = rsqrtf(ss + EPS) * (part == 0 ? 0.08838834764831845f : 1.f);
            }
#pragma unroll
            for (int cg = 0; cg < 2; ++cg) {
                const int d = cg * 64 + sub * 8;
                bf16_t hv[8];
#pragma unroll
                for (int e = 0; e < 8; ++e) hv[e] = f2bf(val[cg * 8 + e] * scale);
                if (cut != 4 || scale == 123456.789f) {
                    u32x4 w; w.x = hv[0] | ((unsigned)hv[1] << 16); w.y = hv[2] | ((unsigned)hv[3] << 16); w.z = hv[4] | ((unsigned)hv[5] << 16); w.w = hv[6] | ((unsigned)hv[7] << 16);
                    *(u32x4*)(lds + (part == 0 ? G1_QS : (part == 1 ? G1_KS : G1_VS)) + i * 272 + d * 2) = w;
                }
            }
        }
    }
    }
    __syncthreads();
    if (cut == 1 || cut == 4 || cut == 5) return;
    {
        const int which = wid >> 2, mi = (wid >> 1) & 1, ni = wid & 1;
        const unsigned char* Ab = lds + (which ? G1_QS : G1_KS) + (32 * mi + r) * 272 + hl * 16;
        const unsigned char* Bb = lds + G1_KS + (32 * ni + r) * 272 + hl * 16;
        f32x16 acc;
#pragma unroll
        for (int i = 0; i < 16; ++i) acc[i] = 0.f;
#pragma unroll
        for (int s = 0; s < 8; ++s) acc = MFMA32(*(const bf16x8*)(Ab + s * 32), *(const bf16x8*)(Bb + s * 32), acc);
        float* O = (float*)(lds + (which ? G1_QKS : G1_GS));
#pragma unroll
        for (int i = 0; i < 16; ++i) O[(32 * mi + crow(i, hl)) * 64 + 32 * ni + r] = acc[i];
    }
    __syncthreads();
    {
        const float* GS = (const float*)(lds + G1_GS);
#pragma unroll 4
        for (int x = tid; x < 2 * 4096; x += 512) {
            const int dir = x >> 12, i = (x >> 6) & 63, j = x & 63;
            const float* gc = g1_sm(lds, dir, 0);
            const bool before = dir == 0 ? (j < i) : (j > i);
            const float v = before ? g1_sm(lds, dir, 1)[i] * GS[i * 64 + j] * __expf(gc[i] - gc[j]) : 0.f;
            if (dir == 0) ((float*)(lds + G1_AT))[i * 68 + j] = v; else ((float*)(lds + G1_AT + 17408))[(63 - i) * 68 + (63 - j)] = v;
        }
    }
    __syncthreads();
    if (cut == 2) return;
    if (wid < 2) {
        float* T = (float*)(lds + G1_AT + wid * 17408);
        float t[64];
        f32x4 ra[2][16];
        t[0] = (lane == 0) ? 1.f : 0.f;
        ra[1][0] = *(const f32x4*)(T + 1 * 68);
#pragma unroll
        for (int i = 1; i < 64; ++i) {
            const int c = i & 1, nx = c ^ 1;
            if (i < 63) {
#pragma unroll
                for (int j4 = 0; j4 * 4 < i + 1; ++j4) ra[nx][j4] = *(const f32x4*)(T + (i + 1) * 68 + 4 * j4);
            }
            float ac[4] = {(lane == i) ? 1.f : 0.f, 0.f, 0.f, 0.f};
#pragma unroll
            for (int j4 = 0; j4 * 4 < i; ++j4) {
#pragma unroll
                for (int e = 0; e < 4; ++e) if (4 * j4 + e < i) ac[e] -= ra[c][j4][e] * t[4 * j4 + e];
            }
            t[i] = (ac[0] + ac[1]) + (ac[2] + ac[3]);
        }
#pragma unroll
        for (int i = 0; i < 64; ++i) T[i * 68 + lane] = t[i];
    } else {
        bf16_t* rec0e = (bf16_t*)(a.ws + WS_GPRE);
#pragma unroll
        for (int it2 = 0; it2 < 12; ++it2) {
            const int kind = it2 >> 1, x = (tid - 128) + 384 * (it2 & 1), dir = kind >= 3 ? 1 : 0, kk = kind - 3 * dir;
            if (x >= 512) continue;
            bf16_t* rec = rec0e + (size_t)chunk_index(dir, b, h, cc) * GP_REC;
            const float* gc = g1_sm(lds, dir, 0); const float* ekd = g1_sm(lds, dir, 3); const float* eg = g1_sm(lds, dir, 4);
            if (kk == 0) {
                const int c = x >> 3, g16 = x & 7;
                const u32x4 x0 = *(const u32x4*)(lds + G1_QS + c * 272 + g16 * 32), x1 = *(const u32x4*)(lds + G1_QS + c * 272 + g16 * 32 + 16);
                const unsigned pm[8] = {x0.x, x0.y, x1.x, x1.y, x0.z, x0.w, x1.z, x1.w};
                const float sc = eg[c];
                u32x4 o0, o1;
                o0.x = pk2(__uint_as_float(pm[0] << 16) * sc, __uint_as_float(pm[0] & 0xffff0000u) * sc); o0.y = pk2(__uint_as_float(pm[1] << 16) * sc, __uint_as_float(pm[1] & 0xffff0000u) * sc);
                o0.z = pk2(__uint_as_float(pm[2] << 16) * sc, __uint_as_float(pm[2] & 0xffff0000u) * sc); o0.w = pk2(__uint_as_float(pm[3] << 16) * sc, __uint_as_float(pm[3] & 0xffff0000u) * sc);
                o1.x = pk2(__uint_as_float(pm[4] << 16) * sc, __uint_as_float(pm[4] & 0xffff0000u) * sc); o1.y = pk2(__uint_as_float(pm[5] << 16) * sc, __uint_as_float(pm[5] & 0xffff0000u) * sc);
                o1.z = pk2(__uint_as_float(pm[6] << 16) * sc, __uint_as_float(pm[6] & 0xffff0000u) * sc); o1.w = pk2(__uint_as_float(pm[7] << 16) * sc, __uint_as_float(pm[7] & 0xffff0000u) * sc);
                u32x4* dp = (u32x4*)(rec + GP_QD + c * 128 + g16 * 16); dp[0] = o0; dp[1] = o1;
            } else if (kk == 1) {
                const int dk = x >> 2, g16 = x & 3;
                const bf16_t* kp = (const bf16_t*)(lds + G1_KS) + dk + (g16 * 16) * 136;
                unsigned ow[8];
#pragma unroll
                for (int q = 0; q < 8; ++q) {
                    const int p0 = 2 * q, p1 = 2 * q + 1; const int c0 = swap23(p0), c1 = swap23(p1);
                    ow[q] = pk2(bf2f(kp[c0 * 136]) * ekd[16 * g16 + c0], bf2f(kp[c1 * 136]) * ekd[16 * g16 + c1]);
                }
                u32x4* dp = (u32x4*)(rec + GP_KDT + dk * 64 + g16 * 16);
                dp[0] = (u32x4){ow[0], ow[1], ow[2], ow[3]}; dp[1] = (u32x4){ow[4], ow[5], ow[6], ow[7]};
            } else {
                const int i = x >> 3, sub = x & 7;
                const float* QKm = (const float*)(lds + G1_QKS) + i * 64;
                const float gi = gc[i];
                unsigned ow[4];
#pragma unroll
                for (int q = 0; q < 4; ++q) {
                    float v[2];
#pragma unroll
                    for (int e = 0; e < 2; ++e) {
                        const int jp = 8 * sub + 2 * q + e, j = (jp & ~15) + swap23(jp & 15);
                        const bool ok = dir == 0 ? (j <= i) : (j >= i);
                        v[e] = ok ? QKm[j] * __expf(gi - gc[j]) : 0.f;
                    }
                    ow[q] = pk2(v[0], v[1]);
                }
                *(u32x4*)(rec + GP_QK + i * 64 + 8 * sub) = (u32x4){ow[0], ow[1], ow[2], ow[3]};
            }
        }
    }
    __syncthreads();
    bf16_t* rec0 = (bf16_t*)(a.ws + WS_GPRE);
#pragma unroll 1
    for (int rep6_ = 0; rep6_ < G1REP6; ++rep6_) {
    {
        const int dir = wid >> 2, n = wid & 3;
        bf16_t* rec = rec0 + (size_t)chunk_index(dir, b, h, cc) * GP_REC;
        const float* T = (const float*)(lds + G1_AT + dir * 17408);
        f32x4 tq[2][4][2];
        f32x4 c1[4][2], c2[4][2];
        bf16x8 bv[4], bk[4];
#pragma unroll
        for (int s = 0; s < 4; ++s) {
            const float* p1 = g1_sm(lds, dir, 1) + 16 * s + 8 * hl; const float* p2 = g1_sm(lds, dir, 2) + 16 * s + 8 * hl;
            c1[s][0] = *(const f32x4*)p1; c1[s][1] = *(const f32x4*)(p1 + 4); c2[s][0] = *(const f32x4*)p2; c2[s][1] = *(const f32x4*)(p2 + 4);
            {
                const unsigned toff = (unsigned)((16 * s + 8 * hl + ((lane & 15) >> 2)) * 272 + (32 * n + 16 * ((lane >> 4) & 1)) * 2 + 8 * (lane & 3));
                const s16x4 v0 = tr_read((const LAS unsigned char*)lds + G1_VS + toff), v1 = tr_read((const LAS unsigned char*)lds + G1_VS + toff + 4 * 272);
                const s16x4 k0 = tr_read((const LAS unsigned char*)lds + G1_KS + toff), k1 = tr_read((const LAS unsigned char*)lds + G1_KS + toff + 4 * 272);
                bv[s] = (bf16x8){v0[0], v0[1], v0[2], v0[3], v1[0], v1[1], v1[2], v1[3]};
                bk[s] = (bf16x8){k0[0], k0[1], k0[2], k0[3], k1[0], k1[1], k1[2], k1[3]};
            }
#pragma unroll
            for (int m = 0; m < 2; ++m) {
                if (dir == 0) { const float* tp = T + (32 * m + r) * 68 + 16 * s + 8 * hl; tq[m][s][0] = *(const f32x4*)tp; tq[m][s][1] = *(const f32x4*)(tp + 4); }
                else { const float* tp = T + (63 - (32 * m + r)) * 68 + 56 - 16 * s - 8 * hl; const f32x4 x0 = *(const f32x4*)tp, x1 = *(const f32x4*)(tp + 4);
                       tq[m][s][0] = (f32x4){x1[3], x1[2], x1[1], x1[0]}; tq[m][s][1] = (f32x4){x0[3], x0[2], x0[1], x0[0]}; }
            }
        }
#pragma unroll
        for (int prod = 0; prod < 2; ++prod) {
#pragma unroll
            for (int m = 0; m < 2; ++m) {
                f32x16 acc;
#pragma unroll
                for (int i = 0; i < 16; ++i) acc[i] = 0.f;
#pragma unroll
                for (int s = 0; s < 4; ++s) {
                    const f32x4 ta = tq[m][s][0], tb = tq[m][s][1];
                    const f32x4 ca = prod == 0 ? c1[s][0] : c2[s][0], cb = prod == 0 ? c1[s][1] : c2[s][1];
                    u32x4 aw; aw.x = pk2(ta[0] * ca[0], ta[1] * ca[1]); aw.y = pk2(ta[2] * ca[2], ta[3] * ca[3]); aw.z = pk2(tb[0] * cb[0], tb[1] * cb[1]); aw.w = pk2(tb[2] * cb[2], tb[3] * cb[3]);
                    acc = MFMA32(__builtin_bit_cast(bf16x8, aw), prod == 0 ? bv[s] : bk[s], acc);
                }
                if (prod == 0) {
                    u32x4 w0, w1;
                    w0.x = pk2(acc[0], acc[1]); w0.y = pk2(acc[2], acc[3]); w0.z = pk2(acc[4], acc[5]); w0.w = pk2(acc[6], acc[7]);
                    w1.x = pk2(acc[8], acc[9]); w1.y = pk2(acc[10], acc[11]); w1.z = pk2(acc[12], acc[13]); w1.w = pk2(acc[14], acc[15]);
                    u32x4* up = (u32x4*)(rec + GP_U + ((m * 4 + n) * 64 + lane) * 16);
                    up[0] = w0; up[1] = w1;
                } else {
                    const int dkp = 32 * n + (r & 16) + swap23(r & 15);
#pragma unroll
                    for (int i = 0; i < 16; ++i) rec[GP_WN + (32 * m + crow(i, hl)) * 128 + dkp] = f2bf(-acc[i]);
                }
            }
        }
    }
    }
    __syncthreads();
}
DI void ph_g1(const Args& a, int l, unsigned char* lds, int cut = 0) {
#pragma unroll 1
    for (int task = blockIdx.x; task < 16 * 68; task += gridDim.x) {
        const int bh = task / 68, cc = task % 68;
        g1_task(a, l, bh >> 2, bh & 3, cc, lds, cut);
    }
}

#ifndef PROBE_SCAN_FAKE
#define PROBE_SCAN_FAKE 0
#endif
constexpr int SC_WN = 0, SC_QD = 16384, SC_KDT = 32768, SC_QK = 49152, SC_BUF = 57344, SC_GL = 2 * SC_BUF;
DI int scan_cc(int dir, int step) { return dir == 0 ? step : (step < 4 ? 3 - step : 71 - step); }
DI unsigned scan_src_off(int p) {
    if (p < 2048) { const int row = (p & 1023) >> 4, s16 = p & 15; return (unsigned)((p >> 10) * 16384 + row * 256 + ((s16 ^ (row & 15)) << 4)); }
    const int q = p - 2048, row = q >> 3, s8 = q & 7;
    return (unsigned)(32768 + row * 128 + ((s8 ^ ((row >> 1) & 7)) << 4));
}
#define SCAN_BAR() asm volatile("s_barrier" ::: "memory")
DI void scan_block(const Args& a, int l, int dir, int b, int h, unsigned char* lds, int fake = 0) {
    const int tid = tidx(), lane = tid & 63, wid = tid >> 6, r = lane & 31, hl = lane >> 5;
    const bf16_t* rec0 = (const bf16_t*)(a.ws + WS_GPRE);
    const float* GL = (const float*)(a.ws + WS_GL);
    const bool loader = wid >= 4;
    const int n = wid & 3, lw = __builtin_amdgcn_readfirstlane(wid) - 4;
    bf16_t* OD = (bf16_t*)(a.ws + (dir ? WS_OB : WS_OF));
    f32x16 st[4];
#pragma unroll
    for (int t = 0; t < 4; ++t)
#pragma unroll
        for (int i = 0; i < 16; ++i) st[t][i] = 0.f;
    u32x4 un[4]; float gln = 0.f;
    unsigned swq[8], skq[6];
    if (loader) {
#pragma unroll
        for (int j = 0; j < 8; ++j) swq[j] = scan_src_off((lw * 8 + j) * 64 + lane);
#pragma unroll
        for (int j = 0; j < 6; ++j) skq[j] = scan_src_off(2048 + (lw * 6 + j) * 64 + lane);
    }
#define DMA_WQ(chunk_, bufsel_) do { const int c_ = (chunk_) < 68 ? (chunk_) : 67; const unsigned char* src_ = (const unsigned char*)(rec0 + (size_t)chunk_index(dir, b, h, scan_cc(dir, c_)) * GP_REC); \
        LAS unsigned char* nb_ = (LAS unsigned char*)lds + (bufsel_) * SC_BUF; \
        _Pragma("unroll") for (int j = 0; j < 8; ++j) __builtin_amdgcn_global_load_lds((const unsigned*)(src_ + swq[j]), (LAS unsigned*)(nb_ + (lw * 8 + j) * 1024), 16, 0, 0); } while (0)
#define DMA_KQ(chunk_, bufsel_) do { const int c_ = (chunk_) < 68 ? (chunk_) : 67; const unsigned char* src_ = (const unsigned char*)(rec0 + (size_t)chunk_index(dir, b, h, scan_cc(dir, c_)) * GP_REC); \
        LAS unsigned char* nb_ = (LAS unsigned char*)lds + (bufsel_) * SC_BUF; \
        _Pragma("unroll") for (int j = 0; j < 6; ++j) __builtin_amdgcn_global_load_lds((const unsigned*)(src_ + skq[j]), (LAS unsigned*)(nb_ + 32768 + (lw * 6 + j) * 1024), 16, 0, 0); } while (0)
    if (loader) {
        DMA_WQ(0, 0); DMA_KQ(0, 0); DMA_WQ(1, 1);
        asm volatile("s_waitcnt vmcnt(8)" ::: "memory");
    } else {
        const int ci = chunk_index(dir, b, h, scan_cc(dir, 0));
        const bf16_t* rec = rec0 + (size_t)ci * GP_REC;
#pragma unroll
        for (int m = 0; m < 2; ++m) { const u32x4* up = (const u32x4*)(rec + GP_U + ((m * 4 + n) * 64 + lane) * 16); un[2 * m] = up[0]; un[2 * m + 1] = up[1]; }
        gln = GL[ci];
    }
    SCAN_BAR();
#pragma unroll 1
    for (int step = 0; step < 68; ++step) {
        const int cur = step & 1;
        if (loader) {
            if (fake != 1) {
                DMA_KQ(step + 1, cur ^ 1);
                asm volatile("s_waitcnt vmcnt(14)" ::: "memory");
                SCAN_BAR();
                DMA_WQ(step + 2, cur);
                asm volatile("s_waitcnt vmcnt(14)" ::: "memory");
                SCAN_BAR();
            } else { SCAN_BAR(); SCAN_BAR(); }
        } else {
            if (fake != 2) {
            const int cc = scan_cc(dir, step);
            const int row0 = cc < 4 ? b * CTX + cc * 64 : NCTX + b * SEQ + (cc - 4) * 64;
            const unsigned char* buf = lds + cur * SC_BUF;
            const float gl = gln;
            const unsigned char* pwn = buf + SC_WN + r * 256;
            const unsigned char* pqd = buf + SC_QD + r * 256;
            const unsigned char* pqk = buf + SC_QK + r * 128;
            const unsigned char* pkd = buf + SC_KDT + r * 128;
            const int x16 = r & 15, x8 = (r >> 1) & 7;
#define FR256(base, tile, blk) (*(const bf16x8*)((base) + (tile) * 32 * 256 + ((((blk) ^ x16)) << 4)))
#define FR128(base, tile, blk) (*(const bf16x8*)((base) + (tile) * 32 * 128 + ((((blk) ^ x8)) << 4)))
            bf16x8 fa[2][4];
#pragma unroll
            for (int m = 0; m < 2; ++m) { fa[0][m] = FR256(pwn, m, hl); fa[0][2 + m] = FR256(pqd, m, hl); }
            f32x16 vn[2];
#pragma unroll
            for (int m = 0; m < 2; ++m) {
                const u32x4 u0 = un[2 * m], u1 = un[2 * m + 1];
#pragma unroll
                for (int k = 0; k < 4; ++k) { vn[m][2 * k] = __uint_as_float(u0[k] << 16); vn[m][2 * k + 1] = __uint_as_float(u0[k] & 0xffff0000u); vn[m][8 + 2 * k] = __uint_as_float(u1[k] << 16); vn[m][8 + 2 * k + 1] = __uint_as_float(u1[k] & 0xffff0000u); }
            }
            if (step + 1 < 68) {
                const int ci1 = chunk_index(dir, b, h, scan_cc(dir, step + 1));
                const bf16_t* rec = rec0 + (size_t)ci1 * GP_REC;
#pragma unroll
                for (int m = 0; m < 2; ++m) { const u32x4* up = (const u32x4*)(rec + GP_U + ((m * 4 + n) * 64 + lane) * 16); un[2 * m] = up[0]; un[2 * m + 1] = up[1]; }
                gln = GL[ci1];
            }
            f32x16 o[2];
#pragma unroll
            for (int m = 0; m < 2; ++m)
#pragma unroll
                for (int i = 0; i < 16; ++i) o[m][i] = 0.f;
#pragma unroll
            for (int kk = 0; kk < 8; ++kk) {
                const int c = kk & 1, nx = c ^ 1;
                if (kk < 7) {
#pragma unroll
                    for (int m = 0; m < 2; ++m) { fa[nx][m] = FR256(pwn, m, 2 * (kk + 1) + hl); fa[nx][2 + m] = FR256(pqd, m, 2 * (kk + 1) + hl); }
                }
                const bf16x8 sbk = pack8(st[kk >> 1], kk & 1);
#pragma unroll
                for (int m = 0; m < 2; ++m) { vn[m] = MFMA32(fa[c][m], sbk, vn[m]); o[m] = MFMA32(fa[c][2 + m], sbk, o[m]); }
            }
            asm volatile("s_waitcnt lgkmcnt(0)" ::: "memory");
            SCAN_BAR();
            bf16x8 fb[2][3];
            fb[0][0] = FR128(pqk, 0, hl); fb[0][1] = FR128(pqk, 1, hl); fb[0][2] = FR128(pkd, 0, hl);
#pragma unroll
            for (int t = 0; t < 4; ++t)
#pragma unroll
                for (int i = 0; i < 16; ++i) st[t][i] *= gl;
#pragma unroll
            for (int h2 = 0; h2 < 8; ++h2) {
                const int kk = h2 >> 1, part = h2 & 1, c = h2 & 1, nx = c ^ 1;
                if (h2 < 7) {
                    const int k1 = (h2 + 1) >> 1;
                    if (part == 0) {
#pragma unroll
                        for (int t = 1; t < 4; ++t) fb[nx][t - 1] = FR128(pkd, t, 2 * k1 + hl);
                    } else { fb[nx][0] = FR128(pqk, 0, 2 * k1 + hl); fb[nx][1] = FR128(pqk, 1, 2 * k1 + hl); fb[nx][2] = FR128(pkd, 0, 2 * k1 + hl); }
                }
                const bf16x8 vbk = pack8(vn[kk >> 1], kk & 1);
                if (part == 0) { o[0] = MFMA32(fb[c][0], vbk, o[0]); o[1] = MFMA32(fb[c][1], vbk, o[1]); st[0] = MFMA32(fb[c][2], vbk, st[0]); }
                else { st[1] = MFMA32(fb[c][0], vbk, st[1]); st[2] = MFMA32(fb[c][1], vbk, st[2]); st[3] = MFMA32(fb[c][2], vbk, st[3]); }
            }
#undef FR256
#undef FR128
#pragma unroll
            for (int m = 0; m < 2; ++m)
#pragma unroll
                for (int i = 0; i < 16; ++i) OD[(size_t)(row0 + 32 * m + crow(i, hl)) * 512 + h * 128 + 32 * n + r] = f2bf(o[m][i]);
            asm volatile("s_waitcnt lgkmcnt(0)" ::: "memory");
            SCAN_BAR();
            } else { SCAN_BAR(); SCAN_BAR(); }
        }
    }
    if (loader) asm volatile("s_waitcnt vmcnt(0)" ::: "memory");
    __syncthreads();
#undef DMA_WQ
#undef DMA_KQ
}
#undef SCAN_BAR
DI void ph_scan(const Args& a, int l, unsigned char* lds) {
    const int x = blockIdx.x;
#if PROBE_SCAN_FAKE
    scan_block(a, l, x >> 4, (x >> 2) & 3, x & 3, lds, PROBE_SCAN_FAKE); __syncthreads();
#endif
    scan_block(a, l, x >> 4, (x >> 2) & 3, x & 3, lds);
}

__global__ void __launch_bounds__(256) nv_inproj(Args a) {
    const int l = a.layer;
    const int row = blockIdx.y, cd = blockIdx.x * 256 + threadIdx.x;
    const int cs = cd < 3584 ? cd : cd + 16;
    const float* w = a.in[6] + (size_t)l * 1024 * N_IN;
    const bf16_t* hr = (const bf16_t*)(a.ws + WS_H) + (size_t)row * 1024;
    const bool isrope = (cd < 1024) && (row >= NCTX);
    const int cs2 = cs ^ 16;
    float acc = 0.f, acc2 = 0.f;
    for (int k = 0; k < 1024; ++k) { const float h = bf2f(hr[k]); acc += h * w[(size_t)k * N_IN + cs]; if (isrope) acc2 += h * w[(size_t)k * N_IN + cs2]; }
    if (cd < 1024) {
        float v = acc;
        if (isrope) {
            const float* rope = (const float*)(a.ws + WS_ROPE);
            const int t = (row - NCTX) & 4095, d = cd & 63, axis = (d >> 5) & 1, half = (d >> 4) & 1, f = d & 15;
            const int pos = axis ? (t & 63) : (t >> 6);
            const float c = rope[(pos * 16 + f) * 2], s = rope[(pos * 16 + f) * 2 + 1];
            v = half == 0 ? acc * c - acc2 * s : acc * c + acc2 * s;
        }
        if (cd < 512) ((bf16_t*)(a.ws + WS_QA))[(size_t)row * 512 + cd] = f2bf(v * QSCALE);
        else ((bf16_t*)(a.ws + WS_KA))[(size_t)row * 512 + cd - 512] = f2bf(v);
    } else if (cd < 1536) ((bf16_t*)(a.ws + WS_VA))[(size_t)row * 512 + cd - 1024] = f2bf(acc);
    else if (cd < 3072) ((bf16_t*)(a.ws + WS_QKV))[(size_t)row * 1536 + cd - 1536] = f2bf(acc);
    else if (cd < 3584) ((bf16_t*)(a.ws + WS_Z))[(size_t)row * 512 + cd - 3072] = f2bf(acc);
    else ((bf16_t*)(a.ws + WS_SG))[(size_t)row * 2048 + cd - 3584] = f2bf(sigmoidf_(acc));
}

__global__ void __launch_bounds__(256) nv_attn(Args a) {
    const int row = blockIdx.x * 256 + threadIdx.x;
    const int h = blockIdx.y >> 2, comp = (blockIdx.y >> 1) & 1, dh = blockIdx.y & 1;
    const bf16_t* QA = (const bf16_t*)(a.ws + WS_QA); const bf16_t* KA = (const bf16_t*)(a.ws + WS_KA); const bf16_t* VA = (const bf16_t*)(a.ws + WS_VA);
    float* ON = (float*)(a.ws + WS_ON);
    const bool isctx = row < NCTX;
    const int b = isctx ? (row >> 8) : ((row - NCTX) >> 12);
    float q[64];
    { const bf16_t* qp = QA + (size_t)row * 512 + h * 128 + comp * 64;
#pragma unroll
      for (int i = 0; i < 64; ++i) q[i] = bf2f(qp[i]); }
    float acc[64];
#pragma unroll
    for (int i = 0; i < 64; ++i) acc[i] = 0.f;
    float m = -1e30f, lsum = 0.f;
    const int nkeys = isctx ? CTX : CTX + SEQ;
    for (int kk = 0; kk < nkeys; ++kk) {
        const int kr = kk < CTX ? b * CTX + kk : NCTX + b * SEQ + (kk - CTX);
        const bf16_t* kp = KA + (size_t)kr * 512 + h * 128 + comp * 64;
        float s = 0.f;
#pragma unroll
        for (int i = 0; i < 64; ++i) s += q[i] * bf2f(kp[i]);
        const float mn = fmaxf(m, s), corr = exp2f(m - mn), p = exp2f(s - mn);
        lsum = lsum * corr + p; m = mn;
        const bf16_t* vp = VA + (size_t)kr * 512 + h * 128 + dh * 64;
#pragma unroll
        for (int i = 0; i < 64; ++i) acc[i] = acc[i] * corr + p * bf2f(vp[i]);
    }
    const float inv = 1.f / lsum;
    float* op = ON + ((size_t)comp * TT + row) * 512 + h * 128 + dh * 64;
#pragma unroll
    for (int i = 0; i < 64; ++i) op[i] = acc[i] * inv;
}
DI float lam_of(const Args& a, int l) {
    float s1 = 0.f, s2 = 0.f;
    for (int i = 0; i < 64; ++i) { s1 += a.in[8][l * 64 + i] * a.in[9][l * 64 + i]; s2 += a.in[10][l * 64 + i] * a.in[11][l * 64 + i]; }
    return expf(s1) - expf(s2) + lam_init_of(l);
}
__global__ void __launch_bounds__(256) nv_attn_combine(Args a) {
    const int l = a.layer;
    const int idx = blockIdx.x * 256 + threadIdx.x; if (idx >= TT * 4) return;
    const int row = idx >> 2, h = idx & 3;
    const float lam = lam_of(a, l), li = lam_init_of(l);
    const float* ON = (const float*)(a.ws + WS_ON);
    const float* o0 = ON + (size_t)row * 512 + h * 128; const float* o1 = ON + ((size_t)TT + row) * 512 + h * 128;
    float ss = 0.f;
    for (int i = 0; i < 128; ++i) { const float o = o0[i] - lam * o1[i]; ss += o * o; }
    const float r = rsqrtf(ss * (1.f / 128.f) + EPS) * (1.f - li);
    bf16_t* ya = (bf16_t*)(a.ws + WS_YAB) + (size_t)row * 512 + h * 128;
    const float* sg = a.in[12] + l * 128;
    for (int i = 0; i < 128; ++i) ya[i] = f2bf((o0[i] - lam * o1[i]) * r * sg[i]);
}
__global__ void __launch_bounds__(256) nv_conv(Args a) {
    const int l = a.layer;
    const int row = blockIdx.y, ch = blockIdx.x * 256 + threadIdx.x;
    const bf16_t* QKV = (const bf16_t*)(a.ws + WS_QKV); float* CO = (float*)(a.ws + WS_CONVO);
    const float* cw = a.in[7] + l * 5 * 1536;
    int s0, len; if (row < NCTX) { s0 = (row >> 8) << 8; len = CTX; } else { s0 = NCTX + (((row - NCTX) >> 12) << 12); len = SEQ; }
    const int t = row - s0; float acc = 0.f;
    for (int j = 0; j < 5; ++j) { const int tt = t + j - 2; if (tt >= 0 && tt < len) acc += cw[j * 1536 + ch] * bf2f(QKV[(size_t)(s0 + tt) * 1536 + ch]); }
    CO[(size_t)row * 1536 + ch] = siluf_(acc);
}
__global__ void __launch_bounds__(256) nv_norm(Args a) {
    const int idx = blockIdx.x * 256 + threadIdx.x; if (idx >= TT * 8) return;
    const int row = idx >> 3, h = (idx >> 1) & 3, which = idx & 1;
    float* p = (float*)(a.ws + WS_CONVO) + (size_t)row * 1536 + which * 512 + h * 128;
    float ss = 0.f; for (int i = 0; i < 128; ++i) ss += p[i] * p[i];
    const float r = rsqrtf(ss + EPS) * (which == 0 ? 0.08838834764831845f : 1.f);
    for (int i = 0; i < 128; ++i) p[i] *= r;
}
__global__ void __launch_bounds__(128) nv_scan(Args a) {
    const int l = a.layer;
    const int dir = blockIdx.x >> 4, b = (blockIdx.x >> 2) & 3, h = blockIdx.x & 3, e = threadIdx.x;
    __shared__ float sq[128], sk[128];
    const float* CO = (const float*)(a.ws + WS_CONVO); const float* AB = (const float*)(a.ws + WS_AB);
    bf16_t* OD = (bf16_t*)(a.ws + (dir ? WS_OB : WS_OF));
    const float nal = -expf(a.in[13][l * 8 + dir * 4 + h]), dtb = a.in[14][l * 8 + dir * 4 + h];
    float s[128];
#pragma unroll
    for (int d = 0; d < 128; ++d) s[d] = 0.f;
    for (int step = 0; step < CTX + SEQ; ++step) {
        int row;
        if (step < CTX) { const int t = dir ? (CTX - 1 - step) : step; row = b * CTX + t; }
        else { const int t = dir ? (SEQ - 1 - (step - CTX)) : (step - CTX); row = NCTX + b * SEQ + t; }
        __syncthreads();
        sq[e] = CO[(size_t)row * 1536 + h * 128 + e]; sk[e] = CO[(size_t)row * 1536 + 512 + h * 128 + e];
        const float v = CO[(size_t)row * 1536 + 1024 + h * 128 + e];
        __syncthreads();
        const float g = nal * softplusf_(AB[(size_t)row * 16 + dir * 4 + h] + dtb);
        const float av = expf(g), beta = sigmoidf_(AB[(size_t)row * 16 + 8 + dir * 4 + h]);
        float r = 0.f, qs = 0.f, qk = 0.f;
#pragma unroll
        for (int d = 0; d < 128; ++d) { r += sk[d] * s[d]; qs += sq[d] * s[d]; qk += sq[d] * sk[d]; }
        const float vn = beta * (v - av * r);
        const float o = av * qs + qk * vn;
#pragma unroll
        for (int d = 0; d < 128; ++d) s[d] = av * s[d] + sk[d] * vn;
        OD[(size_t)row * 512 + h * 128 + e] = f2bf(o);
    }
}
__global__ void __launch_bounds__(256) nv_merge1(Args a) {
    const int l = a.layer;
    const int row = blockIdx.y, c = blockIdx.x * 256 + threadIdx.x;
    const bf16_t* YA = (const bf16_t*)(a.ws + WS_YAB) + (size_t)row * 512; const bf16_t* YB = (const bf16_t*)(a.ws + WS_YAB) + ((size_t)TT + row) * 512;
    const float* wpa = a.in[16] + (size_t)l * 512 * 1024; const float* wpb = a.in[17] + (size_t)l * 512 * 1024;
    float pa = 0.f, pb = 0.f;
    for (int k = 0; k < 512; ++k) { pa += bf2f(YA[k]) * wpa[(size_t)k * 1024 + c]; pb += bf2f(YB[k]) * wpb[(size_t)k * 1024 + c]; }
    const bf16_t* SG = (const bf16_t*)(a.ws + WS_SG) + (size_t)row * 2048;
    ((bf16_t*)(a.ws + WS_M))[(size_t)row * 1024 + c] = f2bf(bf2f(SG[c]) * pa + bf2f(SG[1024 + c]) * pb);
}
__global__ void __launch_bounds__(256) nv_wo(Args a) {
    const int l = a.layer;
    const int row = blockIdx.y, c = blockIdx.x * 256 + threadIdx.x;
    const bf16_t* M = (const bf16_t*)(a.ws + WS_M) + (size_t)row * 1024; const float* wo = a.in[18] + (size_t)l * 1024 * 1024;
    float acc = 0.f;
    for (int k = 0; k < 1024; ++k) acc += bf2f(M[k]) * wo[(size_t)k * 1024 + c];
    float* X = (float*)(a.ws + WS_X) + (size_t)row * 1024 + c;
    const float* m = (const float*)(a.ws + WS_MODS) + (size_t)(l * 5 + mod_set(row)) * 6144;
    *X = ALPHA * *X + m[2 * 1024 + c] * acc;
}
__global__ void __launch_bounds__(256) nv_moe1(Args a) {
    const int l = a.layer;
    const int as = blockIdx.y, j = blockIdx.x * 256 + threadIdx.x;
    const int row = as >> 1; if (l == DEPTH - 1 && row < NCTX) return;
    const int e = ((const int*)(a.ws + WS_ROUTE_E))[as];
    const bf16_t* hr = (const bf16_t*)(a.ws + WS_H) + (size_t)row * 1024;
    const float* w1 = a.in[23] + ((size_t)l * 16 + e) * 1024 * 512; const float* w3 = a.in[24] + ((size_t)l * 16 + e) * 1024 * 512;
    float g = 0.f, u = 0.f;
    for (int k = 0; k < 1024; ++k) { const float hv = bf2f(hr[k]); g += hv * w1[(size_t)k * 512 + j]; u += hv * w3[(size_t)k * 512 + j]; }
    ((bf16_t*)(a.ws + WS_ACT))[(size_t)as * 512 + j] = f2bf(siluf_(g) * u);
}
__global__ void __launch_bounds__(256) nv_moe2(Args a) {
    const int l = a.layer;
    const int as = blockIdx.y, c = blockIdx.x * 256 + threadIdx.x;
    const int row = as >> 1; if (l == DEPTH - 1 && row < NCTX) return;
    const int e = ((const int*)(a.ws + WS_ROUTE_E))[as];
    const bf16_t* ar = (const bf16_t*)(a.ws + WS_ACT) + (size_t)as * 512;
    const float* w2 = a.in[25] + ((size_t)l * 16 + e) * 512 * 1024;
    float acc = 0.f;
    for (int k = 0; k < 512; ++k) acc += bf2f(ar[k]) * w2[(size_t)k * 1024 + c];
    ((bf16_t*)(a.ws + WS_YS))[(size_t)as * 1024 + c] = f2bf(acc);
}


enum Op { OP_MODS = 0, OP_CONVERT, OP_PREP0, OP_INPROJ, OP_ATTN_G1, OP_SCAN, OP_YB, OP_MERGE1, OP_WO, OP_LN1, OP_SLOT, OP_UP, OP_DOWN, OP_COMBINE, OP_NONE };
constexpr int NSTEP_PRE = 2, NSTEP_LAYER = 11, NSTEPS = NSTEP_PRE + NSTEP_LAYER * DEPTH;
__host__ __device__ inline void decode_step(int step, int& op, int& l) {
    if (step < NSTEP_PRE) { l = 0; op = step == 0 ? OP_MODS : OP_PREP0; return; }
    const int s = step - NSTEP_PRE; l = s / NSTEP_LAYER; op = OP_INPROJ + s % NSTEP_LAYER;
}

#ifndef PROBE_XBAR
#define PROBE_XBAR 0
#endif
#ifndef PROBE_WO2
#define PROBE_WO2 0
#endif
#ifndef PROBE_LN12
#define PROBE_LN12 0
#endif
#ifndef PROBE_CMB2
#define PROBE_CMB2 0
#endif
#ifndef PROBE_ATT2
#define PROBE_ATT2 0
#endif
#ifndef PROBE_G12
#define PROBE_G12 0
#endif
#ifndef PROBE_OP
#define PROBE_OP -1
#endif
#ifndef PROBE_N
#define PROBE_N 1
#endif
#ifndef PROBE_PAD
#define PROBE_PAD 7
#endif
#ifndef ONLY_OP
#define ONLY_OP -1
#endif
#define EN(o) (ONLY_OP < 0 || ONLY_OP == (o))
__global__ void __launch_bounds__(512, 2) mk(Args a_in) {
    extern __shared__ __attribute__((aligned(16))) unsigned char lds[];
    const int tid = threadIdx.x;
    volatile LAS unsigned* MISC = (volatile LAS unsigned*)((LAS unsigned char*)lds + LDS_MISC);
    if (tid < 64) MISC[tid] = 0u;
    __syncthreads();
    XcdBarrier bar; bar.bar = (unsigned*)(a_in.ws + WS_CTL) + 4096; bar.x = 0; bar.st = nullptr;
    if (a_in.hi - a_in.lo > 1) bar = xcd_barrier_post((unsigned*)(a_in.ws + WS_CTL) + 4096, MISC + 8);
    const int G = gridDim.x;
#pragma unroll 1
    for (int step = a_in.lo; step < a_in.hi; ++step) {
        int op, l; decode_step(step, op, l);
        if ((op == OP_WO || op == OP_DOWN) && (a_in.hi - a_in.lo > 1)) continue;
        Args a = a_in;
        { unsigned z; asm volatile("s_mov_b32 %0, 0" : "=s"(z)); a.ws = a_in.ws + z; a.out = a_in.out + z;
#pragma unroll
          for (int i = 0; i < 28; ++i) a.in[i] = a_in.in[i] + z; }
#if PROBE_OP >= 0
        const int nrep_ = (op == PROBE_OP) ? 1 + PROBE_N : 1;
#pragma unroll 1
        for (int rep_ = 0; rep_ < nrep_; ++rep_) {
        const int padm_ = (rep_ > 0) ? PROBE_PAD : 7;
        if (rep_ > 0) xcd_barrier(bar);
#else
        const int padm_ = 7;
        {
#endif
        if (EN(OP_MODS) && op == OP_MODS) {
            ph_mods(a, lds);
            { const int t_ = tidx(); convert_run(a, 0, -1, blockIdx.x * 8 + (t_ >> 6), G * 8, (float*)(lds + 40960 + (t_ >> 6) * 8704), t_ & 63); }
            __syncthreads();
        }
        else if (EN(OP_PREP0) && op == OP_PREP0) ph_prep0(a, lds);
        else if (EN(OP_INPROJ) && op == OP_INPROJ) {
            pg8::Gemm g{(const bf16_t*)(a.ws + WS_H), (const bf16_t*)(a.ws + WS_WIN), TT, NPROJ, 1024};
            pg8::StaticOrder S; S.init(TT, NPROJ, G, (int)blockIdx.x);
            EpiInproj E{a.ws};
            pg8::gemm_phase<EpiInproj, pg8::StaticOrder, true, true>((LAS unsigned char*)lds, g, S, E);
        }
        else if (EN(OP_ATTN_G1) && op == OP_ATTN_G1) {
            if (a_in.pad & padm_ & 1) {
#if PROBE_ATT2
                ph_attn<PROBE_ATT2>(a, l, (LAS unsigned char*)lds); __syncthreads();
#endif
                ph_attn<0>(a, l, (LAS unsigned char*)lds);
            }
            if (a_in.pad & padm_ & 2) {
#if PROBE_G12
                ph_g1(a, l, lds, PROBE_G12 - 1); __syncthreads();
#endif
                ph_g1(a, l, lds);
            }
        }
        else if (EN(OP_SCAN) && op == OP_SCAN) {
            const int t_ = tidx(), w_ = t_ >> 6;
            const bool scanner = (a_in.pad & 4) && blockIdx.x < 32;
            const bool do_conv_ = (padm_ & 8) || (padm_ == 7);
            if (scanner) { if (padm_ & 4) ph_scan(a, l, lds); }
            else {
                const int nscan = (a_in.pad & 4) ? 32 : 0;
                const int rank = ((int)blockIdx.x - nscan) * 8 + w_;
                if (do_conv_) convert_run(a, l + 1, l, rank, (G - nscan) * 8, (float*)(lds + w_ * 16384), t_ & 63);
            }
            __syncthreads();
        }
        else if (EN(OP_YB) && op == OP_YB) ph_yb(a, l);
        else if (EN(OP_MERGE1) && op == OP_MERGE1) {
            {
                pg8::Gemm g{(const bf16_t*)(a.ws + WS_YAB), (const bf16_t*)(a.ws + WS_WPAB), 2 * TT, 2048, 512};
                SchedMerge1 S{G, (int)blockIdx.x, l == DEPTH - 1 ? 4 : 0, a.ws, l};
                EpiMerge1 E{a.ws};
                pg8::gemm_phase<EpiMerge1, SchedMerge1, true, true>((LAS unsigned char*)lds, g, S, E);
            }
            {
                pg8::Gemm g{(const bf16_t*)(a.ws + WS_M), (const bf16_t*)(a.ws + WS_WO), TT, 1024, 1024};
                SchedWoWait S{G, (int)blockIdx.x, l == DEPTH - 1 ? 4 : 0, a.ws, l};
                EpiWo E{a.ws, l, 0};
                pg8::gemm_phase<EpiWo, SchedWoWait, true, true>((LAS unsigned char*)lds, g, S, E);
            }
        }
        else if (EN(OP_LN1) && op == OP_LN1) {
#if PROBE_LN12
            ph_ln1_router(a, l, lds, PROBE_LN12); __syncthreads();
#endif
            ph_ln1_router(a, l, lds);
        }
        else if (EN(OP_SLOT) && op == OP_SLOT) ph_slot(a, l, lds);
        else if (EN(OP_UP) && op == OP_UP) {
            const int* meta = (const int*)(a.ws + WS_META);
            const int ntl = meta[META_NT];
            {
                pg8::Gemm g{(const bf16_t*)(a.ws + WS_XS), (const bf16_t*)(a.ws + WS_W13), NSLOT, 16384, 1024};
                SchedMoe S{G, (int)blockIdx.x, ntl, meta + META_TE, a.ws, l, 1};
                EpiUp E{a.ws};
                pg8::gemm_phase<EpiUp, SchedMoe, true, true>((LAS unsigned char*)lds, g, S, E);
            }
            {
                pg8::Gemm g{(const bf16_t*)(a.ws + WS_ACT), (const bf16_t*)(a.ws + WS_W2), NSLOT, 16384, 512};
                SchedMoe S{G, (int)blockIdx.x, ntl, meta + META_TE, a.ws, l, 2};
                EpiDown E{a.ws};
                pg8::gemm_phase<EpiDown, SchedMoe, true, true>((LAS unsigned char*)lds, g, S, E);
            }
        }
        else if (EN(OP_COMBINE) && op == OP_COMBINE) {
#if PROBE_CMB2
            ph_combine_ln2(a, l, lds, 1); __syncthreads();
#endif
            ph_combine_ln2(a, l, lds);
        }
        }
        if (step + 1 < a_in.hi) { xcd_barrier(bar);
#if PROBE_XBAR
            for (int xb_ = 0; xb_ < PROBE_XBAR; ++xb_) xcd_barrier(bar);
#endif
        }
    }
}

#ifndef FAST_MASK
#define FAST_MASK 0xffffffffu
#endif
#ifndef MK_SINGLE
#define MK_SINGLE 1
#endif
#ifndef FAST_ATTN
#define FAST_ATTN 1
#endif
#ifndef FAST_G1
#define FAST_G1 1
#endif
#ifndef FAST_SCAN
#define FAST_SCAN 1
#endif
static bool op_fast(int op) {
    if (op == OP_ATTN_G1) return false;
    if (op == OP_SCAN) return FAST_SCAN != 0;
    return (FAST_MASK >> op) & 1u;
}
extern "C" void kernel_launch(void* const* d_in, const int* in_sizes, int n_in, void* d_out, int out_size, void* d_ws, size_t ws_size, hipStream_t stream) {
    if (n_in != 28 || ws_size < WS_END) { fprintf(stderr, "kernel_launch: unexpected n_in %d / ws_size %zu (need %zu)\n", n_in, ws_size, (size_t)WS_END); return; }
    Args a{};
    for (int i = 0; i < 28; ++i) a.in[i] = (const float*)d_in[i];
    a.out = (float*)d_out; a.ws = (unsigned char*)d_ws;
    static bool attr_done = false;
    if (!attr_done) {
        if (hipFuncSetAttribute((const void*)mk, hipFuncAttributeMaxDynamicSharedMemorySize, LDS_BYTES) != hipSuccess) fprintf(stderr, "hipFuncSetAttribute failed\n");
        attr_done = true;
    }
    hipMemsetAsync((char*)d_ws + WS_CTL, 0, 1 * MiB, stream);
#if MK_SINGLE
    a.lo = 0; a.hi = NSTEPS; a.pad = 7;
    hipLaunchKernelGGL(mk, dim3(256), dim3(512), LDS_BYTES, stream, a);
#else
    for (int step = 0; step < NSTEPS; ++step) {
        int op, l; decode_step(step, op, l);
        a.layer = l;
        if (op == OP_ATTN_G1) {
            if (FAST_ATTN || FAST_G1) { a.lo = step; a.hi = step + 1; a.pad = (FAST_ATTN ? 1 : 0) | (FAST_G1 ? 2 : 0); hipLaunchKernelGGL(mk, dim3(256), dim3(512), LDS_BYTES, stream, a); a.pad = 0; a.lo = 0; a.hi = 0; }
            if (!FAST_ATTN) {
                hipLaunchKernelGGL(nv_attn, dim3(TT / 256, 16), dim3(256), 0, stream, a);
                hipLaunchKernelGGL(nv_attn_combine, dim3(TT * 4 / 256), dim3(256), 0, stream, a);
            }
            if (!FAST_G1) {
                hipLaunchKernelGGL(nv_conv, dim3(1536 / 256, TT), dim3(256), 0, stream, a);
                hipLaunchKernelGGL(nv_norm, dim3(TT * 8 / 256), dim3(256), 0, stream, a);
            }
            continue;
        }
        if (op == OP_SCAN) {
            a.lo = step; a.hi = step + 1; a.pad = FAST_SCAN ? 4 : 0; hipLaunchKernelGGL(mk, dim3(256), dim3(512), LDS_BYTES, stream, a); a.pad = 0; a.lo = 0; a.hi = 0;
            if (!FAST_SCAN) hipLaunchKernelGGL(nv_scan, dim3(32), dim3(128), 0, stream, a);
            continue;
        }
        if (op_fast(op)) { a.lo = step; a.hi = step + 1; hipLaunchKernelGGL(mk, dim3(256), dim3(512), LDS_BYTES, stream, a); continue; }
        a.lo = 0; a.hi = 0;
        switch (op) {
        case OP_INPROJ: hipLaunchKernelGGL(nv_inproj, dim3(NPROJ / 256, TT), dim3(256), 0, stream, a); break;
        case OP_MERGE1: hipLaunchKernelGGL(nv_merge1, dim3(4, TT), dim3(256), 0, stream, a); break;
        case OP_WO: hipLaunchKernelGGL(nv_wo, dim3(4, TT), dim3(256), 0, stream, a); break;
        case OP_SLOT: break;
        case OP_UP: hipLaunchKernelGGL(nv_moe1, dim3(2, NASSIGN), dim3(256), 0, stream, a); break;
        case OP_DOWN: hipLaunchKernelGGL(nv_moe2, dim3(4, NASSIGN), dim3(256), 0, stream, a); break;
        default: fprintf(stderr, "no naive kernel for op %d\n", op); break;
        }
    }
#endif
}
```

```cpp
#include <hip/hip_runtime.h>
#include <cstdio>
#include <cstdint>

#define DI __device__ __forceinline__
typedef unsigned short bf16_t;
typedef short bf16x8 __attribute__((ext_vector_type(8)));
typedef float f32x4 __attribute__((ext_vector_type(4)));
typedef float f32x2 __attribute__((ext_vector_type(2)));
typedef float f32x16 __attribute__((ext_vector_type(16)));
typedef unsigned u32x4 __attribute__((ext_vector_type(4)));
typedef unsigned u32x2 __attribute__((ext_vector_type(2)));
typedef __bf16 bf16x2_t __attribute__((ext_vector_type(2)));

constexpr int D = 1024, NB = 4, SEQ = 4096, CTX = 256, DEPTH = 4;
constexpr int NCTX = NB * CTX;
constexpr int TT = NCTX + NB * SEQ;
constexpr int N_IN = 5648, NPROJ = 5632;
constexpr int NE = 16;
constexpr float EPS = 1e-6f;
constexpr float ALPHA = 1.681792830507429f;
constexpr float QSCALE = 0.125f * 1.4426950408889634f;
constexpr int NASSIGN = TT * 2;
constexpr int NSLOT = NASSIGN + NE * 256;

constexpr size_t MiB = 1u << 20;
constexpr size_t WS_CTL = 0;
constexpr size_t WS_MODS = 1 * MiB;
constexpr size_t WS_ROPE = 2 * MiB;
constexpr size_t WS_META = 2 * MiB + 65536;
constexpr size_t WS_ROUTE_E = 3 * MiB;
constexpr size_t WS_ROUTE_W = 3 * MiB + 262144;
constexpr size_t WS_DEST = 3 * MiB + 524288;
constexpr size_t WS_SLOTA = 3 * MiB + 786432;
constexpr size_t WS_AB = 4 * MiB;
constexpr size_t WS_GL = 6 * MiB;
constexpr size_t WS_WIN = 8 * MiB;
constexpr size_t WS_WPAB = 20 * MiB;
constexpr size_t WS_WO = 22 * MiB;
constexpr size_t WS_W13 = 24 * MiB;
constexpr size_t WS_W2 = 56 * MiB;
constexpr size_t WS_X = 72 * MiB;
constexpr size_t WS_H = 140 * MiB;
constexpr size_t WS_QA = 174 * MiB;
constexpr size_t WS_KA = 191 * MiB;
constexpr size_t WS_VA = 208 * MiB;
constexpr size_t WS_QKV = 225 * MiB;
constexpr size_t WS_Z = 276 * MiB;
constexpr size_t WS_SG = 293 * MiB;
constexpr size_t WS_GPRE = 361 * MiB;
constexpr size_t WS_OF = 514 * MiB;
constexpr size_t WS_OB = 531 * MiB;
constexpr size_t WS_YAB = 548 * MiB;
constexpr size_t WS_M = 582 * MiB;
constexpr size_t WS_END = 616 * MiB;
constexpr size_t WS_XS = 174 * MiB;
constexpr size_t WS_ACT = 250 * MiB;
constexpr size_t WS_YS = 288 * MiB;
constexpr size_t WS_ON = 361 * MiB;
constexpr size_t WS_CONVO = 361 * MiB;

DI float bf2f(bf16_t v) { return __uint_as_float(((unsigned)v) << 16); }
DI unsigned pk2(float lo, float hi) { f32x2 v = {lo, hi}; bf16x2_t b = __builtin_convertvector(v, bf16x2_t); return __builtin_bit_cast(unsigned, b); }
DI bf16_t f2bf(float f) { return (bf16_t)(pk2(f, 0.f) & 0xffffu); }
DI float sigmoidf_(float x) { return __builtin_amdgcn_rcpf(1.f + __builtin_amdgcn_exp2f(-1.4426950408889634f * x)); }
DI float siluf_(float x) { return x * __builtin_amdgcn_rcpf(1.f + __builtin_amdgcn_exp2f(-1.4426950408889634f * x)); }
DI float softplusf_(float x) { return fmaxf(x, 0.f) + log1pf(__expf(-fabsf(x))); }
template <int CTRL> DI float dppmov(float v) { return __uint_as_float(__builtin_amdgcn_update_dpp(0u, __float_as_uint(v), CTRL, 0xf, 0xf, true)); }
DI float xor32(float x, bool hi32) { auto rr = __builtin_amdgcn_permlane32_swap(__float_as_uint(x), __float_as_uint(x), false, false); return __uint_as_float(hi32 ? rr[0] : rr[1]); }
DI float xor16(float x, bool odd16) { auto rr = __builtin_amdgcn_permlane16_swap(__float_as_uint(x), __float_as_uint(x), false, false); return __uint_as_float(odd16 ? rr[0] : rr[1]); }
DI float wave_sum(float v) {
    v += dppmov<0xB1>(v); v += dppmov<0x4E>(v); v += dppmov<0x124>(v); v += dppmov<0x128>(v);
    { auto rr = __builtin_amdgcn_permlane16_swap(__float_as_uint(v), __float_as_uint(v), false, false); v = __uint_as_float(rr[0]) + __uint_as_float(rr[1]); }
    { auto rr = __builtin_amdgcn_permlane32_swap(__float_as_uint(v), __float_as_uint(v), false, false); v = __uint_as_float(rr[0]) + __uint_as_float(rr[1]); }
    return v;
}
DI int jj16_of_lane(int lane) { return ((lane >> 5) & 1) * 8 + ((lane >> 4) & 1) * 4 + ((lane >> 3) & 1) * 2 + ((lane >> 2) & 1); }
DI int lane_of_jj16(int jj) { return 32 * (jj >> 3) + 16 * ((jj >> 2) & 1) + 8 * ((jj >> 1) & 1) + 4 * (jj & 1); }
DI float reduce16(const float (&p)[16], int lane) {
    const bool b5 = lane & 32, b4 = lane & 16, b3 = lane & 8, b2 = lane & 4;
    float q8[8], q4[4], q2[2];
#pragma unroll
    for (int j = 0; j < 8; ++j) { const float keep = b5 ? p[j + 8] : p[j], send = b5 ? p[j] : p[j + 8]; q8[j] = keep + xor32(send, b5); }
#pragma unroll
    for (int j = 0; j < 4; ++j) { const float keep = b4 ? q8[j + 4] : q8[j], send = b4 ? q8[j] : q8[j + 4]; q4[j] = keep + xor16(send, b4); }
#pragma unroll
    for (int j = 0; j < 2; ++j) { const float keep = b3 ? q4[j + 2] : q4[j], send = b3 ? q4[j] : q4[j + 2]; q2[j] = keep + dppmov<0x128>(send); }
    float q1;
    { const float keep = b2 ? q2[1] : q2[0], send = b2 ? q2[0] : q2[1]; const float pa = dppmov<0x124>(send), pb = dppmov<0x12C>(send); q1 = keep + (b2 ? pa : pb); }
    q1 += dppmov<0x4E>(q1); q1 += dppmov<0xB1>(q1);
    return q1;
}
DI int mod_set(int row) { return row < NCTX ? 4 : ((row - NCTX) >> 12); }
DI float lam_init_of(int l) { return 0.8f - 0.6f * __expf(-0.3f * (float)l); }

DI int tidx() { int t = threadIdx.x; asm volatile("" : "+v"(t)); return t; }

struct Args {
    const float* in[28];
    float* out;
    unsigned char* ws;
    int lo, hi, layer, pad;
};


namespace pg8 {
#define PG8_LAS __attribute__((address_space(3)))
typedef unsigned short bf16_t;
typedef short bf16x8 __attribute__((ext_vector_type(8)));
typedef float f32x4 __attribute__((ext_vector_type(4)));
typedef unsigned u32x4 __attribute__((ext_vector_type(4)));
constexpr int BM = 256, BK = 64, HALF = 128, HTB = HALF * BK * 2  , STAGE_BYTES = 8 * HTB, NXCD = 8, WGM = 8;

__host__ __device__ __forceinline__ int lds_byte(int r, int c) { const int st = (r >> 4) * 2 + (c >> 5), rr = r & 15, cc = c & 31, ob = rr * 64 + cc * 2; return st * 1024 + (ob ^ (((ob >> 9) & 1) << 5)); }
__host__ __device__ __forceinline__ void stage_rc(int b, int& R, int& C) { const int st = b / 1024, sb = b % 1024, swz = sb ^ (((sb >> 9) & 1) << 5); R = (st >> 1) * 16 + swz / 64; C = (st & 1) * 32 + (swz % 64) / 2; }
__host__ __device__ __forceinline__ int perm32(int rho) { const int n = rho >> 4, i = rho & 15; return 8 * (i >> 2) + 4 * n + (i & 3); }

struct Unit { int pm, pn; };
struct Gemm { const bf16_t* A; const bf16_t* Bt; int M, N, K; };

struct StaticOrder {
    int nM, nN, nwg, G, c;
    __host__ __device__ void init(int M, int N, int G_, int c_) { nM = M / BM; nN = N / BM; nwg = nM * nN; G = G_; c = c_; }
    __host__ __device__ bool next(int i, Unit& u) const {
        const long L = (long)i * G + c; if (L >= nwg) return false;
        int wgid = (int)L; { const int q = nwg / NXCD, r = nwg % NXCD, xcd = wgid % NXCD, off = wgid / NXCD; wgid = (xcd < r ? xcd * (q + 1) : r * (q + 1) + (xcd - r) * q) + off; }
        const int nig = WGM * nN, gid = wgid / nig, fm = gid * WGM, gsz = (nM - fm) < WGM ? (nM - fm) : WGM;
        u.pm = fm + ((wgid % nig) % gsz); u.pn = (wgid % nig) / gsz; return true;
    }
    __device__ __forceinline__ void a_ready(const Unit&) const {}
    __device__ __forceinline__ void done(const Unit&) const {}
};

template <class Epi, class Sched, bool ALIGN_EPI = false, bool SP2 = false>
__device__ __forceinline__ void gemm_phase(PG8_LAS unsigned char* lds, const Gemm g, const Sched& S, const Epi& E) {
    const int tid = tidx(), wid = __builtin_amdgcn_readfirstlane(tid >> 6), lane = tid & 63, wr = wid >> 2, wc = wid & 3, fr = lane & 15, fq = lane >> 4;
    const int K = g.K, nt = K / BK;
    unsigned voffA[2], voffB[2];
#pragma unroll
    for (int i = 0; i < 2; ++i) { int R, C; stage_rc(tid * 16 + i * 8192, R, C); const int Rb = Epi::PERM ? ((R & ~31) + perm32(R & 31)) : R;
        voffA[i] = (unsigned)(R * K + C) * 2u; voffB[i] = (unsigned)(Rb * K + C) * 2u; }
    const size_t kstep = (size_t)(BK * 2);
    const size_t hstep = (size_t)HALF * K * 2;
    const size_t tstep = 2 * hstep;
    const unsigned ldsw = (unsigned)wid * 1024u;
    const int aoff = lds_byte(wr * 64 + fr, fq * 8), boff = lds_byte(wc * 32 + fr, fq * 8);
#define PG8_SA(b, h) (((b) * 2 + (h)) * HTB)
#define PG8_SB(b, h) ((4 + (b) * 2 + (h)) * HTB)
#define PG8_STAGE(bufoff, gbase, voff) do { _Pragma("unroll") for (int _i = 0; _i < 2; ++_i) \
        __builtin_amdgcn_global_load_lds((const unsigned*)((const char*)(gbase) + (voff)[_i]), (PG8_LAS unsigned*)(lds + (bufoff) + ldsw + _i * 8192), 16, 0, 0); } while (0)
#define PG8_LDA(dst, b, h) do { _Pragma("unroll") for (int m = 0; m < 4; ++m) _Pragma("unroll") for (int k = 0; k < 2; ++k) dst[m][k] = *(const PG8_LAS bf16x8*)(lds + PG8_SA(b, h) + aoff + m * 2048 + k * 1024); } while (0)
#define PG8_LDB(dst, b, h) do { _Pragma("unroll") for (int n = 0; n < 2; ++n) _Pragma("unroll") for (int k = 0; k < 2; ++k) dst[n][k] = *(const PG8_LAS bf16x8*)(lds + PG8_SB(b, h) + boff + n * 2048 + k * 1024); } while (0)
#define PG8_MMA(ai, bj, At, Bt) do { __builtin_amdgcn_s_setprio(1); _Pragma("unroll") for (int m = 0; m < 4; ++m) _Pragma("unroll") for (int n = 0; n < 2; ++n) _Pragma("unroll") for (int k = 0; k < 2; ++k) \
        acc[ai][bj][m][n] = __builtin_amdgcn_mfma_f32_16x16x32_bf16(Bt[n][k], At[m][k], acc[ai][bj][m][n], 0, 0, 0); __builtin_amdgcn_s_setprio(0); } while (0)
#define PG8_WAIT_V(n) asm volatile("s_waitcnt vmcnt(" #n ")" ::: "memory")
#define PG8_WAIT_L(n) asm volatile("s_waitcnt lgkmcnt(" #n ")" ::: "memory")
#define PG8_BAR __builtin_amdgcn_s_barrier()
#define PG8_SCHED __builtin_amdgcn_sched_barrier(0)
    Unit cur, nxt; int ui = 0;
    if (!S.next(0, cur)) return;
    f32x4 acc[2][2][4][2];
#pragma unroll
    for (int a = 0; a < 2; ++a)
#pragma unroll
        for (int b = 0; b < 2; ++b)
#pragma unroll
            for (int m = 0; m < 4; ++m)
#pragma unroll
                for (int n = 0; n < 2; ++n) acc[a][b][m][n] = (f32x4){0.f, 0.f, 0.f, 0.f};
    bf16x8 At[4][2], B0[2][2], B1[2][2];
    const char* cA = (const char*)g.A + (size_t)cur.pm * tstep; const char* cB = (const char*)g.Bt + (size_t)cur.pn * tstep;
    S.a_ready(cur);
    if constexpr (SP2) {
        PG8_STAGE(PG8_SB(0, 0), cB, voffB); PG8_STAGE(PG8_SB(0, 1), cB + hstep, voffB); PG8_STAGE(PG8_SA(0, 0), cA, voffA); PG8_STAGE(PG8_SA(0, 1), cA + hstep, voffA);
        if (wr == 1) PG8_BAR;
        PG8_WAIT_V(2); PG8_BAR;
        PG8_STAGE(PG8_SB(1, 0), cB + kstep, voffB); PG8_STAGE(PG8_SA(1, 0), cA + kstep, voffA); PG8_STAGE(PG8_SB(1, 1), cB + hstep + kstep, voffB);
        PG8_WAIT_V(6); PG8_BAR;
    } else {
        PG8_STAGE(PG8_SB(0, 0), cB, voffB); PG8_STAGE(PG8_SA(0, 0), cA, voffA); PG8_STAGE(PG8_SB(0, 1), cB + hstep, voffB); PG8_STAGE(PG8_SA(0, 1), cA + hstep, voffA);
        if (wr == 1) PG8_BAR;
        PG8_WAIT_V(4); PG8_BAR;
        PG8_STAGE(PG8_SB(1, 0), cB + kstep, voffB); PG8_STAGE(PG8_SA(1, 0), cA + kstep, voffA); PG8_STAGE(PG8_SB(1, 1), cB + hstep + kstep, voffB);
        PG8_WAIT_V(6); PG8_BAR;
    }
    for (;;) {
        const bool has_next = S.next(ui + 1, nxt);
        const char* nA = has_next ? (const char*)g.A + (size_t)nxt.pm * tstep : cA; const char* nB = has_next ? (const char*)g.Bt + (size_t)nxt.pn * tstep : cB;
        for (int t = 0; t < nt; t += 2) {
            const bool last = (t == nt - 2);
            const char* a1 = cA + (size_t)(t + 1) * kstep;
            const char* a2 = last ? nA : cA + (size_t)(t + 2) * kstep; const char* b2 = last ? nB : cB + (size_t)(t + 2) * kstep;
            const char* a3 = a2 + kstep; const char* b3 = b2 + kstep;
            if (last && has_next) S.a_ready(nxt);
            if constexpr (SP2) {
            PG8_LDB(B0, 0, 0); PG8_LDB(B1, 0, 1); PG8_SCHED; PG8_LDA(At, 0, 0); PG8_STAGE(PG8_SA(1, 1), a1 + hstep, voffA);
            PG8_WAIT_V(8); PG8_WAIT_L(0); PG8_BAR; PG8_MMA(0, 0, At, B0); PG8_MMA(0, 1, At, B1); PG8_BAR; PG8_SCHED;
            PG8_LDA(At, 0, 1); PG8_STAGE(PG8_SB(0, 0), b2, voffB); PG8_STAGE(PG8_SB(0, 1), b2 + hstep, voffB); PG8_STAGE(PG8_SA(0, 0), a2, voffA);
            PG8_WAIT_V(8); PG8_WAIT_L(0); PG8_BAR; PG8_MMA(1, 0, At, B0); PG8_MMA(1, 1, At, B1); PG8_BAR; PG8_SCHED;
            PG8_LDB(B0, 1, 0); PG8_LDB(B1, 1, 1); PG8_SCHED; PG8_LDA(At, 1, 0); PG8_STAGE(PG8_SA(0, 1), a2 + hstep, voffA);
            PG8_WAIT_V(8); PG8_WAIT_L(0); PG8_BAR; PG8_MMA(0, 0, At, B0); PG8_MMA(0, 1, At, B1); PG8_BAR; PG8_SCHED;
            PG8_LDA(At, 1, 1); PG8_STAGE(PG8_SB(1, 0), b3, voffB); PG8_STAGE(PG8_SB(1, 1), b3 + hstep, voffB); PG8_STAGE(PG8_SA(1, 0), a3, voffA);
            PG8_WAIT_V(8); PG8_WAIT_L(0); PG8_BAR; PG8_MMA(1, 0, At, B0); PG8_MMA(1, 1, At, B1); PG8_BAR; PG8_SCHED;
            } else {
            PG8_LDB(B0, 0, 0); PG8_SCHED; PG8_LDA(At, 0, 0); PG8_STAGE(PG8_SA(1, 1), a1 + hstep, voffA);
            PG8_WAIT_L(8); PG8_BAR; PG8_WAIT_L(0); PG8_MMA(0, 0, At, B0); PG8_BAR; PG8_SCHED;
            PG8_LDB(B1, 0, 1); PG8_STAGE(PG8_SB(0, 0), b2, voffB);
            PG8_BAR; PG8_WAIT_L(0); PG8_MMA(0, 1, At, B1); PG8_BAR;
            PG8_LDA(At, 0, 1); PG8_STAGE(PG8_SA(0, 0), a2, voffA);
            PG8_BAR; PG8_WAIT_L(0); PG8_MMA(1, 0, At, B0); PG8_BAR; PG8_SCHED;
            PG8_STAGE(PG8_SB(0, 1), b2 + hstep, voffB);
            PG8_WAIT_V(6); PG8_BAR; PG8_MMA(1, 1, At, B1); PG8_BAR;
            PG8_LDB(B0, 1, 0); PG8_SCHED; PG8_LDA(At, 1, 0); PG8_STAGE(PG8_SA(0, 1), a2 + hstep, voffA);
            PG8_WAIT_L(8); PG8_BAR; PG8_WAIT_L(0); PG8_MMA(0, 0, At, B0); PG8_BAR; PG8_SCHED;
            PG8_LDB(B1, 1, 1); PG8_STAGE(PG8_SB(1, 0), b3, voffB);
            PG8_BAR; PG8_WAIT_L(0); PG8_MMA(0, 1, At, B1); PG8_BAR;
            PG8_LDA(At, 1, 1); PG8_STAGE(PG8_SA(1, 0), a3, voffA);
            PG8_BAR; PG8_WAIT_L(0); PG8_MMA(1, 0, At, B0); PG8_BAR; PG8_SCHED;
            PG8_STAGE(PG8_SB(1, 1), b3 + hstep, voffB);
            PG8_WAIT_V(6); PG8_BAR; PG8_MMA(1, 1, At, B1); PG8_BAR;
            }
        }
        if constexpr (ALIGN_EPI) { if (wr == 0) PG8_BAR; }
        if constexpr (!Epi::AFTER_DRAIN) { E(acc, cur, wr, wc, fr, fq); S.done(cur); }
        if (!has_next) break;
#pragma unroll
        for (int a = 0; a < 2; ++a)
#pragma unroll
            for (int b = 0; b < 2; ++b)
#pragma unroll
                for (int m = 0; m < 4; ++m)
#pragma unroll
                    for (int n = 0; n < 2; ++n) acc[a][b][m][n] = (f32x4){0.f, 0.f, 0.f, 0.f};
        cur = nxt; cA = nA; cB = nB; ++ui;
        if constexpr (ALIGN_EPI) { if (wr == 1) PG8_BAR; }
    }
    PG8_WAIT_V(0);
    if constexpr (!ALIGN_EPI) { if (wr == 0) PG8_BAR; }
    PG8_BAR;
    if constexpr (Epi::AFTER_DRAIN) { E.fused(acc, cur, wr, wc, fr, fq, lds, wid, lane); S.done(cur); }
#undef PG8_SA
#undef PG8_SB
#undef PG8_STAGE
#undef PG8_LDA
#undef PG8_LDB
#undef PG8_MMA
#undef PG8_WAIT_V
#undef PG8_WAIT_L
#undef PG8_BAR
#undef PG8_SCHED
}
}

#define LAS __attribute__((address_space(3)))
constexpr int LDS_BYTES = 147456;
constexpr int LDS_MISC = 131072 + 8192;

DI void ph_mods(const Args& a, unsigned char* lds) {
    float (*sc)[1024] = (float (*)[1024])lds;
    float (*red)[5][128] = (float (*)[5][128])(lds + 20480);
    const float* c = a.in[1]; const float* cctx = a.in[3]; const float* mod_w = a.in[4]; const float* mod_b = a.in[5];
    float* mods = (float*)(a.ws + WS_MODS);
    const int tid = tidx(), lane = tid & 63, wid = tid >> 6;
    for (int i = tid; i < 5 * 1024; i += 512) { int s = i >> 10, k = i & 1023; float v = s < 4 ? c[s * 1024 + k] : cctx[k]; sc[s][k] = siluf_(v); }
    __syncthreads();
    for (int item = blockIdx.x; item < DEPTH * 48; item += gridDim.x) {
        const int l = item / 48, c0 = (item % 48) * 128;
        const int half = lane >> 5, cg = lane & 31;
        f32x4 acc[5];
#pragma unroll
        for (int s = 0; s < 5; ++s) acc[s] = (f32x4){0.f, 0.f, 0.f, 0.f};
        const float* wp = mod_w + (size_t)l * 1024 * 6144 + c0 + 4 * cg;
#pragma unroll 4
        for (int kk = 0; kk < 64; ++kk) {
            const int k = wid * 128 + 2 * kk + half;
            const f32x4 w = *(const f32x4*)(wp + (size_t)k * 6144);
#pragma unroll
            for (int s = 0; s < 5; ++s) acc[s] += w * sc[s][k];
        }
#pragma unroll
        for (int s = 0; s < 5; ++s) {
#pragma unroll
            for (int j = 0; j < 4; ++j) { float v = acc[s][j]; v += __shfl_xor(v, 32); acc[s][j] = v; }
            if (half == 0) {
#pragma unroll
                for (int j = 0; j < 4; ++j) red[wid][s][4 * cg + j] = acc[s][j];
            }
        }
        __syncthreads();
        for (int i = tid; i < 5 * 128; i += 512) {
            const int s = i >> 7, cc = i & 127; float v = 0.f;
#pragma unroll
            for (int w = 0; w < 8; ++w) v += red[w][s][cc];
            mods[((size_t)l * 5 + s) * 6144 + c0 + cc] = v + mod_b[l * 6144 + c0 + cc];
        }
        __syncthreads();
    }
    if (blockIdx.x == gridDim.x - 1) {
        float* rope = (float*)(a.ws + WS_ROPE);
        for (int i = tid; i < 64 * 16; i += 512) {
            const int pos = i >> 4, f = i & 15;
            const float inv = powf(10000.0f, -(float)f / 16.0f);
            const float ang = (float)pos * inv;
            rope[2 * i] = cosf(ang); rope[2 * i + 1] = sinf(ang);
        }
    }
}

DI void row_ln(f32x4 (&v)[4], const float* g, const float* b, int lane) {
    float s = 0.f;
#pragma unroll
    for (int j = 0; j < 4; ++j) s += (v[j][0] + v[j][1]) + (v[j][2] + v[j][3]);
    const float mean = wave_sum(s) * (1.f / 1024.f);
    float q = 0.f;
#pragma unroll
    for (int j = 0; j < 4; ++j) { v[j] = v[j] - mean; q += (v[j][0] * v[j][0] + v[j][1] * v[j][1]) + (v[j][2] * v[j][2] + v[j][3] * v[j][3]); }
    const float rstd = rsqrtf(wave_sum(q) * (1.f / 1024.f) + EPS);
#pragma unroll
    for (int j = 0; j < 4; ++j) {
        const f32x4 gg = *(const f32x4*)(g + 256 * j + 4 * lane), bb = *(const f32x4*)(b + 256 * j + 4 * lane);
        v[j] = v[j] * rstd * gg + bb;
    }
}
DI void row_ln_r(f32x4 (&v)[4], const f32x4 (&gg)[4], const f32x4 (&bb)[4]) {
    float s = 0.f;
#pragma unroll
    for (int j = 0; j < 4; ++j) s += (v[j][0] + v[j][1]) + (v[j][2] + v[j][3]);
    const float mean = wave_sum(s) * (1.f / 1024.f);
    float q = 0.f;
#pragma unroll
    for (int j = 0; j < 4; ++j) { v[j] = v[j] - mean; q += (v[j][0] * v[j][0] + v[j][1] * v[j][1]) + (v[j][2] * v[j][2] + v[j][3] * v[j][3]); }
    const float rstd = rsqrtf(wave_sum(q) * (1.f / 1024.f) + EPS);
#pragma unroll
    for (int j = 0; j < 4; ++j) v[j] = v[j] * rstd * gg[j] + bb[j];
}
DI void row_modulate(f32x4 (&h)[4], const f32x4 (&x)[4], const float* shift, const float* scale, int lane) {
#pragma unroll
    for (int j = 0; j < 4; ++j) {
        const f32x4 sh = *(const f32x4*)(shift + 256 * j + 4 * lane), scl = *(const f32x4*)(scale + 256 * j + 4 * lane);
        h[j] = x[j] * (1.f + scl) + sh;
    }
}
DI void row_store_bf16(bf16_t* dst, const f32x4 (&h)[4], int lane) {
#pragma unroll
    for (int j = 0; j < 4; ++j) { u32x2 w; w.x = pk2(h[j][0], h[j][1]); w.y = pk2(h[j][2], h[j][3]); *(u32x2*)(dst + 256 * j + 4 * lane) = w; }
}
DI float row_gemv16(const f32x4 (&h)[4], const float* WT, int lane) {
    float p[16];
#pragma unroll
    for (int jj = 0; jj < 16; ++jj) {
        float acc = 0.f;
#pragma unroll
        for (int j = 0; j < 4; ++j) { const f32x4 w = *(const f32x4*)(WT + jj * 1024 + 256 * j + 4 * lane); acc += (h[j][0] * w[0] + h[j][1] * w[1]) + (h[j][2] * w[2] + h[j][3] * w[3]); }
        asm volatile("" : "+v"(acc));
        p[jj] = acc;
    }
    return reduce16(p, lane);
}
DI void stage_wt16(float* WT, const float* W, int ld, int col0, int tid) {
    for (int c = tid; c < 1024; c += 512) {
        const float* p = W + (size_t)c * ld + col0;
#pragma unroll
        for (int q = 0; q < 4; ++q) { const f32x4 w = *(const f32x4*)(p + 4 * q);
#pragma unroll
            for (int i = 0; i < 4; ++i) WT[(4 * q + i) * 1024 + c] = w[i]; }
    }
}

DI void ph_prep0(const Args& a, unsigned char* lds) {
    float* WT = (float*)lds;
    const int tid = tidx(), lane = tid & 63, wid = tid >> 6;
    stage_wt16(WT, a.in[6], N_IN, 3584, tid);
    __syncthreads();
    const float* mods = (const float*)(a.ws + WS_MODS);
    float* X = (float*)(a.ws + WS_X); bf16_t* H = (bf16_t*)(a.ws + WS_H); float* AB = (float*)(a.ws + WS_AB);
    const int rstride = gridDim.x * 8;
    f32x4 xn[4];
    { const int row = blockIdx.x * 8 + wid; const float* src = row < NCTX ? a.in[2] + (size_t)row * 1024 : a.in[0] + (size_t)(row - NCTX) * 1024;
#pragma unroll
      for (int j = 0; j < 4; ++j) xn[j] = *(const f32x4*)(src + 256 * j + 4 * lane); }
#pragma unroll 1
    for (int row = blockIdx.x * 8 + wid; row < TT; row += rstride) {
        f32x4 x[4], h[4];
#pragma unroll
        for (int j = 0; j < 4; ++j) x[j] = xn[j];
        { const int rn = row + rstride; if (rn < TT) { const float* src = rn < NCTX ? a.in[2] + (size_t)rn * 1024 : a.in[0] + (size_t)(rn - NCTX) * 1024;
#pragma unroll
            for (int j = 0; j < 4; ++j) xn[j] = *(const f32x4*)(src + 256 * j + 4 * lane); } }
#pragma unroll
        for (int j = 0; j < 4; ++j) *(f32x4*)(X + (size_t)row * 1024 + 256 * j + 4 * lane) = x[j];
        const float* m = mods + (size_t)(0 * 5 + mod_set(row)) * 6144;
        row_modulate(h, x, m, m + 1024, lane);
        row_store_bf16(H + (size_t)row * 1024, h, lane);
        { const float abv = row_gemv16(h, WT, lane); if ((lane & 3) == 0) AB[(size_t)row * 16 + jj16_of_lane(lane)] = abv; }
    }
    __syncthreads();
}

DI void ph_yb(const Args& a, int l) {
    const int tid = tidx(), lane = tid & 63, wid = tid >> 6;
    const bf16_t* OF = (const bf16_t*)(a.ws + WS_OF); const bf16_t* OB = (const bf16_t*)(a.ws + WS_OB); const bf16_t* Z = (const bf16_t*)(a.ws + WS_Z);
    bf16_t* YB = (bf16_t*)(a.ws + WS_YAB) + (size_t)TT * 512;
    const float* ogp = a.in[15] + l * 128 + ((8 * lane) & 127);
    float og[8];
#pragma unroll
    for (int i = 0; i < 8; ++i) og[i] = ogp[i];
    const int rstride = gridDim.x * 8;
    int row0 = blockIdx.x * 8 + wid; if (l == DEPTH - 1) { while (row0 < NCTX) row0 += rstride; }
    u32x4 fn = (u32x4){0u, 0u, 0u, 0u}, bn = fn, zn = fn;
    if (row0 < TT) { const size_t o0 = (size_t)row0 * 512 + 8 * lane; fn = *(const u32x4*)(OF + o0); bn = *(const u32x4*)(OB + o0); zn = *(const u32x4*)(Z + o0); }
#pragma unroll 1
    for (int row = row0; row < TT; row += rstride) {
        const size_t off = (size_t)row * 512 + 8 * lane;
        const u32x4 f = fn, b = bn, z = zn;
        if (row + rstride < TT) { const size_t o1 = (size_t)(row + rstride) * 512 + 8 * lane; fn = *(const u32x4*)(OF + o1); bn = *(const u32x4*)(OB + o1); zn = *(const u32x4*)(Z + o1); }
        float o[8]; float ss = 0.f;
#pragma unroll
        for (int i = 0; i < 4; ++i) {
            o[2 * i] = __uint_as_float(f[i] << 16) + __uint_as_float(b[i] << 16);
            o[2 * i + 1] = __uint_as_float(f[i] & 0xffff0000u) + __uint_as_float(b[i] & 0xffff0000u);
            ss += o[2 * i] * o[2 * i] + o[2 * i + 1] * o[2 * i + 1];
        }
        ss += __shfl_xor(ss, 1); ss += __shfl_xor(ss, 2); ss += __shfl_xor(ss, 4); ss += __shfl_xor(ss, 8);
        const float r = rsqrtf(ss * (1.f / 128.f) + EPS);
        u32x4 w;
#pragma unroll
        for (int i = 0; i < 4; ++i) {
            const float z0 = __uint_as_float(z[i] << 16), z1 = __uint_as_float(z[i] & 0xffff0000u);
            const float y0 = o[2 * i] * r * og[2 * i] * siluf_(z0), y1 = o[2 * i + 1] * r * og[2 * i + 1] * siluf_(z1);
            w[i] = pk2(y0, y1);
        }
        *(u32x4*)(YB + off) = w;
    }
}

constexpr int LOCAL_ASSIGN = 9 * 8 * 2;
DI void ph_ln1_router(const Args& a, int l, unsigned char* lds, int rd = 0) {
    float* WT = (float*)lds;
    int* le = (int*)(lds + 65536);
    const int tid = tidx(), lane = tid & 63, wid = tid >> 6;
    stage_wt16(WT, a.in[21], 16, 0, tid);
    if (tid < LOCAL_ASSIGN) le[tid] = -1;
    __syncthreads();
    const float* mods = (const float*)(a.ws + WS_MODS);
    const float* X = (const float*)(a.ws + WS_X); float* XO = rd ? (float*)(a.ws + WS_GPRE) : (float*)(a.ws + WS_X); bf16_t* H = rd ? (bf16_t*)(a.ws + WS_GPRE + 72 * MiB) : (bf16_t*)(a.ws + WS_H);
    int* RE = rd ? (int*)(a.ws + WS_GPRE + 110 * MiB) : (int*)(a.ws + WS_ROUTE_E); float* RW = rd ? (float*)(a.ws + WS_GPRE + 111 * MiB) : (float*)(a.ws + WS_ROUTE_W);
    const float* g = a.in[19] + l * 1024; const float* bb = a.in[20] + l * 1024; const float* rb = a.in[22];
    const int kfirst = (l == DEPTH - 1 && (int)(blockIdx.x * 8 + wid) < NCTX) ? 1 : 0;
    f32x4 lg4[4], lb4[4];
#pragma unroll
    for (int j = 0; j < 4; ++j) { lg4[j] = *(const f32x4*)(g + 256 * j + 4 * lane); lb4[j] = *(const f32x4*)(bb + 256 * j + 4 * lane); }
    f32x4 xn[4];
    { const int row = blockIdx.x * 8 + wid + 2048 * kfirst;
#pragma unroll
      for (int j = 0; j < 4; ++j) xn[j] = *(const f32x4*)(X + (size_t)row * 1024 + 256 * j + 4 * lane); }
#pragma unroll 1
    for (int k = kfirst; k < 9; ++k) {
        const int row = blockIdx.x * 8 + wid + 2048 * k;
        if (row >= TT) break;
        f32x4 x[4], h[4], msh[4], msc[4];
#pragma unroll
        for (int j = 0; j < 4; ++j) x[j] = xn[j];
        const float* m = mods + (size_t)(l * 5 + mod_set(row)) * 6144;
#pragma unroll
        for (int j = 0; j < 4; ++j) { msh[j] = *(const f32x4*)(m + 3 * 1024 + 256 * j + 4 * lane); msc[j] = *(const f32x4*)(m + 4 * 1024 + 256 * j + 4 * lane); }
        if (row + 2048 < TT) {
#pragma unroll
            for (int j = 0; j < 4; ++j) xn[j] = *(const f32x4*)(X + (size_t)(row + 2048) * 1024 + 256 * j + 4 * lane);
        }
        row_ln_r(x, lg4, lb4);
#pragma unroll
        for (int j = 0; j < 4; ++j) h[j] = x[j] * (1.f + msc[j]) + msh[j];
        row_store_bf16(H + (size_t)row * 1024, h, lane);
        if (rd >= 2) continue;
        const float lgv = row_gemv16(h, WT, lane);
        float sc[16], sel[16];
#pragma unroll
        for (int e = 0; e < 16; ++e) { const float lg = __uint_as_float(__builtin_amdgcn_readlane(__float_as_uint(lgv), lane_of_jj16(e))); sc[e] = __builtin_amdgcn_rcpf(1.f + __builtin_amdgcn_exp2f(-1.4426950408889634f * lg)); sel[e] = sc[e] + rb[e]; }
        float best_gs = -1e30f; int best = 0;
#pragma unroll
        for (int gI = 0; gI < 4; ++gI) {
            const float v0 = sel[4 * gI], v1 = sel[4 * gI + 1], v2 = sel[4 * gI + 2], v3 = sel[4 * gI + 3];
            const float mx = fmaxf(fmaxf(v0, v1), fmaxf(v2, v3));
            float second;
            if (v0 == mx) second = fmaxf(v1, fmaxf(v2, v3));
            else if (v1 == mx) second = fmaxf(v0, fmaxf(v2, v3));
            else if (v2 == mx) second = fmaxf(fmaxf(v0, v1), v3);
            else second = fmaxf(fmaxf(v0, v1), v2);
            const float gs = mx + second;
            if (gs > best_gs) { best_gs = gs; best = gI; }
        }
        float i0 = 0.f, i1 = 0.f, i2 = 0.f, i3 = 0.f, s0 = 0.f, s1 = 0.f, s2 = 0.f, s3 = 0.f;
#pragma unroll
        for (int gI = 0; gI < 4; ++gI) if (gI == best) { i0 = sel[4 * gI]; i1 = sel[4 * gI + 1]; i2 = sel[4 * gI + 2]; i3 = sel[4 * gI + 3]; s0 = sc[4 * gI]; s1 = sc[4 * gI + 1]; s2 = sc[4 * gI + 2]; s3 = sc[4 * gI + 3]; }
        int a0 = 0; float m0 = i0, w0 = s0;
        if (i1 > m0) { a0 = 1; m0 = i1; w0 = s1; }
        if (i2 > m0) { a0 = 2; m0 = i2; w0 = s2; }
        if (i3 > m0) { a0 = 3; m0 = i3; w0 = s3; }
        int a1 = -1; float m1 = -1e30f, w1 = 0.f;
        if (a0 != 0 && i0 > m1) { a1 = 0; m1 = i0; w1 = s0; }
        if (a0 != 1 && i1 > m1) { a1 = 1; m1 = i1; w1 = s1; }
        if (a0 != 2 && i2 > m1) { a1 = 2; m1 = i2; w1 = s2; }
        if (a0 != 3 && i3 > m1) { a1 = 3; m1 = i3; w1 = s3; }
        if (lane == 0) {
            const float inv = 1.f / (w0 + w1);
            RE[2 * row] = best * 4 + a0; RE[2 * row + 1] = best * 4 + a1;
            RW[2 * row] = w0 * inv; RW[2 * row + 1] = w1 * inv;
            le[(k * 8 + wid) * 2] = best * 4 + a0; le[(k * 8 + wid) * 2 + 1] = best * 4 + a1;
        }
    }
    __syncthreads();
    if (tid < 16) {
        int cnt = 0;
        for (int i = 0; i < LOCAL_ASSIGN; ++i) cnt += (le[i] == tid) ? 1 : 0;
        ((int*)(a.ws + (rd ? WS_GPRE + 112 * MiB : WS_META)))[blockIdx.x * 16 + tid] = cnt;
    }
    __syncthreads();
}

constexpr int META_NT = 4096, META_TE = 4096 + 16;
DI void ph_slot(const Args& a, int l, unsigned char* lds) {
    int* bc = (int*)lds;
    int* tot = (int*)(lds + 16384);
    int* ls = (int*)(lds + 16384 + 1024);
    const int tid = tidx(), lane = tid & 63, wid = tid >> 6;
    const int* meta = (const int*)(a.ws + WS_META);
    int* metaw = (int*)(a.ws + WS_META);
    const int G = gridDim.x;
    for (int i = tid; i < G * 16; i += 512) bc[i] = meta[i];
    if (tid < LOCAL_ASSIGN) ls[tid] = -1;
    __syncthreads();
    {
        int* part = (int*)(lds + 16384 + 4096);
        const int e = tid & 15, pr = tid >> 4; int t = 0, before = 0;
#pragma unroll
        for (int q = 0; q < 8; ++q) { const int b = pr * 8 + q; if (b < G) { const int c = bc[b * 16 + e]; t += c; if (b < (int)blockIdx.x) before += c; } }
        part[pr * 16 + e] = t; part[512 + pr * 16 + e] = before;
        __syncthreads();
        if (tid < 16) { int tt = 0, bb = 0;
#pragma unroll
            for (int q = 0; q < 32; ++q) { tt += part[q * 16 + tid]; bb += part[512 + q * 16 + tid]; }
            tot[tid] = tt; tot[16 + tid] = bb; }
    }
    __syncthreads();
    if (tid == 0) {
        int ps = 0, nt = 0;
#pragma unroll 1
        for (int e = 0; e < 16; ++e) {
            tot[32 + e] = ps; tot[64 + e] = nt; const int tiles = (tot[e] + 255) >> 8;
            nt += tiles; ps += tiles * 256;
        }
        tot[48] = ps; tot[80] = nt;
    }
    __syncthreads();
    if (blockIdx.x == 0) {
        const int nt = tot[80];
        if (tid == 0) metaw[META_NT] = nt;
        if (tid < nt) { int e = 0;
#pragma unroll 1
            for (int q = 1; q < 16; ++q) e += (tot[64 + q] <= tid) ? 1 : 0;
            metaw[META_TE + tid] = e; }
    }
    const int* RE = (const int*)(a.ws + WS_ROUTE_E);
    int* DEST = (int*)(a.ws + WS_DEST); int* SLOTA = (int*)(a.ws + WS_SLOTA);
    int* le2 = (int*)(lds + 16384 + 2048);
    int my_row = -1, my_kk = 0;
    if (tid < LOCAL_ASSIGN) {
        const int row = blockIdx.x * 8 + ((tid >> 1) & 7) + 2048 * (tid >> 4); my_kk = tid & 1;
        int e = -1;
        if (row < TT && !(l == DEPTH - 1 && row < NCTX)) { e = RE[2 * row + my_kk]; my_row = row; }
        le2[tid] = e;
    }
    __syncthreads();
    if (tid < 16) {
        int pos = tot[32 + tid] + tot[16 + tid];
        for (int li = 0; li < LOCAL_ASSIGN; ++li) if (le2[li] == tid) { ls[li] = pos; ++pos; }
    }
    __syncthreads();
    if (tid < LOCAL_ASSIGN && my_row >= 0) { const int pos = ls[tid]; DEST[2 * my_row + my_kk] = pos; SLOTA[pos] = 2 * my_row + my_kk; }
    if (blockIdx.x < 16) {
        const int e = blockIdx.x; const int s0 = tot[32 + e] + tot[e], s1 = tot[32 + e] + (((tot[e] + 255) >> 8) << 8);
        for (int s = s0 + tid; s < s1; s += 512) SLOTA[s] = -1;
    }
    __syncthreads();
    const bf16_t* H = (const bf16_t*)(a.ws + WS_H); bf16_t* XS = (bf16_t*)(a.ws + WS_XS);
#pragma unroll 1
    for (int b0 = 0; b0 < 18; b0 += 6) {
        u32x4 r0[6], r1[6]; int sl[6];
#pragma unroll
        for (int q = 0; q < 6; ++q) {
            const int li = wid + 8 * (b0 + q); sl[q] = ls[li];
            const int row = blockIdx.x * 8 + ((li >> 1) & 7) + 2048 * (li >> 4);
            if (sl[q] >= 0) { const u32x4* sp = (const u32x4*)(H + (size_t)row * 1024); r0[q] = sp[lane]; r1[q] = sp[lane + 64]; }
        }
#pragma unroll
        for (int q = 0; q < 6; ++q) if (sl[q] >= 0) { u32x4* d = (u32x4*)(XS + (size_t)sl[q] * 1024); d[lane] = r0[q]; d[lane + 64] = r1[q]; }
    }
    __syncthreads();
}

DI void ph_combine_ln2(const Args& a, int l, unsigned char* lds, int rd = 0) {
    float* WT = (float*)lds;
    const bool last = (l == DEPTH - 1);
    const int tid = tidx(), lane = tid & 63, wid = tid >> 6;
    if (!last) { stage_wt16(WT, a.in[6] + (size_t)(l + 1) * 1024 * N_IN, N_IN, 3584, tid); }
    __syncthreads();
    const float* mods = (const float*)(a.ws + WS_MODS);
    const float* X = (const float*)(a.ws + WS_X); float* XO = rd ? (float*)(a.ws + WS_GPRE) : (float*)(a.ws + WS_X); bf16_t* H = rd ? (bf16_t*)(a.ws + WS_GPRE + 72 * MiB) : (bf16_t*)(a.ws + WS_H); float* AB = rd ? (float*)(a.ws + WS_GPRE + 110 * MiB) : (float*)(a.ws + WS_AB);
    float* OUT = rd ? (float*)(a.ws + WS_GPRE) : a.out;
    const bf16_t* YS = (const bf16_t*)(a.ws + WS_YS); const float* RW = (const float*)(a.ws + WS_ROUTE_W);
    const float* g = a.in[26] + l * 1024; const float* bb = a.in[27] + l * 1024;
    const int rstride = gridDim.x * 8;
    int row0 = blockIdx.x * 8 + wid; if (last) { while (row0 < NCTX) row0 += rstride; }
    f32x4 xn[4]; u32x2 yn0[4], yn1[4]; float wn0 = 0.f, wn1 = 0.f;
    if (row0 < TT) {
        wn0 = RW[2 * row0]; wn1 = RW[2 * row0 + 1];
#pragma unroll
        for (int j = 0; j < 4; ++j) { const int c = 256 * j + 4 * lane; xn[j] = *(const f32x4*)(X + (size_t)row0 * 1024 + c);
            yn0[j] = *(const u32x2*)(YS + (size_t)(2 * row0) * 1024 + c); yn1[j] = *(const u32x2*)(YS + (size_t)(2 * row0 + 1) * 1024 + c); }
    }
    f32x4 lg4[4], lb4[4], l1g[4], l1b[4];
#pragma unroll
    for (int j = 0; j < 4; ++j) { lg4[j] = *(const f32x4*)(g + 256 * j + 4 * lane); lb4[j] = *(const f32x4*)(bb + 256 * j + 4 * lane);
        l1g[j] = *(const f32x4*)(a.in[19] + l * 1024 + 256 * j + 4 * lane); l1b[j] = *(const f32x4*)(a.in[20] + l * 1024 + 256 * j + 4 * lane); }
#pragma unroll 1
    for (int row = row0; row < TT; row += rstride) {
        const float w0 = wn0, w1 = wn1;
        const float* m = mods + (size_t)(l * 5 + mod_set(row)) * 6144;
        const float* mn = mods + (size_t)((last ? l : l + 1) * 5 + mod_set(row)) * 6144;
        f32x4 x[4], h[4], gt[4], msh[4], msc[4]; u32x2 ya[4], yb[4];
#pragma unroll
        for (int j = 0; j < 4; ++j) { x[j] = xn[j]; ya[j] = yn0[j]; yb[j] = yn1[j]; }
#pragma unroll
        for (int j = 0; j < 4; ++j) { const int c = 256 * j + 4 * lane; gt[j] = *(const f32x4*)(m + 5 * 1024 + c); msh[j] = *(const f32x4*)(mn + c); msc[j] = *(const f32x4*)(mn + 1024 + c); }
        { const int rn = row + rstride;
          if (rn < TT) {
            wn0 = RW[2 * rn]; wn1 = RW[2 * rn + 1];
#pragma unroll
            for (int j = 0; j < 4; ++j) { const int c = 256 * j + 4 * lane; xn[j] = *(const f32x4*)(X + (size_t)rn * 1024 + c);
                yn0[j] = *(const u32x2*)(YS + (size_t)(2 * rn) * 1024 + c); yn1[j] = *(const u32x2*)(YS + (size_t)(2 * rn + 1) * 1024 + c); }
          } }
        row_ln_r(x, l1g, l1b);
#pragma unroll
        for (int j = 0; j < 4; ++j) {
            const u32x2 y0 = ya[j], y1 = yb[j];
            f32x4 y;
            y[0] = w0 * __uint_as_float(y0.x << 16) + w1 * __uint_as_float(y1.x << 16);
            y[1] = w0 * __uint_as_float(y0.x & 0xffff0000u) + w1 * __uint_as_float(y1.x & 0xffff0000u);
            y[2] = w0 * __uint_as_float(y0.y << 16) + w1 * __uint_as_float(y1.y << 16);
            y[3] = w0 * __uint_as_float(y0.y & 0xffff0000u) + w1 * __uint_as_float(y1.y & 0xffff0000u);
            x[j] = ALPHA * x[j] + gt[j] * y;
        }
        row_ln_r(x, lg4, lb4);
        if (last) {
#pragma unroll
            for (int j = 0; j < 4; ++j) *(f32x4*)(OUT + (size_t)(row - NCTX) * 1024 + 256 * j + 4 * lane) = x[j];
        } else {
#pragma unroll
            for (int j = 0; j < 4; ++j) *(f32x4*)(XO + (size_t)row * 1024 + 256 * j + 4 * lane) = x[j];
#pragma unroll
            for (int j = 0; j < 4; ++j) h[j] = x[j] * (1.f + msc[j]) + msh[j];
            row_store_bf16(H + (size_t)row * 1024, h, lane);
            { const float abv = row_gemv16(h, WT, lane); if ((lane & 3) == 0) AB[(size_t)row * 16 + jj16_of_lane(lane)] = abv; }
        }
    }
    __syncthreads();
}

DI void transpose_item(const float* W, int ldw, int K, int ncols, bf16_t* WT, int item, float* scr, int lane) {
    const int nblk = ncols >> 5, kb = item / nblk, nb = item - kb * nblk, k0 = 64 * kb, n0 = 32 * nb;
#pragma unroll 8
    for (int i = 0; i < 32; ++i) { const int kk = 2 * i + (lane >> 5); scr[kk * 33 + (lane & 31)] = W[(size_t)(k0 + kk) * ldw + n0 + (lane & 31)]; }
    asm volatile("s_waitcnt lgkmcnt(0)" ::: "memory");
    const int c = lane & 7;
#pragma unroll
    for (int j = 0; j < 4; ++j) { const int n = (lane >> 3) + 8 * j; const float* s = scr + (8 * c) * 33 + n;
        u32x4 o; o.x = pk2(s[0 * 33], s[1 * 33]); o.y = pk2(s[2 * 33], s[3 * 33]); o.z = pk2(s[4 * 33], s[5 * 33]); o.w = pk2(s[6 * 33], s[7 * 33]);
        *(u32x4*)(WT + (size_t)(n0 + n) * K + k0 + 8 * c) = o; }
    asm volatile("s_waitcnt lgkmcnt(0)" ::: "memory");
}
constexpr int CV_A = 2816, CV_B = 13312;
DI void convert_A(const Args& a, int l, int item, float* scr, int lane) {
    const float* w = a.in[6] + (size_t)l * 1024 * N_IN; bf16_t* wt = (bf16_t*)(a.ws + WS_WIN);
    if (item < 1792) transpose_item(w, N_IN, 1024, 3584, wt, item, scr, lane);
    else transpose_item(w + 3600, N_IN, 1024, 2048, wt + (size_t)3584 * 1024, item - 1792, scr, lane);
}
DI void convert_B(const Args& a, int l, int item, float* scr, int lane) {
    if (item < 256) { transpose_item(a.in[16] + (size_t)l * 512 * 1024, 1024, 512, 1024, (bf16_t*)(a.ws + WS_WPAB), item, scr, lane); return; }
    item -= 256;
    if (item < 256) { transpose_item(a.in[17] + (size_t)l * 512 * 1024, 1024, 512, 1024, (bf16_t*)(a.ws + WS_WPAB) + (size_t)1024 * 512, item, scr, lane); return; }
    item -= 256;
    if (item < 512) { transpose_item(a.in[18] + (size_t)l * 1024 * 1024, 1024, 1024, 1024, (bf16_t*)(a.ws + WS_WO), item, scr, lane); return; }
    item -= 512;
    if (item < 8192) {
        const int job = item >> 6, it = item & 63; const int e = job >> 3, t = (job >> 1) & 3, which = job & 1;
        const float* w = (which ? a.in[24] : a.in[23]) + ((size_t)l * 16 + e) * 1024 * 512 + 128 * t;
        transpose_item(w, 512, 1024, 128, (bf16_t*)(a.ws + WS_W13) + ((size_t)e * 1024 + 256 * t + 128 * which) * 1024, it, scr, lane); return;
    }
    item -= 8192;
    { const int e = item >> 8, it = item & 255;
      transpose_item(a.in[25] + ((size_t)l * 16 + e) * 512 * 1024, 1024, 512, 1024, (bf16_t*)(a.ws + WS_W2) + (size_t)e * 1024 * 512, it, scr, lane); }
}
DI void convert_run(const Args& a, int lA, int lB, int rank, int nw, float* scr, int lane) {
    const int nA = (lA >= 0 && lA < DEPTH) ? CV_A : 0, nB = (lB >= 0 && lB < DEPTH) ? CV_B : 0;
#pragma unroll 1
    for (int it = rank; it < nA + nB; it += nw) { if (it < nA) convert_A(a, lA, it, scr, lane); else convert_B(a, lB, it - nA, scr, lane); }
}

#define XB_TMO      128
#define XB_XCNT(j)  (256  + 64 * (j))
#define XB_XSUB(j)  (1280 + 64 * (j))
#define XB_XGEN(j)  (2304 + 64 * (j))
#define XB_TOP      3328
#define XB_TOPGEN   3392
#define XCD_BAR_WORDS 3456
#define XB_SPIN_CAP (1u << 18)

__device__ __forceinline__ unsigned xb_ld(unsigned* p)              { return __hip_atomic_load(p, __ATOMIC_RELAXED, __HIP_MEMORY_SCOPE_AGENT); }
__device__ __forceinline__ unsigned xb_add(unsigned* p, unsigned v) { return __hip_atomic_fetch_add(p, v, __ATOMIC_RELAXED, __HIP_MEMORY_SCOPE_AGENT); }
__device__ __forceinline__ unsigned xb_xcc_id() { return (unsigned)__builtin_amdgcn_s_getreg((3 << 11) | 20) & 0xFu; }
#define XB_SPIN(cond, bar) do { unsigned _sp = 0; while (cond) { __builtin_amdgcn_s_sleep(1); \
    if ((++_sp & 255u) == 0u) { if (xb_ld(&(bar)[XB_TMO])) break; if (_sp > XB_SPIN_CAP) { atomicAdd(&(bar)[XB_TMO], 1u); break; } } } } while (0)

struct XcdBarrier {
    unsigned* bar; unsigned x;
    volatile LAS unsigned* st;
};

__device__ __forceinline__ XcdBarrier xcd_barrier_post(unsigned* bar, volatile LAS unsigned* st) {
    XcdBarrier b; b.bar = bar; b.x = xb_xcc_id(); b.st = st;
    if (tidx() == 0) (void)xb_add(&bar[XB_XCNT(b.x)], 1u);
    return b;
}
__device__ __forceinline__ void xcd_barrier_complete(unsigned* bar, unsigned x, unsigned& nloc, unsigned& nx) {
    const unsigned G = gridDim.x * gridDim.y * gridDim.z;
    unsigned sum, cnt, mine, sp = 0u;
    for (;;) {
        sum = 0u; cnt = 0u; mine = 0u;
#pragma unroll
        for (unsigned j = 0; j < 16; ++j) { const unsigned c = xb_ld(&bar[XB_XCNT(j)]); sum += c; cnt += (c > 0u) ? 1u : 0u; mine = (j == x) ? c : mine; }
        if (sum == G) break;
        __builtin_amdgcn_s_sleep(1);
        if ((++sp & 255u) == 0u) { if (xb_ld(&bar[XB_TMO])) break; if (sp > XB_SPIN_CAP) { atomicAdd(&bar[XB_TMO], 1u); break; } }
    }
    nloc = mine > 0u ? mine : 1u; nx = cnt > 0u ? cnt : 1u;
}

__device__ __forceinline__ void xcd_barrier(const XcdBarrier& b) {
    asm volatile("s_waitcnt vmcnt(0)" ::: "memory");
    __syncthreads();
    if (tidx() == 0) {
        unsigned* bar = b.bar;
        __builtin_amdgcn_s_waitcnt(0);
        unsigned nloc = b.st[0], nx = b.st[1];
        if (nloc == 0u) { xcd_barrier_complete(bar, b.x, nloc, nx); b.st[0] = nloc; b.st[1] = nx; }
        const unsigned old = xb_add(&bar[XB_XSUB(b.x)], 1u);
        const unsigned gen = old / nloc;
        if (old + 1u == (gen + 1u) * nloc) {
            __builtin_amdgcn_fence(__ATOMIC_RELEASE, "agent");
            asm volatile("s_waitcnt vmcnt(0)" ::: "memory");
            const unsigned og = xb_add(&bar[XB_TOP], 1u);
            const unsigned tg = og / nx;
            if (og + 1u == (tg + 1u) * nx) xb_add(&bar[XB_TOPGEN], 1u);
            else XB_SPIN(xb_ld(&bar[XB_TOPGEN]) == tg, bar);
            __builtin_amdgcn_fence(__ATOMIC_ACQUIRE, "agent");
            xb_add(&bar[XB_XGEN(b.x)], 1u);
            asm volatile("s_waitcnt vmcnt(0)" ::: "memory");
        } else {
            XB_SPIN(xb_ld(&bar[XB_XGEN(b.x)]) == gen, bar);
            __builtin_amdgcn_fence(__ATOMIC_ACQUIRE, "agent");
            asm volatile("s_waitcnt vmcnt(0)" ::: "memory");
        }
    }
    __syncthreads();
}

constexpr int CW_PANEL = 16384;
DI unsigned* panel_word(unsigned char* ws, int l, int kind, int p) { return (unsigned*)(ws + WS_CTL) + CW_PANEL + ((l * 2 + kind) * 160 + p) * 64; }
DI void store16_wt(void* p, u32x4 v) { asm volatile("global_store_dwordx4 %0, %1, off sc1\n\ts_nop 1" :: "v"(p), "v"(v) : "memory"); }
DI void panel_publish(unsigned* w) {
    asm volatile("s_waitcnt vmcnt(0)" ::: "memory");
    if ((tidx() & 63) == 0) __hip_atomic_fetch_add(w, 1u, __ATOMIC_RELAXED, __HIP_MEMORY_SCOPE_AGENT);
}
DI void panel_wait(unsigned* w, unsigned need) {
    if (tidx() < 64) {
        unsigned spins = 0;
        while ((unsigned)__builtin_amdgcn_readfirstlane(__hip_atomic_load(w, __ATOMIC_RELAXED, __HIP_MEMORY_SCOPE_AGENT)) < need) { __builtin_amdgcn_s_sleep(2); if (++spins > (1u << 22)) break; }
        __builtin_amdgcn_fence(__ATOMIC_ACQUIRE, "agent");
        asm volatile("s_waitcnt vmcnt(0)" ::: "memory");
    }
    asm volatile("" ::: "memory"); __builtin_amdgcn_s_barrier(); asm volatile("" ::: "memory");
}
DI int unit_set(int pm) { return pm < 4 ? 4 : ((pm - 4) >> 4); }
struct EpiInproj {
    static constexpr bool PERM = true, AFTER_DRAIN = false;
    unsigned char* ws;
    DI void operator()(const f32x4 (&acc)[2][2][4][2], const pg8::Unit& u, int wr, int wc, int fr, int fq) const {
        const int pn = u.pn; bf16_t* dst; int ld, colt, mode;
        if (pn < 2) { dst = (bf16_t*)(ws + WS_QA); ld = 512; colt = pn * 256; mode = 1; }
        else if (pn < 4) { dst = (bf16_t*)(ws + WS_KA); ld = 512; colt = (pn - 2) * 256; mode = 2; }
        else if (pn < 6) { dst = (bf16_t*)(ws + WS_VA); ld = 512; colt = (pn - 4) * 256; mode = 0; }
        else if (pn < 12) { dst = (bf16_t*)(ws + WS_QKV); ld = 1536; colt = (pn - 6) * 256; mode = 0; }
        else if (pn < 14) { dst = (bf16_t*)(ws + WS_Z); ld = 512; colt = (pn - 12) * 256; mode = 0; }
        else { dst = (bf16_t*)(ws + WS_SG); ld = 2048; colt = (pn - 14) * 256; mode = 3; }
        const bool rope = (mode == 1 || mode == 2) && u.pm >= 4;
        const float qs = (mode == 1) ? QSCALE : 1.f;
        const float* rtab = (const float*)(ws + WS_ROPE);
        const int row0 = u.pm * 256 + wr * 64 + fr;
        const float sgn = (fq >> 1) ? 1.f : -1.f;
        f32x4 csn[2][2];
        if (rope) {
            const int t = (row0 - NCTX) & 4095; const int pos = (wc & 1) ? (t & 63) : (t >> 6);
            const float* rp = rtab + (pos * 16 + 8 * (fq & 1)) * 2;
#pragma unroll
            for (int n = 0; n < 2; ++n) { csn[n][0] = *(const f32x4*)(rp + 8 * n); csn[n][1] = *(const f32x4*)(rp + 8 * n + 4); }
        }
#pragma unroll
        for (int s = 0; s < 8; ++s) {
            const int ai = s >> 2, m = s & 3;
            const int row = row0 + ai * 128 + m * 16;
            f32x4 cs[2][2];
            if (rope) {
#pragma unroll
                for (int n = 0; n < 2; ++n) { cs[n][0] = csn[n][0]; cs[n][1] = csn[n][1]; }
                if (s < 7) {
                    const int r1 = row0 + ((s + 1) >> 2) * 128 + ((s + 1) & 3) * 16;
                    const int t = (r1 - NCTX) & 4095; const int pos = (wc & 1) ? (t & 63) : (t >> 6);
                    const float* rp = rtab + (pos * 16 + 8 * (fq & 1)) * 2;
#pragma unroll
                    for (int n = 0; n < 2; ++n) { csn[n][0] = *(const f32x4*)(rp + 8 * n); csn[n][1] = *(const f32x4*)(rp + 8 * n + 4); }
                }
            }
#pragma unroll
            for (int bj = 0; bj < 2; ++bj) {
                f32x4 v[2] = {acc[ai][bj][m][0], acc[ai][bj][m][1]};
                if (rope) {
#pragma unroll
                    for (int n = 0; n < 2; ++n)
#pragma unroll
                        for (int j = 0; j < 4; ++j) {
                            const float x = v[n][j], xp = __shfl_xor(x, 32);
                            const float c = cs[n][j >> 1][(j & 1) * 2], sv = cs[n][j >> 1][(j & 1) * 2 + 1];
                            v[n][j] = x * c + sgn * xp * sv;
                        }
                }
                if (mode == 3) {
#pragma unroll
                    for (int n = 0; n < 2; ++n)
#pragma unroll
                        for (int j = 0; j < 4; ++j) v[n][j] = sigmoidf_(v[n][j]);
                }
                u32x4 w; w.x = pk2(v[0][0] * qs, v[0][1] * qs); w.y = pk2(v[0][2] * qs, v[0][3] * qs); w.z = pk2(v[1][0] * qs, v[1][1] * qs); w.w = pk2(v[1][2] * qs, v[1][3] * qs);
                *(u32x4*)(dst + (size_t)row * ld + colt + bj * 128 + wc * 32 + 8 * fq) = w;
            }
        }
    }
};
struct EpiMerge1 {
    static constexpr bool PERM = true, AFTER_DRAIN = false;
    unsigned char* ws;
    DI void operator()(const f32x4 (&acc)[2][2][4][2], const pg8::Unit& u, int wr, int wc, int fr, int fq) const {
        const int which = u.pm >= 68 ? 1 : 0; const int pm = u.pm - 68 * which, pn = u.pn - 4 * which;
        const bf16_t* SG = (const bf16_t*)(ws + WS_SG); bf16_t* M = (bf16_t*)(ws + WS_M); bf16_t* MP = (bf16_t*)(ws + WS_GPRE);
        const int row0 = pm * 256 + wr * 64 + fr, colb = pn * 256 + wc * 32 + 8 * fq;
        u32x4 gn[2], on[2], gc[2], oc[2];
#pragma unroll
        for (int bj = 0; bj < 2; ++bj) { gn[bj] = *(const u32x4*)(SG + (size_t)row0 * 2048 + which * 1024 + colb + bj * 128); on[bj] = (u32x4){0u, 0u, 0u, 0u};
            if (which) on[bj] = *(const u32x4*)(MP + (size_t)row0 * 1024 + colb + bj * 128); }
#pragma unroll
        for (int s = 0; s < 8; ++s) {
            const int ai = s >> 2, m = s & 3, row = row0 + ai * 128 + m * 16;
#pragma unroll
            for (int bj = 0; bj < 2; ++bj) { gc[bj] = gn[bj]; oc[bj] = on[bj]; }
            if (s < 7) { const int r1 = row0 + ((s + 1) >> 2) * 128 + ((s + 1) & 3) * 16;
#pragma unroll
                for (int bj = 0; bj < 2; ++bj) { gn[bj] = *(const u32x4*)(SG + (size_t)r1 * 2048 + which * 1024 + colb + bj * 128);
                    if (which) on[bj] = *(const u32x4*)(MP + (size_t)r1 * 1024 + colb + bj * 128); } }
#pragma unroll
            for (int bj = 0; bj < 2; ++bj) {
                float v[8];
#pragma unroll
                for (int i = 0; i < 4; ++i) {
                    v[2 * i] = __uint_as_float(gc[bj][i] << 16) * acc[ai][bj][m][i >> 1][(i & 1) * 2] + __uint_as_float(oc[bj][i] << 16);
                    v[2 * i + 1] = __uint_as_float(gc[bj][i] & 0xffff0000u) * acc[ai][bj][m][i >> 1][(i & 1) * 2 + 1] + __uint_as_float(oc[bj][i] & 0xffff0000u);
                }
                u32x4 w; w.x = pk2(v[0], v[1]); w.y = pk2(v[2], v[3]); w.z = pk2(v[4], v[5]); w.w = pk2(v[6], v[7]);
                if (which) store16_wt(M + (size_t)row * 1024 + colb + bj * 128, w); else *(u32x4*)(MP + (size_t)row * 1024 + colb + bj * 128) = w;
            }
        }
    }
};
struct SchedMerge1 {
    int G, c, pm0; unsigned char* ws; int l;
    DI bool next(int i, pg8::Unit& u) const {
        const int tl = (i >> 1) * G + c; if (tl >= (68 - pm0) * 4) return false;
        const int which = i & 1; u.pm = pm0 + (tl >> 2) + 68 * which; u.pn = (tl & 3) + 4 * which; return true;
    }
    DI void a_ready(const pg8::Unit&) const {}
    DI void done(const pg8::Unit& u) const { if (u.pm >= 68) panel_publish(panel_word(ws, l, 0, u.pm - 68)); }
};
struct SchedWoWait {
    int G, c, pm0; unsigned char* ws; int l;
    DI bool next(int i, pg8::Unit& u) const {
        int tl;
        if (i == 0) tl = c; else if (i == 1 && c >= 16 && c < 32) tl = G + (c - 16); else return false;
        if (tl >= (68 - pm0) * 4) return false;
        u.pm = pm0 + (tl >> 2); u.pn = tl & 3; return true;
    }
    DI void a_ready(const pg8::Unit& u) const { panel_wait(panel_word(ws, l, 0, u.pm), 32u); }
    DI void done(const pg8::Unit&) const {}
};
struct SchedRows {
    int G, c, pm0, nN;
    DI bool next(int i, pg8::Unit& u) const { const int tl = i * G + c; if (tl >= (68 - pm0) * nN) return false; u.pm = pm0 + tl / nN; u.pn = tl % nN; return true; }
    DI void a_ready(const pg8::Unit&) const {}
    DI void done(const pg8::Unit&) const {}
};
struct EpiWo {
    static constexpr bool PERM = false, AFTER_DRAIN = false;
    unsigned char* ws; int l; int rd;
    DI void operator()(const f32x4 (&acc)[2][2][4][2], const pg8::Unit& u, int wr, int wc, int fr, int fq) const {
        const float* X = (const float*)(ws + WS_X); float* XO = rd ? (float*)(ws + WS_GPRE) : (float*)(ws + WS_X);
        const float* mg = (const float*)(ws + WS_MODS) + (size_t)(l * 5 + unit_set(u.pm)) * 6144 + 2 * 1024;
        const int row0 = u.pm * 256 + wr * 64 + fr, col0 = u.pn * 256 + wc * 32 + 4 * fq;
        f32x4 gv[2][2];
#pragma unroll
        for (int bj = 0; bj < 2; ++bj)
#pragma unroll
            for (int n = 0; n < 2; ++n) gv[bj][n] = *(const f32x4*)(mg + col0 + bj * 128 + n * 16);
        f32x4 xc[2][2], xn[2][2];
        { const float* rowp = X + (size_t)row0 * 1024 + col0;
#pragma unroll
          for (int bj = 0; bj < 2; ++bj)
#pragma unroll
              for (int n = 0; n < 2; ++n) xn[bj][n] = *(const f32x4*)(rowp + bj * 128 + n * 16); }
#pragma unroll
        for (int s = 0; s < 8; ++s) {
            const int ai = s >> 2, m = s & 3;
#pragma unroll
            for (int bj = 0; bj < 2; ++bj)
#pragma unroll
                for (int n = 0; n < 2; ++n) xc[bj][n] = xn[bj][n];
            if (s < 7) { const int ai1 = (s + 1) >> 2, m1 = (s + 1) & 3; const float* rp = X + (size_t)(row0 + ai1 * 128 + m1 * 16) * 1024 + col0;
#pragma unroll
                for (int bj = 0; bj < 2; ++bj)
#pragma unroll
                    for (int n = 0; n < 2; ++n) xn[bj][n] = *(const f32x4*)(rp + bj * 128 + n * 16); }
            float* rowp = XO + (size_t)(row0 + ai * 128 + m * 16) * 1024 + col0;
#pragma unroll
            for (int bj = 0; bj < 2; ++bj)
#pragma unroll
                for (int n = 0; n < 2; ++n) *(f32x4*)(rowp + bj * 128 + n * 16) = ALPHA * xc[bj][n] + gv[bj][n] * acc[ai][bj][m][n];
        }
    }
};
struct SchedMoe {
    int G, c, ntiles; const int* tile_e; unsigned char* ws; int l, mode;
    DI bool next(int i, pg8::Unit& u) const {
        int x;
        if (mode != 2 || G != 256) x = i * G + c;
        else {
            if (c < 64) { if (i > 0) return false; x = c; }
            else if (c < 192) { if (i > 2) return false; x = c + 128 * i; }
            else x = 448 + (c - 192) + 64 * i;
        }
        if (x >= ntiles * 4) return false;
        u.pm = x >> 2; u.pn = tile_e[x >> 2] * 4 + (x & 3); return true;
    }
    DI void a_ready(const pg8::Unit& u) const { if (mode == 2) panel_wait(panel_word(ws, l, 1, u.pm), 32u); }
    DI void done(const pg8::Unit& u) const { if (mode == 1) panel_publish(panel_word(ws, l, 1, u.pm)); }
};
struct EpiUp {
    static constexpr bool PERM = true, AFTER_DRAIN = false;
    unsigned char* ws;
    DI void operator()(const f32x4 (&acc)[2][2][4][2], const pg8::Unit& u, int wr, int wc, int fr, int fq) const {
        bf16_t* ACT = (bf16_t*)(ws + WS_ACT);
        const int j = u.pn & 3; const int row0 = u.pm * 256 + wr * 64 + fr; const int col = j * 128 + wc * 32 + 8 * fq;
#pragma unroll
        for (int ai = 0; ai < 2; ++ai)
#pragma unroll
            for (int m = 0; m < 4; ++m) {
                float v[8];
#pragma unroll
                for (int n = 0; n < 2; ++n)
#pragma unroll
                    for (int i = 0; i < 4; ++i) v[4 * n + i] = siluf_(acc[ai][0][m][n][i]) * acc[ai][1][m][n][i];
                u32x4 w; w.x = pk2(v[0], v[1]); w.y = pk2(v[2], v[3]); w.z = pk2(v[4], v[5]); w.w = pk2(v[6], v[7]);
                store16_wt(ACT + (size_t)(row0 + ai * 128 + m * 16) * 512 + col, w);
            }
    }
};
struct EpiDown {
    static constexpr bool PERM = true, AFTER_DRAIN = false;
    unsigned char* ws;
    DI void operator()(const f32x4 (&acc)[2][2][4][2], const pg8::Unit& u, int wr, int wc, int fr, int fq) const {
        bf16_t* YS = (bf16_t*)(ws + WS_YS); const int* SLOTA = (const int*)(ws + WS_SLOTA);
        const int j = u.pn & 3; const int row0 = u.pm * 256 + wr * 64 + fr;
        int asv[2][4];
#pragma unroll
        for (int ai = 0; ai < 2; ++ai)
#pragma unroll
            for (int m = 0; m < 4; ++m) asv[ai][m] = SLOTA[row0 + ai * 128 + m * 16];
#pragma unroll
        for (int ai = 0; ai < 2; ++ai)
#pragma unroll
            for (int m = 0; m < 4; ++m) {
                const int as = asv[ai][m];
                if (as >= 0) {
#pragma unroll
                    for (int bj = 0; bj < 2; ++bj) {
                        const f32x4 v0 = acc[ai][bj][m][0], v1 = acc[ai][bj][m][1];
                        u32x4 w; w.x = pk2(v0[0], v0[1]); w.y = pk2(v0[2], v0[3]); w.z = pk2(v1[0], v1[1]); w.w = pk2(v1[2], v1[3]);
                        *(u32x4*)(YS + (size_t)as * 1024 + j * 256 + bj * 128 + wc * 32 + 8 * fq) = w;
                    }
                }
            }
    }
};

typedef short s16x4 __attribute__((ext_vector_type(4)));
#define MFMA32(a, b, c) __builtin_amdgcn_mfma_f32_32x32x16_bf16((a), (b), (c), 0, 0, 0)
DI int crow(int i, int hl) { return (i & 3) + 8 * (i >> 2) + 4 * hl; }
DI bf16x8 pack8(const f32x16& x, int s) {
    u32x4 p; p.x = pk2(x[8 * s], x[8 * s + 1]); p.y = pk2(x[8 * s + 2], x[8 * s + 3]); p.z = pk2(x[8 * s + 4], x[8 * s + 5]); p.w = pk2(x[8 * s + 6], x[8 * s + 7]);
    return __builtin_bit_cast(bf16x8, p);
}
DI s16x4 tr_read(const LAS unsigned char* p) { return __builtin_bit_cast(s16x4, __builtin_amdgcn_ds_read_tr16_b64_v4i16((LAS s16x4*)p)); }
constexpr int AT_KB = 9216, AT_VB = 16384, AT_K0 = 0, AT_V0 = 2 * AT_KB, AT_ST = 65536;

struct AttnIt { const bf16_t* kp; const bf16_t* vp; int kc0, kl0, nT; unsigned kdst, vdst0, kread, vread; };
template <int FAKE> DI void attn_iter(int t, const AttnIt& g, LAS unsigned char* lds, unsigned kA, unsigned kB, unsigned vA, unsigned vB, u32x4& rk, u32x4& rv0, u32x4& rv1,
                  f32x16 (&st)[2], f32x16 (&sn)[2], f32x16 (&o)[4], float& mrun, float& lrun, const bf16x8 (&qf)[4]) {
    const int kc0 = g.kc0, kl0 = g.kl0, nT = g.nT;
#define KROW(t_) ((t_) < 4 ? kc0 + 64 * (t_) : kl0 + 64 * ((t_) - 4))
    *(LAS u32x4*)(lds + kB + g.kdst) = rk; *(LAS u32x4*)(lds + vB + g.vdst0) = rv0; *(LAS u32x4*)(lds + vB + g.vdst0 + 2048) = rv1;
    { const int tk = (t + 3 < nT) ? t + 3 : nT - 1, tv = (t + 2 < nT) ? t + 2 : nT - 1;
      const int krk = KROW(tk), krv = KROW(tv);
      if (FAKE != 4) { rk = *(const u32x4*)(g.kp + (size_t)krk * 512); rv0 = *(const u32x4*)(g.vp + (size_t)krv * 512); rv1 = *(const u32x4*)(g.vp + (size_t)(krv + 32) * 512); } }
#undef KROW
    const LAS unsigned char* kb = lds + kA + g.kread;
    const LAS unsigned char* vb = lds + vA + g.vread;
    bf16x8 kf[4];
#pragma unroll
    for (int x = 0; x < 4; ++x) kf[x] = *(const LAS bf16x8*)(kb + (x & 1) * 32 * 144 + (x >> 1) * 32);
    s16x4 lo[2][2], hi[2][2];
#pragma unroll
    for (int k2 = 0; k2 < 2; ++k2) { lo[0][k2] = tr_read(vb + k2 * 4096); hi[0][k2] = tr_read(vb + k2 * 4096 + 512); }
    float mx = fmaxf(fmaxf(st[0][0], st[0][1]), st[0][2]);
#pragma unroll
    for (int i = 3; i < 15; i += 2) mx = fmaxf(fmaxf(mx, st[0][i]), st[0][i + 1]);
    mx = fmaxf(mx, st[0][15]);
#pragma unroll
    for (int i = 0; i < 16; i += 2) mx = fmaxf(fmaxf(mx, st[1][i]), st[1][i + 1]);
    { auto rr = __builtin_amdgcn_permlane32_swap(__float_as_uint(mx), __float_as_uint(mx), false, false); mx = fmaxf(__uint_as_float(rr[0]), __uint_as_float(rr[1])); }
    const float mnew = fmaxf(mrun, mx), alpha = __builtin_amdgcn_exp2f(mrun - mnew);
    mrun = mnew;
    float ps = 0.f;
    __builtin_amdgcn_sched_barrier(0);
#pragma unroll
    for (int x = 0; x < 8; ++x) {
        if (FAKE == 5) { sn[x & 1] = st[x & 1]; } else
        if (x < 2) { f32x16 z;
#pragma unroll
            for (int i = 0; i < 16; ++i) z[i] = 0.f;
            sn[x & 1] = MFMA32(kf[x & 3], qf[x >> 1], z); }
        else sn[x & 1] = MFMA32(kf[x & 3], qf[x >> 1], sn[x & 1]);
        if (x < 4) kf[x] = *(const LAS bf16x8*)(kb + (x & 1) * 32 * 144 + ((x + 4) >> 1) * 32);
#pragma unroll
        for (int e = 0; e < 4; ++e) { const int i = 4 * (x & 3) + e, kt = x >> 2; const float p = FAKE == 2 ? (st[kt][i] - mnew) : __builtin_amdgcn_exp2f(st[kt][i] - mnew); st[kt][i] = p; ps += p; }
        __builtin_amdgcn_sched_barrier(0);
    }
    lrun = lrun * alpha + ps;
    bf16x8 pb[4];
#pragma unroll
    for (int ks = 0; ks < 4; ++ks) pb[ks] = pack8(st[ks >> 1], ks & 1);
#pragma unroll
    for (int i = 0; i < 16; ++i) { if (FAKE != 7) { o[0][i] *= alpha; o[1][i] *= alpha; } }
    __builtin_amdgcn_sched_barrier(0);
#pragma unroll
    for (int u = 0; u < (FAKE == 3 ? 0 : 8); ++u) {
        const int ks = u >> 1, dp = u & 1;
        if (u < 7) {
            const int ks1 = (u + 1) >> 1, dp1 = (u + 1) & 1;
#pragma unroll
            for (int k2 = 0; k2 < 2; ++k2) { lo[(u + 1) & 1][k2] = tr_read(vb + (2 * dp1 + k2) * 4096 + ks1 * 1024); hi[(u + 1) & 1][k2] = tr_read(vb + (2 * dp1 + k2) * 4096 + ks1 * 1024 + 512); }
        }
#pragma unroll
        for (int k2 = 0; k2 < 2; ++k2) {
            const int d = 2 * dp + k2;
            const bf16x8 vf = (bf16x8){lo[u & 1][k2][0], lo[u & 1][k2][1], lo[u & 1][k2][2], lo[u & 1][k2][3], hi[u & 1][k2][0], hi[u & 1][k2][1], hi[u & 1][k2][2], hi[u & 1][k2][3]};
            o[d] = MFMA32(vf, pb[ks], o[d]);
            if (u == 0 && FAKE != 7) {
#pragma unroll
                for (int e = 0; e < 16; ++e) o[2 + k2][e] *= alpha;
            }
        }
        __builtin_amdgcn_sched_barrier(0);
    }
    if (FAKE != 6) __syncthreads();
}
constexpr int AT3_K = 0, AT3_V = 3 * AT_KB;
template <int FAKE> DI void attn_unit(const Args& a, int l, int h, int qrow0, int nT, int kc0, int kl0, float lam, LAS unsigned char* lds) {
    const int tid = tidx(), lane = tid & 63, wid = tid >> 6, r = lane & 31, hl = lane >> 5;
    const bf16_t* QA = (const bf16_t*)(a.ws + WS_QA); const bf16_t* KA = (const bf16_t*)(a.ws + WS_KA); const bf16_t* VA = (const bf16_t*)(a.ws + WS_VA);
    const int qrow = qrow0 + 32 * wid + r;
    const int kkey = tid >> 3, kch = tid & 7;
    const unsigned kdst = (unsigned)(kkey * 144 + kch * 16);
    const int vkey0 = tid >> 4, vch = tid & 15;
    const unsigned vdst0 = (unsigned)((vch >> 2) * 4096 + vkey0 * 64 + (vch & 3) * 16);
    const unsigned kread = (unsigned)(r * 144 + hl * 16);
    const unsigned vread = (unsigned)(((lane >> 4) & 1) * 32 + (lane & 3) * 8 + (4 * hl + ((lane & 15) >> 2)) * 64);
#define KROW(t_) ((t_) < 4 ? kc0 + 64 * (t_) : kl0 + 64 * ((t_) - 4))
#pragma unroll 1
    for (int comp = 0; comp < 2; ++comp) {
        bf16x8 qf[4];
#pragma unroll
        for (int s = 0; s < 4; ++s) qf[s] = *(const bf16x8*)(QA + (size_t)qrow * 512 + h * 128 + comp * 64 + 16 * s + 8 * hl);
        f32x16 o[4];
#pragma unroll
        for (int d = 0; d < 4; ++d)
#pragma unroll
            for (int i = 0; i < 16; ++i) o[d][i] = 0.f;
        float mrun = -1e30f, lrun = 0.f;
        const bf16_t* kp = KA + (size_t)kkey * 512 + h * 128 + comp * 64 + kch * 8;
        const bf16_t* vp = VA + (size_t)vkey0 * 512 + h * 128 + vch * 8;
        u32x4 rk, rv0, rv1;
        {
            const int kr0 = KROW(0), kr1 = KROW(1), kr2 = KROW(2);
            const u32x4 k0 = *(const u32x4*)(kp + (size_t)kr0 * 512), k1 = *(const u32x4*)(kp + (size_t)kr1 * 512);
            const u32x4 v0 = *(const u32x4*)(vp + (size_t)kr0 * 512), v1 = *(const u32x4*)(vp + (size_t)(kr0 + 32) * 512);
            rk = *(const u32x4*)(kp + (size_t)kr2 * 512); rv0 = *(const u32x4*)(vp + (size_t)kr1 * 512); rv1 = *(const u32x4*)(vp + (size_t)(kr1 + 32) * 512);
            *(LAS u32x4*)(lds + AT3_K + kdst) = k0; *(LAS u32x4*)(lds + AT3_K + AT_KB + kdst) = k1;
            *(LAS u32x4*)(lds + AT3_V + vdst0) = v0; *(LAS u32x4*)(lds + AT3_V + vdst0 + 2048) = v1;
        }
        __syncthreads();
        f32x16 st[2];
#pragma unroll
        for (int kt = 0; kt < 2; ++kt) {
#pragma unroll
            for (int i = 0; i < 16; ++i) st[kt][i] = 0.f;
#pragma unroll
            for (int s = 0; s < 4; ++s) st[kt] = MFMA32(*(const LAS bf16x8*)(lds + AT3_K + kread + kt * 32 * 144 + s * 32), qf[s], st[kt]);
        }
        unsigned kA = AT3_K + AT_KB, kB = AT3_K + 2 * AT_KB, kC = AT3_K;
        unsigned vA = AT3_V, vB = AT3_V + AT_VB, vC = AT3_V + 2 * AT_VB;
        const AttnIt geo{kp, vp, kc0, kl0, nT, kdst, vdst0, kread, vread};
        f32x16 sn[2];
#pragma unroll 1
        for (int t = 0; t < nT; t += 2) {
            attn_iter<FAKE>(t, geo, lds, kA, kB, vA, vB, rk, rv0, rv1, st, sn, o, mrun, lrun, qf);
            attn_iter<FAKE>(t + 1, geo, lds, kB, kC, vB, vC, rk, rv0, rv1, sn, st, o, mrun, lrun, qf);
            { const unsigned tk_ = kC; kC = kB; kB = kA; kA = tk_; const unsigned tv_ = vC; vC = vB; vB = vA; vA = tv_; }
        }
        const float ltot = lrun + __shfl_xor(lrun, 32);
        const float inv = 1.f / ltot;
        const int tid2 = tidx(), lane2 = tid2 & 63, wid2 = tid2 >> 6, hl2 = lane2 >> 5;
        const int qrow2 = qrow0 + 32 * wid2 + (lane2 & 31);
        unsigned char* stash = a.ws + WS_M + (size_t)blockIdx.x * 65536 + wid2 * 8192 + lane2 * 16;
        if (comp == 0) {
#pragma unroll
            for (int d = 0; d < 4; ++d) {
                u32x4 w0, w1;
                w0.x = pk2(o[d][0] * inv, o[d][1] * inv); w0.y = pk2(o[d][2] * inv, o[d][3] * inv); w0.z = pk2(o[d][4] * inv, o[d][5] * inv); w0.w = pk2(o[d][6] * inv, o[d][7] * inv);
                w1.x = pk2(o[d][8] * inv, o[d][9] * inv); w1.y = pk2(o[d][10] * inv, o[d][11] * inv); w1.z = pk2(o[d][12] * inv, o[d][13] * inv); w1.w = pk2(o[d][14] * inv, o[d][15] * inv);
                *(u32x4*)(stash + (2 * d) * 1024) = w0; *(u32x4*)(stash + (2 * d + 1) * 1024) = w1;
            }
        } else {
            bf16_t* YA = FAKE ? (bf16_t*)(a.ws + WS_GPRE) : (bf16_t*)(a.ws + WS_YAB);
            int l2_ = l; asm volatile("" : "+v"(l2_));
            const float li = lam_init_of(l2_);
            float ss = 0.f;
#pragma unroll
            for (int d = 0; d < 4; ++d) {
                const u32x4 on0 = *(const u32x4*)(stash + (2 * d) * 1024), on1s = *(const u32x4*)(stash + (2 * d + 1) * 1024);
#pragma unroll
                for (int k = 0; k < 4; ++k) {
                    const unsigned wa = on0[k], wb = on1s[k];
                    const float a0 = __uint_as_float(wa << 16), a1 = __uint_as_float(wa & 0xffff0000u), b0 = __uint_as_float(wb << 16), b1 = __uint_as_float(wb & 0xffff0000u);
                    o[d][2 * k] = a0 - lam * o[d][2 * k] * inv; o[d][2 * k + 1] = a1 - lam * o[d][2 * k + 1] * inv;
                    o[d][8 + 2 * k] = b0 - lam * o[d][8 + 2 * k] * inv; o[d][8 + 2 * k + 1] = b1 - lam * o[d][8 + 2 * k + 1] * inv;
                    ss += o[d][2 * k] * o[d][2 * k] + o[d][2 * k + 1] * o[d][2 * k + 1] + o[d][8 + 2 * k] * o[d][8 + 2 * k] + o[d][8 + 2 * k + 1] * o[d][8 + 2 * k + 1];
                }
            }
            ss += __shfl_xor(ss, 32);
            const float rs = rsqrtf(ss * (1.f / 128.f) + EPS) * (1.f - li);
            const float* sg = a.in[12] + l * 128;
#pragma unroll
            for (int d = 0; d < 4; ++d)
#pragma unroll
                for (int ig = 0; ig < 4; ++ig) {
                    const int dv0 = 32 * d + 8 * ig + 4 * hl2;
                    const f32x4 g4 = *(const f32x4*)(sg + dv0);
                    u32x2 w; w.x = pk2(o[d][4 * ig] * rs * g4[0], o[d][4 * ig + 1] * rs * g4[1]); w.y = pk2(o[d][4 * ig + 2] * rs * g4[2], o[d][4 * ig + 3] * rs * g4[3]);
                    *(u32x2*)(YA + (size_t)qrow2 * 512 + h * 128 + dv0) = w;
                }
        }
    }
#undef KROW
}
template <int FAKE> DI void ph_attn(const Args& a, int l, LAS unsigned char* lds) {
    const int ln_ = tidx() & 63;
    const float s1 = wave_sum(a.in[8][l * 64 + ln_] * a.in[9][l * 64 + ln_]), s2 = wave_sum(a.in[10][l * 64 + ln_] * a.in[11][l * 64 + ln_]);
    int l3_ = l; asm volatile("" : "+v"(l3_));
    const float lam = expf(s1) - expf(s2) + lam_init_of(l3_);
    const int G = gridDim.x, bx = blockIdx.x;
    const int vcu = (G % 8 == 0) ? (bx % 8) * (G / 8) + bx / 8 : bx;
    for (int u = vcu; u < 256; u += G) {
        const int bh = u >> 4, qt = u & 15, b = bh >> 2, h = bh & 3;
        attn_unit<FAKE>(a, l, h, NCTX + b * SEQ + qt * 256, 68, b * CTX, NCTX + b * SEQ, lam, lds);
    }
    if (l < DEPTH - 1) {
        if (G >= 80) { if (bx >= 64 && bx < 80) { const int u = bx - 64, b = u >> 2, h = u & 3; attn_unit<FAKE>(a, l, h, b * CTX, 4, b * CTX, 0, lam, lds); } }
        else for (int u = vcu; u < 16; u += G) { const int b = u >> 2, h = u & 3; attn_unit<FAKE>(a, l, h, b * CTX, 4, b * CTX, 0, lam, lds); }
    }
}

constexpr int GP_WN = 0, GP_QD = 8192, GP_KDT = 16384, GP_QK = 24576, GP_U = 28672, GP_REC = 36864;
DI int swap23(int p) { return (p & ~12) | ((p & 4) << 1) | ((p & 8) >> 1); }
DI int chunk_index(int dir, int b, int h, int cc) { return ((dir * 4 + b) * 4 + h) * 68 + cc; }
constexpr int G1_XS = 71680, G1_XST = 832, G1_WS = 71680 + 68 * 832;
constexpr int G1_QS = 0, G1_KS = 17408, G1_VS = 34816  , G1_GS = 71680, G1_QKS = 88064, G1_AT = 104448  , G1_SM = LDS_MISC + 256;
DI float* g1_sm(unsigned char* lds, int dir, int kind) { return (float*)(lds + G1_SM) + (dir * 5 + kind) * 64; }

#ifndef G1REP1
#define G1REP1 1
#endif
#ifndef G1REP6
#define G1REP6 1
#endif
#ifndef G1REP7
#define G1REP7 1
#endif
DI void g1_task(const Args& a, int l, int b, int h, int cc, unsigned char* lds, int cut = 0) {
    const int tid = tidx(), lane = tid & 63, wid = tid >> 6, r = lane & 31, hl = lane >> 5;
    const int s0 = cc < 4 ? b * CTX : NCTX + b * SEQ, len = cc < 4 ? CTX : SEQ, t0 = cc < 4 ? cc * 64 : (cc - 4) * 64;
    const bf16_t* QKV = (const bf16_t*)(a.ws + WS_QKV);
    const float* cw = a.in[7] + (size_t)l * 5 * 1536;
    if (wid < 2) {
        const int dir = wid, row = s0 + t0 + lane;
        const float* AB = (const float*)(a.ws + WS_AB);
        const float nal = -expf(a.in[13][l * 8 + dir * 4 + h]), dtb = a.in[14][l * 8 + dir * 4 + h];
        const float g = nal * softplusf_(AB[(size_t)row * 16 + dir * 4 + h] + dtb);
        const float beta = sigmoidf_(AB[(size_t)row * 16 + 8 + dir * 4 + h]);
        float c = g;
        if (dir == 0) {
#pragma unroll
            for (int o = 1; o < 64; o <<= 1) { const float v = __shfl_up(c, o); if (lane >= o) c += v; }
        } else {
#pragma unroll
            for (int o = 1; o < 64; o <<= 1) { const float v = __shfl_down(c, o); if (lane + o < 64) c += v; }
        }
        const float glref = __shfl(c, dir == 0 ? 63 : 0);
        const float eg = __expf(c);
        g1_sm(lds, dir, 0)[lane] = c; g1_sm(lds, dir, 1)[lane] = beta; g1_sm(lds, dir, 2)[lane] = beta * eg; g1_sm(lds, dir, 3)[lane] = __expf(glref - c); g1_sm(lds, dir, 4)[lane] = eg;
        if (lane == 0) ((float*)(a.ws + WS_GL))[chunk_index(dir, b, h, cc)] = __expf(glref);
    }
#pragma unroll 1
    for (int rep1_ = 0; rep1_ < G1REP1; ++rep1_) {
    {
        unsigned char* xs = lds + G1_XS; float* wsm = (float*)(lds + G1_WS);
        u32x4 xv[7];
#pragma unroll
        for (int it = 0; it < 7; ++it) {
            const int p = tid + 512 * it; const int pc = p < 68 * 48 ? p : 68 * 48 - 1;
            const int rr = pc / 48, q = pc - rr * 48, part = q >> 4, c8 = q & 15;
            const int tt = t0 + rr - 2; const int ttc = tt < 0 ? 0 : (tt >= len ? len - 1 : tt);
            xv[it] = *(const u32x4*)(QKV + (size_t)(s0 + ttc) * 1536 + part * 512 + h * 128 + c8 * 8);
            if (tt != ttc) xv[it] = (u32x4){0u, 0u, 0u, 0u};
        }
#pragma unroll
        for (int it = 0; it < 7; ++it) {
            const int p = tid + 512 * it;
            if (p < 68 * 48) { const int rr = p / 48, q = p - rr * 48, part = q >> 4, c8 = q & 15; *(u32x4*)(xs + rr * G1_XST + part * 256 + c8 * 16) = xv[it]; }
        }
        if (tid < 480) { const int j = tid / 96, q = tid - j * 96, part = q >> 5, c4 = q & 31;
            *(f32x4*)(wsm + j * 384 + part * 128 + c4 * 4) = *(const f32x4*)(cw + j * 1536 + part * 512 + h * 128 + c4 * 4); }
    }
    __syncthreads();
    if (cut == 3) return;
    {
        const int i = tid >> 3, sub = tid & 7;
        const unsigned char* xs = lds + G1_XS; const float* wsm = (const float*)(lds + G1_WS);
#pragma unroll
        for (int part = 0; part < 3; ++part) {
            float val[16];
#pragma unroll
            for (int cg = 0; cg < 2; ++cg) {
                const int d = cg * 64 + sub * 8;
                float acc[8];
#pragma unroll
                for (int e = 0; e < 8; ++e) acc[e] = 0.f;
#pragma unroll
                for (int j = 0; j < 5; ++j) {
                    {
                        const u32x4 x = *(const u32x4*)(xs + (i + j) * G1_XST + part * 256 + d * 2);
                        const f32x4 w0 = *(const f32x4*)(wsm + j * 384 + part * 128 + d), w1 = *(const f32x4*)(wsm + j * 384 + part * 128 + d + 4);
                        acc[0] += w0[0] * __uint_as_float(x[0] << 16); acc[1] += w0[1] * __uint_as_float(x[0] & 0xffff0000u);
                        acc[2] += w0[2] * __uint_as_float(x[1] << 16); acc[3] += w0[3] * __uint_as_float(x[1] & 0xffff0000u);
                        acc[4] += w1[0] * __uint_as_float(x[2] << 16); acc[5] += w1[1] * __uint_as_float(x[2] & 0xffff0000u);
                        acc[6] += w1[2] * __uint_as_float(x[3] << 16); acc[7] += w1[3] * __uint_as_float(x[3] & 0xffff0000u);
                    }
                }
#pragma unroll
                for (int e = 0; e < 8; ++e) val[cg * 8 + e] = (cut == 5) ? acc[e] : siluf_(acc[e]);
            }
            float scale = 1.f;
            if (part < 2) {
                float ss = 0.f;
#pragma unroll
                for (int e = 0; e < 16; ++e) ss += val[e] * val[e];
                ss += __shfl_xor(ss, 1); ss += __shfl_xor(ss, 2); ss += __shfl_xor(ss, 4);
                scale = rsqrtf(ss + EPS) * (part == 0 ? 0.08838834764831845f : 1.f);
            }
#pragma unroll
            for (int cg = 0; cg < 2; ++cg) {
                const int d = cg * 64 + sub * 8;
                bf16_t hv[8];
#pragma unroll
                for (int e = 0; e < 8; ++e) hv[e] = f2bf(val[cg * 8 + e] * scale);
                if (cut != 4 || scale == 123456.789f) {
                    u32x4 w; w.x = hv[0] | ((unsigned)hv[1] << 16); w.y = hv[2] | ((unsigned)hv[3] << 16); w.z = hv[4] | ((unsigned)hv[5] << 16); w.w = hv[6] | ((unsigned)hv[7] << 16);
                    *(u32x4*)(lds + (part == 0 ? G1_QS : (part == 1 ? G1_KS : G1_VS)) + i * 272 + d * 2) = w;
                }
            }
        }
    }
    }
    __syncthreads();
    if (cut == 1 || cut == 4 || cut == 5) return;
    {
        const int which = wid >> 2, mi = (wid >> 1) & 1, ni = wid & 1;
        const unsigned char* Ab = lds + (which ? G1_QS : G1_KS) + (32 * mi + r) * 272 + hl * 16;
        const unsigned char* Bb = lds + G1_KS + (32 * ni + r) * 272 + hl * 16;
        f32x16 acc;
#pragma unroll
        for (int i = 0; i < 16; ++i) acc[i] = 0.f;
#pragma unroll
        for (int s = 0; s < 8; ++s) acc = MFMA32(*(const bf16x8*)(Ab + s * 32), *(const bf16x8*)(Bb + s * 32), acc);
        float* O = (float*)(lds + (which ? G1_QKS : G1_GS));
#pragma unroll
        for (int i = 0; i < 16; ++i) O[(32 * mi + crow(i, hl)) * 64 + 32 * ni + r] = acc[i];
    }
    __syncthreads();
    {
        const float* GS = (const float*)(lds + G1_GS);
#pragma unroll 4
        for (int x = tid; x < 2 * 4096; x += 512) {
            const int dir = x >> 12, i = (x >> 6) & 63, j = x & 63;
            const float* gc = g1_sm(lds, dir, 0);
            const bool before = dir == 0 ? (j < i) : (j > i);
            const float v = before ? g1_sm(lds, dir, 1)[i] * GS[i * 64 + j] * __expf(gc[i] - gc[j]) : 0.f;
            if (dir == 0) ((float*)(lds + G1_AT))[i * 68 + j] = v; else ((float*)(lds + G1_AT + 17408))[(63 - i) * 68 + (63 - j)] = v;
        }
    }
    __syncthreads();
    if (cut == 2) return;
    if (wid < 2) {
        float* T = (float*)(lds + G1_AT + wid * 17408);
        float t[64];
        f32x4 ra[2][16];
        t[0] = (lane == 0) ? 1.f : 0.f;
        ra[1][0] = *(const f32x4*)(T + 1 * 68);
#pragma unroll
        for (int i = 1; i < 64; ++i) {
            const int c = i & 1, nx = c ^ 1;
            if (i < 63) {
#pragma unroll
                for (int j4 = 0; j4 * 4 < i + 1; ++j4) ra[nx][j4] = *(const f32x4*)(T + (i + 1) * 68 + 4 * j4);
            }
            float ac[4] = {(lane == i) ? 1.f : 0.f, 0.f, 0.f, 0.f};
#pragma unroll
            for (int j4 = 0; j4 * 4 < i; ++j4) {
#pragma unroll
                for (int e = 0; e < 4; ++e) if (4 * j4 + e < i) ac[e] -= ra[c][j4][e] * t[4 * j4 + e];
            }
            t[i] = (ac[0] + ac[1]) + (ac[2] + ac[3]);
        }
#pragma unroll
        for (int i = 0; i < 64; ++i) T[i * 68 + lane] = t[i];
    } else {
        bf16_t* rec0e = (bf16_t*)(a.ws + WS_GPRE);
#pragma unroll
        for (int it2 = 0; it2 < 12; ++it2) {
            const int kind = it2 >> 1, x = (tid - 128) + 384 * (it2 & 1), dir = kind >= 3 ? 1 : 0, kk = kind - 3 * dir;
            if (x >= 512) continue;
            bf16_t* rec = rec0e + (size_t)chunk_index(dir, b, h, cc) * GP_REC;
            const float* gc = g1_sm(lds, dir, 0); const float* ekd = g1_sm(lds, dir, 3); const float* eg = g1_sm(lds, dir, 4);
            if (kk == 0) {
                const int c = x >> 3, g16 = x & 7;
                const u32x4 x0 = *(const u32x4*)(lds + G1_QS + c * 272 + g16 * 32), x1 = *(const u32x4*)(lds + G1_QS + c * 272 + g16 * 32 + 16);
                const unsigned pm[8] = {x0.x, x0.y, x1.x, x1.y, x0.z, x0.w, x1.z, x1.w};
                const float sc = eg[c];
                u32x4 o0, o1;
                o0.x = pk2(__uint_as_float(pm[0] << 16) * sc, __uint_as_float(pm[0] & 0xffff0000u) * sc); o0.y = pk2(__uint_as_float(pm[1] << 16) * sc, __uint_as_float(pm[1] & 0xffff0000u) * sc);
                o0.z = pk2(__uint_as_float(pm[2] << 16) * sc, __uint_as_float(pm[2] & 0xffff0000u) * sc); o0.w = pk2(__uint_as_float(pm[3] << 16) * sc, __uint_as_float(pm[3] & 0xffff0000u) * sc);
                o1.x = pk2(__uint_as_float(pm[4] << 16) * sc, __uint_as_float(pm[4] & 0xffff0000u) * sc); o1.y = pk2(__uint_as_float(pm[5] << 16) * sc, __uint_as_float(pm[5] & 0xffff0000u) * sc);
                o1.z = pk2(__uint_as_float(pm[6] << 16) * sc, __uint_as_float(pm[6] & 0xffff0000u) * sc); o1.w = pk2(__uint_as_float(pm[7] << 16) * sc, __uint_as_float(pm[7] & 0xffff0000u) * sc);
                u32x4* dp = (u32x4*)(rec + GP_QD + c * 128 + g16 * 16); dp[0] = o0; dp[1] = o1;
            } else if (kk == 1) {
                const int dk = x >> 2, g16 = x & 3;
                const bf16_t* kp = (const bf16_t*)(lds + G1_KS) + dk + (g16 * 16) * 136;
                unsigned ow[8];
#pragma unroll
                for (int q = 0; q < 8; ++q) {
                    const int p0 = 2 * q, p1 = 2 * q + 1; const int c0 = swap23(p0), c1 = swap23(p1);
                    ow[q] = pk2(bf2f(kp[c0 * 136]) * ekd[16 * g16 + c0], bf2f(kp[c1 * 136]) * ekd[16 * g16 + c1]);
                }
                u32x4* dp = (u32x4*)(rec + GP_KDT + dk * 64 + g16 * 16);
                dp[0] = (u32x4){ow[0], ow[1], ow[2], ow[3]}; dp[1] = (u32x4){ow[4], ow[5], ow[6], ow[7]};
            } else {
                const int i = x >> 3, sub = x & 7;
                const float* QKm = (const float*)(lds + G1_QKS) + i * 64;
                const float gi = gc[i];
                unsigned ow[4];
#pragma unroll
                for (int q = 0; q < 4; ++q) {
                    float v[2];
#pragma unroll
                    for (int e = 0; e < 2; ++e) {
                        const int jp = 8 * sub + 2 * q + e, j = (jp & ~15) + swap23(jp & 15);
                        const bool ok = dir == 0 ? (j <= i) : (j >= i);
                        v[e] = ok ? QKm[j] * __expf(gi - gc[j]) : 0.f;
                    }
                    ow[q] = pk2(v[0], v[1]);
                }
                *(u32x4*)(rec + GP_QK + i * 64 + 8 * sub) = (u32x4){ow[0], ow[1], ow[2], ow[3]};
            }
        }
    }
    __syncthreads();
    bf16_t* rec0 = (bf16_t*)(a.ws + WS_GPRE);
#pragma unroll 1
    for (int rep6_ = 0; rep6_ < G1REP6; ++rep6_) {
    {
        const int dir = wid >> 2, n = wid & 3;
        bf16_t* rec = rec0 + (size_t)chunk_index(dir, b, h, cc) * GP_REC;
        const float* T = (const float*)(lds + G1_AT + dir * 17408);
        f32x4 tq[2][4][2];
        f32x4 c1[4][2], c2[4][2];
        bf16x8 bv[4], bk[4];
#pragma unroll
        for (int s = 0; s < 4; ++s) {
            const float* p1 = g1_sm(lds, dir, 1) + 16 * s + 8 * hl; const float* p2 = g1_sm(lds, dir, 2) + 16 * s + 8 * hl;
            c1[s][0] = *(const f32x4*)p1; c1[s][1] = *(const f32x4*)(p1 + 4); c2[s][0] = *(const f32x4*)p2; c2[s][1] = *(const f32x4*)(p2 + 4);
            {
                const unsigned toff = (unsigned)((16 * s + 8 * hl + ((lane & 15) >> 2)) * 272 + (32 * n + 16 * ((lane >> 4) & 1)) * 2 + 8 * (lane & 3));
                const s16x4 v0 = tr_read((const LAS unsigned char*)lds + G1_VS + toff), v1 = tr_read((const LAS unsigned char*)lds + G1_VS + toff + 4 * 272);
                const s16x4 k0 = tr_read((const LAS unsigned char*)lds + G1_KS + toff), k1 = tr_read((const LAS unsigned char*)lds + G1_KS + toff + 4 * 272);
                bv[s] = (bf16x8){v0[0], v0[1], v0[2], v0[3], v1[0], v1[1], v1[2], v1[3]};
                bk[s] = (bf16x8){k0[0], k0[1], k0[2], k0[3], k1[0], k1[1], k1[2], k1[3]};
            }
#pragma unroll
            for (int m = 0; m < 2; ++m) {
                if (dir == 0) { const float* tp = T + (32 * m + r) * 68 + 16 * s + 8 * hl; tq[m][s][0] = *(const f32x4*)tp; tq[m][s][1] = *(const f32x4*)(tp + 4); }
                else { const float* tp = T + (63 - (32 * m + r)) * 68 + 56 - 16 * s - 8 * hl; const f32x4 x0 = *(const f32x4*)tp, x1 = *(const f32x4*)(tp + 4);
                       tq[m][s][0] = (f32x4){x1[3], x1[2], x1[1], x1[0]}; tq[m][s][1] = (f32x4){x0[3], x0[2], x0[1], x0[0]}; }
            }
        }
#pragma unroll
        for (int prod = 0; prod < 2; ++prod) {
#pragma unroll
            for (int m = 0; m < 2; ++m) {
                f32x16 acc;
#pragma unroll
                for (int i = 0; i < 16; ++i) acc[i] = 0.f;
#pragma unroll
                for (int s = 0; s < 4; ++s) {
                    const f32x4 ta = tq[m][s][0], tb = tq[m][s][1];
                    const f32x4 ca = prod == 0 ? c1[s][0] : c2[s][0], cb = prod == 0 ? c1[s][1] : c2[s][1];
                    u32x4 aw; aw.x = pk2(ta[0] * ca[0], ta[1] * ca[1]); aw.y = pk2(ta[2] * ca[2], ta[3] * ca[3]); aw.z = pk2(tb[0] * cb[0], tb[1] * cb[1]); aw.w = pk2(tb[2] * cb[2], tb[3] * cb[3]);
                    acc = MFMA32(__builtin_bit_cast(bf16x8, aw), prod == 0 ? bv[s] : bk[s], acc);
                }
                if (prod == 0) {
                    u32x4 w0, w1;
                    w0.x = pk2(acc[0], acc[1]); w0.y = pk2(acc[2], acc[3]); w0.z = pk2(acc[4], acc[5]); w0.w = pk2(acc[6], acc[7]);
                    w1.x = pk2(acc[8], acc[9]); w1.y = pk2(acc[10], acc[11]); w1.z = pk2(acc[12], acc[13]); w1.w = pk2(acc[14], acc[15]);
                    u32x4* up = (u32x4*)(rec + GP_U + ((m * 4 + n) * 64 + lane) * 16);
                    up[0] = w0; up[1] = w1;
                } else {
                    const int dkp = 32 * n + (r & 16) + swap23(r & 15);
#pragma unroll
                    for (int i = 0; i < 16; ++i) rec[GP_WN + (32 * m + crow(i, hl)) * 128 + dkp] = f2bf(-acc[i]);
                }
            }
        }
    }
    }
    __syncthreads();
}
DI void ph_g1(const Args& a, int l, unsigned char* lds, int cut = 0) {
#pragma unroll 1
    for (int task = blockIdx.x; task < 16 * 68; task += gridDim.x) {
        const int bh = task / 68, cc = task % 68;
        g1_task(a, l, bh >> 2, bh & 3, cc, lds, cut);
    }
}

#ifndef PROBE_SCAN_FAKE
#define PROBE_SCAN_FAKE 0
#endif
constexpr int SC_WN = 0, SC_QD = 16384, SC_KDT = 32768, SC_QK = 49152, SC_BUF = 57344, SC_GL = 2 * SC_BUF;
DI int scan_cc(int dir, int step) { return dir == 0 ? step : (step < 4 ? 3 - step : 71 - step); }
DI unsigned scan_src_off(int p) {
    if (p < 2048) { const int row = (p & 1023) >> 4, s16 = p & 15; return (unsigned)((p >> 10) * 16384 + row * 256 + ((s16 ^ (row & 15)) << 4)); }
    const int q = p - 2048, row = q >> 3, s8 = q & 7;
    return (unsigned)(32768 + row * 128 + ((s8 ^ ((row >> 1) & 7)) << 4));
}
#define SCAN_BAR() asm volatile("s_barrier" ::: "memory")
DI void scan_block(const Args& a, int l, int dir, int b, int h, unsigned char* lds, int fake = 0) {
    const int tid = tidx(), lane = tid & 63, wid = tid >> 6, r = lane & 31, hl = lane >> 5;
    const bf16_t* rec0 = (const bf16_t*)(a.ws + WS_GPRE);
    const float* GL = (const float*)(a.ws + WS_GL);
    const bool loader = wid >= 4;
    const int n = wid & 3, lw = __builtin_amdgcn_readfirstlane(wid) - 4;
    bf16_t* OD = (bf16_t*)(a.ws + (dir ? WS_OB : WS_OF));
    f32x16 st[4];
#pragma unroll
    for (int t = 0; t < 4; ++t)
#pragma unroll
        for (int i = 0; i < 16; ++i) st[t][i] = 0.f;
    u32x4 un[4]; float gln = 0.f;
    unsigned swq[8], skq[6];
    if (loader) {
#pragma unroll
        for (int j = 0; j < 8; ++j) swq[j] = scan_src_off((lw * 8 + j) * 64 + lane);
#pragma unroll
        for (int j = 0; j < 6; ++j) skq[j] = scan_src_off(2048 + (lw * 6 + j) * 64 + lane);
    }
#define DMA_WQ(chunk_, bufsel_) do { const int c_ = (chunk_) < 68 ? (chunk_) : 67; const unsigned char* src_ = (const unsigned char*)(rec0 + (size_t)chunk_index(dir, b, h, scan_cc(dir, c_)) * GP_REC); \
        LAS unsigned char* nb_ = (LAS unsigned char*)lds + (bufsel_) * SC_BUF; \
        _Pragma("unroll") for (int j = 0; j < 8; ++j) __builtin_amdgcn_global_load_lds((const unsigned*)(src_ + swq[j]), (LAS unsigned*)(nb_ + (lw * 8 + j) * 1024), 16, 0, 0); } while (0)
#define DMA_KQ(chunk_, bufsel_) do { const int c_ = (chunk_) < 68 ? (chunk_) : 67; const unsigned char* src_ = (const unsigned char*)(rec0 + (size_t)chunk_index(dir, b, h, scan_cc(dir, c_)) * GP_REC); \
        LAS unsigned char* nb_ = (LAS unsigned char*)lds + (bufsel_) * SC_BUF; \
        _Pragma("unroll") for (int j = 0; j < 6; ++j) __builtin_amdgcn_global_load_lds((const unsigned*)(src_ + skq[j]), (LAS unsigned*)(nb_ + 32768 + (lw * 6 + j) * 1024), 16, 0, 0); } while (0)
    if (loader) {
        DMA_WQ(0, 0); DMA_KQ(0, 0); DMA_WQ(1, 1);
        asm volatile("s_waitcnt vmcnt(8)" ::: "memory");
    } else {
        const int ci = chunk_index(dir, b, h, scan_cc(dir, 0));
        const bf16_t* rec = rec0 + (size_t)ci * GP_REC;
#pragma unroll
        for (int m = 0; m < 2; ++m) { const u32x4* up = (const u32x4*)(rec + GP_U + ((m * 4 + n) * 64 + lane) * 16); un[2 * m] = up[0]; un[2 * m + 1] = up[1]; }
        gln = GL[ci];
    }
    SCAN_BAR();
#pragma unroll 1
    for (int step = 0; step < 68; ++step) {
        const int cur = step & 1;
        if (loader) {
            if (fake != 1) {
                DMA_KQ(step + 1, cur ^ 1);
                asm volatile("s_waitcnt vmcnt(14)" ::: "memory");
                SCAN_BAR();
                DMA_WQ(step + 2, cur);
                asm volatile("s_waitcnt vmcnt(14)" ::: "memory");
                SCAN_BAR();
            } else { SCAN_BAR(); SCAN_BAR(); }
        } else {
            if (fake != 2) {
            const int cc = scan_cc(dir, step);
            const int row0 = cc < 4 ? b * CTX + cc * 64 : NCTX + b * SEQ + (cc - 4) * 64;
            const unsigned char* buf = lds + cur * SC_BUF;
            const float gl = gln;
            const unsigned char* pwn = buf + SC_WN + r * 256;
            const unsigned char* pqd = buf + SC_QD + r * 256;
            const unsigned char* pqk = buf + SC_QK + r * 128;
            const unsigned char* pkd = buf + SC_KDT + r * 128;
            const int x16 = r & 15, x8 = (r >> 1) & 7;
#define FR256(base, tile, blk) (*(const bf16x8*)((base) + (tile) * 32 * 256 + ((((blk) ^ x16)) << 4)))
#define FR128(base, tile, blk) (*(const bf16x8*)((base) + (tile) * 32 * 128 + ((((blk) ^ x8)) << 4)))
            bf16x8 fa[2][4];
#pragma unroll
            for (int m = 0; m < 2; ++m) { fa[0][m] = FR256(pwn, m, hl); fa[0][2 + m] = FR256(pqd, m, hl); }
            f32x16 vn[2];
#pragma unroll
            for (int m = 0; m < 2; ++m) {
                const u32x4 u0 = un[2 * m], u1 = un[2 * m + 1];
#pragma unroll
                for (int k = 0; k < 4; ++k) { vn[m][2 * k] = __uint_as_float(u0[k] << 16); vn[m][2 * k + 1] = __uint_as_float(u0[k] & 0xffff0000u); vn[m][8 + 2 * k] = __uint_as_float(u1[k] << 16); vn[m][8 + 2 * k + 1] = __uint_as_float(u1[k] & 0xffff0000u); }
            }
            if (step + 1 < 68) {
                const int ci1 = chunk_index(dir, b, h, scan_cc(dir, step + 1));
                const bf16_t* rec = rec0 + (size_t)ci1 * GP_REC;
#pragma unroll
                for (int m = 0; m < 2; ++m) { const u32x4* up = (const u32x4*)(rec + GP_U + ((m * 4 + n) * 64 + lane) * 16); un[2 * m] = up[0]; un[2 * m + 1] = up[1]; }
                gln = GL[ci1];
            }
            f32x16 o[2];
#pragma unroll
            for (int m = 0; m < 2; ++m)
#pragma unroll
                for (int i = 0; i < 16; ++i) o[m][i] = 0.f;
#pragma unroll
            for (int kk = 0; kk < 8; ++kk) {
                const int c = kk & 1, nx = c ^ 1;
                if (kk < 7) {
#pragma unroll
                    for (int m = 0; m < 2; ++m) { fa[nx][m] = FR256(pwn, m, 2 * (kk + 1) + hl); fa[nx][2 + m] = FR256(pqd, m, 2 * (kk + 1) + hl); }
                }
                const bf16x8 sbk = pack8(st[kk >> 1], kk & 1);
#pragma unroll
                for (int m = 0; m < 2; ++m) { vn[m] = MFMA32(fa[c][m], sbk, vn[m]); o[m] = MFMA32(fa[c][2 + m], sbk, o[m]); }
            }
            asm volatile("s_waitcnt lgkmcnt(0)" ::: "memory");
            SCAN_BAR();
            bf16x8 fb[2][3];
            fb[0][0] = FR128(pqk, 0, hl); fb[0][1] = FR128(pqk, 1, hl); fb[0][2] = FR128(pkd, 0, hl);
#pragma unroll
            for (int t = 0; t < 4; ++t)
#pragma unroll
                for (int i = 0; i < 16; ++i) st[t][i] *= gl;
#pragma unroll
            for (int h2 = 0; h2 < 8; ++h2) {
                const int kk = h2 >> 1, part = h2 & 1, c = h2 & 1, nx = c ^ 1;
                if (h2 < 7) {
                    const int k1 = (h2 + 1) >> 1;
                    if (part == 0) {
#pragma unroll
                        for (int t = 1; t < 4; ++t) fb[nx][t - 1] = FR128(pkd, t, 2 * k1 + hl);
                    } else { fb[nx][0] = FR128(pqk, 0, 2 * k1 + hl); fb[nx][1] = FR128(pqk, 1, 2 * k1 + hl); fb[nx][2] = FR128(pkd, 0, 2 * k1 + hl); }
                }
                const bf16x8 vbk = pack8(vn[kk >> 1], kk & 1);
                if (part == 0) { o[0] = MFMA32(fb[c][0], vbk, o[0]); o[1] = MFMA32(fb[c][1], vbk, o[1]); st[0] = MFMA32(fb[c][2], vbk, st[0]); }
                else { st[1] = MFMA32(fb[c][0], vbk, st[1]); st[2] = MFMA32(fb[c][1], vbk, st[2]); st[3] = MFMA32(fb[c][2], vbk, st[3]); }
            }
#undef FR256
#undef FR128
#pragma unroll
            for (int m = 0; m < 2; ++m)
#pragma unroll
                for (int i = 0; i < 16; ++i) OD[(size_t)(row0 + 32 * m + crow(i, hl)) * 512 + h * 128 + 32 * n + r] = f2bf(o[m][i]);
            asm volatile("s_waitcnt lgkmcnt(0)" ::: "memory");
            SCAN_BAR();
            } else { SCAN_BAR(); SCAN_BAR(); }
        }
    }
    if (loader) asm volatile("s_waitcnt vmcnt(0)" ::: "memory");
    __syncthreads();
#undef DMA_WQ
#undef DMA_KQ
}
#undef SCAN_BAR
DI void ph_scan(const Args& a, int l, unsigned char* lds) {
    const int x = blockIdx.x;
#if PROBE_SCAN_FAKE
    scan_block(a, l, x >> 4, (x >> 2) & 3, x & 3, lds, PROBE_SCAN_FAKE); __syncthreads();
#endif
    scan_block(a, l, x >> 4, (x >> 2) & 3, x & 3, lds);
}

__global__ void __launch_bounds__(256) nv_inproj(Args a) {
    const int l = a.layer;
    const int row = blockIdx.y, cd = blockIdx.x * 256 + threadIdx.x;
    const int cs = cd < 3584 ? cd : cd + 16;
    const float* w = a.in[6] + (size_t)l * 1024 * N_IN;
    const bf16_t* hr = (const bf16_t*)(a.ws + WS_H) + (size_t)row * 1024;
    const bool isrope = (cd < 1024) && (row >= NCTX);
    const int cs2 = cs ^ 16;
    float acc = 0.f, acc2 = 0.f;
    for (int k = 0; k < 1024; ++k) { const float h = bf2f(hr[k]); acc += h * w[(size_t)k * N_IN + cs]; if (isrope) acc2 += h * w[(size_t)k * N_IN + cs2]; }
    if (cd < 1024) {
        float v = acc;
        if (isrope) {
            const float* rope = (const float*)(a.ws + WS_ROPE);
            const int t = (row - NCTX) & 4095, d = cd & 63, axis = (d >> 5) & 1, half = (d >> 4) & 1, f = d & 15;
            const int pos = axis ? (t & 63) : (t >> 6);
            const float c = rope[(pos * 16 + f) * 2], s = rope[(pos * 16 + f) * 2 + 1];
            v = half == 0 ? acc * c - acc2 * s : acc * c + acc2 * s;
        }
        if (cd < 512) ((bf16_t*)(a.ws + WS_QA))[(size_t)row * 512 + cd] = f2bf(v * QSCALE);
        else ((bf16_t*)(a.ws + WS_KA))[(size_t)row * 512 + cd - 512] = f2bf(v);
    } else if (cd < 1536) ((bf16_t*)(a.ws + WS_VA))[(size_t)row * 512 + cd - 1024] = f2bf(acc);
    else if (cd < 3072) ((bf16_t*)(a.ws + WS_QKV))[(size_t)row * 1536 + cd - 1536] = f2bf(acc);
    else if (cd < 3584) ((bf16_t*)(a.ws + WS_Z))[(size_t)row * 512 + cd - 3072] = f2bf(acc);
    else ((bf16_t*)(a.ws + WS_SG))[(size_t)row * 2048 + cd - 3584] = f2bf(sigmoidf_(acc));
}

__global__ void __launch_bounds__(256) nv_attn(Args a) {
    const int row = blockIdx.x * 256 + threadIdx.x;
    const int h = blockIdx.y >> 2, comp = (blockIdx.y >> 1) & 1, dh = blockIdx.y & 1;
    const bf16_t* QA = (const bf16_t*)(a.ws + WS_QA); const bf16_t* KA = (const bf16_t*)(a.ws + WS_KA); const bf16_t* VA = (const bf16_t*)(a.ws + WS_VA);
    float* ON = (float*)(a.ws + WS_ON);
    const bool isctx = row < NCTX;
    const int b = isctx ? (row >> 8) : ((row - NCTX) >> 12);
    float q[64];
    { const bf16_t* qp = QA + (size_t)row * 512 + h * 128 + comp * 64;
#pragma unroll
      for (int i = 0; i < 64; ++i) q[i] = bf2f(qp[i]); }
    float acc[64];
#pragma unroll
    for (int i = 0; i < 64; ++i) acc[i] = 0.f;
    float m = -1e30f, lsum = 0.f;
    const int nkeys = isctx ? CTX : CTX + SEQ;
    for (int kk = 0; kk < nkeys; ++kk) {
        const int kr = kk < CTX ? b * CTX + kk : NCTX + b * SEQ + (kk - CTX);
        const bf16_t* kp = KA + (size_t)kr * 512 + h * 128 + comp * 64;
        float s = 0.f;
#pragma unroll
        for (int i = 0; i < 64; ++i) s += q[i] * bf2f(kp[i]);
        const float mn = fmaxf(m, s), corr = exp2f(m - mn), p = exp2f(s - mn);
        lsum = lsum * corr + p; m = mn;
        const bf16_t* vp = VA + (size_t)kr * 512 + h * 128 + dh * 64;
#pragma unroll
        for (int i = 0; i < 64; ++i) acc[i] = acc[i] * corr + p * bf2f(vp[i]);
    }
    const float inv = 1.f / lsum;
    float* op = ON + ((size_t)comp * TT + row) * 512 + h * 128 + dh * 64;
#pragma unroll
    for (int i = 0; i < 64; ++i) op[i] = acc[i] * inv;
}
DI float lam_of(const Args& a, int l) {
    float s1 = 0.f, s2 = 0.f;
    for (int i = 0; i < 64; ++i) { s1 += a.in[8][l * 64 + i] * a.in[9][l * 64 + i]; s2 += a.in[10][l * 64 + i] * a.in[11][l * 64 + i]; }
    return expf(s1) - expf(s2) + lam_init_of(l);
}
__global__ void __launch_bounds__(256) nv_attn_combine(Args a) {
    const int l = a.layer;
    const int idx = blockIdx.x * 256 + threadIdx.x; if (idx >= TT * 4) return;
    const int row = idx >> 2, h = idx & 3;
    const float lam = lam_of(a, l), li = lam_init_of(l);
    const float* ON = (const float*)(a.ws + WS_ON);
    const float* o0 = ON + (size_t)row * 512 + h * 128; const float* o1 = ON + ((size_t)TT + row) * 512 + h * 128;
    float ss = 0.f;
    for (int i = 0; i < 128; ++i) { const float o = o0[i] - lam * o1[i]; ss += o * o; }
    const float r = rsqrtf(ss * (1.f / 128.f) + EPS) * (1.f - li);
    bf16_t* ya = (bf16_t*)(a.ws + WS_YAB) + (size_t)row * 512 + h * 128;
    const float* sg = a.in[12] + l * 128;
    for (int i = 0; i < 128; ++i) ya[i] = f2bf((o0[i] - lam * o1[i]) * r * sg[i]);
}
__global__ void __launch_bounds__(256) nv_conv(Args a) {
    const int l = a.layer;
    const int row = blockIdx.y, ch = blockIdx.x * 256 + threadIdx.x;
    const bf16_t* QKV = (const bf16_t*)(a.ws + WS_QKV); float* CO = (float*)(a.ws + WS_CONVO);
    const float* cw = a.in[7] + l * 5 * 1536;
    int s0, len; if (row < NCTX) { s0 = (row >> 8) << 8; len = CTX; } else { s0 = NCTX + (((row - NCTX) >> 12) << 12); len = SEQ; }
    const int t = row - s0; float acc = 0.f;
    for (int j = 0; j < 5; ++j) { const int tt = t + j - 2; if (tt >= 0 && tt < len) acc += cw[j * 1536 + ch] * bf2f(QKV[(size_t)(s0 + tt) * 1536 + ch]); }
    CO[(size_t)row * 1536 + ch] = siluf_(acc);
}
__global__ void __launch_bounds__(256) nv_norm(Args a) {
    const int idx = blockIdx.x * 256 + threadIdx.x; if (idx >= TT * 8) return;
    const int row = idx >> 3, h = (idx >> 1) & 3, which = idx & 1;
    float* p = (float*)(a.ws + WS_CONVO) + (size_t)row * 1536 + which * 512 + h * 128;
    float ss = 0.f; for (int i = 0; i < 128; ++i) ss += p[i] * p[i];
    const float r = rsqrtf(ss + EPS) * (which == 0 ? 0.08838834764831845f : 1.f);
    for (int i = 0; i < 128; ++i) p[i] *= r;
}
__global__ void __launch_bounds__(128) nv_scan(Args a) {
    const int l = a.layer;
    const int dir = blockIdx.x >> 4, b = (blockIdx.x >> 2) & 3, h = blockIdx.x & 3, e = threadIdx.x;
    __shared__ float sq[128], sk[128];
    const float* CO = (const float*)(a.ws + WS_CONVO); const float* AB = (const float*)(a.ws + WS_AB);
    bf16_t* OD = (bf16_t*)(a.ws + (dir ? WS_OB : WS_OF));
    const float nal = -expf(a.in[13][l * 8 + dir * 4 + h]), dtb = a.in[14][l * 8 + dir * 4 + h];
    float s[128];
#pragma unroll
    for (int d = 0; d < 128; ++d) s[d] = 0.f;
    for (int step = 0; step < CTX + SEQ; ++step) {
        int row;
        if (step < CTX) { const int t = dir ? (CTX - 1 - step) : step; row = b * CTX + t; }
        else { const int t = dir ? (SEQ - 1 - (step - CTX)) : (step - CTX); row = NCTX + b * SEQ + t; }
        __syncthreads();
        sq[e] = CO[(size_t)row * 1536 + h * 128 + e]; sk[e] = CO[(size_t)row * 1536 + 512 + h * 128 + e];
        const float v = CO[(size_t)row * 1536 + 1024 + h * 128 + e];
        __syncthreads();
        const float g = nal * softplusf_(AB[(size_t)row * 16 + dir * 4 + h] + dtb);
        const float av = expf(g), beta = sigmoidf_(AB[(size_t)row * 16 + 8 + dir * 4 + h]);
        float r = 0.f, qs = 0.f, qk = 0.f;
#pragma unroll
        for (int d = 0; d < 128; ++d) { r += sk[d] * s[d]; qs += sq[d] * s[d]; qk += sq[d] * sk[d]; }
        const float vn = beta * (v - av * r);
        const float o = av * qs + qk * vn;
#pragma unroll
        for (int d = 0; d < 128; ++d) s[d] = av * s[d] + sk[d] * vn;
        OD[(size_t)row * 512 + h * 128 + e] = f2bf(o);
    }
}
__global__ void __launch_bounds__(256) nv_merge1(Args a) {
    const int l = a.layer;
    const int row = blockIdx.y, c = blockIdx.x * 256 + threadIdx.x;
    const bf16_t* YA = (const bf16_t*)(a.ws + WS_YAB) + (size_t)row * 512; const bf16_t* YB = (const bf16_t*)(a.ws + WS_YAB) + ((size_t)TT + row) * 512;
    const float* wpa = a.in[16] + (size_t)l * 512 * 1024; const float* wpb = a.in[17] + (size_t)l * 512 * 1024;
    float pa = 0.f, pb = 0.f;
    for (int k = 0; k < 512; ++k) { pa += bf2f(YA[k]) * wpa[(size_t)k * 1024 + c]; pb += bf2f(YB[k]) * wpb[(size_t)k * 1024 + c]; }
    const bf16_t* SG = (const bf16_t*)(a.ws + WS_SG) + (size_t)row * 2048;
    ((bf16_t*)(a.ws + WS_M))[(size_t)row * 1024 + c] = f2bf(bf2f(SG[c]) * pa + bf2f(SG[1024 + c]) * pb);
}
__global__ void __launch_bounds__(256) nv_wo(Args a) {
    const int l = a.layer;
    const int row = blockIdx.y, c = blockIdx.x * 256 + threadIdx.x;
    const bf16_t* M = (const bf16_t*)(a.ws + WS_M) + (size_t)row * 1024; const float* wo = a.in[18] + (size_t)l * 1024 * 1024;
    float acc = 0.f;
    for (int k = 0; k < 1024; ++k) acc += bf2f(M[k]) * wo[(size_t)k * 1024 + c];
    float* X = (float*)(a.ws + WS_X) + (size_t)row * 1024 + c;
    const float* m = (const float*)(a.ws + WS_MODS) + (size_t)(l * 5 + mod_set(row)) * 6144;
    *X = ALPHA * *X + m[2 * 1024 + c] * acc;
}
__global__ void __launch_bounds__(256) nv_moe1(Args a) {
    const int l = a.layer;
    const int as = blockIdx.y, j = blockIdx.x * 256 + threadIdx.x;
    const int row = as >> 1; if (l == DEPTH - 1 && row < NCTX) return;
    const int e = ((const int*)(a.ws + WS_ROUTE_E))[as];
    const bf16_t* hr = (const bf16_t*)(a.ws + WS_H) + (size_t)row * 1024;
    const float* w1 = a.in[23] + ((size_t)l * 16 + e) * 1024 * 512; const float* w3 = a.in[24] + ((size_t)l * 16 + e) * 1024 * 512;
    float g = 0.f, u = 0.f;
    for (int k = 0; k < 1024; ++k) { const float hv = bf2f(hr[k]); g += hv * w1[(size_t)k * 512 + j]; u += hv * w3[(size_t)k * 512 + j]; }
    ((bf16_t*)(a.ws + WS_ACT))[(size_t)as * 512 + j] = f2bf(siluf_(g) * u);
}
__global__ void __launch_bounds__(256) nv_moe2(Args a) {
    const int l = a.layer;
    const int as = blockIdx.y, c = blockIdx.x * 256 + threadIdx.x;
    const int row = as >> 1; if (l == DEPTH - 1 && row < NCTX) return;
    const int e = ((const int*)(a.ws + WS_ROUTE_E))[as];
    const bf16_t* ar = (const bf16_t*)(a.ws + WS_ACT) + (size_t)as * 512;
    const float* w2 = a.in[25] + ((size_t)l * 16 + e) * 512 * 1024;
    float acc = 0.f;
    for (int k = 0; k < 512; ++k) acc += bf2f(ar[k]) * w2[(size_t)k * 1024 + c];
    ((bf16_t*)(a.ws + WS_YS))[(size_t)as * 1024 + c] = f2bf(acc);
}


enum Op { OP_MODS = 0, OP_CONVERT, OP_PREP0, OP_INPROJ, OP_ATTN_G1, OP_SCAN, OP_YB, OP_MERGE1, OP_WO, OP_LN1, OP_SLOT, OP_UP, OP_DOWN, OP_COMBINE, OP_NONE };
constexpr int NSTEP_PRE = 2, NSTEP_LAYER = 11, NSTEPS = NSTEP_PRE + NSTEP_LAYER * DEPTH;
__host__ __device__ inline void decode_step(int step, int& op, int& l) {
    if (step < NSTEP_PRE) { l = 0; op = step == 0 ? OP_MODS : OP_PREP0; return; }
    const int s = step - NSTEP_PRE; l = s / NSTEP_LAYER; op = OP_INPROJ + s % NSTEP_LAYER;
}

#ifndef PROBE_XBAR
#define PROBE_XBAR 0
#endif
#ifndef PROBE_WO2
#define PROBE_WO2 0
#endif
#ifndef PROBE_LN12
#define PROBE_LN12 0
#endif
#ifndef PROBE_CMB2
#define PROBE_CMB2 0
#endif
#ifndef PROBE_ATT2
#define PROBE_ATT2 0
#endif
#ifndef PROBE_G12
#define PROBE_G12 0
#endif
#ifndef PROBE_OP
#define PROBE_OP -1
#endif
#ifndef PROBE_N
#define PROBE_N 1
#endif
#ifndef PROBE_PAD
#define PROBE_PAD 7
#endif
#ifndef ONLY_OP
#define ONLY_OP -1
#endif
#define EN(o) (ONLY_OP < 0 || ONLY_OP == (o))
__global__ void __launch_bounds__(512, 2) mk(Args a_in) {
    extern __shared__ __attribute__((aligned(16))) unsigned char lds[];
    const int tid = threadIdx.x;
    volatile LAS unsigned* MISC = (volatile LAS unsigned*)((LAS unsigned char*)lds + LDS_MISC);
    if (tid < 64) MISC[tid] = 0u;
    __syncthreads();
    XcdBarrier bar; bar.bar = (unsigned*)(a_in.ws + WS_CTL) + 4096; bar.x = 0; bar.st = nullptr;
    if (a_in.hi - a_in.lo > 1) bar = xcd_barrier_post((unsigned*)(a_in.ws + WS_CTL) + 4096, MISC + 8);
    const int G = gridDim.x;
#pragma unroll 1
    for (int step = a_in.lo; step < a_in.hi; ++step) {
        int op, l; decode_step(step, op, l);
        if ((op == OP_WO || op == OP_DOWN) && (a_in.hi - a_in.lo > 1)) continue;
        Args a = a_in;
        { unsigned z; asm volatile("s_mov_b32 %0, 0" : "=s"(z)); a.ws = a_in.ws + z; a.out = a_in.out + z;
#pragma unroll
          for (int i = 0; i < 28; ++i) a.in[i] = a_in.in[i] + z; }
#if PROBE_OP >= 0
        const int nrep_ = (op == PROBE_OP) ? 1 + PROBE_N : 1;
#pragma unroll 1
        for (int rep_ = 0; rep_ < nrep_; ++rep_) {
        const int padm_ = (rep_ > 0) ? PROBE_PAD : 7;
        if (rep_ > 0) xcd_barrier(bar);
#else
        const int padm_ = 7;
        {
#endif
        if (EN(OP_MODS) && op == OP_MODS) {
            ph_mods(a, lds);
            { const int t_ = tidx(); convert_run(a, 0, -1, blockIdx.x * 8 + (t_ >> 6), G * 8, (float*)(lds + 40960 + (t_ >> 6) * 8704), t_ & 63); }
            __syncthreads();
        }
        else if (EN(OP_PREP0) && op == OP_PREP0) ph_prep0(a, lds);
        else if (EN(OP_INPROJ) && op == OP_INPROJ) {
            pg8::Gemm g{(const bf16_t*)(a.ws + WS_H), (const bf16_t*)(a.ws + WS_WIN), TT, NPROJ, 1024};
            pg8::StaticOrder S; S.init(TT, NPROJ, G, (int)blockIdx.x);
            EpiInproj E{a.ws};
            pg8::gemm_phase<EpiInproj, pg8::StaticOrder, true, true>((LAS unsigned char*)lds, g, S, E);
        }
        else if (EN(OP_ATTN_G1) && op == OP_ATTN_G1) {
            if (a_in.pad & padm_ & 1) {
#if PROBE_ATT2
                ph_attn<PROBE_ATT2>(a, l, (LAS unsigned char*)lds); __syncthreads();
#endif
                ph_attn<0>(a, l, (LAS unsigned char*)lds);
            }
            if (a_in.pad & padm_ & 2) {
#if PROBE_G12
                ph_g1(a, l, lds, PROBE_G12 - 1); __syncthreads();
#endif
                ph_g1(a, l, lds);
            }
        }
        else if (EN(OP_SCAN) && op == OP_SCAN) {
            const int t_ = tidx(), w_ = t_ >> 6;
            const bool scanner = (a_in.pad & 4) && blockIdx.x < 32;
            const bool do_conv_ = (padm_ & 8) || (padm_ == 7);
            if (scanner) { if (padm_ & 4) ph_scan(a, l, lds); }
            else {
                const int nscan = (a_in.pad & 4) ? 32 : 0;
                const int rank = ((int)blockIdx.x - nscan) * 8 + w_;
                if (do_conv_) convert_run(a, l + 1, l, rank, (G - nscan) * 8, (float*)(lds + w_ * 16384), t_ & 63);
            }
            __syncthreads();
        }
        else if (EN(OP_YB) && op == OP_YB) ph_yb(a, l);
        else if (EN(OP_MERGE1) && op == OP_MERGE1) {
            {
                pg8::Gemm g{(const bf16_t*)(a.ws + WS_YAB), (const bf16_t*)(a.ws + WS_WPAB), 2 * TT, 2048, 512};
                SchedMerge1 S{G, (int)blockIdx.x, l == DEPTH - 1 ? 4 : 0, a.ws, l};
                EpiMerge1 E{a.ws};
                pg8::gemm_phase<EpiMerge1, SchedMerge1, true, true>((LAS unsigned char*)lds, g, S, E);
            }
            {
                pg8::Gemm g{(const bf16_t*)(a.ws + WS_M), (const bf16_t*)(a.ws + WS_WO), TT, 1024, 1024};
                SchedWoWait S{G, (int)blockIdx.x, l == DEPTH - 1 ? 4 : 0, a.ws, l};
                EpiWo E{a.ws, l, 0};
                pg8::gemm_phase<EpiWo, SchedWoWait, true, true>((LAS unsigned char*)lds, g, S, E);
            }
        }
        else if (EN(OP_LN1) && op == OP_LN1) {
#if PROBE_LN12
            ph_ln1_router(a, l, lds, PROBE_LN12); __syncthreads();
#endif
            ph_ln1_router(a, l, lds);
        }
        else if (EN(OP_SLOT) && op == OP_SLOT) ph_slot(a, l, lds);
        else if (EN(OP_UP) && op == OP_UP) {
            const int* meta = (const int*)(a.ws + WS_META);
            const int ntl = meta[META_NT];
            {
                pg8::Gemm g{(const bf16_t*)(a.ws + WS_XS), (const bf16_t*)(a.ws + WS_W13), NSLOT, 16384, 1024};
                SchedMoe S{G, (int)blockIdx.x, ntl, meta + META_TE, a.ws, l, 1};
                EpiUp E{a.ws};
                pg8::gemm_phase<EpiUp, SchedMoe, true, true>((LAS unsigned char*)lds, g, S, E);
            }
            {
                pg8::Gemm g{(const bf16_t*)(a.ws + WS_ACT), (const bf16_t*)(a.ws + WS_W2), NSLOT, 16384, 512};
                SchedMoe S{G, (int)blockIdx.x, ntl, meta + META_TE, a.ws, l, 2};
                EpiDown E{a.ws};
                pg8::gemm_phase<EpiDown, SchedMoe, true, true>((LAS unsigned char*)lds, g, S, E);
            }
        }
        else if (EN(OP_COMBINE) && op == OP_COMBINE) {
#if PROBE_CMB2
            ph_combine_ln2(a, l, lds, 1); __syncthreads();
#endif
            ph_combine_ln2(a, l, lds);
        }
        }
        if (step + 1 < a_in.hi) { xcd_barrier(bar);
#if PROBE_XBAR
            for (int xb_ = 0; xb_ < PROBE_XBAR; ++xb_) xcd_barrier(bar);
#endif
        }
    }
}

#ifndef FAST_MASK
#define FAST_MASK 0xffffffffu
#endif
#ifndef MK_SINGLE
#define MK_SINGLE 1
#endif
#ifndef FAST_ATTN
#define FAST_ATTN 1
#endif
#ifndef FAST_G1
#define FAST_G1 1
#endif
#ifndef FAST_SCAN
#define FAST_SCAN 1
#endif
static bool op_fast(int op) {
    if (op == OP_ATTN_G1) return false;
    if (op == OP_SCAN) return FAST_SCAN != 0;
    return (FAST_MASK >> op) & 1u;
}
extern "C" void kernel_launch(void* const* d_in, const int* in_sizes, int n_in, void* d_out, int out_size, void* d_ws, size_t ws_size, hipStream_t stream) {
    if (n_in != 28 || ws_size < WS_END) { fprintf(stderr, "kernel_launch: unexpected n_in %d / ws_size %zu (need %zu)\n", n_in, ws_size, (size_t)WS_END); return; }
    Args a{};
    for (int i = 0; i < 28; ++i) a.in[i] = (const float*)d_in[i];
    a.out = (float*)d_out; a.ws = (unsigned char*)d_ws;
    static bool attr_done = false;
    if (!attr_done) {
        if (hipFuncSetAttribute((const void*)mk, hipFuncAttributeMaxDynamicSharedMemorySize, LDS_BYTES) != hipSuccess) fprintf(stderr, "hipFuncSetAttribute failed\n");
        attr_done = true;
    }
    hipMemsetAsync((char*)d_ws + WS_CTL, 0, 1 * MiB, stream);
#if MK_SINGLE
    a.lo = 0; a.hi = NSTEPS; a.pad = 7;
    hipLaunchKernelGGL(mk, dim3(256), dim3(512), LDS_BYTES, stream, a);
#else
    for (int step = 0; step < NSTEPS; ++step) {
        int op, l; decode_step(step, op, l);
        a.layer = l;
        if (op == OP_ATTN_G1) {
            if (FAST_ATTN || FAST_G1) { a.lo = step; a.hi = step + 1; a.pad = (FAST_ATTN ? 1 : 0) | (FAST_G1 ? 2 : 0); hipLaunchKernelGGL(mk, dim3(256), dim3(512), LDS_BYTES, stream, a); a.pad = 0; a.lo = 0; a.hi = 0; }
            if (!FAST_ATTN) {
                hipLaunchKernelGGL(nv_attn, dim3(TT / 256, 16), dim3(256), 0, stream, a);
                hipLaunchKernelGGL(nv_attn_combine, dim3(TT * 4 / 256), dim3(256), 0, stream, a);
            }
            if (!FAST_G1) {
                hipLaunchKernelGGL(nv_conv, dim3(1536 / 256, TT), dim3(256), 0, stream, a);
                hipLaunchKernelGGL(nv_norm, dim3(TT * 8 / 256), dim3(256), 0, stream, a);
            }
            continue;
        }
        if (op == OP_SCAN) {
            a.lo = step; a.hi = step + 1; a.pad = FAST_SCAN ? 4 : 0; hipLaunchKernelGGL(mk, dim3(256), dim3(512), LDS_BYTES, stream, a); a.pad = 0; a.lo = 0; a.hi = 0;
            if (!FAST_SCAN) hipLaunchKernelGGL(nv_scan, dim3(32), dim3(128), 0, stream, a);
            continue;
        }
        if (op_fast(op)) { a.lo = step; a.hi = step + 1; hipLaunchKernelGGL(mk, dim3(256), dim3(512), LDS_BYTES, stream, a); continue; }
        a.lo = 0; a.hi = 0;
        switch (op) {
        case OP_INPROJ: hipLaunchKernelGGL(nv_inproj, dim3(NPROJ / 256, TT), dim3(256), 0, stream, a); break;
        case OP_MERGE1: hipLaunchKernelGGL(nv_merge1, dim3(4, TT), dim3(256), 0, stream, a); break;
        case OP_WO: hipLaunchKernelGGL(nv_wo, dim3(4, TT), dim3(256), 0, stream, a); break;
        case OP_SLOT: break;
        case OP_UP: hipLaunchKernelGGL(nv_moe1, dim3(2, NASSIGN), dim3(256), 0, stream, a); break;
        case OP_DOWN: hipLaunchKernelGGL(nv_moe2, dim3(4, NASSIGN), dim3(256), 0, stream, a); break;
        default: fprintf(stderr, "no naive kernel for op %d\n", op); break;
        }
    }
#endif
}
```

```cpp
#include <hip/hip_runtime.h>
#include <cstdio>
#include <cstdint>

#define DI __device__ __forceinline__
typedef unsigned short bf16_t;
typedef short bf16x8 __attribute__((ext_vector_type(8)));
typedef float f32x4 __attribute__((ext_vector_type(4)));
typedef float f32x2 __attribute__((ext_vector_type(2)));
typedef float f32x16 __attribute__((ext_vector_type(16)));
typedef unsigned u32x4 __attribute__((ext_vector_type(4)));
typedef unsigned u32x2 __attribute__((ext_vector_type(2)));
typedef __bf16 bf16x2_t __attribute__((ext_vector_type(2)));

constexpr int D = 1024, NB = 4, SEQ = 4096, CTX = 256, DEPTH = 4;
constexpr int NCTX = NB * CTX;
constexpr int TT = NCTX + NB * SEQ;
constexpr int N_IN = 5648, NPROJ = 5632;
constexpr int NE = 16;
constexpr float EPS = 1e-6f;
constexpr float ALPHA = 1.681792830507429f;
constexpr float QSCALE = 0.125f * 1.4426950408889634f;
constexpr int NASSIGN = TT * 2;
constexpr int NSLOT = NASSIGN + NE * 256;

constexpr size_t MiB = 1u << 20;
constexpr size_t WS_CTL = 0;
constexpr size_t WS_MODS = 1 * MiB;
constexpr size_t WS_ROPE = 2 * MiB;
constexpr size_t WS_META = 2 * MiB + 65536;
constexpr size_t WS_ROUTE_E = 3 * MiB;
constexpr size_t WS_ROUTE_W = 3 * MiB + 262144;
constexpr size_t WS_DEST = 3 * MiB + 524288;
constexpr size_t WS_SLOTA = 3 * MiB + 786432;
constexpr size_t WS_AB = 4 * MiB;
constexpr size_t WS_GL = 6 * MiB;
constexpr size_t WS_WIN = 8 * MiB;
constexpr size_t WS_WPAB = 20 * MiB;
constexpr size_t WS_WO = 22 * MiB;
constexpr size_t WS_W13 = 24 * MiB;
constexpr size_t WS_W2 = 56 * MiB;
constexpr size_t WS_X = 72 * MiB;
constexpr size_t WS_H = 140 * MiB;
constexpr size_t WS_QA = 174 * MiB;
constexpr size_t WS_KA = 191 * MiB;
constexpr size_t WS_VA = 208 * MiB;
constexpr size_t WS_QKV = 225 * MiB;
constexpr size_t WS_Z = 276 * MiB;
constexpr size_t WS_SG = 293 * MiB;
constexpr size_t WS_GPRE = 361 * MiB;
constexpr size_t WS_OF = 514 * MiB;
constexpr size_t WS_OB = 531 * MiB;
constexpr size_t WS_YAB = 548 * MiB;
constexpr size_t WS_M = 582 * MiB;
constexpr size_t WS_END = 616 * MiB;
constexpr size_t WS_XS = 174 * MiB;
constexpr size_t WS_ACT = 250 * MiB;
constexpr size_t WS_YS = 288 * MiB;
constexpr size_t WS_ON = 361 * MiB;
constexpr size_t WS_CONVO = 361 * MiB;

DI float bf2f(bf16_t v) { return __uint_as_float(((unsigned)v) << 16); }
DI unsigned pk2(float lo, float hi) { f32x2 v = {lo, hi}; bf16x2_t b = __builtin_convertvector(v, bf16x2_t); return __builtin_bit_cast(unsigned, b); }
DI bf16_t f2bf(float f) { return (bf16_t)(pk2(f, 0.f) & 0xffffu); }
DI float sigmoidf_(float x) { return __builtin_amdgcn_rcpf(1.f + __builtin_amdgcn_exp2f(-1.4426950408889634f * x)); }
DI float siluf_(float x) { return x * __builtin_amdgcn_rcpf(1.f + __builtin_amdgcn_exp2f(-1.4426950408889634f * x)); }
DI float softplusf_(float x) { return fmaxf(x, 0.f) + log1pf(__expf(-fabsf(x))); }
template <int CTRL> DI float dppmov(float v) { return __uint_as_float(__builtin_amdgcn_update_dpp(0u, __float_as_uint(v), CTRL, 0xf, 0xf, true)); }
DI float xor32(float x, bool hi32) { auto rr = __builtin_amdgcn_permlane32_swap(__float_as_uint(x), __float_as_uint(x), false, false); return __uint_as_float(hi32 ? rr[0] : rr[1]); }
DI float xor16(float x, bool odd16) { auto rr = __builtin_amdgcn_permlane16_swap(__float_as_uint(x), __float_as_uint(x), false, false); return __uint_as_float(odd16 ? rr[0] : rr[1]); }
DI float wave_sum(float v) {
    v += dppmov<0xB1>(v); v += dppmov<0x4E>(v); v += dppmov<0x124>(v); v += dppmov<0x128>(v);
    { auto rr = __builtin_amdgcn_permlane16_swap(__float_as_uint(v), __float_as_uint(v), false, false); v = __uint_as_float(rr[0]) + __uint_as_float(rr[1]); }
    { auto rr = __builtin_amdgcn_permlane32_swap(__float_as_uint(v), __float_as_uint(v), false, false); v = __uint_as_float(rr[0]) + __uint_as_float(rr[1]); }
    return v;
}
DI int jj16_of_lane(int lane) { return ((lane >> 5) & 1) * 8 + ((lane >> 4) & 1) * 4 + ((lane >> 3) & 1) * 2 + ((lane >> 2) & 1); }
DI int lane_of_jj16(int jj) { return 32 * (jj >> 3) + 16 * ((jj >> 2) & 1) + 8 * ((jj >> 1) & 1) + 4 * (jj & 1); }
DI float reduce16(const float (&p)[16], int lane) {
    const bool b5 = lane & 32, b4 = lane & 16, b3 = lane & 8, b2 = lane & 4;
    float q8[8], q4[4], q2[2];
#pragma unroll
    for (int j = 0; j < 8; ++j) { const float keep = b5 ? p[j + 8] : p[j], send = b5 ? p[j] : p[j + 8]; q8[j] = keep + xor32(send, b5); }
#pragma unroll
    for (int j = 0; j < 4; ++j) { const float keep = b4 ? q8[j + 4] : q8[j], send = b4 ? q8[j] : q8[j + 4]; q4[j] = keep + xor16(send, b4); }
#pragma unroll
    for (int j = 0; j < 2; ++j) { const float keep = b3 ? q4[j + 2] : q4[j], send = b3 ? q4[j] : q4[j + 2]; q2[j] = keep + dppmov<0x128>(send); }
    float q1;
    { const float keep = b2 ? q2[1] : q2[0], send = b2 ? q2[0] : q2[1]; const float pa = dppmov<0x124>(send), pb = dppmov<0x12C>(send); q1 = keep + (b2 ? pa : pb); }
    q1 += dppmov<0x4E>(q1); q1 += dppmov<0xB1>(q1);
    return q1;
}
DI int mod_set(int row) { return row < NCTX ? 4 : ((row - NCTX) >> 12); }
DI float lam_init_of(int l) { return 0.8f - 0.6f * __expf(-0.3f * (float)l); }

DI int tidx() { int t = threadIdx.x; asm volatile("" : "+v"(t)); return t; }

struct Args {
    const float* in[28];
    float* out;
    unsigned char* ws;
    int lo, hi, layer, pad;
};


namespace pg8 {
#define PG8_LAS __attribute__((address_space(3)))
typedef unsigned short bf16_t;
typedef short bf16x8 __attribute__((ext_vector_type(8)));
typedef float f32x4 __attribute__((ext_vector_type(4)));
typedef unsigned u32x4 __attribute__((ext_vector_type(4)));
constexpr int BM = 256, BK = 64, HALF = 128, HTB = HALF * BK * 2  , STAGE_BYTES = 8 * HTB, NXCD = 8, WGM = 8;

__host__ __device__ __forceinline__ int lds_byte(int r, int c) { const int st = (r >> 4) * 2 + (c >> 5), rr = r & 15, cc = c & 31, ob = rr * 64 + cc * 2; return st * 1024 + (ob ^ (((ob >> 9) & 1) << 5)); }
__host__ __device__ __forceinline__ void stage_rc(int b, int& R, int& C) { const int st = b / 1024, sb = b % 1024, swz = sb ^ (((sb >> 9) & 1) << 5); R = (st >> 1) * 16 + swz / 64; C = (st & 1) * 32 + (swz % 64) / 2; }
__host__ __device__ __forceinline__ int perm32(int rho) { const int n = rho >> 4, i = rho & 15; return 8 * (i >> 2) + 4 * n + (i & 3); }

struct Unit { int pm, pn; };
struct Gemm { const bf16_t* A; const bf16_t* Bt; int M, N, K; };

struct StaticOrder {
    int nM, nN, nwg, G, c;
    __host__ __device__ void init(int M, int N, int G_, int c_) { nM = M / BM; nN = N / BM; nwg = nM * nN; G = G_; c = c_; }
    __host__ __device__ bool next(int i, Unit& u) const {
        const long L = (long)i * G + c; if (L >= nwg) return false;
        int wgid = (int)L; { const int q = nwg / NXCD, r = nwg % NXCD, xcd = wgid % NXCD, off = wgid / NXCD; wgid = (xcd < r ? xcd * (q + 1) : r * (q + 1) + (xcd - r) * q) + off; }
        const int nig = WGM * nN, gid = wgid / nig, fm = gid * WGM, gsz = (nM - fm) < WGM ? (nM - fm) : WGM;
        u.pm = fm + ((wgid % nig) % gsz); u.pn = (wgid % nig) / gsz; return true;
    }
    __device__ __forceinline__ void a_ready(const Unit&) const {}
    __device__ __forceinline__ void done(const Unit&) const {}
};

template <class Epi, class Sched, bool ALIGN_EPI = false, bool SP2 = false>
__device__ __forceinline__ void gemm_phase(PG8_LAS unsigned char* lds, const Gemm g, const Sched& S, const Epi& E) {
    const int tid = tidx(), wid = __builtin_amdgcn_readfirstlane(tid >> 6), lane = tid & 63, wr = wid >> 2, wc = wid & 3, fr = lane & 15, fq = lane >> 4;
    const int K = g.K, nt = K / BK;
    unsigned voffA[2], voffB[2];
#pragma unroll
    for (int i = 0; i < 2; ++i) { int R, C; stage_rc(tid * 16 + i * 8192, R, C); const int Rb = Epi::PERM ? ((R & ~31) + perm32(R & 31)) : R;
        voffA[i] = (unsigned)(R * K + C) * 2u; voffB[i] = (unsigned)(Rb * K + C) * 2u; }
    const size_t kstep = (size_t)(BK * 2);
    const size_t hstep = (size_t)HALF * K * 2;
    const size_t tstep = 2 * hstep;
    const unsigned ldsw = (unsigned)wid * 1024u;
    const int aoff = lds_byte(wr * 64 + fr, fq * 8), boff = lds_byte(wc * 32 + fr, fq * 8);
#define PG8_SA(b, h) (((b) * 2 + (h)) * HTB)
#define PG8_SB(b, h) ((4 + (b) * 2 + (h)) * HTB)
#define PG8_STAGE(bufoff, gbase, voff) do { _Pragma("unroll") for (int _i = 0; _i < 2; ++_i) \
        __builtin_amdgcn_global_load_lds((const unsigned*)((const char*)(gbase) + (voff)[_i]), (PG8_LAS unsigned*)(lds + (bufoff) + ldsw + _i * 8192), 16, 0, 0); } while (0)
#define PG8_LDA(dst, b, h) do { _Pragma("unroll") for (int m = 0; m < 4; ++m) _Pragma("unroll") for (int k = 0; k < 2; ++k) dst[m][k] = *(const PG8_LAS bf16x8*)(lds + PG8_SA(b, h) + aoff + m * 2048 + k * 1024); } while (0)
#define PG8_LDB(dst, b, h) do { _Pragma("unroll") for (int n = 0; n < 2; ++n) _Pragma("unroll") for (int k = 0; k < 2; ++k) dst[n][k] = *(const PG8_LAS bf16x8*)(lds + PG8_SB(b, h) + boff + n * 2048 + k * 1024); } while (0)
#define PG8_MMA(ai, bj, At, Bt) do { __builtin_amdgcn_s_setprio(1); _Pragma("unroll") for (int m = 0; m < 4; ++m) _Pragma("unroll") for (int n = 0; n < 2; ++n) _Pragma("unroll") for (int k = 0; k < 2; ++k) \
        acc[ai][bj][m][n] = __builtin_amdgcn_mfma_f32_16x16x32_bf16(Bt[n][k], At[m][k], acc[ai][bj][m][n], 0, 0, 0); __builtin_amdgcn_s_setprio(0); } while (0)
#define PG8_WAIT_V(n) asm volatile("s_waitcnt vmcnt(" #n ")" ::: "memory")
#define PG8_WAIT_L(n) asm volatile("s_waitcnt lgkmcnt(" #n ")" ::: "memory")
#define PG8_BAR __builtin_amdgcn_s_barrier()
#define PG8_SCHED __builtin_amdgcn_sched_barrier(0)
    Unit cur, nxt; int ui = 0;
    if (!S.next(0, cur)) return;
    f32x4 acc[2][2][4][2];
#pragma unroll
    for (int a = 0; a < 2; ++a)
#pragma unroll
        for (int b = 0; b < 2; ++b)
#pragma unroll
            for (int m = 0; m < 4; ++m)
#pragma unroll
                for (int n = 0; n < 2; ++n) acc[a][b][m][n] = (f32x4){0.f, 0.f, 0.f, 0.f};
    bf16x8 At[4][2], B0[2][2], B1[2][2];
    const char* cA = (const char*)g.A + (size_t)cur.pm * tstep; const char* cB = (const char*)g.Bt + (size_t)cur.pn * tstep;
    S.a_ready(cur);
    if constexpr (SP2) {
        PG8_STAGE(PG8_SB(0, 0), cB, voffB); PG8_STAGE(PG8_SB(0, 1), cB + hstep, voffB); PG8_STAGE(PG8_SA(0, 0), cA, voffA); PG8_STAGE(PG8_SA(0, 1), cA + hstep, voffA);
        if (wr == 1) PG8_BAR;
        PG8_WAIT_V(2); PG8_BAR;
        PG8_STAGE(PG8_SB(1, 0), cB + kstep, voffB); PG8_STAGE(PG8_SA(1, 0), cA + kstep, voffA); PG8_STAGE(PG8_SB(1, 1), cB + hstep + kstep, voffB);
        PG8_WAIT_V(6); PG8_BAR;
    } else {
        PG8_STAGE(PG8_SB(0, 0), cB, voffB); PG8_STAGE(PG8_SA(0, 0), cA, voffA); PG8_STAGE(PG8_SB(0, 1), cB + hstep, voffB); PG8_STAGE(PG8_SA(0, 1), cA + hstep, voffA);
        if (wr == 1) PG8_BAR;
        PG8_WAIT_V(4); PG8_BAR;
        PG8_STAGE(PG8_SB(1, 0), cB + kstep, voffB); PG8_STAGE(PG8_SA(1, 0), cA + kstep, voffA); PG8_STAGE(PG8_SB(1, 1), cB + hstep + kstep, voffB);
        PG8_WAIT_V(6); PG8_BAR;
    }
    for (;;) {
        const bool has_next = S.next(ui + 1, nxt);
        const char* nA = has_next ? (const char*)g.A + (size_t)nxt.pm * tstep : cA; const char* nB = has_next ? (const char*)g.Bt + (size_t)nxt.pn * tstep : cB;
        for (int t = 0; t < nt; t += 2) {
            const bool last = (t == nt - 2);
            const char* a1 = cA + (size_t)(t + 1) * kstep;
            const char* a2 = last ? nA : cA + (size_t)(t + 2) * kstep; const char* b2 = last ? nB : cB + (size_t)(t + 2) * kstep;
            const char* a3 = a2 + kstep; const char* b3 = b2 + kstep;
            if (last && has_next) S.a_ready(nxt);
            if constexpr (SP2) {
            PG8_LDB(B0, 0, 0); PG8_LDB(B1, 0, 1); PG8_SCHED; PG8_LDA(At, 0, 0); PG8_STAGE(PG8_SA(1, 1), a1 + hstep, voffA);
            PG8_WAIT_V(8); PG8_WAIT_L(0); PG8_BAR; PG8_MMA(0, 0, At, B0); PG8_MMA(0, 1, At, B1); PG8_BAR; PG8_SCHED;
            PG8_LDA(At, 0, 1); PG8_STAGE(PG8_SB(0, 0), b2, voffB); PG8_STAGE(PG8_SB(0, 1), b2 + hstep, voffB); PG8_STAGE(PG8_SA(0, 0), a2, voffA);
            PG8_WAIT_V(8); PG8_WAIT_L(0); PG8_BAR; PG8_MMA(1, 0, At, B0); PG8_MMA(1, 1, At, B1); PG8_BAR; PG8_SCHED;
            PG8_LDB(B0, 1, 0); PG8_LDB(B1, 1, 1); PG8_SCHED; PG8_LDA(At, 1, 0); PG8_STAGE(PG8_SA(0, 1), a2 + hstep, voffA);
            PG8_WAIT_V(8); PG8_WAIT_L(0); PG8_BAR; PG8_MMA(0, 0, At, B0); PG8_MMA(0, 1, At, B1); PG8_BAR; PG8_SCHED;
            PG8_LDA(At, 1, 1); PG8_STAGE(PG8_SB(1, 0), b3, voffB); PG8_STAGE(PG8_SB(1, 1), b3 + hstep, voffB); PG8_STAGE(PG8_SA(1, 0), a3, voffA);
            PG8_WAIT_V(8); PG8_WAIT_L(0); PG8_BAR; PG8_MMA(1, 0, At, B0); PG8_MMA(1, 1, At, B1); PG8_BAR; PG8_SCHED;
            } else {
            PG8_LDB(B0, 0, 0); PG8_SCHED; PG8_LDA(At, 0, 0); PG8_STAGE(PG8_SA(1, 1), a1 + hstep, voffA);
            PG8_WAIT_L(8); PG8_BAR; PG8_WAIT_L(0); PG8_MMA(0, 0, At, B0); PG8_BAR; PG8_SCHED;
            PG8_LDB(B1, 0, 1); PG8_STAGE(PG8_SB(0, 0), b2, voffB);
            PG8_BAR; PG8_WAIT_L(0); PG8_MMA(0, 1, At, B1); PG8_BAR;
            PG8_LDA(At, 0, 1); PG8_STAGE(PG8_SA(0, 0), a2, voffA);
            PG8_BAR; PG8_WAIT_L(0); PG8_MMA(1, 0, At, B0); PG8_BAR; PG8_SCHED;
            PG8_STAGE(PG8_SB(0, 1), b2 + hstep, voffB);
            PG8_WAIT_V(6); PG8_BAR; PG8_MMA(1, 1, At, B1); PG8_BAR;
            PG8_LDB(B0, 1, 0); PG8_SCHED; PG8_LDA(At, 1, 0); PG8_STAGE(PG8_SA(0, 1), a2 + hstep, voffA);
            PG8_WAIT_L(8); PG8_BAR; PG8_WAIT_L(0); PG8_MMA(0, 0, At, B0); PG8_BAR; PG8_SCHED;
            PG8_LDB(B1, 1, 1); PG8_STAGE(PG8_SB(1, 0), b3, voffB);
            PG8_BAR; PG8_WAIT_L(0); PG8_MMA(0, 1, At, B1); PG8_BAR;
            PG8_LDA(At, 1, 1); PG8_STAGE(PG8_SA(1, 0), a3, voffA);
            PG8_BAR; PG8_WAIT_L(0); PG8_MMA(1, 0, At, B0); PG8_BAR; PG8_SCHED;
            PG8_STAGE(PG8_SB(1, 1), b3 + hstep, voffB);
            PG8_WAIT_V(6); PG8_BAR; PG8_MMA(1, 1, At, B1); PG8_BAR;
            }
        }
        if constexpr (ALIGN_EPI) { if (wr == 0) PG8_BAR; }
        if constexpr (!Epi::AFTER_DRAIN) { E(acc, cur, wr, wc, fr, fq); S.done(cur); }
        if (!has_next) break;
#pragma unroll
        for (int a = 0; a < 2; ++a)
#pragma unroll
            for (int b = 0; b < 2; ++b)
#pragma unroll
                for (int m = 0; m < 4; ++m)
#pragma unroll
                    for (int n = 0; n < 2; ++n) acc[a][b][m][n] = (f32x4){0.f, 0.f, 0.f, 0.f};
        cur = nxt; cA = nA; cB = nB; ++ui;
        if constexpr (ALIGN_EPI) { if (wr == 1) PG8_BAR; }
    }
    PG8_WAIT_V(0);
    if constexpr (!ALIGN_EPI) { if (wr == 0) PG8_BAR; }
    PG8_BAR;
    if constexpr (Epi::AFTER_DRAIN) { E.fused(acc, cur, wr, wc, fr, fq, lds, wid, lane); S.done(cur); }
#undef PG8_SA
#undef PG8_SB
#undef PG8_STAGE
#undef PG8_LDA
#undef PG8_LDB
#undef PG8_MMA
#undef PG8_WAIT_V
#undef PG8_WAIT_L
#undef PG8_BAR
#undef PG8_SCHED
}
}

constexpr int CW_PANEL = 16384;
DI unsigned* panel_word(unsigned char* ws, int l, int kind, int p) { return (unsigned*)(ws + WS_CTL) + CW_PANEL + ((l * 3 + kind) * 160 + p) * 64; }
DI void store16_wt(void* p, u32x4 v) { asm volatile("global_store_dwordx4 %0, %1, off sc1\n\ts_nop 1" :: "v"(p), "v"(v) : "memory"); }
DI void panel_publish(unsigned* w) {
    asm volatile("s_waitcnt vmcnt(0)" ::: "memory");
    if ((tidx() & 63) == 0) __hip_atomic_fetch_add(w, 1u, __ATOMIC_RELAXED, __HIP_MEMORY_SCOPE_AGENT);
}
DI void panel_wait(unsigned* w, unsigned need) {
    if (tidx() < 64) {
        unsigned spins = 0;
        while ((unsigned)__builtin_amdgcn_readfirstlane(__hip_atomic_load(w, __ATOMIC_RELAXED, __HIP_MEMORY_SCOPE_AGENT)) < need) { __builtin_amdgcn_s_sleep(2); if (++spins > (1u << 22)) break; }
        __builtin_amdgcn_fence(__ATOMIC_ACQUIRE, "agent");
        asm volatile("s_waitcnt vmcnt(0)" ::: "memory");
    }
    asm volatile("" ::: "memory"); __builtin_amdgcn_s_barrier(); asm volatile("" ::: "memory");
}

#define LAS __attribute__((address_space(3)))
constexpr int LDS_BYTES = 147456;
constexpr int LDS_MISC = 131072 + 8192;

DI void ph_mods(const Args& a, unsigned char* lds) {
    float (*sc)[1024] = (float (*)[1024])lds;
    float (*red)[5][128] = (float (*)[5][128])(lds + 20480);
    const float* c = a.in[1]; const float* cctx = a.in[3]; const float* mod_w = a.in[4]; const float* mod_b = a.in[5];
    float* mods = (float*)(a.ws + WS_MODS);
    const int tid = tidx(), lane = tid & 63, wid = tid >> 6;
    for (int i = tid; i < 5 * 1024; i += 512) { int s = i >> 10, k = i & 1023; float v = s < 4 ? c[s * 1024 + k] : cctx[k]; sc[s][k] = siluf_(v); }
    __syncthreads();
    for (int item = blockIdx.x; item < DEPTH * 48; item += gridDim.x) {
        const int l = item / 48, c0 = (item % 48) * 128;
        const int half = lane >> 5, cg = lane & 31;
        f32x4 acc[5];
#pragma unroll
        for (int s = 0; s < 5; ++s) acc[s] = (f32x4){0.f, 0.f, 0.f, 0.f};
        const float* wp = mod_w + (size_t)l * 1024 * 6144 + c0 + 4 * cg;
#pragma unroll 4
        for (int kk = 0; kk < 64; ++kk) {
            const int k = wid * 128 + 2 * kk + half;
            const f32x4 w = *(const f32x4*)(wp + (size_t)k * 6144);
#pragma unroll
            for (int s = 0; s < 5; ++s) acc[s] += w * sc[s][k];
        }
#pragma unroll
        for (int s = 0; s < 5; ++s) {
#pragma unroll
            for (int j = 0; j < 4; ++j) { float v = acc[s][j]; v += __shfl_xor(v, 32); acc[s][j] = v; }
            if (half == 0) {
#pragma unroll
                for (int j = 0; j < 4; ++j) red[wid][s][4 * cg + j] = acc[s][j];
            }
        }
        __syncthreads();
        for (int i = tid; i < 5 * 128; i += 512) {
            const int s = i >> 7, cc = i & 127; float v = 0.f;
#pragma unroll
            for (int w = 0; w < 8; ++w) v += red[w][s][cc];
            mods[((size_t)l * 5 + s) * 6144 + c0 + cc] = v + mod_b[l * 6144 + c0 + cc];
        }
        __syncthreads();
    }
    if (blockIdx.x == gridDim.x - 1) {
        float* rope = (float*)(a.ws + WS_ROPE);
        for (int i = tid; i < 64 * 16; i += 512) {
            const int pos = i >> 4, f = i & 15;
            const float inv = powf(10000.0f, -(float)f / 16.0f);
            const float ang = (float)pos * inv;
            rope[2 * i] = cosf(ang); rope[2 * i + 1] = sinf(ang);
        }
    }
}

DI void row_ln(f32x4 (&v)[4], const float* g, const float* b, int lane) {
    float s = 0.f;
#pragma unroll
    for (int j = 0; j < 4; ++j) s += (v[j][0] + v[j][1]) + (v[j][2] + v[j][3]);
    const float mean = wave_sum(s) * (1.f / 1024.f);
    float q = 0.f;
#pragma unroll
    for (int j = 0; j < 4; ++j) { v[j] = v[j] - mean; q += (v[j][0] * v[j][0] + v[j][1] * v[j][1]) + (v[j][2] * v[j][2] + v[j][3] * v[j][3]); }
    const float rstd = rsqrtf(wave_sum(q) * (1.f / 1024.f) + EPS);
#pragma unroll
    for (int j = 0; j < 4; ++j) {
        const f32x4 gg = *(const f32x4*)(g + 256 * j + 4 * lane), bb = *(const f32x4*)(b + 256 * j + 4 * lane);
        v[j] = v[j] * rstd * gg + bb;
    }
}
DI void row_ln_r(f32x4 (&v)[4], const f32x4 (&gg)[4], const f32x4 (&bb)[4]) {
    float s = 0.f;
#pragma unroll
    for (int j = 0; j < 4; ++j) s += (v[j][0] + v[j][1]) + (v[j][2] + v[j][3]);
    const float mean = wave_sum(s) * (1.f / 1024.f);
    float q = 0.f;
#pragma unroll
    for (int j = 0; j < 4; ++j) { v[j] = v[j] - mean; q += (v[j][0] * v[j][0] + v[j][1] * v[j][1]) + (v[j][2] * v[j][2] + v[j][3] * v[j][3]); }
    const float rstd = rsqrtf(wave_sum(q) * (1.f / 1024.f) + EPS);
#pragma unroll
    for (int j = 0; j < 4; ++j) v[j] = v[j] * rstd * gg[j] + bb[j];
}
DI void row_modulate(f32x4 (&h)[4], const f32x4 (&x)[4], const float* shift, const float* scale, int lane) {
#pragma unroll
    for (int j = 0; j < 4; ++j) {
        const f32x4 sh = *(const f32x4*)(shift + 256 * j + 4 * lane), scl = *(const f32x4*)(scale + 256 * j + 4 * lane);
        h[j] = x[j] * (1.f + scl) + sh;
    }
}
DI void row_store_bf16(bf16_t* dst, const f32x4 (&h)[4], int lane) {
#pragma unroll
    for (int j = 0; j < 4; ++j) { u32x2 w; w.x = pk2(h[j][0], h[j][1]); w.y = pk2(h[j][2], h[j][3]); *(u32x2*)(dst + 256 * j + 4 * lane) = w; }
}
DI float row_gemv16(const f32x4 (&h)[4], const float* WT, int lane) {
    float p[16];
#pragma unroll
    for (int jj = 0; jj < 16; ++jj) {
        float acc = 0.f;
#pragma unroll
        for (int j = 0; j < 4; ++j) { const f32x4 w = *(const f32x4*)(WT + jj * 1024 + 256 * j + 4 * lane); acc += (h[j][0] * w[0] + h[j][1] * w[1]) + (h[j][2] * w[2] + h[j][3] * w[3]); }
        asm volatile("" : "+v"(acc));
        p[jj] = acc;
    }
    return reduce16(p, lane);
}
DI void stage_wt16(float* WT, const float* W, int ld, int col0, int tid) {
    for (int c = tid; c < 1024; c += 512) {
        const float* p = W + (size_t)c * ld + col0;
#pragma unroll
        for (int q = 0; q < 4; ++q) { const f32x4 w = *(const f32x4*)(p + 4 * q);
#pragma unroll
            for (int i = 0; i < 4; ++i) WT[(4 * q + i) * 1024 + c] = w[i]; }
    }
}

DI void ph_prep0(const Args& a, unsigned char* lds) {
    float* WT = (float*)lds;
    const int tid = tidx(), lane = tid & 63, wid = tid >> 6;
    stage_wt16(WT, a.in[6], N_IN, 3584, tid);
    __syncthreads();
    const float* mods = (const float*)(a.ws + WS_MODS);
    float* X = (float*)(a.ws + WS_X); bf16_t* H = (bf16_t*)(a.ws + WS_H); float* AB = (float*)(a.ws + WS_AB);
    const int rstride = gridDim.x * 8;
    f32x4 xn[4];
    { const int row = blockIdx.x * 8 + wid; const float* src = row < NCTX ? a.in[2] + (size_t)row * 1024 : a.in[0] + (size_t)(row - NCTX) * 1024;
#pragma unroll
      for (int j = 0; j < 4; ++j) xn[j] = *(const f32x4*)(src + 256 * j + 4 * lane); }
#pragma unroll 1
    for (int row = blockIdx.x * 8 + wid; row < TT; row += rstride) {
        f32x4 x[4], h[4];
#pragma unroll
        for (int j = 0; j < 4; ++j) x[j] = xn[j];
        { const int rn = row + rstride; if (rn < TT) { const float* src = rn < NCTX ? a.in[2] + (size_t)rn * 1024 : a.in[0] + (size_t)(rn - NCTX) * 1024;
#pragma unroll
            for (int j = 0; j < 4; ++j) xn[j] = *(const f32x4*)(src + 256 * j + 4 * lane); } }
#pragma unroll
        for (int j = 0; j < 4; ++j) *(f32x4*)(X + (size_t)row * 1024 + 256 * j + 4 * lane) = x[j];
        const float* m = mods + (size_t)(0 * 5 + mod_set(row)) * 6144;
        row_modulate(h, x, m, m + 1024, lane);
        row_store_bf16(H + (size_t)row * 1024, h, lane);
        { const float abv = row_gemv16(h, WT, lane); if ((lane & 3) == 0) AB[(size_t)row * 16 + jj16_of_lane(lane)] = abv; }
    }
    __syncthreads();
}

DI void ph_yb(const Args& a, int l) {
    const int tid = tidx(), lane = tid & 63, wid = tid >> 6;
    const bf16_t* OF = (const bf16_t*)(a.ws + WS_OF); const bf16_t* OB = (const bf16_t*)(a.ws + WS_OB); const bf16_t* Z = (const bf16_t*)(a.ws + WS_Z);
    bf16_t* YB = (bf16_t*)(a.ws + WS_YAB) + (size_t)TT * 512;
    const float* ogp = a.in[15] + l * 128 + ((8 * lane) & 127);
    float og[8];
#pragma unroll
    for (int i = 0; i < 8; ++i) og[i] = ogp[i];
    const int rstride = gridDim.x * 8;
    int row0 = blockIdx.x * 8 + wid; if (l == DEPTH - 1) { while (row0 < NCTX) row0 += rstride; }
    u32x4 fn = (u32x4){0u, 0u, 0u, 0u}, bn = fn, zn = fn;
    if (row0 < TT) { const size_t o0 = (size_t)row0 * 512 + 8 * lane; fn = *(const u32x4*)(OF + o0); bn = *(const u32x4*)(OB + o0); zn = *(const u32x4*)(Z + o0); }
#pragma unroll 1
    for (int row = row0; row < TT; row += rstride) {
        const size_t off = (size_t)row * 512 + 8 * lane;
        const u32x4 f = fn, b = bn, z = zn;
        if (row + rstride < TT) { const size_t o1 = (size_t)(row + rstride) * 512 + 8 * lane; fn = *(const u32x4*)(OF + o1); bn = *(const u32x4*)(OB + o1); zn = *(const u32x4*)(Z + o1); }
        float o[8]; float ss = 0.f;
#pragma unroll
        for (int i = 0; i < 4; ++i) {
            o[2 * i] = __uint_as_float(f[i] << 16) + __uint_as_float(b[i] << 16);
            o[2 * i + 1] = __uint_as_float(f[i] & 0xffff0000u) + __uint_as_float(b[i] & 0xffff0000u);
            ss += o[2 * i] * o[2 * i] + o[2 * i + 1] * o[2 * i + 1];
        }
        ss += __shfl_xor(ss, 1); ss += __shfl_xor(ss, 2); ss += __shfl_xor(ss, 4); ss += __shfl_xor(ss, 8);
        const float r = rsqrtf(ss * (1.f / 128.f) + EPS);
        u32x4 w;
#pragma unroll
        for (int i = 0; i < 4; ++i) {
            const float z0 = __uint_as_float(z[i] << 16), z1 = __uint_as_float(z[i] & 0xffff0000u);
            const float y0 = o[2 * i] * r * og[2 * i] * siluf_(z0), y1 = o[2 * i + 1] * r * og[2 * i + 1] * siluf_(z1);
            w[i] = pk2(y0, y1);
        }
        *(u32x4*)(YB + off) = w;
    }
}

constexpr int LN1_KMAX = 10;
constexpr int LOCAL_ASSIGN = LN1_KMAX * 8 * 2;
DI int ln1_nb0(int l) { return l == DEPTH - 1 ? 0 : 32; }
DI int ln1_row(int nb0, int w, int k) { const int bs = (int)blockIdx.x - nb0; return bs < 0 ? TT : bs * 8 + w + ((int)gridDim.x - nb0) * 8 * k; }
DI void ph_ln1_router(const Args& a, int l, unsigned char* lds, int rd = 0, int fused = 0) {
    float* WT = (float*)lds;
    int* le = (int*)(lds + 65536);
    const int tid = tidx(), lane = tid & 63, wid = tid >> 6;
    stage_wt16(WT, a.in[21], 16, 0, tid);
    if (tid < LOCAL_ASSIGN) le[tid] = -1;
    __syncthreads();
    const float* mods = (const float*)(a.ws + WS_MODS);
    const float* X = (const float*)(a.ws + WS_X); bf16_t* H = rd ? (bf16_t*)(a.ws + WS_GPRE + 72 * MiB) : (bf16_t*)(a.ws + WS_H);
    int* RE = rd ? (int*)(a.ws + WS_GPRE + 110 * MiB) : (int*)(a.ws + WS_ROUTE_E); float* RW = rd ? (float*)(a.ws + WS_GPRE + 111 * MiB) : (float*)(a.ws + WS_ROUTE_W);
    const float* g = a.in[19] + l * 1024; const float* bb = a.in[20] + l * 1024; const float* rb = a.in[22];
    const int nb0 = ln1_nb0(l);
    f32x4 lg4[4], lb4[4];
#pragma unroll
    for (int j = 0; j < 4; ++j) { lg4[j] = *(const f32x4*)(g + 256 * j + 4 * lane); lb4[j] = *(const f32x4*)(bb + 256 * j + 4 * lane); }
    f32x4 xn[4];
    int kready = fused ? 0 : LN1_KMAX;
    bool have_next = false;
#pragma unroll 1
    for (int k = 0; k < LN1_KMAX; ++k) {
        const int row = ln1_row(nb0, wid, k);
        if (row >= TT) break;
        if (l == DEPTH - 1 && row < NCTX) { have_next = false; continue; }
        if (k >= kready) {
            unsigned* w0p = panel_word(a.ws, l, 2, row >> 8);
            unsigned spins = 0;
            while ((unsigned)__builtin_amdgcn_readfirstlane(__hip_atomic_load(w0p, __ATOMIC_RELAXED, __HIP_MEMORY_SCOPE_AGENT)) < 32u) { __builtin_amdgcn_s_sleep(2); if (++spins > (1u << 22)) break; }
            kready = k + 1;
#pragma unroll 1
            while (kready < LN1_KMAX) {
                const int r2 = ln1_row(nb0, wid, kready); if (r2 >= TT) break;
                if ((unsigned)__builtin_amdgcn_readfirstlane(__hip_atomic_load(panel_word(a.ws, l, 2, r2 >> 8), __ATOMIC_RELAXED, __HIP_MEMORY_SCOPE_AGENT)) < 32u) break;
                ++kready;
            }
            __builtin_amdgcn_fence(__ATOMIC_ACQUIRE, "agent");
            have_next = false;
        }
        f32x4 x[4], h[4], msh[4], msc[4];
        if (have_next) {
#pragma unroll
            for (int j = 0; j < 4; ++j) x[j] = xn[j];
        } else {
#pragma unroll
            for (int j = 0; j < 4; ++j) x[j] = *(const f32x4*)(X + (size_t)row * 1024 + 256 * j + 4 * lane);
        }
        const float* m = mods + (size_t)(l * 5 + mod_set(row)) * 6144;
#pragma unroll
        for (int j = 0; j < 4; ++j) { msh[j] = *(const f32x4*)(m + 3 * 1024 + 256 * j + 4 * lane); msc[j] = *(const f32x4*)(m + 4 * 1024 + 256 * j + 4 * lane); }
        { const int rn = (k + 1 < LN1_KMAX) ? ln1_row(nb0, wid, k + 1) : TT;
          have_next = (k + 1 < kready) && rn < TT;
          if (have_next) {
#pragma unroll
            for (int j = 0; j < 4; ++j) xn[j] = *(const f32x4*)(X + (size_t)rn * 1024 + 256 * j + 4 * lane);
          } }
        row_ln_r(x, lg4, lb4);
#pragma unroll
        for (int j = 0; j < 4; ++j) h[j] = x[j] * (1.f + msc[j]) + msh[j];
        row_store_bf16(H + (size_t)row * 1024, h, lane);
        if (rd >= 2) continue;
        const float lgv = row_gemv16(h, WT, lane);
        float sc[16], sel[16];
#pragma unroll
        for (int e = 0; e < 16; ++e) { const float lg = __uint_as_float(__builtin_amdgcn_readlane(__float_as_uint(lgv), lane_of_jj16(e))); sc[e] = __builtin_amdgcn_rcpf(1.f + __builtin_amdgcn_exp2f(-1.4426950408889634f * lg)); sel[e] = sc[e] + rb[e]; }
        float best_gs = -1e30f; int best = 0;
#pragma unroll
        for (int gI = 0; gI < 4; ++gI) {
            const float v0 = sel[4 * gI], v1 = sel[4 * gI + 1], v2 = sel[4 * gI + 2], v3 = sel[4 * gI + 3];
            const float mx = fmaxf(fmaxf(v0, v1), fmaxf(v2, v3));
            float second;
            if (v0 == mx) second = fmaxf(v1, fmaxf(v2, v3));
            else if (v1 == mx) second = fmaxf(v0, fmaxf(v2, v3));
            else if (v2 == mx) second = fmaxf(fmaxf(v0, v1), v3);
            else second = fmaxf(fmaxf(v0, v1), v2);
            const float gs = mx + second;
            if (gs > best_gs) { best_gs = gs; best = gI; }
        }
        float i0 = 0.f, i1 = 0.f, i2 = 0.f, i3 = 0.f, s0 = 0.f, s1 = 0.f, s2 = 0.f, s3 = 0.f;
#pragma unroll
        for (int gI = 0; gI < 4; ++gI) if (gI == best) { i0 = sel[4 * gI]; i1 = sel[4 * gI + 1]; i2 = sel[4 * gI + 2]; i3 = sel[4 * gI + 3]; s0 = sc[4 * gI]; s1 = sc[4 * gI + 1]; s2 = sc[4 * gI + 2]; s3 = sc[4 * gI + 3]; }
        int a0 = 0; float m0 = i0, w0 = s0;
        if (i1 > m0) { a0 = 1; m0 = i1; w0 = s1; }
        if (i2 > m0) { a0 = 2; m0 = i2; w0 = s2; }
        if (i3 > m0) { a0 = 3; m0 = i3; w0 = s3; }
        int a1 = -1; float m1 = -1e30f, w1 = 0.f;
        if (a0 != 0 && i0 > m1) { a1 = 0; m1 = i0; w1 = s0; }
        if (a0 != 1 && i1 > m1) { a1 = 1; m1 = i1; w1 = s1; }
        if (a0 != 2 && i2 > m1) { a1 = 2; m1 = i2; w1 = s2; }
        if (a0 != 3 && i3 > m1) { a1 = 3; m1 = i3; w1 = s3; }
        if (lane == 0) {
            const float inv = 1.f / (w0 + w1);
            RE[2 * row] = best * 4 + a0; RE[2 * row + 1] = best * 4 + a1;
            RW[2 * row] = w0 * inv; RW[2 * row + 1] = w1 * inv;
            le[(k * 8 + wid) * 2] = best * 4 + a0; le[(k * 8 + wid) * 2 + 1] = best * 4 + a1;
        }
    }
    __syncthreads();
    if (tid < 16) {
        int cnt = 0;
        for (int i = 0; i < LOCAL_ASSIGN; ++i) cnt += (le[i] == tid) ? 1 : 0;
        ((int*)(a.ws + (rd ? WS_GPRE + 112 * MiB : WS_META)))[blockIdx.x * 16 + tid] = cnt;
    }
    __syncthreads();
}

constexpr int META_NT = 4096, META_TE = 4096 + 16;
DI void ph_slot(const Args& a, int l, unsigned char* lds) {
    int* bc = (int*)lds;
    int* tot = (int*)(lds + 16384);
    int* ls = (int*)(lds + 16384 + 1024);
    const int tid = tidx(), lane = tid & 63, wid = tid >> 6;
    const int* meta = (const int*)(a.ws + WS_META);
    int* metaw = (int*)(a.ws + WS_META);
    const int G = gridDim.x;
    for (int i = tid; i < G * 16; i += 512) bc[i] = meta[i];
    if (tid < LOCAL_ASSIGN) ls[tid] = -1;
    __syncthreads();
    {
        int* part = (int*)(lds + 16384 + 4096);
        const int e = tid & 15, pr = tid >> 4; int t = 0, before = 0;
#pragma unroll
        for (int q = 0; q < 8; ++q) { const int b = pr * 8 + q; if (b < G) { const int c = bc[b * 16 + e]; t += c; if (b < (int)blockIdx.x) before += c; } }
        part[pr * 16 + e] = t; part[512 + pr * 16 + e] = before;
        __syncthreads();
        if (tid < 16) { int tt = 0, bb = 0;
#pragma unroll
            for (int q = 0; q < 32; ++q) { tt += part[q * 16 + tid]; bb += part[512 + q * 16 + tid]; }
            tot[tid] = tt; tot[16 + tid] = bb; }
    }
    __syncthreads();
    if (tid == 0) {
        int ps = 0, nt = 0;
#pragma unroll 1
        for (int e = 0; e < 16; ++e) {
            tot[32 + e] = ps; tot[64 + e] = nt; const int tiles = (tot[e] + 255) >> 8;
            nt += tiles; ps += tiles * 256;
        }
        tot[48] = ps; tot[80] = nt;
    }
    __syncthreads();
    if (blockIdx.x == 0) {
        const int nt = tot[80];
        if (tid == 0) metaw[META_NT] = nt;
        if (tid < nt) { int e = 0;
#pragma unroll 1
            for (int q = 1; q < 16; ++q) e += (tot[64 + q] <= tid) ? 1 : 0;
            metaw[META_TE + tid] = e; }
    }
    const int* RE = (const int*)(a.ws + WS_ROUTE_E);
    int* DEST = (int*)(a.ws + WS_DEST); int* SLOTA = (int*)(a.ws + WS_SLOTA);
    int* le2 = (int*)(lds + 16384 + 2048);
    int my_row = -1, my_kk = 0;
    if (tid < LOCAL_ASSIGN) {
        const int row = ln1_row(ln1_nb0(l), (tid >> 1) & 7, tid >> 4); my_kk = tid & 1;
        int e = -1;
        if (row < TT && !(l == DEPTH - 1 && row < NCTX)) { e = RE[2 * row + my_kk]; my_row = row; }
        le2[tid] = e;
    }
    __syncthreads();
    if (tid < 16) {
        int pos = tot[32 + tid] + tot[16 + tid];
        for (int li = 0; li < LOCAL_ASSIGN; ++li) if (le2[li] == tid) { ls[li] = pos; ++pos; }
    }
    __syncthreads();
    if (tid < LOCAL_ASSIGN && my_row >= 0) { const int pos = ls[tid]; DEST[2 * my_row + my_kk] = pos; SLOTA[pos] = 2 * my_row + my_kk; }
    if (blockIdx.x < 16) {
        const int e = blockIdx.x; const int s0 = tot[32 + e] + tot[e], s1 = tot[32 + e] + (((tot[e] + 255) >> 8) << 8);
        for (int s = s0 + tid; s < s1; s += 512) SLOTA[s] = -1;
    }
    __syncthreads();
    const bf16_t* H = (const bf16_t*)(a.ws + WS_H); bf16_t* XS = (bf16_t*)(a.ws + WS_XS);
#pragma unroll 1
    for (int b0 = 0; b0 < 20; b0 += 5) {
        u32x4 r0[5], r1[5]; int sl[5];
#pragma unroll
        for (int q = 0; q < 5; ++q) {
            const int li = wid + 8 * (b0 + q); sl[q] = ls[li];
            const int row = ln1_row(ln1_nb0(l), (li >> 1) & 7, li >> 4);
            if (sl[q] >= 0) { const u32x4* sp = (const u32x4*)(H + (size_t)row * 1024); r0[q] = sp[lane]; r1[q] = sp[lane + 64]; }
        }
#pragma unroll
        for (int q = 0; q < 5; ++q) if (sl[q] >= 0) { u32x4* d = (u32x4*)(XS + (size_t)sl[q] * 1024); d[lane] = r0[q]; d[lane + 64] = r1[q]; }
    }
    __syncthreads();
}

DI void ph_combine_ln2(const Args& a, int l, unsigned char* lds, int rd = 0) {
    float* WT = (float*)lds;
    const bool last = (l == DEPTH - 1);
    const int tid = tidx(), lane = tid & 63, wid = tid >> 6;
    if (!last) { stage_wt16(WT, a.in[6] + (size_t)(l + 1) * 1024 * N_IN, N_IN, 3584, tid); }
    __syncthreads();
    const float* mods = (const float*)(a.ws + WS_MODS);
    const float* X = (const float*)(a.ws + WS_X); float* XO = rd ? (float*)(a.ws + WS_GPRE) : (float*)(a.ws + WS_X); bf16_t* H = rd ? (bf16_t*)(a.ws + WS_GPRE + 72 * MiB) : (bf16_t*)(a.ws + WS_H); float* AB = rd ? (float*)(a.ws + WS_GPRE + 110 * MiB) : (float*)(a.ws + WS_AB);
    float* OUT = rd ? (float*)(a.ws + WS_GPRE) : a.out;
    const bf16_t* YS = (const bf16_t*)(a.ws + WS_YS); const float* RW = (const float*)(a.ws + WS_ROUTE_W);
    const float* g = a.in[26] + l * 1024; const float* bb = a.in[27] + l * 1024;
    const int rstride = gridDim.x * 8;
    int row0 = blockIdx.x * 8 + wid; if (last) { while (row0 < NCTX) row0 += rstride; }
    f32x4 xn[4]; u32x2 yn0[4], yn1[4]; float wn0 = 0.f, wn1 = 0.f;
    if (row0 < TT) {
        wn0 = RW[2 * row0]; wn1 = RW[2 * row0 + 1];
#pragma unroll
        for (int j = 0; j < 4; ++j) { const int c = 256 * j + 4 * lane; xn[j] = *(const f32x4*)(X + (size_t)row0 * 1024 + c);
            yn0[j] = *(const u32x2*)(YS + (size_t)(2 * row0) * 1024 + c); yn1[j] = *(const u32x2*)(YS + (size_t)(2 * row0 + 1) * 1024 + c); }
    }
    f32x4 lg4[4], lb4[4], l1g[4], l1b[4];
#pragma unroll
    for (int j = 0; j < 4; ++j) { lg4[j] = *(const f32x4*)(g + 256 * j + 4 * lane); lb4[j] = *(const f32x4*)(bb + 256 * j + 4 * lane);
        l1g[j] = *(const f32x4*)(a.in[19] + l * 1024 + 256 * j + 4 * lane); l1b[j] = *(const f32x4*)(a.in[20] + l * 1024 + 256 * j + 4 * lane); }
#pragma unroll 1
    for (int row = row0; row < TT; row += rstride) {
        const float w0 = wn0, w1 = wn1;
        const float* m = mods + (size_t)(l * 5 + mod_set(row)) * 6144;
        const float* mn = mods + (size_t)((last ? l : l + 1) * 5 + mod_set(row)) * 6144;
        f32x4 x[4], h[4], gt[4], msh[4], msc[4]; u32x2 ya[4], yb[4];
#pragma unroll
        for (int j = 0; j < 4; ++j) { x[j] = xn[j]; ya[j] = yn0[j]; yb[j] = yn1[j]; }
#pragma unroll
        for (int j = 0; j < 4; ++j) { const int c = 256 * j + 4 * lane; gt[j] = *(const f32x4*)(m + 5 * 1024 + c); msh[j] = *(const f32x4*)(mn + c); msc[j] = *(const f32x4*)(mn + 1024 + c); }
        { const int rn = row + rstride;
          if (rn < TT) {
            wn0 = RW[2 * rn]; wn1 = RW[2 * rn + 1];
#pragma unroll
            for (int j = 0; j < 4; ++j) { const int c = 256 * j + 4 * lane; xn[j] = *(const f32x4*)(X + (size_t)rn * 1024 + c);
                yn0[j] = *(const u32x2*)(YS + (size_t)(2 * rn) * 1024 + c); yn1[j] = *(const u32x2*)(YS + (size_t)(2 * rn + 1) * 1024 + c); }
          } }
        row_ln_r(x, l1g, l1b);
#pragma unroll
        for (int j = 0; j < 4; ++j) {
            const u32x2 y0 = ya[j], y1 = yb[j];
            f32x4 y;
            y[0] = w0 * __uint_as_float(y0.x << 16) + w1 * __uint_as_float(y1.x << 16);
            y[1] = w0 * __uint_as_float(y0.x & 0xffff0000u) + w1 * __uint_as_float(y1.x & 0xffff0000u);
            y[2] = w0 * __uint_as_float(y0.y << 16) + w1 * __uint_as_float(y1.y << 16);
            y[3] = w0 * __uint_as_float(y0.y & 0xffff0000u) + w1 * __uint_as_float(y1.y & 0xffff0000u);
            x[j] = ALPHA * x[j] + gt[j] * y;
        }
        row_ln_r(x, lg4, lb4);
        if (last) {
#pragma unroll
            for (int j = 0; j < 4; ++j) *(f32x4*)(OUT + (size_t)(row - NCTX) * 1024 + 256 * j + 4 * lane) = x[j];
        } else {
#pragma unroll
            for (int j = 0; j < 4; ++j) *(f32x4*)(XO + (size_t)row * 1024 + 256 * j + 4 * lane) = x[j];
#pragma unroll
            for (int j = 0; j < 4; ++j) h[j] = x[j] * (1.f + msc[j]) + msh[j];
            row_store_bf16(H + (size_t)row * 1024, h, lane);
            { const float abv = row_gemv16(h, WT, lane); if ((lane & 3) == 0) AB[(size_t)row * 16 + jj16_of_lane(lane)] = abv; }
        }
    }
    __syncthreads();
}

DI void transpose_item(const float* W, int ldw, int K, int ncols, bf16_t* WT, int item, float* scr, int lane) {
    const int nblk = ncols >> 5, kb = item / nblk, nb = item - kb * nblk, k0 = 64 * kb, n0 = 32 * nb;
#pragma unroll 8
    for (int i = 0; i < 32; ++i) { const int kk = 2 * i + (lane >> 5); scr[kk * 33 + (lane & 31)] = W[(size_t)(k0 + kk) * ldw + n0 + (lane & 31)]; }
    asm volatile("s_waitcnt lgkmcnt(0)" ::: "memory");
    const int c = lane & 7;
#pragma unroll
    for (int j = 0; j < 4; ++j) { const int n = (lane >> 3) + 8 * j; const float* s = scr + (8 * c) * 33 + n;
        u32x4 o; o.x = pk2(s[0 * 33], s[1 * 33]); o.y = pk2(s[2 * 33], s[3 * 33]); o.z = pk2(s[4 * 33], s[5 * 33]); o.w = pk2(s[6 * 33], s[7 * 33]);
        *(u32x4*)(WT + (size_t)(n0 + n) * K + k0 + 8 * c) = o; }
    asm volatile("s_waitcnt lgkmcnt(0)" ::: "memory");
}
constexpr int CV_A = 2816, CV_B = 13312;
DI void convert_A(const Args& a, int l, int item, float* scr, int lane) {
    const float* w = a.in[6] + (size_t)l * 1024 * N_IN; bf16_t* wt = (bf16_t*)(a.ws + WS_WIN);
    if (item < 1792) transpose_item(w, N_IN, 1024, 3584, wt, item, scr, lane);
    else transpose_item(w + 3600, N_IN, 1024, 2048, wt + (size_t)3584 * 1024, item - 1792, scr, lane);
}
DI void convert_B(const Args& a, int l, int item, float* scr, int lane) {
    if (item < 256) { transpose_item(a.in[16] + (size_t)l * 512 * 1024, 1024, 512, 1024, (bf16_t*)(a.ws + WS_WPAB), item, scr, lane); return; }
    item -= 256;
    if (item < 256) { transpose_item(a.in[17] + (size_t)l * 512 * 1024, 1024, 512, 1024, (bf16_t*)(a.ws + WS_WPAB) + (size_t)1024 * 512, item, scr, lane); return; }
    item -= 256;
    if (item < 512) { transpose_item(a.in[18] + (size_t)l * 1024 * 1024, 1024, 1024, 1024, (bf16_t*)(a.ws + WS_WO), item, scr, lane); return; }
    item -= 512;
    if (item < 8192) {
        const int job = item >> 6, it = item & 63; const int e = job >> 3, t = (job >> 1) & 3, which = job & 1;
        const float* w = (which ? a.in[24] : a.in[23]) + ((size_t)l * 16 + e) * 1024 * 512 + 128 * t;
        transpose_item(w, 512, 1024, 128, (bf16_t*)(a.ws + WS_W13) + ((size_t)e * 1024 + 256 * t + 128 * which) * 1024, it, scr, lane); return;
    }
    item -= 8192;
    { const int e = item >> 8, it = item & 255;
      transpose_item(a.in[25] + ((size_t)l * 16 + e) * 512 * 1024, 1024, 512, 1024, (bf16_t*)(a.ws + WS_W2) + (size_t)e * 1024 * 512, it, scr, lane); }
}
DI void convert_run(const Args& a, int lA, int lB, int rank, int nw, float* scr, int lane) {
    const int nA = (lA >= 0 && lA < DEPTH) ? CV_A : 0, nB = (lB >= 0 && lB < DEPTH) ? CV_B : 0;
#pragma unroll 1
    for (int it = rank; it < nA + nB; it += nw) { if (it < nA) convert_A(a, lA, it, scr, lane); else convert_B(a, lB, it - nA, scr, lane); }
}

#define XB_TMO      128
#define XB_XCNT(j)  (256  + 64 * (j))
#define XB_XSUB(j)  (1280 + 64 * (j))
#define XB_XGEN(j)  (2304 + 64 * (j))
#define XB_TOP      3328
#define XB_TOPGEN   3392
#define XCD_BAR_WORDS 3456
#define XB_SPIN_CAP (1u << 18)

__device__ __forceinline__ unsigned xb_ld(unsigned* p)              { return __hip_atomic_load(p, __ATOMIC_RELAXED, __HIP_MEMORY_SCOPE_AGENT); }
__device__ __forceinline__ unsigned xb_add(unsigned* p, unsigned v) { return __hip_atomic_fetch_add(p, v, __ATOMIC_RELAXED, __HIP_MEMORY_SCOPE_AGENT); }
__device__ __forceinline__ unsigned xb_xcc_id() { return (unsigned)__builtin_amdgcn_s_getreg((3 << 11) | 20) & 0xFu; }
#define XB_SPIN(cond, bar) do { unsigned _sp = 0; while (cond) { __builtin_amdgcn_s_sleep(1); \
    if ((++_sp & 255u) == 0u) { if (xb_ld(&(bar)[XB_TMO])) break; if (_sp > XB_SPIN_CAP) { atomicAdd(&(bar)[XB_TMO], 1u); break; } } } } while (0)

struct XcdBarrier {
    unsigned* bar; unsigned x;
    volatile LAS unsigned* st;
};

__device__ __forceinline__ XcdBarrier xcd_barrier_post(unsigned* bar, volatile LAS unsigned* st) {
    XcdBarrier b; b.bar = bar; b.x = xb_xcc_id(); b.st = st;
    if (tidx() == 0) (void)xb_add(&bar[XB_XCNT(b.x)], 1u);
    return b;
}
__device__ __forceinline__ void xcd_barrier_complete(unsigned* bar, unsigned x, unsigned& nloc, unsigned& nx) {
    const unsigned G = gridDim.x * gridDim.y * gridDim.z;
    unsigned sum, cnt, mine, sp = 0u;
    for (;;) {
        sum = 0u; cnt = 0u; mine = 0u;
#pragma unroll
        for (unsigned j = 0; j < 16; ++j) { const unsigned c = xb_ld(&bar[XB_XCNT(j)]); sum += c; cnt += (c > 0u) ? 1u : 0u; mine = (j == x) ? c : mine; }
        if (sum == G) break;
        __builtin_amdgcn_s_sleep(1);
        if ((++sp & 255u) == 0u) { if (xb_ld(&bar[XB_TMO])) break; if (sp > XB_SPIN_CAP) { atomicAdd(&bar[XB_TMO], 1u); break; } }
    }
    nloc = mine > 0u ? mine : 1u; nx = cnt > 0u ? cnt : 1u;
}

__device__ __forceinline__ void xcd_barrier(const XcdBarrier& b) {
    asm volatile("s_waitcnt vmcnt(0)" ::: "memory");
    __syncthreads();
    if (tidx() == 0) {
        unsigned* bar = b.bar;
        __builtin_amdgcn_s_waitcnt(0);
        unsigned nloc = b.st[0], nx = b.st[1];
        if (nloc == 0u) { xcd_barrier_complete(bar, b.x, nloc, nx); b.st[0] = nloc; b.st[1] = nx; }
        const unsigned old = xb_add(&bar[XB_XSUB(b.x)], 1u);
        const unsigned gen = old / nloc;
        if (old + 1u == (gen + 1u) * nloc) {
            __builtin_amdgcn_fence(__ATOMIC_RELEASE, "agent");
            asm volatile("s_waitcnt vmcnt(0)" ::: "memory");
            const unsigned og = xb_add(&bar[XB_TOP], 1u);
            const unsigned tg = og / nx;
            if (og + 1u == (tg + 1u) * nx) xb_add(&bar[XB_TOPGEN], 1u);
            else XB_SPIN(xb_ld(&bar[XB_TOPGEN]) == tg, bar);
            __builtin_amdgcn_fence(__ATOMIC_ACQUIRE, "agent");
            xb_add(&bar[XB_XGEN(b.x)], 1u);
            asm volatile("s_waitcnt vmcnt(0)" ::: "memory");
        } else {
            XB_SPIN(xb_ld(&bar[XB_XGEN(b.x)]) == gen, bar);
            __builtin_amdgcn_fence(__ATOMIC_ACQUIRE, "agent");
            asm volatile("s_waitcnt vmcnt(0)" ::: "memory");
        }
    }
    __syncthreads();
}

DI int unit_set(int pm) { return pm < 4 ? 4 : ((pm - 4) >> 4); }
struct EpiInproj {
    static constexpr bool PERM = true, AFTER_DRAIN = false;
    unsigned char* ws;
    DI void operator()(const f32x4 (&acc)[2][2][4][2], const pg8::Unit& u, int wr, int wc, int fr, int fq) const {
        const int pn = u.pn; bf16_t* dst; int ld, colt, mode;
        if (pn < 2) { dst = (bf16_t*)(ws + WS_QA); ld = 512; colt = pn * 256; mode = 1; }
        else if (pn < 4) { dst = (bf16_t*)(ws + WS_KA); ld = 512; colt = (pn - 2) * 256; mode = 2; }
        else if (pn < 6) { dst = (bf16_t*)(ws + WS_VA); ld = 512; colt = (pn - 4) * 256; mode = 0; }
        else if (pn < 12) { dst = (bf16_t*)(ws + WS_QKV); ld = 1536; colt = (pn - 6) * 256; mode = 0; }
        else if (pn < 14) { dst = (bf16_t*)(ws + WS_Z); ld = 512; colt = (pn - 12) * 256; mode = 0; }
        else { dst = (bf16_t*)(ws + WS_SG); ld = 2048; colt = (pn - 14) * 256; mode = 3; }
        const bool rope = (mode == 1 || mode == 2) && u.pm >= 4;
        const float qs = (mode == 1) ? QSCALE : 1.f;
        const float* rtab = (const float*)(ws + WS_ROPE);
        const int row0 = u.pm * 256 + wr * 64 + fr;
        const float sgn = (fq >> 1) ? 1.f : -1.f;
        f32x4 csn[2][2];
        if (rope) {
            const int t = (row0 - NCTX) & 4095; const int pos = (wc & 1) ? (t & 63) : (t >> 6);
            const float* rp = rtab + (pos * 16 + 8 * (fq & 1)) * 2;
#pragma unroll
            for (int n = 0; n < 2; ++n) { csn[n][0] = *(const f32x4*)(rp + 8 * n); csn[n][1] = *(const f32x4*)(rp + 8 * n + 4); }
        }
#pragma unroll
        for (int s = 0; s < 8; ++s) {
            const int ai = s >> 2, m = s & 3;
            const int row = row0 + ai * 128 + m * 16;
            f32x4 cs[2][2];
            if (rope) {
#pragma unroll
                for (int n = 0; n < 2; ++n) { cs[n][0] = csn[n][0]; cs[n][1] = csn[n][1]; }
                if (s < 7) {
                    const int r1 = row0 + ((s + 1) >> 2) * 128 + ((s + 1) & 3) * 16;
                    const int t = (r1 - NCTX) & 4095; const int pos = (wc & 1) ? (t & 63) : (t >> 6);
                    const float* rp = rtab + (pos * 16 + 8 * (fq & 1)) * 2;
#pragma unroll
                    for (int n = 0; n < 2; ++n) { csn[n][0] = *(const f32x4*)(rp + 8 * n); csn[n][1] = *(const f32x4*)(rp + 8 * n + 4); }
                }
            }
#pragma unroll
            for (int bj = 0; bj < 2; ++bj) {
                f32x4 v[2] = {acc[ai][bj][m][0], acc[ai][bj][m][1]};
                if (rope) {
#pragma unroll
                    for (int n = 0; n < 2; ++n)
#pragma unroll
                        for (int j = 0; j < 4; ++j) {
                            const float x = v[n][j], xp = __shfl_xor(x, 32);
                            const float c = cs[n][j >> 1][(j & 1) * 2], sv = cs[n][j >> 1][(j & 1) * 2 + 1];
                            v[n][j] = x * c + sgn * xp * sv;
                        }
                }
                if (mode == 3) {
#pragma unroll
                    for (int n = 0; n < 2; ++n)
#pragma unroll
                        for (int j = 0; j < 4; ++j) v[n][j] = sigmoidf_(v[n][j]);
                }
                u32x4 w; w.x = pk2(v[0][0] * qs, v[0][1] * qs); w.y = pk2(v[0][2] * qs, v[0][3] * qs); w.z = pk2(v[1][0] * qs, v[1][1] * qs); w.w = pk2(v[1][2] * qs, v[1][3] * qs);
                *(u32x4*)(dst + (size_t)row * ld + colt + bj * 128 + wc * 32 + 8 * fq) = w;
            }
        }
    }
};
struct EpiMerge1 {
    static constexpr bool PERM = true, AFTER_DRAIN = false;
    unsigned char* ws;
    DI void operator()(const f32x4 (&acc)[2][2][4][2], const pg8::Unit& u, int wr, int wc, int fr, int fq) const {
        const int which = u.pm >= 68 ? 1 : 0; const int pm = u.pm - 68 * which, pn = u.pn - 4 * which;
        const bf16_t* SG = (const bf16_t*)(ws + WS_SG); bf16_t* M = (bf16_t*)(ws + WS_M); bf16_t* MP = (bf16_t*)(ws + WS_GPRE);
        const int row0 = pm * 256 + wr * 64 + fr, colb = pn * 256 + wc * 32 + 8 * fq;
        u32x4 gn[2], on[2], gc[2], oc[2];
#pragma unroll
        for (int bj = 0; bj < 2; ++bj) { gn[bj] = *(const u32x4*)(SG + (size_t)row0 * 2048 + which * 1024 + colb + bj * 128); on[bj] = (u32x4){0u, 0u, 0u, 0u};
            if (which) on[bj] = *(const u32x4*)(MP + (size_t)row0 * 1024 + colb + bj * 128); }
#pragma unroll
        for (int s = 0; s < 8; ++s) {
            const int ai = s >> 2, m = s & 3, row = row0 + ai * 128 + m * 16;
#pragma unroll
            for (int bj = 0; bj < 2; ++bj) { gc[bj] = gn[bj]; oc[bj] = on[bj]; }
            if (s < 7) { const int r1 = row0 + ((s + 1) >> 2) * 128 + ((s + 1) & 3) * 16;
#pragma unroll
                for (int bj = 0; bj < 2; ++bj) { gn[bj] = *(const u32x4*)(SG + (size_t)r1 * 2048 + which * 1024 + colb + bj * 128);
                    if (which) on[bj] = *(const u32x4*)(MP + (size_t)r1 * 1024 + colb + bj * 128); } }
#pragma unroll
            for (int bj = 0; bj < 2; ++bj) {
                float v[8];
#pragma unroll
                for (int i = 0; i < 4; ++i) {
                    v[2 * i] = __uint_as_float(gc[bj][i] << 16) * acc[ai][bj][m][i >> 1][(i & 1) * 2] + __uint_as_float(oc[bj][i] << 16);
                    v[2 * i + 1] = __uint_as_float(gc[bj][i] & 0xffff0000u) * acc[ai][bj][m][i >> 1][(i & 1) * 2 + 1] + __uint_as_float(oc[bj][i] & 0xffff0000u);
                }
                u32x4 w; w.x = pk2(v[0], v[1]); w.y = pk2(v[2], v[3]); w.z = pk2(v[4], v[5]); w.w = pk2(v[6], v[7]);
                if (which) store16_wt(M + (size_t)row * 1024 + colb + bj * 128, w); else *(u32x4*)(MP + (size_t)row * 1024 + colb + bj * 128) = w;
            }
        }
    }
};
struct SchedMerge1 {
    int G, c, pm0; unsigned char* ws; int l;
    DI bool next(int i, pg8::Unit& u) const {
        const int tl = (i >> 1) * G + c; if (tl >= (68 - pm0) * 4) return false;
        const int which = i & 1; u.pm = pm0 + (tl >> 2) + 68 * which; u.pn = (tl & 3) + 4 * which; return true;
    }
    DI void a_ready(const pg8::Unit&) const {}
    DI void done(const pg8::Unit& u) const { if (u.pm >= 68) panel_publish(panel_word(ws, l, 0, u.pm - 68)); }
};
struct SchedWoWait {
    int G, c, pm0; unsigned char* ws; int l;
    DI bool next(int i, pg8::Unit& u) const {
        int tl;
        if (i == 0) tl = c; else if (i == 1 && c >= 16 && c < 32) tl = G + (c - 16); else return false;
        if (tl >= (68 - pm0) * 4) return false;
        u.pm = pm0 + (tl >> 2); u.pn = tl & 3; return true;
    }
    DI void a_ready(const pg8::Unit& u) const { panel_wait(panel_word(ws, l, 0, u.pm), 32u); }
    DI void done(const pg8::Unit& u) const { panel_publish(panel_word(ws, l, 2, u.pm)); }
};
struct SchedRows {
    int G, c, pm0, nN;
    DI bool next(int i, pg8::Unit& u) const { const int tl = i * G + c; if (tl >= (68 - pm0) * nN) return false; u.pm = pm0 + tl / nN; u.pn = tl % nN; return true; }
    DI void a_ready(const pg8::Unit&) const {}
    DI void done(const pg8::Unit&) const {}
};
struct EpiWo {
    static constexpr bool PERM = false, AFTER_DRAIN = false;
    unsigned char* ws; int l; int rd;
    DI void operator()(const f32x4 (&acc)[2][2][4][2], const pg8::Unit& u, int wr, int wc, int fr, int fq) const {
        const float* X = (const float*)(ws + WS_X); float* XO = rd ? (float*)(ws + WS_GPRE) : (float*)(ws + WS_X);
        const float* mg = (const float*)(ws + WS_MODS) + (size_t)(l * 5 + unit_set(u.pm)) * 6144 + 2 * 1024;
        const int row0 = u.pm * 256 + wr * 64 + fr, col0 = u.pn * 256 + wc * 32 + 4 * fq;
        f32x4 gv[2][2];
#pragma unroll
        for (int bj = 0; bj < 2; ++bj)
#pragma unroll
            for (int n = 0; n < 2; ++n) gv[bj][n] = *(const f32x4*)(mg + col0 + bj * 128 + n * 16);
        f32x4 xc[2][2], xn[2][2];
        { const float* rowp = X + (size_t)row0 * 1024 + col0;
#pragma unroll
          for (int bj = 0; bj < 2; ++bj)
#pragma unroll
              for (int n = 0; n < 2; ++n) xn[bj][n] = *(const f32x4*)(rowp + bj * 128 + n * 16); }
#pragma unroll
        for (int s = 0; s < 8; ++s) {
            const int ai = s >> 2, m = s & 3;
#pragma unroll
            for (int bj = 0; bj < 2; ++bj)
#pragma unroll
                for (int n = 0; n < 2; ++n) xc[bj][n] = xn[bj][n];
            if (s < 7) { const int ai1 = (s + 1) >> 2, m1 = (s + 1) & 3; const float* rp = X + (size_t)(row0 + ai1 * 128 + m1 * 16) * 1024 + col0;
#pragma unroll
                for (int bj = 0; bj < 2; ++bj)
#pragma unroll
                    for (int n = 0; n < 2; ++n) xn[bj][n] = *(const f32x4*)(rp + bj * 128 + n * 16); }
            float* rowp = XO + (size_t)(row0 + ai * 128 + m * 16) * 1024 + col0;
#pragma unroll
            for (int bj = 0; bj < 2; ++bj)
#pragma unroll
                for (int n = 0; n < 2; ++n) { const f32x4 xv = ALPHA * xc[bj][n] + gv[bj][n] * acc[ai][bj][m][n]; store16_wt(rowp + bj * 128 + n * 16, __builtin_bit_cast(u32x4, xv)); }
        }
    }
};
struct SchedMoe {
    int G, c, ntiles; const int* tile_e; unsigned char* ws; int l, mode;
    DI bool next(int i, pg8::Unit& u) const {
        int x;
        if (mode != 2 || G != 256) x = i * G + c;
        else {
            if (c < 64) { if (i > 0) return false; x = c; }
            else if (c < 192) { if (i > 2) return false; x = c + 128 * i; }
            else x = 448 + (c - 192) + 64 * i;
        }
        if (x >= ntiles * 4) return false;
        u.pm = x >> 2; u.pn = tile_e[x >> 2] * 4 + (x & 3); return true;
    }
    DI void a_ready(const pg8::Unit& u) const { if (mode == 2) panel_wait(panel_word(ws, l, 1, u.pm), 32u); }
    DI void done(const pg8::Unit& u) const { if (mode == 1) panel_publish(panel_word(ws, l, 1, u.pm)); }
};
struct EpiUp {
    static constexpr bool PERM = true, AFTER_DRAIN = false;
    unsigned char* ws;
    DI void operator()(const f32x4 (&acc)[2][2][4][2], const pg8::Unit& u, int wr, int wc, int fr, int fq) const {
        bf16_t* ACT = (bf16_t*)(ws + WS_ACT);
        const int j = u.pn & 3; const int row0 = u.pm * 256 + wr * 64 + fr; const int col = j * 128 + wc * 32 + 8 * fq;
#pragma unroll
        for (int ai = 0; ai < 2; ++ai)
#pragma unroll
            for (int m = 0; m < 4; ++m) {
                float v[8];
#pragma unroll
                for (int n = 0; n < 2; ++n)
#pragma unroll
                    for (int i = 0; i < 4; ++i) v[4 * n + i] = siluf_(acc[ai][0][m][n][i]) * acc[ai][1][m][n][i];
                u32x4 w; w.x = pk2(v[0], v[1]); w.y = pk2(v[2], v[3]); w.z = pk2(v[4], v[5]); w.w = pk2(v[6], v[7]);
                store16_wt(ACT + (size_t)(row0 + ai * 128 + m * 16) * 512 + col, w);
            }
    }
};
struct EpiDown {
    static constexpr bool PERM = true, AFTER_DRAIN = false;
    unsigned char* ws;
    DI void operator()(const f32x4 (&acc)[2][2][4][2], const pg8::Unit& u, int wr, int wc, int fr, int fq) const {
        bf16_t* YS = (bf16_t*)(ws + WS_YS); const int* SLOTA = (const int*)(ws + WS_SLOTA);
        const int j = u.pn & 3; const int row0 = u.pm * 256 + wr * 64 + fr;
        int asv[2][4];
#pragma unroll
        for (int ai = 0; ai < 2; ++ai)
#pragma unroll
            for (int m = 0; m < 4; ++m) asv[ai][m] = SLOTA[row0 + ai * 128 + m * 16];
#pragma unroll
        for (int ai = 0; ai < 2; ++ai)
#pragma unroll
            for (int m = 0; m < 4; ++m) {
                const int as = asv[ai][m];
                if (as >= 0) {
#pragma unroll
                    for (int bj = 0; bj < 2; ++bj) {
                        const f32x4 v0 = acc[ai][bj][m][0], v1 = acc[ai][bj][m][1];
                        u32x4 w; w.x = pk2(v0[0], v0[1]); w.y = pk2(v0[2], v0[3]); w.z = pk2(v1[0], v1[1]); w.w = pk2(v1[2], v1[3]);
                        *(u32x4*)(YS + (size_t)as * 1024 + j * 256 + bj * 128 + wc * 32 + 8 * fq) = w;
                    }
                }
            }
    }
};

typedef short s16x4 __attribute__((ext_vector_type(4)));
#define MFMA32(a, b, c) __builtin_amdgcn_mfma_f32_32x32x16_bf16((a), (b), (c), 0, 0, 0)
DI int crow(int i, int hl) { return (i & 3) + 8 * (i >> 2) + 4 * hl; }
DI bf16x8 pack8(const f32x16& x, int s) {
    u32x4 p; p.x = pk2(x[8 * s], x[8 * s + 1]); p.y = pk2(x[8 * s + 2], x[8 * s + 3]); p.z = pk2(x[8 * s + 4], x[8 * s + 5]); p.w = pk2(x[8 * s + 6], x[8 * s + 7]);
    return __builtin_bit_cast(bf16x8, p);
}
DI s16x4 tr_read(const LAS unsigned char* p) { return __builtin_bit_cast(s16x4, __builtin_amdgcn_ds_read_tr16_b64_v4i16((LAS s16x4*)p)); }
constexpr int AT_KB = 9216, AT_VB = 16384, AT_K0 = 0, AT_V0 = 2 * AT_KB, AT_ST = 65536;

struct AttnIt { const bf16_t* kp; const bf16_t* vp; int kc0, kl0, nT; unsigned kdst, vdst0, kread, vread; };
template <int FAKE> DI void attn_iter(int t, const AttnIt& g, LAS unsigned char* lds, unsigned kA, unsigned kB, unsigned vA, unsigned vB, u32x4& rk, u32x4& rv0, u32x4& rv1,
                  f32x16 (&st)[2], f32x16 (&sn)[2], f32x16 (&o)[4], float& mrun, float& lrun, const bf16x8 (&qf)[4]) {
    const int kc0 = g.kc0, kl0 = g.kl0, nT = g.nT;
#define KROW(t_) ((t_) < 4 ? kc0 + 64 * (t_) : kl0 + 64 * ((t_) - 4))
    *(LAS u32x4*)(lds + kB + g.kdst) = rk; *(LAS u32x4*)(lds + vB + g.vdst0) = rv0; *(LAS u32x4*)(lds + vB + g.vdst0 + 2048) = rv1;
    { const int tk = (t + 3 < nT) ? t + 3 : nT - 1, tv = (t + 2 < nT) ? t + 2 : nT - 1;
      const int krk = KROW(tk), krv = KROW(tv);
      if (FAKE != 4) { rk = *(const u32x4*)(g.kp + (size_t)krk * 512); rv0 = *(const u32x4*)(g.vp + (size_t)krv * 512); rv1 = *(const u32x4*)(g.vp + (size_t)(krv + 32) * 512); } }
#undef KROW
    const LAS unsigned char* kb = lds + kA + g.kread;
    const LAS unsigned char* vb = lds + vA + g.vread;
    bf16x8 kf[4];
#pragma unroll
    for (int x = 0; x < 4; ++x) kf[x] = *(const LAS bf16x8*)(kb + (x & 1) * 32 * 144 + (x >> 1) * 32);
    s16x4 lo[2][2], hi[2][2];
#pragma unroll
    for (int k2 = 0; k2 < 2; ++k2) { lo[0][k2] = tr_read(vb + k2 * 4096); hi[0][k2] = tr_read(vb + k2 * 4096 + 512); }
    float mx = fmaxf(fmaxf(st[0][0], st[0][1]), st[0][2]);
#pragma unroll
    for (int i = 3; i < 15; i += 2) mx = fmaxf(fmaxf(mx, st[0][i]), st[0][i + 1]);
    mx = fmaxf(mx, st[0][15]);
#pragma unroll
    for (int i = 0; i < 16; i += 2) mx = fmaxf(fmaxf(mx, st[1][i]), st[1][i + 1]);
    { auto rr = __builtin_amdgcn_permlane32_swap(__float_as_uint(mx), __float_as_uint(mx), false, false); mx = fmaxf(__uint_as_float(rr[0]), __uint_as_float(rr[1])); }
    const float mnew = fmaxf(mrun, mx), alpha = __builtin_amdgcn_exp2f(mrun - mnew);
    mrun = mnew;
    float ps = 0.f;
    __builtin_amdgcn_sched_barrier(0);
#pragma unroll
    for (int x = 0; x < 8; ++x) {
        if (FAKE == 5) { sn[x & 1] = st[x & 1]; } else
        if (x < 2) { f32x16 z;
#pragma unroll
            for (int i = 0; i < 16; ++i) z[i] = 0.f;
            sn[x & 1] = MFMA32(kf[x & 3], qf[x >> 1], z); }
        else sn[x & 1] = MFMA32(kf[x & 3], qf[x >> 1], sn[x & 1]);
        if (x < 4) kf[x] = *(const LAS bf16x8*)(kb + (x & 1) * 32 * 144 + ((x + 4) >> 1) * 32);
#pragma unroll
        for (int e = 0; e < 4; ++e) { const int i = 4 * (x & 3) + e, kt = x >> 2; const float p = FAKE == 2 ? (st[kt][i] - mnew) : __builtin_amdgcn_exp2f(st[kt][i] - mnew); st[kt][i] = p; ps += p; }
        __builtin_amdgcn_sched_barrier(0);
    }
    lrun = lrun * alpha + ps;
    bf16x8 pb[4];
#pragma unroll
    for (int ks = 0; ks < 4; ++ks) pb[ks] = pack8(st[ks >> 1], ks & 1);
#pragma unroll
    for (int i = 0; i < 16; ++i) { if (FAKE != 7) { o[0][i] *= alpha; o[1][i] *= alpha; } }
    __builtin_amdgcn_sched_barrier(0);
#pragma unroll
    for (int u = 0; u < (FAKE == 3 ? 0 : 8); ++u) {
        const int ks = u >> 1, dp = u & 1;
        if (u < 7) {
            const int ks1 = (u + 1) >> 1, dp1 = (u + 1) & 1;
#pragma unroll
            for (int k2 = 0; k2 < 2; ++k2) { lo[(u + 1) & 1][k2] = tr_read(vb + (2 * dp1 + k2) * 4096 + ks1 * 1024); hi[(u + 1) & 1][k2] = tr_read(vb + (2 * dp1 + k2) * 4096 + ks1 * 1024 + 512); }
        }
#pragma unroll
        for (int k2 = 0; k2 < 2; ++k2) {
            const int d = 2 * dp + k2;
            const bf16x8 vf = (bf16x8){lo[u & 1][k2][0], lo[u & 1][k2][1], lo[u & 1][k2][2], lo[u & 1][k2][3], hi[u & 1][k2][0], hi[u & 1][k2][1], hi[u & 1][k2][2], hi[u & 1][k2][3]};
            o[d] = MFMA32(vf, pb[ks], o[d]);
            if (u == 0 && FAKE != 7) {
#pragma unroll
                for (int e = 0; e < 16; ++e) o[2 + k2][e] *= alpha;
            }
        }
        __builtin_amdgcn_sched_barrier(0);
    }
    if (FAKE != 6) __syncthreads();
}
constexpr int AT3_K = 0, AT3_V = 3 * AT_KB;
template <int FAKE> DI void attn_unit(const Args& a, int l, int h, int qrow0, int nT, int kc0, int kl0, float lam, LAS unsigned char* lds) {
    const int tid = tidx(), lane = tid & 63, wid = tid >> 6, r = lane & 31, hl = lane >> 5;
    const bf16_t* QA = (const bf16_t*)(a.ws + WS_QA); const bf16_t* KA = (const bf16_t*)(a.ws + WS_KA); const bf16_t* VA = (const bf16_t*)(a.ws + WS_VA);
    const int qrow = qrow0 + 32 * wid + r;
    const int kkey = tid >> 3, kch = tid & 7;
    const unsigned kdst = (unsigned)(kkey * 144 + kch * 16);
    const int vkey0 = tid >> 4, vch = tid & 15;
    const unsigned vdst0 = (unsigned)((vch >> 2) * 4096 + vkey0 * 64 + (vch & 3) * 16);
    const unsigned kread = (unsigned)(r * 144 + hl * 16);
    const unsigned vread = (unsigned)(((lane >> 4) & 1) * 32 + (lane & 3) * 8 + (4 * hl + ((lane & 15) >> 2)) * 64);
#define KROW(t_) ((t_) < 4 ? kc0 + 64 * (t_) : kl0 + 64 * ((t_) - 4))
#pragma unroll 1
    for (int comp = 0; comp < 2; ++comp) {
        bf16x8 qf[4];
#pragma unroll
        for (int s = 0; s < 4; ++s) qf[s] = *(const bf16x8*)(QA + (size_t)qrow * 512 + h * 128 + comp * 64 + 16 * s + 8 * hl);
        f32x16 o[4];
#pragma unroll
        for (int d = 0; d < 4; ++d)
#pragma unroll
            for (int i = 0; i < 16; ++i) o[d][i] = 0.f;
        float mrun = -1e30f, lrun = 0.f;
        const bf16_t* kp = KA + (size_t)kkey * 512 + h * 128 + comp * 64 + kch * 8;
        const bf16_t* vp = VA + (size_t)vkey0 * 512 + h * 128 + vch * 8;
        u32x4 rk, rv0, rv1;
        {
            const int kr0 = KROW(0), kr1 = KROW(1), kr2 = KROW(2);
            const u32x4 k0 = *(const u32x4*)(kp + (size_t)kr0 * 512), k1 = *(const u32x4*)(kp + (size_t)kr1 * 512);
            const u32x4 v0 = *(const u32x4*)(vp + (size_t)kr0 * 512), v1 = *(const u32x4*)(vp + (size_t)(kr0 + 32) * 512);
            rk = *(const u32x4*)(kp + (size_t)kr2 * 512); rv0 = *(const u32x4*)(vp + (size_t)kr1 * 512); rv1 = *(const u32x4*)(vp + (size_t)(kr1 + 32) * 512);
            *(LAS u32x4*)(lds + AT3_K + kdst) = k0; *(LAS u32x4*)(lds + AT3_K + AT_KB + kdst) = k1;
            *(LAS u32x4*)(lds + AT3_V + vdst0) = v0; *(LAS u32x4*)(lds + AT3_V + vdst0 + 2048) = v1;
        }
        __syncthreads();
        f32x16 st[2];
#pragma unroll
        for (int kt = 0; kt < 2; ++kt) {
#pragma unroll
            for (int i = 0; i < 16; ++i) st[kt][i] = 0.f;
#pragma unroll
            for (int s = 0; s < 4; ++s) st[kt] = MFMA32(*(const LAS bf16x8*)(lds + AT3_K + kread + kt * 32 * 144 + s * 32), qf[s], st[kt]);
        }
        unsigned kA = AT3_K + AT_KB, kB = AT3_K + 2 * AT_KB, kC = AT3_K;
        unsigned vA = AT3_V, vB = AT3_V + AT_VB, vC = AT3_V + 2 * AT_VB;
        const AttnIt geo{kp, vp, kc0, kl0, nT, kdst, vdst0, kread, vread};
        f32x16 sn[2];
#pragma unroll 1
        for (int t = 0; t < nT; t += 2) {
            attn_iter<FAKE>(t, geo, lds, kA, kB, vA, vB, rk, rv0, rv1, st, sn, o, mrun, lrun, qf);
            attn_iter<FAKE>(t + 1, geo, lds, kB, kC, vB, vC, rk, rv0, rv1, sn, st, o, mrun, lrun, qf);
            { const unsigned tk_ = kC; kC = kB; kB = kA; kA = tk_; const unsigned tv_ = vC; vC = vB; vB = vA; vA = tv_; }
        }
        const float ltot = lrun + __shfl_xor(lrun, 32);
        const float inv = 1.f / ltot;
        const int tid2 = tidx(), lane2 = tid2 & 63, wid2 = tid2 >> 6, hl2 = lane2 >> 5;
        const int qrow2 = qrow0 + 32 * wid2 + (lane2 & 31);
        unsigned char* stash = a.ws + WS_M + (size_t)blockIdx.x * 65536 + wid2 * 8192 + lane2 * 16;
        if (comp == 0) {
#pragma unroll
            for (int d = 0; d < 4; ++d) {
                u32x4 w0, w1;
                w0.x = pk2(o[d][0] * inv, o[d][1] * inv); w0.y = pk2(o[d][2] * inv, o[d][3] * inv); w0.z = pk2(o[d][4] * inv, o[d][5] * inv); w0.w = pk2(o[d][6] * inv, o[d][7] * inv);
                w1.x = pk2(o[d][8] * inv, o[d][9] * inv); w1.y = pk2(o[d][10] * inv, o[d][11] * inv); w1.z = pk2(o[d][12] * inv, o[d][13] * inv); w1.w = pk2(o[d][14] * inv, o[d][15] * inv);
                *(u32x4*)(stash + (2 * d) * 1024) = w0; *(u32x4*)(stash + (2 * d + 1) * 1024) = w1;
            }
        } else {
            bf16_t* YA = FAKE ? (bf16_t*)(a.ws + WS_GPRE) : (bf16_t*)(a.ws + WS_YAB);
            int l2_ = l; asm volatile("" : "+v"(l2_));
            const float li = lam_init_of(l2_);
            float ss = 0.f;
#pragma unroll
            for (int d = 0; d < 4; ++d) {
                const u32x4 on0 = *(const u32x4*)(stash + (2 * d) * 1024), on1s = *(const u32x4*)(stash + (2 * d + 1) * 1024);
#pragma unroll
                for (int k = 0; k < 4; ++k) {
                    const unsigned wa = on0[k], wb = on1s[k];
                    const float a0 = __uint_as_float(wa << 16), a1 = __uint_as_float(wa & 0xffff0000u), b0 = __uint_as_float(wb << 16), b1 = __uint_as_float(wb & 0xffff0000u);
                    o[d][2 * k] = a0 - lam * o[d][2 * k] * inv; o[d][2 * k + 1] = a1 - lam * o[d][2 * k + 1] * inv;
                    o[d][8 + 2 * k] = b0 - lam * o[d][8 + 2 * k] * inv; o[d][8 + 2 * k + 1] = b1 - lam * o[d][8 + 2 * k + 1] * inv;
                    ss += o[d][2 * k] * o[d][2 * k] + o[d][2 * k + 1] * o[d][2 * k + 1] + o[d][8 + 2 * k] * o[d][8 + 2 * k] + o[d][8 + 2 * k + 1] * o[d][8 + 2 * k + 1];
                }
            }
            ss += __shfl_xor(ss, 32);
            const float rs = rsqrtf(ss * (1.f / 128.f) + EPS) * (1.f - li);
            const float* sg = a.in[12] + l * 128;
#pragma unroll
            for (int d = 0; d < 4; ++d)
#pragma unroll
                for (int ig = 0; ig < 4; ++ig) {
                    const int dv0 = 32 * d + 8 * ig + 4 * hl2;
                    const f32x4 g4 = *(const f32x4*)(sg + dv0);
                    u32x2 w; w.x = pk2(o[d][4 * ig] * rs * g4[0], o[d][4 * ig + 1] * rs * g4[1]); w.y = pk2(o[d][4 * ig + 2] * rs * g4[2], o[d][4 * ig + 3] * rs * g4[3]);
                    *(u32x2*)(YA + (size_t)qrow2 * 512 + h * 128 + dv0) = w;
                }
        }
    }
#undef KROW
}
template <int FAKE> DI void ph_attn(const Args& a, int l, LAS unsigned char* lds) {
    const int ln_ = tidx() & 63;
    const float s1 = wave_sum(a.in[8][l * 64 + ln_] * a.in[9][l * 64 + ln_]), s2 = wave_sum(a.in[10][l * 64 + ln_] * a.in[11][l * 64 + ln_]);
    int l3_ = l; asm volatile("" : "+v"(l3_));
    const float lam = expf(s1) - expf(s2) + lam_init_of(l3_);
    const int G = gridDim.x, bx = blockIdx.x;
    const int vcu = (G % 8 == 0) ? (bx % 8) * (G / 8) + bx / 8 : bx;
    for (int u = vcu; u < 256; u += G) {
        const int bh = u >> 4, qt = u & 15, b = bh >> 2, h = bh & 3;
        attn_unit<FAKE>(a, l, h, NCTX + b * SEQ + qt * 256, 68, b * CTX, NCTX + b * SEQ, lam, lds);
    }
    if (l < DEPTH - 1) {
        if (G >= 80) { if (bx >= 64 && bx < 80) { const int u = bx - 64, b = u >> 2, h = u & 3; attn_unit<FAKE>(a, l, h, b * CTX, 4, b * CTX, 0, lam, lds); } }
        else for (int u = vcu; u < 16; u += G) { const int b = u >> 2, h = u & 3; attn_unit<FAKE>(a, l, h, b * CTX, 4, b * CTX, 0, lam, lds); }
    }
}

constexpr int GP_WN = 0, GP_QD = 8192, GP_KDT = 16384, GP_QK = 24576, GP_U = 28672, GP_REC = 36864;
DI int swap23(int p) { return (p & ~12) | ((p & 4) << 1) | ((p & 8) >> 1); }
DI int chunk_index(int dir, int b, int h, int cc) { return ((dir * 4 + b) * 4 + h) * 68 + cc; }
constexpr int G1_XS = 71680, G1_XST = 832, G1_WS = 71680 + 68 * 832;
constexpr int G1_QS = 0, G1_KS = 17408, G1_VS = 34816  , G1_GS = 71680, G1_QKS = 88064, G1_AT = 104448  , G1_SM = LDS_MISC + 256;
DI float* g1_sm(unsigned char* lds, int dir, int kind) { return (float*)(lds + G1_SM) + (dir * 5 + kind) * 64; }

#ifndef G1REP1
#define G1REP1 1
#endif
#ifndef G1REP6
#define G1REP6 1
#endif
#ifndef G1REP7
#define G1REP7 1
#endif
DI void g1_task(const Args& a, int l, int b, int h, int cc, unsigned char* lds, int cut = 0) {
    const int tid = tidx(), lane = tid & 63, wid = tid >> 6, r = lane & 31, hl = lane >> 5;
    const int s0 = cc < 4 ? b * CTX : NCTX + b * SEQ, len = cc < 4 ? CTX : SEQ, t0 = cc < 4 ? cc * 64 : (cc - 4) * 64;
    const bf16_t* QKV = (const bf16_t*)(a.ws + WS_QKV);
    const float* cw = a.in[7] + (size_t)l * 5 * 1536;
    if (wid < 2) {
        const int dir = wid, row = s0 + t0 + lane;
        const float* AB = (const float*)(a.ws + WS_AB);
        const float nal = -expf(a.in[13][l * 8 + dir * 4 + h]), dtb = a.in[14][l * 8 + dir * 4 + h];
        const float g = nal * softplusf_(AB[(size_t)row * 16 + dir * 4 + h] + dtb);
        const float beta = sigmoidf_(AB[(size_t)row * 16 + 8 + dir * 4 + h]);
        float c = g;
        if (dir == 0) {
#pragma unroll
            for (int o = 1; o < 64; o <<= 1) { const float v = __shfl_up(c, o); if (lane >= o) c += v; }
        } else {
#pragma unroll
            for (int o = 1; o < 64; o <<= 1) { const float v = __shfl_down(c, o); if (lane + o < 64) c += v; }
        }
        const float glref = __shfl(c, dir == 0 ? 63 : 0);
        const float eg = __expf(c);
        g1_sm(lds, dir, 0)[lane] = c; g1_sm(lds, dir, 1)[lane] = beta; g1_sm(lds, dir, 2)[lane] = beta * eg; g1_sm(lds, dir, 3)[lane] = __expf(glref - c); g1_sm(lds, dir, 4)[lane] = eg;
        if (lane == 0) ((float*)(a.ws + WS_GL))[chunk_index(dir, b, h, cc)] = __expf(glref);
    }
#pragma unroll 1
    for (int rep1_ = 0; rep1_ < G1REP1; ++rep1_) {
    {
        unsigned char* xs = lds + G1_XS; float* wsm = (float*)(lds + G1_WS);
        u32x4 xv[7];
#pragma unroll
        for (int it = 0; it < 7; ++it) {
            const int p = tid + 512 * it; const int pc = p < 68 * 48 ? p : 68 * 48 - 1;
            const int rr = pc / 48, q = pc - rr * 48, part = q >> 4, c8 = q & 15;
            const int tt = t0 + rr - 2; const int ttc = tt < 0 ? 0 : (tt >= len ? len - 1 : tt);
            xv[it] = *(const u32x4*)(QKV + (size_t)(s0 + ttc) * 1536 + part * 512 + h * 128 + c8 * 8);
            if (tt != ttc) xv[it] = (u32x4){0u, 0u, 0u, 0u};
        }
#pragma unroll
        for (int it = 0; it < 7; ++it) {
            const int p = tid + 512 * it;
            if (p < 68 * 48) { const int rr = p / 48, q = p - rr * 48, part = q >> 4, c8 = q & 15; *(u32x4*)(xs + rr * G1_XST + part * 256 + c8 * 16) = xv[it]; }
        }
        if (tid < 480) { const int j = tid / 96, q = tid - j * 96, part = q >> 5, c4 = q & 31;
            *(f32x4*)(wsm + j * 384 + part * 128 + c4 * 4) = *(const f32x4*)(cw + j * 1536 + part * 512 + h * 128 + c4 * 4); }
    }
    __syncthreads();
    if (cut == 3) return;
    {
        const int i = tid >> 3, sub = tid & 7;
        const unsigned char* xs = lds + G1_XS; const float* wsm = (const float*)(lds + G1_WS);
#pragma unroll
        for (int part = 0; part < 3; ++part) {
            float val[16];
#pragma unroll
            for (int cg = 0; cg < 2; ++cg) {
                const int d = cg * 64 + sub * 8;
                float acc[8];
#pragma unroll
                for (int e = 0; e < 8; ++e) acc[e] = 0.f;
#pragma unroll
                for (int j = 0; j < 5; ++j) {
                    {
                        const u32x4 x = *(const u32x4*)(xs + (i + j) * G1_XST + part * 256 + d * 2);
                        const f32x4 w0 = *(const f32x4*)(wsm + j * 384 + part * 128 + d), w1 = *(const f32x4*)(wsm + j * 384 + part * 128 + d + 4);
                        acc[0] += w0[0] * __uint_as_float(x[0] << 16); acc[1] += w0[1] * __uint_as_float(x[0] & 0xffff0000u);
                        acc[2] += w0[2] * __uint_as_float(x[1] << 16); acc[3] += w0[3] * __uint_as_float(x[1] & 0xffff0000u);
                        acc[4] += w1[0] * __uint_as_float(x[2] << 16); acc[5] += w1[1] * __uint_as_float(x[2] & 0xffff0000u);
                        acc[6] += w1[2] * __uint_as_float(x[3] << 16); acc[7] += w1[3] * __uint_as_float(x[3] & 0xffff0000u);
                    }
                }
#pragma unroll
                for (int e = 0; e < 8; ++e) val[cg * 8 + e] = (cut == 5) ? acc[e] : siluf_(acc[e]);
            }
            float scale = 1.f;
            if (part < 2) {
                float ss = 0.f;
#pragma unroll
                for (int e = 0; e < 16; ++e) ss += val[e] * val[e];
                ss += __shfl_xor(ss, 1); ss += __shfl_xor(ss, 2); ss += __shfl_xor(ss, 4);
                scale = rsqrtf(ss + EPS) * (part == 0 ? 0.08838834764831845f : 1.f);
            }
#pragma unroll
            for (int cg = 0; cg < 2; ++cg) {
                const int d = cg * 64 + sub * 8;
                bf16_t hv[8];
#pragma unroll
                for (int e = 0; e < 8; ++e) hv[e] = f2bf(val[cg * 8 + e] * scale);
                if (cut != 4 || scale == 123456.789f) {
                    u32x4 w; w.x = hv[0] | ((unsigned)hv[1] << 16); w.y = hv[2] | ((unsigned)hv[3] << 16); w.z = hv[4] | ((unsigned)hv[5] << 16); w.w = hv[6] | ((unsigned)hv[7] << 16);
                    *(u32x4*)(lds + (part == 0 ? G1_QS : (part == 1 ? G1_KS : G1_VS)) + i * 272 + d * 2) = w;
                }
            }
        }
    }
    }
    __syncthreads();
    if (cut == 1 || cut == 4 || cut == 5) return;
    {
        const int which = wid >> 2, mi = (wid >> 1) & 1, ni = wid & 1;
        const unsigned char* Ab = lds + (which ? G1_QS : G1_KS) + (32 * mi + r) * 272 + hl * 16;
        const unsigned char* Bb = lds + G1_KS + (32 * ni + r) * 272 + hl * 16;
        f32x16 acc;
#pragma unroll
        for (int i = 0; i < 16; ++i) acc[i] = 0.f;
#pragma unroll
        for (int s = 0; s < 8; ++s) acc = MFMA32(*(const bf16x8*)(Ab + s * 32), *(const bf16x8*)(Bb + s * 32), acc);
        float* O = (float*)(lds + (which ? G1_QKS : G1_GS));
#pragma unroll
        for (int i = 0; i < 16; ++i) O[(32 * mi + crow(i, hl)) * 64 + 32 * ni + r] = acc[i];
    }
    __syncthreads();
    {
        const float* GS = (const float*)(lds + G1_GS);
#pragma unroll 4
        for (int x = tid; x < 2 * 4096; x += 512) {
            const int dir = x >> 12, i = (x >> 6) & 63, j = x & 63;
            const float* gc = g1_sm(lds, dir, 0);
            const bool before = dir == 0 ? (j < i) : (j > i);
            const float v = before ? g1_sm(lds, dir, 1)[i] * GS[i * 64 + j] * __expf(gc[i] - gc[j]) : 0.f;
            if (dir == 0) ((float*)(lds + G1_AT))[i * 68 + j] = v; else ((float*)(lds + G1_AT + 17408))[(63 - i) * 68 + (63 - j)] = v;
        }
    }
    __syncthreads();
    if (cut == 2) return;
    if (wid < 2) {
        float* T = (float*)(lds + G1_AT + wid * 17408);
        float t[64];
        f32x4 ra[2][16];
        t[0] = (lane == 0) ? 1.f : 0.f;
        ra[1][0] = *(const f32x4*)(T + 1 * 68);
#pragma unroll
        for (int i = 1; i < 64; ++i) {
            const int c = i & 1, nx = c ^ 1;
            if (i < 63) {
#pragma unroll
                for (int j4 = 0; j4 * 4 < i + 1; ++j4) ra[nx][j4] = *(const f32x4*)(T + (i + 1) * 68 + 4 * j4);
            }
            float ac[4] = {(lane == i) ? 1.f : 0.f, 0.f, 0.f, 0.f};
#pragma unroll
            for (int j4 = 0; j4 * 4 < i; ++j4) {
#pragma unroll
                for (int e = 0; e < 4; ++e) if (4 * j4 + e < i) ac[e] -= ra[c][j4][e] * t[4 * j4 + e];
            }
            t[i] = (ac[0] + ac[1]) + (ac[2] + ac[3]);
        }
#pragma unroll
        for (int i = 0; i < 64; ++i) T[i * 68 + lane] = t[i];
    } else {
        bf16_t* rec0e = (bf16_t*)(a.ws + WS_GPRE);
#pragma unroll
        for (int it2 = 0; it2 < 12; ++it2) {
            const int kind = it2 >> 1, x = (tid - 128) + 384 * (it2 & 1), dir = kind >= 3 ? 1 : 0, kk = kind - 3 * dir;
            if (x >= 512) continue;
            bf16_t* rec = rec0e + (size_t)chunk_index(dir, b, h, cc) * GP_REC;
            const float* gc = g1_sm(lds, dir, 0); const float* ekd = g1_sm(lds, dir, 3); const float* eg = g1_sm(lds, dir, 4);
            if (kk == 0) {
                const int c = x >> 3, g16 = x & 7;
                const u32x4 x0 = *(const u32x4*)(lds + G1_QS + c * 272 + g16 * 32), x1 = *(const u32x4*)(lds + G1_QS + c * 272 + g16 * 32 + 16);
                const unsigned pm[8] = {x0.x, x0.y, x1.x, x1.y, x0.z, x0.w, x1.z, x1.w};
                const float sc = eg[c];
                u32x4 o0, o1;
                o0.x = pk2(__uint_as_float(pm[0] << 16) * sc, __uint_as_float(pm[0] & 0xffff0000u) * sc); o0.y = pk2(__uint_as_float(pm[1] << 16) * sc, __uint_as_float(pm[1] & 0xffff0000u) * sc);
                o0.z = pk2(__uint_as_float(pm[2] << 16) * sc, __uint_as_float(pm[2] & 0xffff0000u) * sc); o0.w = pk2(__uint_as_float(pm[3] << 16) * sc, __uint_as_float(pm[3] & 0xffff0000u) * sc);
                o1.x = pk2(__uint_as_float(pm[4] << 16) * sc, __uint_as_float(pm[4] & 0xffff0000u) * sc); o1.y = pk2(__uint_as_float(pm[5] << 16) * sc, __uint_as_float(pm[5] & 0xffff0000u) * sc);
                o1.z = pk2(__uint_as_float(pm[6] << 16) * sc, __uint_as_float(pm[6] & 0xffff0000u) * sc); o1.w = pk2(__uint_as_float(pm[7] << 16) * sc, __uint_as_float(pm[7] & 0xffff0000u) * sc);
                u32x4* dp = (u32x4*)(rec + GP_QD + c * 128 + g16 * 16); dp[0] = o0; dp[1] = o1;
            } else if (kk == 1) {
                const int dk = x >> 2, g16 = x & 3;
                const bf16_t* kp = (const bf16_t*)(lds + G1_KS) + dk + (g16 * 16) * 136;
                unsigned ow[8];
#pragma unroll
                for (int q = 0; q < 8; ++q) {
                    const int p0 = 2 * q, p1 = 2 * q + 1; const int c0 = swap23(p0), c1 = swap23(p1);
                    ow[q] = pk2(bf2f(kp[c0 * 136]) * ekd[16 * g16 + c0], bf2f(kp[c1 * 136]) * ekd[16 * g16 + c1]);
                }
                u32x4* dp = (u32x4*)(rec + GP_KDT + dk * 64 + g16 * 16);
                dp[0] = (u32x4){ow[0], ow[1], ow[2], ow[3]}; dp[1] = (u32x4){ow[4], ow[5], ow[6], ow[7]};
            } else {
                const int i = x >> 3, sub = x & 7;
                const float* QKm = (const float*)(lds + G1_QKS) + i * 64;
                const float gi = gc[i];
                unsigned ow[4];
#pragma unroll
                for (int q = 0; q < 4; ++q) {
                    float v[2];
#pragma unroll
                    for (int e = 0; e < 2; ++e) {
                        const int jp = 8 * sub + 2 * q + e, j = (jp & ~15) + swap23(jp & 15);
                        const bool ok = dir == 0 ? (j <= i) : (j >= i);
                        v[e] = ok ? QKm[j] * __expf(gi - gc[j]) : 0.f;
                    }
                    ow[q] = pk2(v[0], v[1]);
                }
                *(u32x4*)(rec + GP_QK + i * 64 + 8 * sub) = (u32x4){ow[0], ow[1], ow[2], ow[3]};
            }
        }
    }
    __syncthreads();
    bf16_t* rec0 = (bf16_t*)(a.ws + WS_GPRE);
#pragma unroll 1
    for (int rep6_ = 0; rep6_ < G1REP6; ++rep6_) {
    {
        const int dir = wid >> 2, n = wid & 3;
        bf16_t* rec = rec0 + (size_t)chunk_index(dir, b, h, cc) * GP_REC;
        const float* T = (const float*)(lds + G1_AT + dir * 17408);
        f32x4 tq[2][4][2];
        f32x4 c1[4][2], c2[4][2];
        bf16x8 bv[4], bk[4];
#pragma unroll
        for (int s = 0; s < 4; ++s) {
            const float* p1 = g1_sm(lds, dir, 1) + 16 * s + 8 * hl; const float* p2 = g1_sm(lds, dir, 2) + 16 * s + 8 * hl;
            c1[s][0] = *(const f32x4*)p1; c1[s][1] = *(const f32x4*)(p1 + 4); c2[s][0] = *(const f32x4*)p2; c2[s][1] = *(const f32x4*)(p2 + 4);
            {
                const unsigned toff = (unsigned)((16 * s + 8 * hl + ((lane & 15) >> 2)) * 272 + (32 * n + 16 * ((lane >> 4) & 1)) * 2 + 8 * (lane & 3));
                const s16x4 v0 = tr_read((const LAS unsigned char*)lds + G1_VS + toff), v1 = tr_read((const LAS unsigned char*)lds + G1_VS + toff + 4 * 272);
                const s16x4 k0 = tr_read((const LAS unsigned char*)lds + G1_KS + toff), k1 = tr_read((const LAS unsigned char*)lds + G1_KS + toff + 4 * 272);
                bv[s] = (bf16x8){v0[0], v0[1], v0[2], v0[3], v1[0], v1[1], v1[2], v1[3]};
                bk[s] = (bf16x8){k0[0], k0[1], k0[2], k0[3], k1[0], k1[1], k1[2], k1[3]};
            }
#pragma unroll
            for (int m = 0; m < 2; ++m) {
                if (dir == 0) { const float* tp = T + (32 * m + r) * 68 + 16 * s + 8 * hl; tq[m][s][0] = *(const f32x4*)tp; tq[m][s][1] = *(const f32x4*)(tp + 4); }
                else { const float* tp = T + (63 - (32 * m + r)) * 68 + 56 - 16 * s - 8 * hl; const f32x4 x0 = *(const f32x4*)tp, x1 = *(const f32x4*)(tp + 4);
                       tq[m][s][0] = (f32x4){x1[3], x1[2], x1[1], x1[0]}; tq[m][s][1] = (f32x4){x0[3], x0[2], x0[1], x0[0]}; }
            }
        }
#pragma unroll
        for (int prod = 0; prod < 2; ++prod) {
#pragma unroll
            for (int m = 0; m < 2; ++m) {
                f32x16 acc;
#pragma unroll
                for (int i = 0; i < 16; ++i) acc[i] = 0.f;
#pragma unroll
                for (int s = 0; s < 4; ++s) {
                    const f32x4 ta = tq[m][s][0], tb = tq[m][s][1];
                    const f32x4 ca = prod == 0 ? c1[s][0] : c2[s][0], cb = prod == 0 ? c1[s][1] : c2[s][1];
                    u32x4 aw; aw.x = pk2(ta[0] * ca[0], ta[1] * ca[1]); aw.y = pk2(ta[2] * ca[2], ta[3] * ca[3]); aw.z = pk2(tb[0] * cb[0], tb[1] * cb[1]); aw.w = pk2(tb[2] * cb[2], tb[3] * cb[3]);
                    acc = MFMA32(__builtin_bit_cast(bf16x8, aw), prod == 0 ? bv[s] : bk[s], acc);
                }
                if (prod == 0) {
                    u32x4 w0, w1;
                    w0.x = pk2(acc[0], acc[1]); w0.y = pk2(acc[2], acc[3]); w0.z = pk2(acc[4], acc[5]); w0.w = pk2(acc[6], acc[7]);
                    w1.x = pk2(acc[8], acc[9]); w1.y = pk2(acc[10], acc[11]); w1.z = pk2(acc[12], acc[13]); w1.w = pk2(acc[14], acc[15]);
                    u32x4* up = (u32x4*)(rec + GP_U + ((m * 4 + n) * 64 + lane) * 16);
                    up[0] = w0; up[1] = w1;
                } else {
                    const int dkp = 32 * n + (r & 16) + swap23(r & 15);
#pragma unroll
                    for (int i = 0; i < 16; ++i) rec[GP_WN + (32 * m + crow(i, hl)) * 128 + dkp] = f2bf(-acc[i]);
                }
            }
        }
    }
    }
    __syncthreads();
}
DI void ph_g1(const Args& a, int l, unsigned char* lds, int cut = 0) {
#pragma unroll 1
    for (int task = blockIdx.x; task < 16 * 68; task += gridDim.x) {
        const int bh = task / 68, cc = task % 68;
        g1_task(a, l, bh >> 2, bh & 3, cc, lds, cut);
    }
}

#ifndef PROBE_SCAN_FAKE
#define PROBE_SCAN_FAKE 0
#endif
constexpr int SC_WN = 0, SC_QD = 16384, SC_KDT = 32768, SC_QK = 49152, SC_BUF = 57344, SC_GL = 2 * SC_BUF;
DI int scan_cc(int dir, int step) { return dir == 0 ? step : (step < 4 ? 3 - step : 71 - step); }
DI unsigned scan_src_off(int p) {
    if (p < 2048) { const int row = (p & 1023) >> 4, s16 = p & 15; return (unsigned)((p >> 10) * 16384 + row * 256 + ((s16 ^ (row & 15)) << 4)); }
    const int q = p - 2048, row = q >> 3, s8 = q & 7;
    return (unsigned)(32768 + row * 128 + ((s8 ^ ((row >> 1) & 7)) << 4));
}
#define SCAN_BAR() asm volatile("s_barrier" ::: "memory")
DI void scan_block(const Args& a, int l, int dir, int b, int h, unsigned char* lds, int fake = 0) {
    const int tid = tidx(), lane = tid & 63, wid = tid >> 6, r = lane & 31, hl = lane >> 5;
    const bf16_t* rec0 = (const bf16_t*)(a.ws + WS_GPRE);
    const float* GL = (const float*)(a.ws + WS_GL);
    const bool loader = wid >= 4;
    const int n = wid & 3, lw = __builtin_amdgcn_readfirstlane(wid) - 4;
    bf16_t* OD = (bf16_t*)(a.ws + (dir ? WS_OB : WS_OF));
    f32x16 st[4];
#pragma unroll
    for (int t = 0; t < 4; ++t)
#pragma unroll
        for (int i = 0; i < 16; ++i) st[t][i] = 0.f;
    u32x4 un[4]; float gln = 0.f;
    unsigned swq[8], skq[6];
    if (loader) {
#pragma unroll
        for (int j = 0; j < 8; ++j) swq[j] = scan_src_off((lw * 8 + j) * 64 + lane);
#pragma unroll
        for (int j = 0; j < 6; ++j) skq[j] = scan_src_off(2048 + (lw * 6 + j) * 64 + lane);
    }
#define DMA_WQ(chunk_, bufsel_) do { const int c_ = (chunk_) < 68 ? (chunk_) : 67; const unsigned char* src_ = (const unsigned char*)(rec0 + (size_t)chunk_index(dir, b, h, scan_cc(dir, c_)) * GP_REC); \
        LAS unsigned char* nb_ = (LAS unsigned char*)lds + (bufsel_) * SC_BUF; \
        _Pragma("unroll") for (int j = 0; j < 8; ++j) __builtin_amdgcn_global_load_lds((const unsigned*)(src_ + swq[j]), (LAS unsigned*)(nb_ + (lw * 8 + j) * 1024), 16, 0, 0); } while (0)
#define DMA_KQ(chunk_, bufsel_) do { const int c_ = (chunk_) < 68 ? (chunk_) : 67; const unsigned char* src_ = (const unsigned char*)(rec0 + (size_t)chunk_index(dir, b, h, scan_cc(dir, c_)) * GP_REC); \
        LAS unsigned char* nb_ = (LAS unsigned char*)lds + (bufsel_) * SC_BUF; \
        _Pragma("unroll") for (int j = 0; j < 6; ++j) __builtin_amdgcn_global_load_lds((const unsigned*)(src_ + skq[j]), (LAS unsigned*)(nb_ + 32768 + (lw * 6 + j) * 1024), 16, 0, 0); } while (0)
    if (loader) {
        DMA_WQ(0, 0); DMA_KQ(0, 0); DMA_WQ(1, 1);
        asm volatile("s_waitcnt vmcnt(8)" ::: "memory");
    } else {
        const int ci = chunk_index(dir, b, h, scan_cc(dir, 0));
        const bf16_t* rec = rec0 + (size_t)ci * GP_REC;
#pragma unroll
        for (int m = 0; m < 2; ++m) { const u32x4* up = (const u32x4*)(rec + GP_U + ((m * 4 + n) * 64 + lane) * 16); un[2 * m] = up[0]; un[2 * m + 1] = up[1]; }
        gln = GL[ci];
    }
    SCAN_BAR();
#pragma unroll 1
    for (int step = 0; step < 68; ++step) {
        const int cur = step & 1;
        if (loader) {
            if (fake != 1) {
                DMA_KQ(step + 1, cur ^ 1);
                asm volatile("s_waitcnt vmcnt(14)" ::: "memory");
                SCAN_BAR();
                DMA_WQ(step + 2, cur);
                asm volatile("s_waitcnt vmcnt(14)" ::: "memory");
                SCAN_BAR();
            } else { SCAN_BAR(); SCAN_BAR(); }
        } else {
            if (fake != 2) {
            const int cc = scan_cc(dir, step);
            const int row0 = cc < 4 ? b * CTX + cc * 64 : NCTX + b * SEQ + (cc - 4) * 64;
            const unsigned char* buf = lds + cur * SC_BUF;
            const float gl = gln;
            const unsigned char* pwn = buf + SC_WN + r * 256;
            const unsigned char* pqd = buf + SC_QD + r * 256;
            const unsigned char* pqk = buf + SC_QK + r * 128;
            const unsigned char* pkd = buf + SC_KDT + r * 128;
            const int x16 = r & 15, x8 = (r >> 1) & 7;
#define FR256(base, tile, blk) (*(const bf16x8*)((base) + (tile) * 32 * 256 + ((((blk) ^ x16)) << 4)))
#define FR128(base, tile, blk) (*(const bf16x8*)((base) + (tile) * 32 * 128 + ((((blk) ^ x8)) << 4)))
            bf16x8 fa[2][4];
#pragma unroll
            for (int m = 0; m < 2; ++m) { fa[0][m] = FR256(pwn, m, hl); fa[0][2 + m] = FR256(pqd, m, hl); }
            f32x16 vn[2];
#pragma unroll
            for (int m = 0; m < 2; ++m) {
                const u32x4 u0 = un[2 * m], u1 = un[2 * m + 1];
#pragma unroll
                for (int k = 0; k < 4; ++k) { vn[m][2 * k] = __uint_as_float(u0[k] << 16); vn[m][2 * k + 1] = __uint_as_float(u0[k] & 0xffff0000u); vn[m][8 + 2 * k] = __uint_as_float(u1[k] << 16); vn[m][8 + 2 * k + 1] = __uint_as_float(u1[k] & 0xffff0000u); }
            }
            if (step + 1 < 68) {
                const int ci1 = chunk_index(dir, b, h, scan_cc(dir, step + 1));
                const bf16_t* rec = rec0 + (size_t)ci1 * GP_REC;
#pragma unroll
                for (int m = 0; m < 2; ++m) { const u32x4* up = (const u32x4*)(rec + GP_U + ((m * 4 + n) * 64 + lane) * 16); un[2 * m] = up[0]; un[2 * m + 1] = up[1]; }
                gln = GL[ci1];
            }
            f32x16 o[2];
#pragma unroll
            for (int m = 0; m < 2; ++m)
#pragma unroll
                for (int i = 0; i < 16; ++i) o[m][i] = 0.f;
#pragma unroll
            for (int kk = 0; kk < 8; ++kk) {
                const int c = kk & 1, nx = c ^ 1;
                if (kk < 7) {
#pragma unroll
                    for (int m = 0; m < 2; ++m) { fa[nx][m] = FR256(pwn, m, 2 * (kk + 1) + hl); fa[nx][2 + m] = FR256(pqd, m, 2 * (kk + 1) + hl); }
                }
                const bf16x8 sbk = pack8(st[kk >> 1], kk & 1);
#pragma unroll
                for (int m = 0; m < 2; ++m) { vn[m] = MFMA32(fa[c][m], sbk, vn[m]); o[m] = MFMA32(fa[c][2 + m], sbk, o[m]); }
            }
            asm volatile("s_waitcnt lgkmcnt(0)" ::: "memory");
            SCAN_BAR();
            bf16x8 fb[2][3];
            fb[0][0] = FR128(pqk, 0, hl); fb[0][1] = FR128(pqk, 1, hl); fb[0][2] = FR128(pkd, 0, hl);
#pragma unroll
            for (int t = 0; t < 4; ++t)
#pragma unroll
                for (int i = 0; i < 16; ++i) st[t][i] *= gl;
#pragma unroll
            for (int h2 = 0; h2 < 8; ++h2) {
                const int kk = h2 >> 1, part = h2 & 1, c = h2 & 1, nx = c ^ 1;
                if (h2 < 7) {
                    const int k1 = (h2 + 1) >> 1;
                    if (part == 0) {
#pragma unroll
                        for (int t = 1; t < 4; ++t) fb[nx][t - 1] = FR128(pkd, t, 2 * k1 + hl);
                    } else { fb[nx][0] = FR128(pqk, 0, 2 * k1 + hl); fb[nx][1] = FR128(pqk, 1, 2 * k1 + hl); fb[nx][2] = FR128(pkd, 0, 2 * k1 + hl); }
                }
                const bf16x8 vbk = pack8(vn[kk >> 1], kk & 1);
                if (part == 0) { o[0] = MFMA32(fb[c][0], vbk, o[0]); o[1] = MFMA32(fb[c][1], vbk, o[1]); st[0] = MFMA32(fb[c][2], vbk, st[0]); }
                else { st[1] = MFMA32(fb[c][0], vbk, st[1]); st[2] = MFMA32(fb[c][1], vbk, st[2]); st[3] = MFMA32(fb[c][2], vbk, st[3]); }
            }
#undef FR256
#undef FR128
#pragma unroll
            for (int m = 0; m < 2; ++m)
#pragma unroll
                for (int i = 0; i < 16; ++i) OD[(size_t)(row0 + 32 * m + crow(i, hl)) * 512 + h * 128 + 32 * n + r] = f2bf(o[m][i]);
            asm volatile("s_waitcnt lgkmcnt(0)" ::: "memory");
            SCAN_BAR();
            } else { SCAN_BAR(); SCAN_BAR(); }
        }
    }
    if (loader) asm volatile("s_waitcnt vmcnt(0)" ::: "memory");
    __syncthreads();
#undef DMA_WQ
#undef DMA_KQ
}
#undef SCAN_BAR
DI void ph_scan(const Args& a, int l, unsigned char* lds) {
    const int x = blockIdx.x;
#if PROBE_SCAN_FAKE
    scan_block(a, l, x >> 4, (x >> 2) & 3, x & 3, lds, PROBE_SCAN_FAKE); __syncthreads();
#endif
    scan_block(a, l, x >> 4, (x >> 2) & 3, x & 3, lds);
}

__global__ void __launch_bounds__(256) nv_inproj(Args a) {
    const int l = a.layer;
    const int row = blockIdx.y, cd = blockIdx.x * 256 + threadIdx.x;
    const int cs = cd < 3584 ? cd : cd + 16;
    const float* w = a.in[6] + (size_t)l * 1024 * N_IN;
    const bf16_t* hr = (const bf16_t*)(a.ws + WS_H) + (size_t)row * 1024;
    const bool isrope = (cd < 1024) && (row >= NCTX);
    const int cs2 = cs ^ 16;
    float acc = 0.f, acc2 = 0.f;
    for (int k = 0; k < 1024; ++k) { const float h = bf2f(hr[k]); acc += h * w[(size_t)k * N_IN + cs]; if (isrope) acc2 += h * w[(size_t)k * N_IN + cs2]; }
    if (cd < 1024) {
        float v = acc;
        if (isrope) {
            const float* rope = (const float*)(a.ws + WS_ROPE);
            const int t = (row - NCTX) & 4095, d = cd & 63, axis = (d >> 5) & 1, half = (d >> 4) & 1, f = d & 15;
            const int pos = axis ? (t & 63) : (t >> 6);
            const float c = rope[(pos * 16 + f) * 2], s = rope[(pos * 16 + f) * 2 + 1];
            v = half == 0 ? acc * c - acc2 * s : acc * c + acc2 * s;
        }
        if (cd < 512) ((bf16_t*)(a.ws + WS_QA))[(size_t)row * 512 + cd] = f2bf(v * QSCALE);
        else ((bf16_t*)(a.ws + WS_KA))[(size_t)row * 512 + cd - 512] = f2bf(v);
    } else if (cd < 1536) ((bf16_t*)(a.ws + WS_VA))[(size_t)row * 512 + cd - 1024] = f2bf(acc);
    else if (cd < 3072) ((bf16_t*)(a.ws + WS_QKV))[(size_t)row * 1536 + cd - 1536] = f2bf(acc);
    else if (cd < 3584) ((bf16_t*)(a.ws + WS_Z))[(size_t)row * 512 + cd - 3072] = f2bf(acc);
    else ((bf16_t*)(a.ws + WS_SG))[(size_t)row * 2048 + cd - 3584] = f2bf(sigmoidf_(acc));
}

__global__ void __launch_bounds__(256) nv_attn(Args a) {
    const int row = blockIdx.x * 256 + threadIdx.x;
    const int h = blockIdx.y >> 2, comp = (blockIdx.y >> 1) & 1, dh = blockIdx.y & 1;
    const bf16_t* QA = (const bf16_t*)(a.ws + WS_QA); const bf16_t* KA = (const bf16_t*)(a.ws + WS_KA); const bf16_t* VA = (const bf16_t*)(a.ws + WS_VA);
    float* ON = (float*)(a.ws + WS_ON);
    const bool isctx = row < NCTX;
    const int b = isctx ? (row >> 8) : ((row - NCTX) >> 12);
    float q[64];
    { const bf16_t* qp = QA + (size_t)row * 512 + h * 128 + comp * 64;
#pragma unroll
      for (int i = 0; i < 64; ++i) q[i] = bf2f(qp[i]); }
    float acc[64];
#pragma unroll
    for (int i = 0; i < 64; ++i) acc[i] = 0.f;
    float m = -1e30f, lsum = 0.f;
    const int nkeys = isctx ? CTX : CTX + SEQ;
    for (int kk = 0; kk < nkeys; ++kk) {
        const int kr = kk < CTX ? b * CTX + kk : NCTX + b * SEQ + (kk - CTX);
        const bf16_t* kp = KA + (size_t)kr * 512 + h * 128 + comp * 64;
        float s = 0.f;
#pragma unroll
        for (int i = 0; i < 64; ++i) s += q[i] * bf2f(kp[i]);
        const float mn = fmaxf(m, s), corr = exp2f(m - mn), p = exp2f(s - mn);
        lsum = lsum * corr + p; m = mn;
        const bf16_t* vp = VA + (size_t)kr * 512 + h * 128 + dh * 64;
#pragma unroll
        for (int i = 0; i < 64; ++i) acc[i] = acc[i] * corr + p * bf2f(vp[i]);
    }
    const float inv = 1.f / lsum;
    float* op = ON + ((size_t)comp * TT + row) * 512 + h * 128 + dh * 64;
#pragma unroll
    for (int i = 0; i < 64; ++i) op[i] = acc[i] * inv;
}
DI float lam_of(const Args& a, int l) {
    float s1 = 0.f, s2 = 0.f;
    for (int i = 0; i < 64; ++i) { s1 += a.in[8][l * 64 + i] * a.in[9][l * 64 + i]; s2 += a.in[10][l * 64 + i] * a.in[11][l * 64 + i]; }
    return expf(s1) - expf(s2) + lam_init_of(l);
}
__global__ void __launch_bounds__(256) nv_attn_combine(Args a) {
    const int l = a.layer;
    const int idx = blockIdx.x * 256 + threadIdx.x; if (idx >= TT * 4) return;
    const int row = idx >> 2, h = idx & 3;
    const float lam = lam_of(a, l), li = lam_init_of(l);
    const float* ON = (const float*)(a.ws + WS_ON);
    const float* o0 = ON + (size_t)row * 512 + h * 128; const float* o1 = ON + ((size_t)TT + row) * 512 + h * 128;
    float ss = 0.f;
    for (int i = 0; i < 128; ++i) { const float o = o0[i] - lam * o1[i]; ss += o * o; }
    const float r = rsqrtf(ss * (1.f / 128.f) + EPS) * (1.f - li);
    bf16_t* ya = (bf16_t*)(a.ws + WS_YAB) + (size_t)row * 512 + h * 128;
    const float* sg = a.in[12] + l * 128;
    for (int i = 0; i < 128; ++i) ya[i] = f2bf((o0[i] - lam * o1[i]) * r * sg[i]);
}
__global__ void __launch_bounds__(256) nv_conv(Args a) {
    const int l = a.layer;
    const int row = blockIdx.y, ch = blockIdx.x * 256 + threadIdx.x;
    const bf16_t* QKV = (const bf16_t*)(a.ws + WS_QKV); float* CO = (float*)(a.ws + WS_CONVO);
    const float* cw = a.in[7] + l * 5 * 1536;
    int s0, len; if (row < NCTX) { s0 = (row >> 8) << 8; len = CTX; } else { s0 = NCTX + (((row - NCTX) >> 12) << 12); len = SEQ; }
    const int t = row - s0; float acc = 0.f;
    for (int j = 0; j < 5; ++j) { const int tt = t + j - 2; if (tt >= 0 && tt < len) acc += cw[j * 1536 + ch] * bf2f(QKV[(size_t)(s0 + tt) * 1536 + ch]); }
    CO[(size_t)row * 1536 + ch] = siluf_(acc);
}
__global__ void __launch_bounds__(256) nv_norm(Args a) {
    const int idx = blockIdx.x * 256 + threadIdx.x; if (idx >= TT * 8) return;
    const int row = idx >> 3, h = (idx >> 1) & 3, which = idx & 1;
    float* p = (float*)(a.ws + WS_CONVO) + (size_t)row * 1536 + which * 512 + h * 128;
    float ss = 0.f; for (int i = 0; i < 128; ++i) ss += p[i] * p[i];
    const float r = rsqrtf(ss + EPS) * (which == 0 ? 0.08838834764831845f : 1.f);
    for (int i = 0; i < 128; ++i) p[i] *= r;
}
__global__ void __launch_bounds__(128) nv_scan(Args a) {
    const int l = a.layer;
    const int dir = blockIdx.x >> 4, b = (blockIdx.x >> 2) & 3, h = blockIdx.x & 3, e = threadIdx.x;
    __shared__ float sq[128], sk[128];
    const float* CO = (const float*)(a.ws + WS_CONVO); const float* AB = (const float*)(a.ws + WS_AB);
    bf16_t* OD = (bf16_t*)(a.ws + (dir ? WS_OB : WS_OF));
    const float nal = -expf(a.in[13][l * 8 + dir * 4 + h]), dtb = a.in[14][l * 8 + dir * 4 + h];
    float s[128];
#pragma unroll
    for (int d = 0; d < 128; ++d) s[d] = 0.f;
    for (int step = 0; step < CTX + SEQ; ++step) {
        int row;
        if (step < CTX) { const int t = dir ? (CTX - 1 - step) : step; row = b * CTX + t; }
        else { const int t = dir ? (SEQ - 1 - (step - CTX)) : (step - CTX); row = NCTX + b * SEQ + t; }
        __syncthreads();
        sq[e] = CO[(size_t)row * 1536 + h * 128 + e]; sk[e] = CO[(size_t)row * 1536 + 512 + h * 128 + e];
        const float v = CO[(size_t)row * 1536 + 1024 + h * 128 + e];
        __syncthreads();
        const float g = nal * softplusf_(AB[(size_t)row * 16 + dir * 4 + h] + dtb);
        const float av = expf(g), beta = sigmoidf_(AB[(size_t)row * 16 + 8 + dir * 4 + h]);
        float r = 0.f, qs = 0.f, qk = 0.f;
#pragma unroll
        for (int d = 0; d < 128; ++d) { r += sk[d] * s[d]; qs += sq[d] * s[d]; qk += sq[d] * sk[d]; }
        const float vn = beta * (v - av * r);
        const float o = av * qs + qk * vn;
#pragma unroll
        for (int d = 0; d < 128; ++d) s[d] = av * s[d] + sk[d] * vn;
        OD[(size_t)row * 512 + h * 128 + e] = f2bf(o);
    }
}
__global__ void __launch_bounds__(256) nv_merge1(Args a) {
    const int l = a.layer;
    const int row = blockIdx.y, c = blockIdx.x * 256 + threadIdx.x;
    const bf16_t* YA = (const bf16_t*)(a.ws + WS_YAB) + (size_t)row * 512; const bf16_t* YB = (const bf16_t*)(a.ws + WS_YAB) + ((size_t)TT + row) * 512;
    const float* wpa = a.in[16] + (size_t)l * 512 * 1024; const float* wpb = a.in[17] + (size_t)l * 512 * 1024;
    float pa = 0.f, pb = 0.f;
    for (int k = 0; k < 512; ++k) { pa += bf2f(YA[k]) * wpa[(size_t)k * 1024 + c]; pb += bf2f(YB[k]) * wpb[(size_t)k * 1024 + c]; }
    const bf16_t* SG = (const bf16_t*)(a.ws + WS_SG) + (size_t)row * 2048;
    ((bf16_t*)(a.ws + WS_M))[(size_t)row * 1024 + c] = f2bf(bf2f(SG[c]) * pa + bf2f(SG[1024 + c]) * pb);
}
__global__ void __launch_bounds__(256) nv_wo(Args a) {
    const int l = a.layer;
    const int row = blockIdx.y, c = blockIdx.x * 256 + threadIdx.x;
    const bf16_t* M = (const bf16_t*)(a.ws + WS_M) + (size_t)row * 1024; const float* wo = a.in[18] + (size_t)l * 1024 * 1024;
    float acc = 0.f;
    for (int k = 0; k < 1024; ++k) acc += bf2f(M[k]) * wo[(size_t)k * 1024 + c];
    float* X = (float*)(a.ws + WS_X) + (size_t)row * 1024 + c;
    const float* m = (const float*)(a.ws + WS_MODS) + (size_t)(l * 5 + mod_set(row)) * 6144;
    *X = ALPHA * *X + m[2 * 1024 + c] * acc;
}
__global__ void __launch_bounds__(256) nv_moe1(Args a) {
    const int l = a.layer;
    const int as = blockIdx.y, j = blockIdx.x * 256 + threadIdx.x;
    const int row = as >> 1; if (l == DEPTH - 1 && row < NCTX) return;
    const int e = ((const int*)(a.ws + WS_ROUTE_E))[as];
    const bf16_t* hr = (const bf16_t*)(a.ws + WS_H) + (size_t)row * 1024;
    const float* w1 = a.in[23] + ((size_t)l * 16 + e) * 1024 * 512; const float* w3 = a.in[24] + ((size_t)l * 16 + e) * 1024 * 512;
    float g = 0.f, u = 0.f;
    for (int k = 0; k < 1024; ++k) { const float hv = bf2f(hr[k]); g += hv * w1[(size_t)k * 512 + j]; u += hv * w3[(size_t)k * 512 + j]; }
    ((bf16_t*)(a.ws + WS_ACT))[(size_t)as * 512 + j] = f2bf(siluf_(g) * u);
}
__global__ void __launch_bounds__(256) nv_moe2(Args a) {
    const int l = a.layer;
    const int as = blockIdx.y, c = blockIdx.x * 256 + threadIdx.x;
    const int row = as >> 1; if (l == DEPTH - 1 && row < NCTX) return;
    const int e = ((const int*)(a.ws + WS_ROUTE_E))[as];
    const bf16_t* ar = (const bf16_t*)(a.ws + WS_ACT) + (size_t)as * 512;
    const float* w2 = a.in[25] + ((size_t)l * 16 + e) * 512 * 1024;
    float acc = 0.f;
    for (int k = 0; k < 512; ++k) acc += bf2f(ar[k]) * w2[(size_t)k * 1024 + c];
    ((bf16_t*)(a.ws + WS_YS))[(size_t)as * 1024 + c] = f2bf(acc);
}


enum Op { OP_MODS = 0, OP_CONVERT, OP_PREP0, OP_INPROJ, OP_ATTN_G1, OP_SCAN, OP_YB, OP_MERGE1, OP_WO, OP_LN1, OP_SLOT, OP_UP, OP_DOWN, OP_COMBINE, OP_NONE };
constexpr int NSTEP_PRE = 2, NSTEP_LAYER = 11, NSTEPS = NSTEP_PRE + NSTEP_LAYER * DEPTH;
__host__ __device__ inline void decode_step(int step, int& op, int& l) {
    if (step < NSTEP_PRE) { l = 0; op = step == 0 ? OP_MODS : OP_PREP0; return; }
    const int s = step - NSTEP_PRE; l = s / NSTEP_LAYER; op = OP_INPROJ + s % NSTEP_LAYER;
}

#ifndef PROBE_XBAR
#define PROBE_XBAR 0
#endif
#ifndef PROBE_WO2
#define PROBE_WO2 0
#endif
#ifndef PROBE_LN12
#define PROBE_LN12 0
#endif
#ifndef PROBE_CMB2
#define PROBE_CMB2 0
#endif
#ifndef PROBE_ATT2
#define PROBE_ATT2 0
#endif
#ifndef PROBE_G12
#define PROBE_G12 0
#endif
#ifndef PROBE_OP
#define PROBE_OP -1
#endif
#ifndef PROBE_N
#define PROBE_N 1
#endif
#ifndef PROBE_PAD
#define PROBE_PAD 7
#endif
#ifndef ONLY_OP
#define ONLY_OP -1
#endif
#define EN(o) (ONLY_OP < 0 || ONLY_OP == (o))
__global__ void __launch_bounds__(512, 2) mk(Args a_in) {
    extern __shared__ __attribute__((aligned(16))) unsigned char lds[];
    const int tid = threadIdx.x;
    volatile LAS unsigned* MISC = (volatile LAS unsigned*)((LAS unsigned char*)lds + LDS_MISC);
    if (tid < 64) MISC[tid] = 0u;
    __syncthreads();
    XcdBarrier bar; bar.bar = (unsigned*)(a_in.ws + WS_CTL) + 4096; bar.x = 0; bar.st = nullptr;
    if (a_in.hi - a_in.lo > 1) bar = xcd_barrier_post((unsigned*)(a_in.ws + WS_CTL) + 4096, MISC + 8);
    const int G = gridDim.x;
#pragma unroll 1
    for (int step = a_in.lo; step < a_in.hi; ++step) {
        int op, l; decode_step(step, op, l);
        if ((op == OP_WO || op == OP_LN1 || op == OP_DOWN) && (a_in.hi - a_in.lo > 1)) continue;
        Args a = a_in;
        { unsigned z; asm volatile("s_mov_b32 %0, 0" : "=s"(z)); a.ws = a_in.ws + z; a.out = a_in.out + z;
#pragma unroll
          for (int i = 0; i < 28; ++i) a.in[i] = a_in.in[i] + z; }
#if PROBE_OP >= 0
        const int nrep_ = (op == PROBE_OP) ? 1 + PROBE_N : 1;
#pragma unroll 1
        for (int rep_ = 0; rep_ < nrep_; ++rep_) {
        const int padm_ = (rep_ > 0) ? PROBE_PAD : 7;
        if (rep_ > 0) xcd_barrier(bar);
#else
        const int padm_ = 7;
        {
#endif
        if (EN(OP_MODS) && op == OP_MODS) {
            ph_mods(a, lds);
            { const int t_ = tidx(); convert_run(a, 0, -1, blockIdx.x * 8 + (t_ >> 6), G * 8, (float*)(lds + 40960 + (t_ >> 6) * 8704), t_ & 63); }
            __syncthreads();
        }
        else if (EN(OP_PREP0) && op == OP_PREP0) ph_prep0(a, lds);
        else if (EN(OP_INPROJ) && op == OP_INPROJ) {
            pg8::Gemm g{(const bf16_t*)(a.ws + WS_H), (const bf16_t*)(a.ws + WS_WIN), TT, NPROJ, 1024};
            pg8::StaticOrder S; S.init(TT, NPROJ, G, (int)blockIdx.x);
            EpiInproj E{a.ws};
            pg8::gemm_phase<EpiInproj, pg8::StaticOrder, true, true>((LAS unsigned char*)lds, g, S, E);
        }
        else if (EN(OP_ATTN_G1) && op == OP_ATTN_G1) {
            if (a_in.pad & padm_ & 1) {
#if PROBE_ATT2
                ph_attn<PROBE_ATT2>(a, l, (LAS unsigned char*)lds); __syncthreads();
#endif
                ph_attn<0>(a, l, (LAS unsigned char*)lds);
            }
            if (a_in.pad & padm_ & 2) {
#if PROBE_G12
                ph_g1(a, l, lds, PROBE_G12 - 1); __syncthreads();
#endif
                ph_g1(a, l, lds);
            }
        }
        else if (EN(OP_SCAN) && op == OP_SCAN) {
            const int t_ = tidx(), w_ = t_ >> 6;
            const bool scanner = (a_in.pad & 4) && blockIdx.x < 32;
            const bool do_conv_ = (padm_ & 8) || (padm_ == 7);
            if (scanner) { if (padm_ & 4) ph_scan(a, l, lds); }
            else {
                const int nscan = (a_in.pad & 4) ? 32 : 0;
                const int rank = ((int)blockIdx.x - nscan) * 8 + w_;
                if (do_conv_) convert_run(a, l + 1, l, rank, (G - nscan) * 8, (float*)(lds + w_ * 16384), t_ & 63);
            }
            __syncthreads();
        }
        else if (EN(OP_YB) && op == OP_YB) ph_yb(a, l);
        else if (EN(OP_MERGE1) && op == OP_MERGE1) {
            {
                pg8::Gemm g{(const bf16_t*)(a.ws + WS_YAB), (const bf16_t*)(a.ws + WS_WPAB), 2 * TT, 2048, 512};
                SchedMerge1 S{G, (int)blockIdx.x, l == DEPTH - 1 ? 4 : 0, a.ws, l};
                EpiMerge1 E{a.ws};
                pg8::gemm_phase<EpiMerge1, SchedMerge1, true, true>((LAS unsigned char*)lds, g, S, E);
            }
            {
                pg8::Gemm g{(const bf16_t*)(a.ws + WS_M), (const bf16_t*)(a.ws + WS_WO), TT, 1024, 1024};
                SchedWoWait S{G, (int)blockIdx.x, l == DEPTH - 1 ? 4 : 0, a.ws, l};
                EpiWo E{a.ws, l, 0};
                pg8::gemm_phase<EpiWo, SchedWoWait, true, true>((LAS unsigned char*)lds, g, S, E);
            }
            if (a_in.hi - a_in.lo > 1) ph_ln1_router(a, l, lds, 0, 1);
        }
        else if (EN(OP_LN1) && op == OP_LN1) {
#if PROBE_LN12
            ph_ln1_router(a, l, lds, PROBE_LN12); __syncthreads();
#endif
            ph_ln1_router(a, l, lds);
        }
        else if (EN(OP_SLOT) && op == OP_SLOT) ph_slot(a, l, lds);
        else if (EN(OP_UP) && op == OP_UP) {
            const int* meta = (const int*)(a.ws + WS_META);
            const int ntl = meta[META_NT];
            {
                pg8::Gemm g{(const bf16_t*)(a.ws + WS_XS), (const bf16_t*)(a.ws + WS_W13), NSLOT, 16384, 1024};
                SchedMoe S{G, (int)blockIdx.x, ntl, meta + META_TE, a.ws, l, 1};
                EpiUp E{a.ws};
                pg8::gemm_phase<EpiUp, SchedMoe, true, true>((LAS unsigned char*)lds, g, S, E);
            }
            {
                pg8::Gemm g{(const bf16_t*)(a.ws + WS_ACT), (const bf16_t*)(a.ws + WS_W2), NSLOT, 16384, 512};
                SchedMoe S{G, (int)blockIdx.x, ntl, meta + META_TE, a.ws, l, 2};
                EpiDown E{a.ws};
                pg8::gemm_phase<EpiDown, SchedMoe, true, true>((LAS unsigned char*)lds, g, S, E);
            }
        }
        else if (EN(OP_COMBINE) && op == OP_COMBINE) {
#if PROBE_CMB2
            ph_combine_ln2(a, l, lds, 1); __syncthreads();
#endif
            ph_combine_ln2(a, l, lds);
        }
        }
        if (step + 1 < a_in.hi) { xcd_barrier(bar);
#if PROBE_XBAR
            for (int xb_ = 0; xb_ < PROBE_XBAR; ++xb_) xcd_barrier(bar);
#endif
        }
    }
}

#ifndef FAST_MASK
#define FAST_MASK 0xffffffffu
#endif
#ifndef MK_SINGLE
#define MK_SINGLE 1
#endif
#ifndef FAST_ATTN
#define FAST_ATTN 1
#endif
#ifndef FAST_G1
#define FAST_G1 1
#endif
#ifndef FAST_SCAN
#define FAST_SCAN 1
#endif
static bool op_fast(int op) {
    if (op == OP_ATTN_G1) return false;
    if (op == OP_SCAN) return FAST_SCAN != 0;
    return (FAST_MASK >> op) & 1u;
}
extern "C" void kernel_launch(void* const* d_in, const int* in_sizes, int n_in, void* d_out, int out_size, void* d_ws, size_t ws_size, hipStream_t stream) {
    if (n_in != 28 || ws_size < WS_END) { fprintf(stderr, "kernel_launch: unexpected n_in %d / ws_size %zu (need %zu)\n", n_in, ws_size, (size_t)WS_END); return; }
    Args a{};
    for (int i = 0; i < 28; ++i) a.in[i] = (const float*)d_in[i];
    a.out = (float*)d_out; a.ws = (unsigned char*)d_ws;
    static bool attr_done = false;
    if (!attr_done) {
        if (hipFuncSetAttribute((const void*)mk, hipFuncAttributeMaxDynamicSharedMemorySize, LDS_BYTES) != hipSuccess) fprintf(stderr, "hipFuncSetAttribute failed\n");
        attr_done = true;
    }
    hipMemsetAsync((char*)d_ws + WS_CTL, 0, 1 * MiB, stream);
#if MK_SINGLE
    a.lo = 0; a.hi = NSTEPS; a.pad = 7;
    hipLaunchKernelGGL(mk, dim3(256), dim3(512), LDS_BYTES, stream, a);
#else
    for (int step = 0; step < NSTEPS; ++step) {
        int op, l; decode_step(step, op, l);
        a.layer = l;
        if (op == OP_ATTN_G1) {
            if (FAST_ATTN || FAST_G1) { a.lo = step; a.hi = step + 1; a.pad = (FAST_ATTN ? 1 : 0) | (FAST_G1 ? 2 : 0); hipLaunchKernelGGL(mk, dim3(256), dim3(512), LDS_BYTES, stream, a); a.pad = 0; a.lo = 0; a.hi = 0; }
            if (!FAST_ATTN) {
                hipLaunchKernelGGL(nv_attn, dim3(TT / 256, 16), dim3(256), 0, stream, a);
                hipLaunchKernelGGL(nv_attn_combine, dim3(TT * 4 / 256), dim3(256), 0, stream, a);
            }
            if (!FAST_G1) {
                hipLaunchKernelGGL(nv_conv, dim3(1536 / 256, TT), dim3(256), 0, stream, a);
                hipLaunchKernelGGL(nv_norm, dim3(TT * 8 / 256), dim3(256), 0, stream, a);
            }
            continue;
        }
        if (op == OP_SCAN) {
            a.lo = step; a.hi = step + 1; a.pad = FAST_SCAN ? 4 : 0; hipLaunchKernelGGL(mk, dim3(256), dim3(512), LDS_BYTES, stream, a); a.pad = 0; a.lo = 0; a.hi = 0;
            if (!FAST_SCAN) hipLaunchKernelGGL(nv_scan, dim3(32), dim3(128), 0, stream, a);
            continue;
        }
        if (op_fast(op)) { a.lo = step; a.hi = step + 1; hipLaunchKernelGGL(mk, dim3(256), dim3(512), LDS_BYTES, stream, a); continue; }
        a.lo = 0; a.hi = 0;
        switch (op) {
        case OP_INPROJ: hipLaunchKernelGGL(nv_inproj, dim3(NPROJ / 256, TT), dim3(256), 0, stream, a); break;
        case OP_MERGE1: hipLaunchKernelGGL(nv_merge1, dim3(4, TT), dim3(256), 0, stream, a); break;
        case OP_WO: hipLaunchKernelGGL(nv_wo, dim3(4, TT), dim3(256), 0, stream, a); break;
        case OP_SLOT: break;
        case OP_UP: hipLaunchKernelGGL(nv_moe1, dim3(2, NASSIGN), dim3(256), 0, stream, a); break;
        case OP_DOWN: hipLaunchKernelGGL(nv_moe2, dim3(4, NASSIGN), dim3(256), 0, stream, a); break;
        default: fprintf(stderr, "no naive kernel for op %d\n", op); break;
        }
    }
#endif
}
```

```cpp
#include <hip/hip_runtime.h>
#include <cstdio>
#include <cstdint>

#define DI __device__ __forceinline__
typedef unsigned short bf16_t;
typedef short bf16x8 __attribute__((ext_vector_type(8)));
typedef float f32x4 __attribute__((ext_vector_type(4)));
typedef float f32x2 __attribute__((ext_vector_type(2)));
typedef float f32x16 __attribute__((ext_vector_type(16)));
typedef unsigned u32x4 __attribute__((ext_vector_type(4)));
typedef unsigned u32x2 __attribute__((ext_vector_type(2)));
typedef __bf16 bf16x2_t __attribute__((ext_vector_type(2)));

constexpr int D = 1024, NB = 4, SEQ = 4096, CTX = 256, DEPTH = 4;
constexpr int NCTX = NB * CTX;
constexpr int TT = NCTX + NB * SEQ;
constexpr int N_IN = 5648, NPROJ = 5632;
constexpr int NE = 16;
constexpr float EPS = 1e-6f;
constexpr float ALPHA = 1.681792830507429f;
constexpr float QSCALE = 0.125f * 1.4426950408889634f;
constexpr int NASSIGN = TT * 2;
constexpr int NSLOT = NASSIGN + NE * 256;

constexpr size_t MiB = 1u << 20;
constexpr size_t WS_CTL = 0;
constexpr size_t WS_MODS = 1 * MiB;
constexpr size_t WS_ROPE = 2 * MiB;
constexpr size_t WS_META = 2 * MiB + 65536;
constexpr size_t WS_ROUTE_E = 3 * MiB;
constexpr size_t WS_ROUTE_W = 3 * MiB + 262144;
constexpr size_t WS_DEST = 3 * MiB + 524288;
constexpr size_t WS_SLOTA = 3 * MiB + 786432;
constexpr size_t WS_AB = 4 * MiB;
constexpr size_t WS_GL = 6 * MiB;
constexpr size_t WS_WIN = 8 * MiB;
constexpr size_t WS_WPAB = 20 * MiB;
constexpr size_t WS_WO = 22 * MiB;
constexpr size_t WS_W13 = 24 * MiB;
constexpr size_t WS_W2 = 56 * MiB;
constexpr size_t WS_X = 72 * MiB;
constexpr size_t WS_H = 140 * MiB;
constexpr size_t WS_QA = 174 * MiB;
constexpr size_t WS_KA = 191 * MiB;
constexpr size_t WS_VA = 208 * MiB;
constexpr size_t WS_QKV = 225 * MiB;
constexpr size_t WS_Z = 276 * MiB;
constexpr size_t WS_SG = 293 * MiB;
constexpr size_t WS_GPRE = 361 * MiB;
constexpr size_t WS_OF = 514 * MiB;
constexpr size_t WS_OB = 531 * MiB;
constexpr size_t WS_YAB = 548 * MiB;
constexpr size_t WS_M = 582 * MiB;
constexpr size_t WS_END = 616 * MiB;
constexpr size_t WS_XS = 174 * MiB;
constexpr size_t WS_ACT = 250 * MiB;
constexpr size_t WS_YS = 288 * MiB;
constexpr size_t WS_ON = 361 * MiB;
constexpr size_t WS_CONVO = 361 * MiB;

DI float bf2f(bf16_t v) { return __uint_as_float(((unsigned)v) << 16); }
DI unsigned pk2(float lo, float hi) { f32x2 v = {lo, hi}; bf16x2_t b = __builtin_convertvector(v, bf16x2_t); return __builtin_bit_cast(unsigned, b); }
DI bf16_t f2bf(float f) { return (bf16_t)(pk2(f, 0.f) & 0xffffu); }
DI float sigmoidf_(float x) { return __builtin_amdgcn_rcpf(1.f + __builtin_amdgcn_exp2f(-1.4426950408889634f * x)); }
DI float siluf_(float x) { return x * __builtin_amdgcn_rcpf(1.f + __builtin_amdgcn_exp2f(-1.4426950408889634f * x)); }
DI float softplusf_(float x) { return fmaxf(x, 0.f) + log1pf(__expf(-fabsf(x))); }
template <int CTRL> DI float dppmov(float v) { return __uint_as_float(__builtin_amdgcn_update_dpp(0u, __float_as_uint(v), CTRL, 0xf, 0xf, true)); }
DI float xor32(float x, bool hi32) { auto rr = __builtin_amdgcn_permlane32_swap(__float_as_uint(x), __float_as_uint(x), false, false); return __uint_as_float(hi32 ? rr[0] : rr[1]); }
DI float xor16(float x, bool odd16) { auto rr = __builtin_amdgcn_permlane16_swap(__float_as_uint(x), __float_as_uint(x), false, false); return __uint_as_float(odd16 ? rr[0] : rr[1]); }
DI float wave_sum(float v) {
    v += dppmov<0xB1>(v); v += dppmov<0x4E>(v); v += dppmov<0x124>(v); v += dppmov<0x128>(v);
    { auto rr = __builtin_amdgcn_permlane16_swap(__float_as_uint(v), __float_as_uint(v), false, false); v = __uint_as_float(rr[0]) + __uint_as_float(rr[1]); }
    { auto rr = __builtin_amdgcn_permlane32_swap(__float_as_uint(v), __float_as_uint(v), false, false); v = __uint_as_float(rr[0]) + __uint_as_float(rr[1]); }
    return v;
}
DI int jj16_of_lane(int lane) { return ((lane >> 5) & 1) * 8 + ((lane >> 4) & 1) * 4 + ((lane >> 3) & 1) * 2 + ((lane >> 2) & 1); }
DI int lane_of_jj16(int jj) { return 32 * (jj >> 3) + 16 * ((jj >> 2) & 1) + 8 * ((jj >> 1) & 1) + 4 * (jj & 1); }
DI float reduce16(const float (&p)[16], int lane) {
    const bool b5 = lane & 32, b4 = lane & 16, b3 = lane & 8, b2 = lane & 4;
    float q8[8], q4[4], q2[2];
#pragma unroll
    for (int j = 0; j < 8; ++j) { const float keep = b5 ? p[j + 8] : p[j], send = b5 ? p[j] : p[j + 8]; q8[j] = keep + xor32(send, b5); }
#pragma unroll
    for (int j = 0; j < 4; ++j) { const float keep = b4 ? q8[j + 4] : q8[j], send = b4 ? q8[j] : q8[j + 4]; q4[j] = keep + xor16(send, b4); }
#pragma unroll
    for (int j = 0; j < 2; ++j) { const float keep = b3 ? q4[j + 2] : q4[j], send = b3 ? q4[j] : q4[j + 2]; q2[j] = keep + dppmov<0x128>(send); }
    float q1;
    { const float keep = b2 ? q2[1] : q2[0], send = b2 ? q2[0] : q2[1]; const float pa = dppmov<0x124>(send), pb = dppmov<0x12C>(send); q1 = keep + (b2 ? pa : pb); }
    q1 += dppmov<0x4E>(q1); q1 += dppmov<0xB1>(q1);
    return q1;
}
DI int mod_set(int row) { return row < NCTX ? 4 : ((row - NCTX) >> 12); }
DI float lam_init_of(int l) { return 0.8f - 0.6f * __expf(-0.3f * (float)l); }

DI int tidx() { int t = threadIdx.x; asm volatile("" : "+v"(t)); return t; }

struct Args {
    const float* in[28];
    float* out;
    unsigned char* ws;
    int lo, hi, layer, pad;
};


namespace pg8 {
#define PG8_LAS __attribute__((address_space(3)))
typedef unsigned short bf16_t;
typedef short bf16x8 __attribute__((ext_vector_type(8)));
typedef float f32x4 __attribute__((ext_vector_type(4)));
typedef unsigned u32x4 __attribute__((ext_vector_type(4)));
constexpr int BM = 256, BK = 64, HALF = 128, HTB = HALF * BK * 2  , STAGE_BYTES = 8 * HTB, NXCD = 8, WGM = 8;

__host__ __device__ __forceinline__ int lds_byte(int r, int c) { const int st = (r >> 4) * 2 + (c >> 5), rr = r & 15, cc = c & 31, ob = rr * 64 + cc * 2; return st * 1024 + (ob ^ (((ob >> 9) & 1) << 5)); }
__host__ __device__ __forceinline__ void stage_rc(int b, int& R, int& C) { const int st = b / 1024, sb = b % 1024, swz = sb ^ (((sb >> 9) & 1) << 5); R = (st >> 1) * 16 + swz / 64; C = (st & 1) * 32 + (swz % 64) / 2; }
__host__ __device__ __forceinline__ int perm32(int rho) { const int n = rho >> 4, i = rho & 15; return 8 * (i >> 2) + 4 * n + (i & 3); }

struct Unit { int pm, pn; };
struct Gemm { const bf16_t* A; const bf16_t* Bt; int M, N, K; };

struct StaticOrder {
    int nM, nN, nwg, G, c;
    __host__ __device__ void init(int M, int N, int G_, int c_) { nM = M / BM; nN = N / BM; nwg = nM * nN; G = G_; c = c_; }
    __host__ __device__ bool next(int i, Unit& u) const {
        const long L = (long)i * G + c; if (L >= nwg) return false;
        int wgid = (int)L; { const int q = nwg / NXCD, r = nwg % NXCD, xcd = wgid % NXCD, off = wgid / NXCD; wgid = (xcd < r ? xcd * (q + 1) : r * (q + 1) + (xcd - r) * q) + off; }
        const int nig = WGM * nN, gid = wgid / nig, fm = gid * WGM, gsz = (nM - fm) < WGM ? (nM - fm) : WGM;
        u.pm = fm + ((wgid % nig) % gsz); u.pn = (wgid % nig) / gsz; return true;
    }
    __device__ __forceinline__ void a_ready(const Unit&) const {}
    __device__ __forceinline__ void done(const Unit&) const {}
};

template <class Epi, class Sched, bool ALIGN_EPI = false, bool SP2 = false>
__device__ __forceinline__ void gemm_phase(PG8_LAS unsigned char* lds, const Gemm g, const Sched& S, const Epi& E) {
    const int tid = tidx(), wid = __builtin_amdgcn_readfirstlane(tid >> 6), lane = tid & 63, wr = wid >> 2, wc = wid & 3, fr = lane & 15, fq = lane >> 4;
    const int K = g.K, nt = K / BK;
    unsigned voffA[2], voffB[2];
#pragma unroll
    for (int i = 0; i < 2; ++i) { int R, C; stage_rc(tid * 16 + i * 8192, R, C); const int Rb = Epi::PERM ? ((R & ~31) + perm32(R & 31)) : R;
        voffA[i] = (unsigned)(R * K + C) * 2u; voffB[i] = (unsigned)(Rb * K + C) * 2u; }
    const size_t kstep = (size_t)(BK * 2);
    const size_t hstep = (size_t)HALF * K * 2;
    const size_t tstep = 2 * hstep;
    const unsigned ldsw = (unsigned)wid * 1024u;
    const int aoff = lds_byte(wr * 64 + fr, fq * 8), boff = lds_byte(wc * 32 + fr, fq * 8);
#define PG8_SA(b, h) (((b) * 2 + (h)) * HTB)
#define PG8_SB(b, h) ((4 + (b) * 2 + (h)) * HTB)
#define PG8_STAGE(bufoff, gbase, voff) do { _Pragma("unroll") for (int _i = 0; _i < 2; ++_i) \
        __builtin_amdgcn_global_load_lds((const unsigned*)((const char*)(gbase) + (voff)[_i]), (PG8_LAS unsigned*)(lds + (bufoff) + ldsw + _i * 8192), 16, 0, 0); } while (0)
#define PG8_LDA(dst, b, h) do { _Pragma("unroll") for (int m = 0; m < 4; ++m) _Pragma("unroll") for (int k = 0; k < 2; ++k) dst[m][k] = *(const PG8_LAS bf16x8*)(lds + PG8_SA(b, h) + aoff + m * 2048 + k * 1024); } while (0)
#define PG8_LDB(dst, b, h) do { _Pragma("unroll") for (int n = 0; n < 2; ++n) _Pragma("unroll") for (int k = 0; k < 2; ++k) dst[n][k] = *(const PG8_LAS bf16x8*)(lds + PG8_SB(b, h) + boff + n * 2048 + k * 1024); } while (0)
#define PG8_MMA(ai, bj, At, Bt) do { __builtin_amdgcn_s_setprio(1); _Pragma("unroll") for (int m = 0; m < 4; ++m) _Pragma("unroll") for (int n = 0; n < 2; ++n) _Pragma("unroll") for (int k = 0; k < 2; ++k) \
        acc[ai][bj][m][n] = __builtin_amdgcn_mfma_f32_16x16x32_bf16(Bt[n][k], At[m][k], acc[ai][bj][m][n], 0, 0, 0); __builtin_amdgcn_s_setprio(0); } while (0)
#define PG8_WAIT_V(n) asm volatile("s_waitcnt vmcnt(" #n ")" ::: "memory")
#define PG8_WAIT_L(n) asm volatile("s_waitcnt lgkmcnt(" #n ")" ::: "memory")
#define PG8_BAR __builtin_amdgcn_s_barrier()
#define PG8_SCHED __builtin_amdgcn_sched_barrier(0)
    Unit cur, nxt; int ui = 0;
    if (!S.next(0, cur)) return;
    f32x4 acc[2][2][4][2];
#pragma unroll
    for (int a = 0; a < 2; ++a)
#pragma unroll
        for (int b = 0; b < 2; ++b)
#pragma unroll
            for (int m = 0; m < 4; ++m)
#pragma unroll
                for (int n = 0; n < 2; ++n) acc[a][b][m][n] = (f32x4){0.f, 0.f, 0.f, 0.f};
    bf16x8 At[4][2], B0[2][2], B1[2][2];
    const char* cA = (const char*)g.A + (size_t)cur.pm * tstep; const char* cB = (const char*)g.Bt + (size_t)cur.pn * tstep;
    S.a_ready(cur);
    if constexpr (SP2) {
        PG8_STAGE(PG8_SB(0, 0), cB, voffB); PG8_STAGE(PG8_SB(0, 1), cB + hstep, voffB); PG8_STAGE(PG8_SA(0, 0), cA, voffA); PG8_STAGE(PG8_SA(0, 1), cA + hstep, voffA);
        if (wr == 1) PG8_BAR;
        PG8_WAIT_V(2); PG8_BAR;
        PG8_STAGE(PG8_SB(1, 0), cB + kstep, voffB); PG8_STAGE(PG8_SA(1, 0), cA + kstep, voffA); PG8_STAGE(PG8_SB(1, 1), cB + hstep + kstep, voffB);
        PG8_WAIT_V(6); PG8_BAR;
    } else {
        PG8_STAGE(PG8_SB(0, 0), cB, voffB); PG8_STAGE(PG8_SA(0, 0), cA, voffA); PG8_STAGE(PG8_SB(0, 1), cB + hstep, voffB); PG8_STAGE(PG8_SA(0, 1), cA + hstep, voffA);
        if (wr == 1) PG8_BAR;
        PG8_WAIT_V(4); PG8_BAR;
        PG8_STAGE(PG8_SB(1, 0), cB + kstep, voffB); PG8_STAGE(PG8_SA(1, 0), cA + kstep, voffA); PG8_STAGE(PG8_SB(1, 1), cB + hstep + kstep, voffB);
        PG8_WAIT_V(6); PG8_BAR;
    }
    for (;;) {
        const bool has_next = S.next(ui + 1, nxt);
        const char* nA = has_next ? (const char*)g.A + (size_t)nxt.pm * tstep : cA; const char* nB = has_next ? (const char*)g.Bt + (size_t)nxt.pn * tstep : cB;
        for (int t = 0; t < nt; t += 2) {
            const bool last = (t == nt - 2);
            const char* a1 = cA + (size_t)(t + 1) * kstep;
            const char* a2 = last ? nA : cA + (size_t)(t + 2) * kstep; const char* b2 = last ? nB : cB + (size_t)(t + 2) * kstep;
            const char* a3 = a2 + kstep; const char* b3 = b2 + kstep;
            if (last && has_next) S.a_ready(nxt);
            if constexpr (SP2) {
            PG8_LDB(B0, 0, 0); PG8_LDB(B1, 0, 1); PG8_SCHED; PG8_LDA(At, 0, 0); PG8_STAGE(PG8_SA(1, 1), a1 + hstep, voffA);
            PG8_WAIT_V(8); PG8_WAIT_L(0); PG8_BAR; PG8_MMA(0, 0, At, B0); PG8_MMA(0, 1, At, B1); PG8_BAR; PG8_SCHED;
            PG8_LDA(At, 0, 1); PG8_STAGE(PG8_SB(0, 0), b2, voffB); PG8_STAGE(PG8_SB(0, 1), b2 + hstep, voffB); PG8_STAGE(PG8_SA(0, 0), a2, voffA);
            PG8_WAIT_V(8); PG8_WAIT_L(0); PG8_BAR; PG8_MMA(1, 0, At, B0); PG8_MMA(1, 1, At, B1); PG8_BAR; PG8_SCHED;
            PG8_LDB(B0, 1, 0); PG8_LDB(B1, 1, 1); PG8_SCHED; PG8_LDA(At, 1, 0); PG8_STAGE(PG8_SA(0, 1), a2 + hstep, voffA);
            PG8_WAIT_V(8); PG8_WAIT_L(0); PG8_BAR; PG8_MMA(0, 0, At, B0); PG8_MMA(0, 1, At, B1); PG8_BAR; PG8_SCHED;
            PG8_LDA(At, 1, 1); PG8_STAGE(PG8_SB(1, 0), b3, voffB); PG8_STAGE(PG8_SB(1, 1), b3 + hstep, voffB); PG8_STAGE(PG8_SA(1, 0), a3, voffA);
            PG8_WAIT_V(8); PG8_WAIT_L(0); PG8_BAR; PG8_MMA(1, 0, At, B0); PG8_MMA(1, 1, At, B1); PG8_BAR; PG8_SCHED;
            } else {
            PG8_LDB(B0, 0, 0); PG8_SCHED; PG8_LDA(At, 0, 0); PG8_STAGE(PG8_SA(1, 1), a1 + hstep, voffA);
            PG8_WAIT_L(8); PG8_BAR; PG8_WAIT_L(0); PG8_MMA(0, 0, At, B0); PG8_BAR; PG8_SCHED;
            PG8_LDB(B1, 0, 1); PG8_STAGE(PG8_SB(0, 0), b2, voffB);
            PG8_BAR; PG8_WAIT_L(0); PG8_MMA(0, 1, At, B1); PG8_BAR;
            PG8_LDA(At, 0, 1); PG8_STAGE(PG8_SA(0, 0), a2, voffA);
            PG8_BAR; PG8_WAIT_L(0); PG8_MMA(1, 0, At, B0); PG8_BAR; PG8_SCHED;
            PG8_STAGE(PG8_SB(0, 1), b2 + hstep, voffB);
            PG8_WAIT_V(6); PG8_BAR; PG8_MMA(1, 1, At, B1); PG8_BAR;
            PG8_LDB(B0, 1, 0); PG8_SCHED; PG8_LDA(At, 1, 0); PG8_STAGE(PG8_SA(0, 1), a2 + hstep, voffA);
            PG8_WAIT_L(8); PG8_BAR; PG8_WAIT_L(0); PG8_MMA(0, 0, At, B0); PG8_BAR; PG8_SCHED;
            PG8_LDB(B1, 1, 1); PG8_STAGE(PG8_SB(1, 0), b3, voffB);
            PG8_BAR; PG8_WAIT_L(0); PG8_MMA(0, 1, At, B1); PG8_BAR;
            PG8_LDA(At, 1, 1); PG8_STAGE(PG8_SA(1, 0), a3, voffA);
            PG8_BAR; PG8_WAIT_L(0); PG8_MMA(1, 0, At, B0); PG8_BAR; PG8_SCHED;
            PG8_STAGE(PG8_SB(1, 1), b3 + hstep, voffB);
            PG8_WAIT_V(6); PG8_BAR; PG8_MMA(1, 1, At, B1); PG8_BAR;
            }
        }
        if constexpr (ALIGN_EPI) { if (wr == 0) PG8_BAR; }
        if constexpr (!Epi::AFTER_DRAIN) { E(acc, cur, wr, wc, fr, fq); S.done(cur); }
        if (!has_next) break;
#pragma unroll
        for (int a = 0; a < 2; ++a)
#pragma unroll
            for (int b = 0; b < 2; ++b)
#pragma unroll
                for (int m = 0; m < 4; ++m)
#pragma unroll
                    for (int n = 0; n < 2; ++n) acc[a][b][m][n] = (f32x4){0.f, 0.f, 0.f, 0.f};
        cur = nxt; cA = nA; cB = nB; ++ui;
        if constexpr (ALIGN_EPI) { if (wr == 1) PG8_BAR; }
    }
    PG8_WAIT_V(0);
    if constexpr (!ALIGN_EPI) { if (wr == 0) PG8_BAR; }
    PG8_BAR;
    if constexpr (Epi::AFTER_DRAIN) { E.fused(acc, cur, wr, wc, fr, fq, lds, wid, lane); S.done(cur); }
#undef PG8_SA
#undef PG8_SB
#undef PG8_STAGE
#undef PG8_LDA
#undef PG8_LDB
#undef PG8_MMA
#undef PG8_WAIT_V
#undef PG8_WAIT_L
#undef PG8_BAR
#undef PG8_SCHED
}
}


#define LAS __attribute__((address_space(3)))
constexpr int LDS_BYTES = 147456;
constexpr int LDS_MISC = 131072 + 8192;

DI void ph_mods(const Args& a, unsigned char* lds) {
    float (*sc)[1024] = (float (*)[1024])lds;
    float (*red)[5][128] = (float (*)[5][128])(lds + 20480);
    const float* c = a.in[1]; const float* cctx = a.in[3]; const float* mod_w = a.in[4]; const float* mod_b = a.in[5];
    float* mods = (float*)(a.ws + WS_MODS);
    const int tid = tidx(), lane = tid & 63, wid = tid >> 6;
    for (int i = tid; i < 5 * 1024; i += 512) { int s = i >> 10, k = i & 1023; float v = s < 4 ? c[s * 1024 + k] : cctx[k]; sc[s][k] = siluf_(v); }
    __syncthreads();
    for (int item = blockIdx.x; item < DEPTH * 48; item += gridDim.x) {
        const int l = item / 48, c0 = (item % 48) * 128;
        const int half = lane >> 5, cg = lane & 31;
        f32x4 acc[5];
#pragma unroll
        for (int s = 0; s < 5; ++s) acc[s] = (f32x4){0.f, 0.f, 0.f, 0.f};
        const float* wp = mod_w + (size_t)l * 1024 * 6144 + c0 + 4 * cg;
#pragma unroll 4
        for (int kk = 0; kk < 64; ++kk) {
            const int k = wid * 128 + 2 * kk + half;
            const f32x4 w = *(const f32x4*)(wp + (size_t)k * 6144);
#pragma unroll
            for (int s = 0; s < 5; ++s) acc[s] += w * sc[s][k];
        }
#pragma unroll
        for (int s = 0; s < 5; ++s) {
#pragma unroll
            for (int j = 0; j < 4; ++j) { float v = acc[s][j]; v += __shfl_xor(v, 32); acc[s][j] = v; }
            if (half == 0) {
#pragma unroll
                for (int j = 0; j < 4; ++j) red[wid][s][4 * cg + j] = acc[s][j];
            }
        }
        __syncthreads();
        for (int i = tid; i < 5 * 128; i += 512) {
            const int s = i >> 7, cc = i & 127; float v = 0.f;
#pragma unroll
            for (int w = 0; w < 8; ++w) v += red[w][s][cc];
            mods[((size_t)l * 5 + s) * 6144 + c0 + cc] = v + mod_b[l * 6144 + c0 + cc];
        }
        __syncthreads();
    }
    if (blockIdx.x == gridDim.x - 1) {
        float* rope = (float*)(a.ws + WS_ROPE);
        for (int i = tid; i < 64 * 16; i += 512) {
            const int pos = i >> 4, f = i & 15;
            const float inv = powf(10000.0f, -(float)f / 16.0f);
            const float ang = (float)pos * inv;
            rope[2 * i] = cosf(ang); rope[2 * i + 1] = sinf(ang);
        }
    }
}

DI void row_ln(f32x4 (&v)[4], const float* g, const float* b, int lane) {
    float s = 0.f;
#pragma unroll
    for (int j = 0; j < 4; ++j) s += (v[j][0] + v[j][1]) + (v[j][2] + v[j][3]);
    const float mean = wave_sum(s) * (1.f / 1024.f);
    float q = 0.f;
#pragma unroll
    for (int j = 0; j < 4; ++j) { v[j] = v[j] - mean; q += (v[j][0] * v[j][0] + v[j][1] * v[j][1]) + (v[j][2] * v[j][2] + v[j][3] * v[j][3]); }
    const float rstd = rsqrtf(wave_sum(q) * (1.f / 1024.f) + EPS);
#pragma unroll
    for (int j = 0; j < 4; ++j) {
        const f32x4 gg = *(const f32x4*)(g + 256 * j + 4 * lane), bb = *(const f32x4*)(b + 256 * j + 4 * lane);
        v[j] = v[j] * rstd * gg + bb;
    }
}
DI void row_ln_r(f32x4 (&v)[4], const f32x4 (&gg)[4], const f32x4 (&bb)[4]) {
    float s = 0.f;
#pragma unroll
    for (int j = 0; j < 4; ++j) s += (v[j][0] + v[j][1]) + (v[j][2] + v[j][3]);
    const float mean = wave_sum(s) * (1.f / 1024.f);
    float q = 0.f;
#pragma unroll
    for (int j = 0; j < 4; ++j) { v[j] = v[j] - mean; q += (v[j][0] * v[j][0] + v[j][1] * v[j][1]) + (v[j][2] * v[j][2] + v[j][3] * v[j][3]); }
    const float rstd = rsqrtf(wave_sum(q) * (1.f / 1024.f) + EPS);
#pragma unroll
    for (int j = 0; j < 4; ++j) v[j] = v[j] * rstd * gg[j] + bb[j];
}
DI void row_modulate(f32x4 (&h)[4], const f32x4 (&x)[4], const float* shift, const float* scale, int lane) {
#pragma unroll
    for (int j = 0; j < 4; ++j) {
        const f32x4 sh = *(const f32x4*)(shift + 256 * j + 4 * lane), scl = *(const f32x4*)(scale + 256 * j + 4 * lane);
        h[j] = x[j] * (1.f + scl) + sh;
    }
}
DI void row_store_bf16(bf16_t* dst, const f32x4 (&h)[4], int lane) {
#pragma unroll
    for (int j = 0; j < 4; ++j) { u32x2 w; w.x = pk2(h[j][0], h[j][1]); w.y = pk2(h[j][2], h[j][3]); *(u32x2*)(dst + 256 * j + 4 * lane) = w; }
}
DI float row_gemv16(const f32x4 (&h)[4], const float* WT, int lane) {
    float p[16];
#pragma unroll
    for (int jj = 0; jj < 16; ++jj) {
        float acc = 0.f;
#pragma unroll
        for (int j = 0; j < 4; ++j) { const f32x4 w = *(const f32x4*)(WT + jj * 1024 + 256 * j + 4 * lane); acc += (h[j][0] * w[0] + h[j][1] * w[1]) + (h[j][2] * w[2] + h[j][3] * w[3]); }
        asm volatile("" : "+v"(acc));
        p[jj] = acc;
    }
    return reduce16(p, lane);
}
DI void stage_wt16(float* WT, const float* W, int ld, int col0, int tid) {
    for (int c = tid; c < 1024; c += 512) {
        const float* p = W + (size_t)c * ld + col0;
#pragma unroll
        for (int q = 0; q < 4; ++q) { const f32x4 w = *(const f32x4*)(p + 4 * q);
#pragma unroll
            for (int i = 0; i < 4; ++i) WT[(4 * q + i) * 1024 + c] = w[i]; }
    }
}

DI void ph_prep0(const Args& a, unsigned char* lds) {
    float* WT = (float*)lds;
    const int tid = tidx(), lane = tid & 63, wid = tid >> 6;
    stage_wt16(WT, a.in[6], N_IN, 3584, tid);
    __syncthreads();
    const float* mods = (const float*)(a.ws + WS_MODS);
    float* X = (float*)(a.ws + WS_X); bf16_t* H = (bf16_t*)(a.ws + WS_H); float* AB = (float*)(a.ws + WS_AB);
    const int rstride = gridDim.x * 8;
    f32x4 xn[4];
    { const int row = blockIdx.x * 8 + wid; const float* src = row < NCTX ? a.in[2] + (size_t)row * 1024 : a.in[0] + (size_t)(row - NCTX) * 1024;
#pragma unroll
      for (int j = 0; j < 4; ++j) xn[j] = *(const f32x4*)(src + 256 * j + 4 * lane); }
#pragma unroll 1
    for (int row = blockIdx.x * 8 + wid; row < TT; row += rstride) {
        f32x4 x[4], h[4];
#pragma unroll
        for (int j = 0; j < 4; ++j) x[j] = xn[j];
        { const int rn = row + rstride; if (rn < TT) { const float* src = rn < NCTX ? a.in[2] + (size_t)rn * 1024 : a.in[0] + (size_t)(rn - NCTX) * 1024;
#pragma unroll
            for (int j = 0; j < 4; ++j) xn[j] = *(const f32x4*)(src + 256 * j + 4 * lane); } }
#pragma unroll
        for (int j = 0; j < 4; ++j) *(f32x4*)(X + (size_t)row * 1024 + 256 * j + 4 * lane) = x[j];
        const float* m = mods + (size_t)(0 * 5 + mod_set(row)) * 6144;
        row_modulate(h, x, m, m + 1024, lane);
        row_store_bf16(H + (size_t)row * 1024, h, lane);
        { const float abv = row_gemv16(h, WT, lane); if ((lane & 3) == 0) AB[(size_t)row * 16 + jj16_of_lane(lane)] = abv; }
    }
    __syncthreads();
}

DI void ph_yb(const Args& a, int l) {
    const int tid = tidx(), lane = tid & 63, wid = tid >> 6;
    const bf16_t* OF = (const bf16_t*)(a.ws + WS_OF); const bf16_t* OB = (const bf16_t*)(a.ws + WS_OB); const bf16_t* Z = (const bf16_t*)(a.ws + WS_Z);
    bf16_t* YB = (bf16_t*)(a.ws + WS_YAB) + (size_t)TT * 512;
    const float* ogp = a.in[15] + l * 128 + ((8 * lane) & 127);
    float og[8];
#pragma unroll
    for (int i = 0; i < 8; ++i) og[i] = ogp[i];
    const int rstride = gridDim.x * 8;
    int row0 = blockIdx.x * 8 + wid; if (l == DEPTH - 1) { while (row0 < NCTX) row0 += rstride; }
    u32x4 fn = (u32x4){0u, 0u, 0u, 0u}, bn = fn, zn = fn;
    if (row0 < TT) { const size_t o0 = (size_t)row0 * 512 + 8 * lane; fn = *(const u32x4*)(OF + o0); bn = *(const u32x4*)(OB + o0); zn = *(const u32x4*)(Z + o0); }
#pragma unroll 1
    for (int row = row0; row < TT; row += rstride) {
        const size_t off = (size_t)row * 512 + 8 * lane;
        const u32x4 f = fn, b = bn, z = zn;
        if (row + rstride < TT) { const size_t o1 = (size_t)(row + rstride) * 512 + 8 * lane; fn = *(const u32x4*)(OF + o1); bn = *(const u32x4*)(OB + o1); zn = *(const u32x4*)(Z + o1); }
        float o[8]; float ss = 0.f;
#pragma unroll
        for (int i = 0; i < 4; ++i) {
            o[2 * i] = __uint_as_float(f[i] << 16) + __uint_as_float(b[i] << 16);
            o[2 * i + 1] = __uint_as_float(f[i] & 0xffff0000u) + __uint_as_float(b[i] & 0xffff0000u);
            ss += o[2 * i] * o[2 * i] + o[2 * i + 1] * o[2 * i + 1];
        }
        ss += __shfl_xor(ss, 1); ss += __shfl_xor(ss, 2); ss += __shfl_xor(ss, 4); ss += __shfl_xor(ss, 8);
        const float r = rsqrtf(ss * (1.f / 128.f) + EPS);
        u32x4 w;
#pragma unroll
        for (int i = 0; i < 4; ++i) {
            const float z0 = __uint_as_float(z[i] << 16), z1 = __uint_as_float(z[i] & 0xffff0000u);
            const float y0 = o[2 * i] * r * og[2 * i] * siluf_(z0), y1 = o[2 * i + 1] * r * og[2 * i + 1] * siluf_(z1);
            w[i] = pk2(y0, y1);
        }
        *(u32x4*)(YB + off) = w;
    }
}

constexpr int LOCAL_ASSIGN = 9 * 8 * 2;
DI void ph_ln1_router(const Args& a, int l, unsigned char* lds, int rd = 0) {
    float* WT = (float*)lds;
    int* le = (int*)(lds + 65536);
    const int tid = tidx(), lane = tid & 63, wid = tid >> 6;
    stage_wt16(WT, a.in[21], 16, 0, tid);
    if (tid < LOCAL_ASSIGN) le[tid] = -1;
    __syncthreads();
    const float* mods = (const float*)(a.ws + WS_MODS);
    const float* X = (const float*)(a.ws + WS_X); float* XO = rd ? (float*)(a.ws + WS_GPRE) : (float*)(a.ws + WS_X); bf16_t* H = rd ? (bf16_t*)(a.ws + WS_GPRE + 72 * MiB) : (bf16_t*)(a.ws + WS_H);
    int* RE = rd ? (int*)(a.ws + WS_GPRE + 110 * MiB) : (int*)(a.ws + WS_ROUTE_E); float* RW = rd ? (float*)(a.ws + WS_GPRE + 111 * MiB) : (float*)(a.ws + WS_ROUTE_W);
    const float* g = a.in[19] + l * 1024; const float* bb = a.in[20] + l * 1024; const float* rb = a.in[22];
    const int kfirst = (l == DEPTH - 1 && (int)(blockIdx.x * 8 + wid) < NCTX) ? 1 : 0;
    f32x4 lg4[4], lb4[4];
#pragma unroll
    for (int j = 0; j < 4; ++j) { lg4[j] = *(const f32x4*)(g + 256 * j + 4 * lane); lb4[j] = *(const f32x4*)(bb + 256 * j + 4 * lane); }
    f32x4 xn[4];
    { const int row = blockIdx.x * 8 + wid + 2048 * kfirst;
#pragma unroll
      for (int j = 0; j < 4; ++j) xn[j] = *(const f32x4*)(X + (size_t)row * 1024 + 256 * j + 4 * lane); }
#pragma unroll 1
    for (int k = kfirst; k < 9; ++k) {
        const int row = blockIdx.x * 8 + wid + 2048 * k;
        if (row >= TT) break;
        f32x4 x[4], h[4], msh[4], msc[4];
#pragma unroll
        for (int j = 0; j < 4; ++j) x[j] = xn[j];
        const float* m = mods + (size_t)(l * 5 + mod_set(row)) * 6144;
#pragma unroll
        for (int j = 0; j < 4; ++j) { msh[j] = *(const f32x4*)(m + 3 * 1024 + 256 * j + 4 * lane); msc[j] = *(const f32x4*)(m + 4 * 1024 + 256 * j + 4 * lane); }
        if (row + 2048 < TT) {
#pragma unroll
            for (int j = 0; j < 4; ++j) xn[j] = *(const f32x4*)(X + (size_t)(row + 2048) * 1024 + 256 * j + 4 * lane);
        }
        row_ln_r(x, lg4, lb4);
#pragma unroll
        for (int j = 0; j < 4; ++j) h[j] = x[j] * (1.f + msc[j]) + msh[j];
        row_store_bf16(H + (size_t)row * 1024, h, lane);
        if (rd >= 2) continue;
        const float lgv = row_gemv16(h, WT, lane);
        float sc[16], sel[16];
#pragma unroll
        for (int e = 0; e < 16; ++e) { const float lg = __uint_as_float(__builtin_amdgcn_readlane(__float_as_uint(lgv), lane_of_jj16(e))); sc[e] = __builtin_amdgcn_rcpf(1.f + __builtin_amdgcn_exp2f(-1.4426950408889634f * lg)); sel[e] = sc[e] + rb[e]; }
        float best_gs = -1e30f; int best = 0;
#pragma unroll
        for (int gI = 0; gI < 4; ++gI) {
            const float v0 = sel[4 * gI], v1 = sel[4 * gI + 1], v2 = sel[4 * gI + 2], v3 = sel[4 * gI + 3];
            const float mx = fmaxf(fmaxf(v0, v1), fmaxf(v2, v3));
            float second;
            if (v0 == mx) second = fmaxf(v1, fmaxf(v2, v3));
            else if (v1 == mx) second = fmaxf(v0, fmaxf(v2, v3));
            else if (v2 == mx) second = fmaxf(fmaxf(v0, v1), v3);
            else second = fmaxf(fmaxf(v0, v1), v2);
            const float gs = mx + second;
            if (gs > best_gs) { best_gs = gs; best = gI; }
        }
        float i0 = 0.f, i1 = 0.f, i2 = 0.f, i3 = 0.f, s0 = 0.f, s1 = 0.f, s2 = 0.f, s3 = 0.f;
#pragma unroll
        for (int gI = 0; gI < 4; ++gI) if (gI == best) { i0 = sel[4 * gI]; i1 = sel[4 * gI + 1]; i2 = sel[4 * gI + 2]; i3 = sel[4 * gI + 3]; s0 = sc[4 * gI]; s1 = sc[4 * gI + 1]; s2 = sc[4 * gI + 2]; s3 = sc[4 * gI + 3]; }
        int a0 = 0; float m0 = i0, w0 = s0;
        if (i1 > m0) { a0 = 1; m0 = i1; w0 = s1; }
        if (i2 > m0) { a0 = 2; m0 = i2; w0 = s2; }
        if (i3 > m0) { a0 = 3; m0 = i3; w0 = s3; }
        int a1 = -1; float m1 = -1e30f, w1 = 0.f;
        if (a0 != 0 && i0 > m1) { a1 = 0; m1 = i0; w1 = s0; }
        if (a0 != 1 && i1 > m1) { a1 = 1; m1 = i1; w1 = s1; }
        if (a0 != 2 && i2 > m1) { a1 = 2; m1 = i2; w1 = s2; }
        if (a0 != 3 && i3 > m1) { a1 = 3; m1 = i3; w1 = s3; }
        if (lane == 0) {
            const float inv = 1.f / (w0 + w1);
            RE[2 * row] = best * 4 + a0; RE[2 * row + 1] = best * 4 + a1;
            RW[2 * row] = w0 * inv; RW[2 * row + 1] = w1 * inv;
            le[(k * 8 + wid) * 2] = best * 4 + a0; le[(k * 8 + wid) * 2 + 1] = best * 4 + a1;
        }
    }
    __syncthreads();
    if (tid < 16) {
        int cnt = 0;
        for (int i = 0; i < LOCAL_ASSIGN; ++i) cnt += (le[i] == tid) ? 1 : 0;
        ((int*)(a.ws + (rd ? WS_GPRE + 112 * MiB : WS_META)))[blockIdx.x * 16 + tid] = cnt;
    }
    __syncthreads();
}

constexpr int META_NT = 4096, META_TE = 4096 + 16;
DI void ph_slot(const Args& a, int l, unsigned char* lds) {
    int* bc = (int*)lds;
    int* tot = (int*)(lds + 16384);
    int* ls = (int*)(lds + 16384 + 1024);
    const int tid = tidx(), lane = tid & 63, wid = tid >> 6;
    const int* meta = (const int*)(a.ws + WS_META);
    int* metaw = (int*)(a.ws + WS_META);
    const int G = gridDim.x;
    for (int i = tid; i < G * 16; i += 512) bc[i] = meta[i];
    if (tid < LOCAL_ASSIGN) ls[tid] = -1;
    __syncthreads();
    {
        int* part = (int*)(lds + 16384 + 4096);
        const int e = tid & 15, pr = tid >> 4; int t = 0, before = 0;
#pragma unroll
        for (int q = 0; q < 8; ++q) { const int b = pr * 8 + q; if (b < G) { const int c = bc[b * 16 + e]; t += c; if (b < (int)blockIdx.x) before += c; } }
        part[pr * 16 + e] = t; part[512 + pr * 16 + e] = before;
        __syncthreads();
        if (tid < 16) { int tt = 0, bb = 0;
#pragma unroll
            for (int q = 0; q < 32; ++q) { tt += part[q * 16 + tid]; bb += part[512 + q * 16 + tid]; }
            tot[tid] = tt; tot[16 + tid] = bb; }
    }
    __syncthreads();
    if (tid == 0) {
        int ps = 0, nt = 0;
#pragma unroll 1
        for (int e = 0; e < 16; ++e) {
            tot[32 + e] = ps; tot[64 + e] = nt; const int tiles = (tot[e] + 255) >> 8;
            nt += tiles; ps += tiles * 256;
        }
        tot[48] = ps; tot[80] = nt;
    }
    __syncthreads();
    if (blockIdx.x == 0) {
        const int nt = tot[80];
        if (tid == 0) metaw[META_NT] = nt;
        if (tid < nt) { int e = 0;
#pragma unroll 1
            for (int q = 1; q < 16; ++q) e += (tot[64 + q] <= tid) ? 1 : 0;
            metaw[META_TE + tid] = e; }
    }
    const int* RE = (const int*)(a.ws + WS_ROUTE_E);
    int* DEST = (int*)(a.ws + WS_DEST); int* SLOTA = (int*)(a.ws + WS_SLOTA);
    int* le2 = (int*)(lds + 16384 + 2048);
    int my_row = -1, my_kk = 0;
    if (tid < LOCAL_ASSIGN) {
        const int row = blockIdx.x * 8 + ((tid >> 1) & 7) + 2048 * (tid >> 4); my_kk = tid & 1;
        int e = -1;
        if (row < TT && !(l == DEPTH - 1 && row < NCTX)) { e = RE[2 * row + my_kk]; my_row = row; }
        le2[tid] = e;
    }
    __syncthreads();
    if (tid < 16) {
        int pos = tot[32 + tid] + tot[16 + tid];
        for (int li = 0; li < LOCAL_ASSIGN; ++li) if (le2[li] == tid) { ls[li] = pos; ++pos; }
    }
    __syncthreads();
    if (tid < LOCAL_ASSIGN && my_row >= 0) { const int pos = ls[tid]; DEST[2 * my_row + my_kk] = pos; SLOTA[pos] = 2 * my_row + my_kk; }
    if (blockIdx.x < 16) {
        const int e = blockIdx.x; const int s0 = tot[32 + e] + tot[e], s1 = tot[32 + e] + (((tot[e] + 255) >> 8) << 8);
        for (int s = s0 + tid; s < s1; s += 512) SLOTA[s] = -1;
    }
    __syncthreads();
    const bf16_t* H = (const bf16_t*)(a.ws + WS_H); bf16_t* XS = (bf16_t*)(a.ws + WS_XS);
#pragma unroll 1
    for (int b0 = 0; b0 < 18; b0 += 6) {
        u32x4 r0[6], r1[6]; int sl[6];
#pragma unroll
        for (int q = 0; q < 6; ++q) {
            const int li = wid + 8 * (b0 + q); sl[q] = ls[li];
            const int row = blockIdx.x * 8 + ((li >> 1) & 7) + 2048 * (li >> 4);
            if (sl[q] >= 0) { const u32x4* sp = (const u32x4*)(H + (size_t)row * 1024); r0[q] = sp[lane]; r1[q] = sp[lane + 64]; }
        }
#pragma unroll
        for (int q = 0; q < 6; ++q) if (sl[q] >= 0) { u32x4* d = (u32x4*)(XS + (size_t)sl[q] * 1024); d[lane] = r0[q]; d[lane + 64] = r1[q]; }
    }
    __syncthreads();
}

DI void ph_combine_ln2(const Args& a, int l, unsigned char* lds, int rd = 0) {
    float* WT = (float*)lds;
    const bool last = (l == DEPTH - 1);
    const int tid = tidx(), lane = tid & 63, wid = tid >> 6;
    if (!last) { stage_wt16(WT, a.in[6] + (size_t)(l + 1) * 1024 * N_IN, N_IN, 3584, tid); }
    __syncthreads();
    const float* mods = (const float*)(a.ws + WS_MODS);
    const float* X = (const float*)(a.ws + WS_X); float* XO = rd ? (float*)(a.ws + WS_GPRE) : (float*)(a.ws + WS_X); bf16_t* H = rd ? (bf16_t*)(a.ws + WS_GPRE + 72 * MiB) : (bf16_t*)(a.ws + WS_H); float* AB = rd ? (float*)(a.ws + WS_GPRE + 110 * MiB) : (float*)(a.ws + WS_AB);
    float* OUT = rd ? (float*)(a.ws + WS_GPRE) : a.out;
    const bf16_t* YS = (const bf16_t*)(a.ws + WS_YS); const float* RW = (const float*)(a.ws + WS_ROUTE_W);
    const float* g = a.in[26] + l * 1024; const float* bb = a.in[27] + l * 1024;
    const int rstride = gridDim.x * 8;
    int row0 = blockIdx.x * 8 + wid; if (last) { while (row0 < NCTX) row0 += rstride; }
    f32x4 xn[4]; u32x2 yn0[4], yn1[4]; float wn0 = 0.f, wn1 = 0.f;
    if (row0 < TT) {
        wn0 = RW[2 * row0]; wn1 = RW[2 * row0 + 1];
#pragma unroll
        for (int j = 0; j < 4; ++j) { const int c = 256 * j + 4 * lane; xn[j] = *(const f32x4*)(X + (size_t)row0 * 1024 + c);
            yn0[j] = *(const u32x2*)(YS + (size_t)(2 * row0) * 1024 + c); yn1[j] = *(const u32x2*)(YS + (size_t)(2 * row0 + 1) * 1024 + c); }
    }
    f32x4 lg4[4], lb4[4], l1g[4], l1b[4];
#pragma unroll
    for (int j = 0; j < 4; ++j) { lg4[j] = *(const f32x4*)(g + 256 * j + 4 * lane); lb4[j] = *(const f32x4*)(bb + 256 * j + 4 * lane);
        l1g[j] = *(const f32x4*)(a.in[19] + l * 1024 + 256 * j + 4 * lane); l1b[j] = *(const f32x4*)(a.in[20] + l * 1024 + 256 * j + 4 * lane); }
#pragma unroll 1
    for (int row = row0; row < TT; row += rstride) {
        const float w0 = wn0, w1 = wn1;
        const float* m = mods + (size_t)(l * 5 + mod_set(row)) * 6144;
        const float* mn = mods + (size_t)((last ? l : l + 1) * 5 + mod_set(row)) * 6144;
        f32x4 x[4], h[4], gt[4], msh[4], msc[4]; u32x2 ya[4], yb[4];
#pragma unroll
        for (int j = 0; j < 4; ++j) { x[j] = xn[j]; ya[j] = yn0[j]; yb[j] = yn1[j]; }
#pragma unroll
        for (int j = 0; j < 4; ++j) { const int c = 256 * j + 4 * lane; gt[j] = *(const f32x4*)(m + 5 * 1024 + c); msh[j] = *(const f32x4*)(mn + c); msc[j] = *(const f32x4*)(mn + 1024 + c); }
        { const int rn = row + rstride;
          if (rn < TT) {
            wn0 = RW[2 * rn]; wn1 = RW[2 * rn + 1];
#pragma unroll
            for (int j = 0; j < 4; ++j) { const int c = 256 * j + 4 * lane; xn[j] = *(const f32x4*)(X + (size_t)rn * 1024 + c);
                yn0[j] = *(const u32x2*)(YS + (size_t)(2 * rn) * 1024 + c); yn1[j] = *(const u32x2*)(YS + (size_t)(2 * rn + 1) * 1024 + c); }
          } }
        row_ln_r(x, l1g, l1b);
#pragma unroll
        for (int j = 0; j < 4; ++j) {
            const u32x2 y0 = ya[j], y1 = yb[j];
            f32x4 y;
            y[0] = w0 * __uint_as_float(y0.x << 16) + w1 * __uint_as_float(y1.x << 16);
            y[1] = w0 * __uint_as_float(y0.x & 0xffff0000u) + w1 * __uint_as_float(y1.x & 0xffff0000u);
            y[2] = w0 * __uint_as_float(y0.y << 16) + w1 * __uint_as_float(y1.y << 16);
            y[3] = w0 * __uint_as_float(y0.y & 0xffff0000u) + w1 * __uint_as_float(y1.y & 0xffff0000u);
            x[j] = ALPHA * x[j] + gt[j] * y;
        }
        row_ln_r(x, lg4, lb4);
        if (last) {
#pragma unroll
            for (int j = 0; j < 4; ++j) *(f32x4*)(OUT + (size_t)(row - NCTX) * 1024 + 256 * j + 4 * lane) = x[j];
        } else {
#pragma unroll
            for (int j = 0; j < 4; ++j) *(f32x4*)(XO + (size_t)row * 1024 + 256 * j + 4 * lane) = x[j];
#pragma unroll
            for (int j = 0; j < 4; ++j) h[j] = x[j] * (1.f + msc[j]) + msh[j];
            row_store_bf16(H + (size_t)row * 1024, h, lane);
            { const float abv = row_gemv16(h, WT, lane); if ((lane & 3) == 0) AB[(size_t)row * 16 + jj16_of_lane(lane)] = abv; }
        }
    }
    __syncthreads();
}

DI void transpose_item(const float* W, int ldw, int K, int ncols, bf16_t* WT, int item, float* scr, int lane) {
    const int nblk = ncols >> 5, kb = item / nblk, nb = item - kb * nblk, k0 = 64 * kb, n0 = 32 * nb;
#pragma unroll 8
    for (int i = 0; i < 32; ++i) { const int kk = 2 * i + (lane >> 5); scr[kk * 33 + (lane & 31)] = W[(size_t)(k0 + kk) * ldw + n0 + (lane & 31)]; }
    asm volatile("s_waitcnt lgkmcnt(0)" ::: "memory");
    const int c = lane & 7;
#pragma unroll
    for (int j = 0; j < 4; ++j) { const int n = (lane >> 3) + 8 * j; const float* s = scr + (8 * c) * 33 + n;
        u32x4 o; o.x = pk2(s[0 * 33], s[1 * 33]); o.y = pk2(s[2 * 33], s[3 * 33]); o.z = pk2(s[4 * 33], s[5 * 33]); o.w = pk2(s[6 * 33], s[7 * 33]);
        *(u32x4*)(WT + (size_t)(n0 + n) * K + k0 + 8 * c) = o; }
    asm volatile("s_waitcnt lgkmcnt(0)" ::: "memory");
}
constexpr int CV_A = 2816, CV_B = 13312;
DI void convert_A(const Args& a, int l, int item, float* scr, int lane) {
    const float* w = a.in[6] + (size_t)l * 1024 * N_IN; bf16_t* wt = (bf16_t*)(a.ws + WS_WIN);
    if (item < 1792) transpose_item(w, N_IN, 1024, 3584, wt, item, scr, lane);
    else transpose_item(w + 3600, N_IN, 1024, 2048, wt + (size_t)3584 * 1024, item - 1792, scr, lane);
}
DI void convert_B(const Args& a, int l, int item, float* scr, int lane) {
    if (item < 256) { transpose_item(a.in[16] + (size_t)l * 512 * 1024, 1024, 512, 1024, (bf16_t*)(a.ws + WS_WPAB), item, scr, lane); return; }
    item -= 256;
    if (item < 256) { transpose_item(a.in[17] + (size_t)l * 512 * 1024, 1024, 512, 1024, (bf16_t*)(a.ws + WS_WPAB) + (size_t)1024 * 512, item, scr, lane); return; }
    item -= 256;
    if (item < 512) { transpose_item(a.in[18] + (size_t)l * 1024 * 1024, 1024, 1024, 1024, (bf16_t*)(a.ws + WS_WO), item, scr, lane); return; }
    item -= 512;
    if (item < 8192) {
        const int job = item >> 6, it = item & 63; const int e = job >> 3, t = (job >> 1) & 3, which = job & 1;
        const float* w = (which ? a.in[24] : a.in[23]) + ((size_t)l * 16 + e) * 1024 * 512 + 128 * t;
        transpose_item(w, 512, 1024, 128, (bf16_t*)(a.ws + WS_W13) + ((size_t)e * 1024 + 256 * t + 128 * which) * 1024, it, scr, lane); return;
    }
    item -= 8192;
    { const int e = item >> 8, it = item & 255;
      transpose_item(a.in[25] + ((size_t)l * 16 + e) * 512 * 1024, 1024, 512, 1024, (bf16_t*)(a.ws + WS_W2) + (size_t)e * 1024 * 512, it, scr, lane); }
}
DI void convert_run(const Args& a, int lA, int lB, int rank, int nw, float* scr, int lane) {
    const int nA = (lA >= 0 && lA < DEPTH) ? CV_A : 0, nB = (lB >= 0 && lB < DEPTH) ? CV_B : 0;
#pragma unroll 1
    for (int it = rank; it < nA + nB; it += nw) { if (it < nA) convert_A(a, lA, it, scr, lane); else convert_B(a, lB, it - nA, scr, lane); }
}


#define XB_TMO      128
#define XB_XCNT(j)  (256  + 64 * (j))
#define XB_XSUB(j)  (1280 + 64 * (j))
#define XB_XGEN(j)  (2304 + 64 * (j))
#define XB_TOP      3328
#define XB_TOPGEN   3392
#define XCD_BAR_WORDS 3456
#define XB_SPIN_CAP (1u << 18)

__device__ __forceinline__ unsigned xb_ld(unsigned* p)              { return __hip_atomic_load(p, __ATOMIC_RELAXED, __HIP_MEMORY_SCOPE_AGENT); }
__device__ __forceinline__ unsigned xb_add(unsigned* p, unsigned v) { return __hip_atomic_fetch_add(p, v, __ATOMIC_RELAXED, __HIP_MEMORY_SCOPE_AGENT); }
__device__ __forceinline__ unsigned xb_xcc_id() { return (unsigned)__builtin_amdgcn_s_getreg((3 << 11) | 20) & 0xFu; }
#define XB_SPIN(cond, bar) do { unsigned _sp = 0; while (cond) { __builtin_amdgcn_s_sleep(1); \
    if ((++_sp & 255u) == 0u) { if (xb_ld(&(bar)[XB_TMO])) break; if (_sp > XB_SPIN_CAP) { atomicAdd(&(bar)[XB_TMO], 1u); break; } } } } while (0)

struct XcdBarrier {
    unsigned* bar; unsigned x;
    volatile LAS unsigned* st;
};

__device__ __forceinline__ XcdBarrier xcd_barrier_post(unsigned* bar, volatile LAS unsigned* st) {
    XcdBarrier b; b.bar = bar; b.x = xb_xcc_id(); b.st = st;
    if (tidx() == 0) (void)xb_add(&bar[XB_XCNT(b.x)], 1u);
    return b;
}
__device__ __forceinline__ void xcd_barrier_complete(unsigned* bar, unsigned x, unsigned& nloc, unsigned& nx) {
    const unsigned G = gridDim.x * gridDim.y * gridDim.z;
    unsigned sum, cnt, mine, sp = 0u;
    for (;;) {
        sum = 0u; cnt = 0u; mine = 0u;
#pragma unroll
        for (unsigned j = 0; j < 16; ++j) { const unsigned c = xb_ld(&bar[XB_XCNT(j)]); sum += c; cnt += (c > 0u) ? 1u : 0u; mine = (j == x) ? c : mine; }
        if (sum == G) break;
        __builtin_amdgcn_s_sleep(1);
        if ((++sp & 255u) == 0u) { if (xb_ld(&bar[XB_TMO])) break; if (sp > XB_SPIN_CAP) { atomicAdd(&bar[XB_TMO], 1u); break; } }
    }
    nloc = mine > 0u ? mine : 1u; nx = cnt > 0u ? cnt : 1u;
}

__device__ __forceinline__ void xcd_barrier(const XcdBarrier& b) {
    asm volatile("s_waitcnt vmcnt(0)" ::: "memory");
    __syncthreads();
    if (tidx() == 0) {
        unsigned* bar = b.bar;
        __builtin_amdgcn_s_waitcnt(0);
        unsigned nloc = b.st[0], nx = b.st[1];
        if (nloc == 0u) { xcd_barrier_complete(bar, b.x, nloc, nx); b.st[0] = nloc; b.st[1] = nx; }
        const unsigned old = xb_add(&bar[XB_XSUB(b.x)], 1u);
        const unsigned gen = old / nloc;
        if (old + 1u == (gen + 1u) * nloc) {
            __builtin_amdgcn_fence(__ATOMIC_RELEASE, "agent");
            asm volatile("s_waitcnt vmcnt(0)" ::: "memory");
            const unsigned og = xb_add(&bar[XB_TOP], 1u);
            const unsigned tg = og / nx;
            if (og + 1u == (tg + 1u) * nx) xb_add(&bar[XB_TOPGEN], 1u);
            else XB_SPIN(xb_ld(&bar[XB_TOPGEN]) == tg, bar);
            __builtin_amdgcn_fence(__ATOMIC_ACQUIRE, "agent");
            xb_add(&bar[XB_XGEN(b.x)], 1u);
            asm volatile("s_waitcnt vmcnt(0)" ::: "memory");
        } else {
            XB_SPIN(xb_ld(&bar[XB_XGEN(b.x)]) == gen, bar);
            __builtin_amdgcn_fence(__ATOMIC_ACQUIRE, "agent");
            asm volatile("s_waitcnt vmcnt(0)" ::: "memory");
        }
    }
    __syncthreads();
}


constexpr int CW_PANEL = 16384;
DI unsigned* panel_word(unsigned char* ws, int l, int kind, int p) { return (unsigned*)(ws + WS_CTL) + CW_PANEL + ((l * 2 + kind) * 160 + p) * 64; }
DI void store16_wt(void* p, u32x4 v) { asm volatile("global_store_dwordx4 %0, %1, off sc1\n\ts_nop 1" :: "v"(p), "v"(v) : "memory"); }
DI void panel_publish(unsigned* w) {
    asm volatile("s_waitcnt vmcnt(0)" ::: "memory");
    if ((tidx() & 63) == 0) __hip_atomic_fetch_add(w, 1u, __ATOMIC_RELAXED, __HIP_MEMORY_SCOPE_AGENT);
}
DI void panel_wait(unsigned* w, unsigned need) {
    if (tidx() < 64) {
        unsigned spins = 0;
        while ((unsigned)__builtin_amdgcn_readfirstlane(__hip_atomic_load(w, __ATOMIC_RELAXED, __HIP_MEMORY_SCOPE_AGENT)) < need) { __builtin_amdgcn_s_sleep(2); if (++spins > (1u << 22)) break; }
        __builtin_amdgcn_fence(__ATOMIC_ACQUIRE, "agent");
        asm volatile("s_waitcnt vmcnt(0)" ::: "memory");
    }
    asm volatile("" ::: "memory"); __builtin_amdgcn_s_barrier(); asm volatile("" ::: "memory");
}
DI int unit_set(int pm) { return pm < 4 ? 4 : ((pm - 4) >> 4); }
struct EpiInproj {
    static constexpr bool PERM = true, AFTER_DRAIN = false;
    unsigned char* ws;
    DI void operator()(const f32x4 (&acc)[2][2][4][2], const pg8::Unit& u, int wr, int wc, int fr, int fq) const {
        const int pn = u.pn; bf16_t* dst; int ld, colt, mode;
        if (pn < 2) { dst = (bf16_t*)(ws + WS_QA); ld = 512; colt = pn * 256; mode = 1; }
        else if (pn < 4) { dst = (bf16_t*)(ws + WS_KA); ld = 512; colt = (pn - 2) * 256; mode = 2; }
        else if (pn < 6) { dst = (bf16_t*)(ws + WS_VA); ld = 512; colt = (pn - 4) * 256; mode = 0; }
        else if (pn < 12) { dst = (bf16_t*)(ws + WS_QKV); ld = 1536; colt = (pn - 6) * 256; mode = 0; }
        else if (pn < 14) { dst = (bf16_t*)(ws + WS_Z); ld = 512; colt = (pn - 12) * 256; mode = 0; }
        else { dst = (bf16_t*)(ws + WS_SG); ld = 2048; colt = (pn - 14) * 256; mode = 3; }
        const bool rope = (mode == 1 || mode == 2) && u.pm >= 4;
        const float qs = (mode == 1) ? QSCALE : 1.f;
        const float* rtab = (const float*)(ws + WS_ROPE);
        const int row0 = u.pm * 256 + wr * 64 + fr;
        const float sgn = (fq >> 1) ? 1.f : -1.f;
        f32x4 csn[2][2];
        if (rope) {
            const int t = (row0 - NCTX) & 4095; const int pos = (wc & 1) ? (t & 63) : (t >> 6);
            const float* rp = rtab + (pos * 16 + 8 * (fq & 1)) * 2;
#pragma unroll
            for (int n = 0; n < 2; ++n) { csn[n][0] = *(const f32x4*)(rp + 8 * n); csn[n][1] = *(const f32x4*)(rp + 8 * n + 4); }
        }
#pragma unroll
        for (int s = 0; s < 8; ++s) {
            const int ai = s >> 2, m = s & 3;
            const int row = row0 + ai * 128 + m * 16;
            f32x4 cs[2][2];
            if (rope) {
#pragma unroll
                for (int n = 0; n < 2; ++n) { cs[n][0] = csn[n][0]; cs[n][1] = csn[n][1]; }
                if (s < 7) {
                    const int r1 = row0 + ((s + 1) >> 2) * 128 + ((s + 1) & 3) * 16;
                    const int t = (r1 - NCTX) & 4095; const int pos = (wc & 1) ? (t & 63) : (t >> 6);
                    const float* rp = rtab + (pos * 16 + 8 * (fq & 1)) * 2;
#pragma unroll
                    for (int n = 0; n < 2; ++n) { csn[n][0] = *(const f32x4*)(rp + 8 * n); csn[n][1] = *(const f32x4*)(rp + 8 * n + 4); }
                }
            }
#pragma unroll
            for (int bj = 0; bj < 2; ++bj) {
                f32x4 v[2] = {acc[ai][bj][m][0], acc[ai][bj][m][1]};
                if (rope) {
#pragma unroll
                    for (int n = 0; n < 2; ++n)
#pragma unroll
                        for (int j = 0; j < 4; ++j) {
                            const float x = v[n][j], xp = __shfl_xor(x, 32);
                            const float c = cs[n][j >> 1][(j & 1) * 2], sv = cs[n][j >> 1][(j & 1) * 2 + 1];
                            v[n][j] = x * c + sgn * xp * sv;
                        }
                }
                if (mode == 3) {
#pragma unroll
                    for (int n = 0; n < 2; ++n)
#pragma unroll
                        for (int j = 0; j < 4; ++j) v[n][j] = sigmoidf_(v[n][j]);
                }
                u32x4 w; w.x = pk2(v[0][0] * qs, v[0][1] * qs); w.y = pk2(v[0][2] * qs, v[0][3] * qs); w.z = pk2(v[1][0] * qs, v[1][1] * qs); w.w = pk2(v[1][2] * qs, v[1][3] * qs);
                *(u32x4*)(dst + (size_t)row * ld + colt + bj * 128 + wc * 32 + 8 * fq) = w;
            }
        }
    }
};
struct EpiMerge1 {
    static constexpr bool PERM = true, AFTER_DRAIN = false;
    unsigned char* ws;
    DI void operator()(const f32x4 (&acc)[2][2][4][2], const pg8::Unit& u, int wr, int wc, int fr, int fq) const {
        const int which = u.pm >= 68 ? 1 : 0; const int pm = u.pm - 68 * which, pn = u.pn - 4 * which;
        const bf16_t* SG = (const bf16_t*)(ws + WS_SG); bf16_t* M = (bf16_t*)(ws + WS_M); bf16_t* MP = (bf16_t*)(ws + WS_GPRE);
        const int row0 = pm * 256 + wr * 64 + fr, colb = pn * 256 + wc * 32 + 8 * fq;
        u32x4 gn[2], on[2], gc[2], oc[2];
#pragma unroll
        for (int bj = 0; bj < 2; ++bj) { gn[bj] = *(const u32x4*)(SG + (size_t)row0 * 2048 + which * 1024 + colb + bj * 128); on[bj] = (u32x4){0u, 0u, 0u, 0u};
            if (which) on[bj] = *(const u32x4*)(MP + (size_t)row0 * 1024 + colb + bj * 128); }
#pragma unroll
        for (int s = 0; s < 8; ++s) {
            const int ai = s >> 2, m = s & 3, row = row0 + ai * 128 + m * 16;
#pragma unroll
            for (int bj = 0; bj < 2; ++bj) { gc[bj] = gn[bj]; oc[bj] = on[bj]; }
            if (s < 7) { const int r1 = row0 + ((s + 1) >> 2) * 128 + ((s + 1) & 3) * 16;
#pragma unroll
                for (int bj = 0; bj < 2; ++bj) { gn[bj] = *(const u32x4*)(SG + (size_t)r1 * 2048 + which * 1024 + colb + bj * 128);
                    if (which) on[bj] = *(const u32x4*)(MP + (size_t)r1 * 1024 + colb + bj * 128); } }
#pragma unroll
            for (int bj = 0; bj < 2; ++bj) {
                float v[8];
#pragma unroll
                for (int i = 0; i < 4; ++i) {
                    v[2 * i] = __uint_as_float(gc[bj][i] << 16) * acc[ai][bj][m][i >> 1][(i & 1) * 2] + __uint_as_float(oc[bj][i] << 16);
                    v[2 * i + 1] = __uint_as_float(gc[bj][i] & 0xffff0000u) * acc[ai][bj][m][i >> 1][(i & 1) * 2 + 1] + __uint_as_float(oc[bj][i] & 0xffff0000u);
                }
                u32x4 w; w.x = pk2(v[0], v[1]); w.y = pk2(v[2], v[3]); w.z = pk2(v[4], v[5]); w.w = pk2(v[6], v[7]);
                if (which) store16_wt(M + (size_t)row * 1024 + colb + bj * 128, w); else *(u32x4*)(MP + (size_t)row * 1024 + colb + bj * 128) = w;
            }
        }
    }
};
struct SchedMerge1 {
    int G, c, pm0; unsigned char* ws; int l;
    DI bool next(int i, pg8::Unit& u) const {
        const int tl = (i >> 1) * G + c; if (tl >= (68 - pm0) * 4) return false;
        const int which = i & 1; u.pm = pm0 + (tl >> 2) + 68 * which; u.pn = (tl & 3) + 4 * which; return true;
    }
    DI void a_ready(const pg8::Unit&) const {}
    DI void done(const pg8::Unit& u) const { if (u.pm >= 68) panel_publish(panel_word(ws, l, 0, u.pm - 68)); }
};
struct SchedWoWait {
    int G, c, pm0; unsigned char* ws; int l;
    DI bool next(int i, pg8::Unit& u) const {
        int tl;
        if (i == 0) tl = c; else if (i == 1 && c >= 16 && c < 32) tl = G + (c - 16); else return false;
        if (tl >= (68 - pm0) * 4) return false;
        u.pm = pm0 + (tl >> 2); u.pn = tl & 3; return true;
    }
    DI void a_ready(const pg8::Unit& u) const { panel_wait(panel_word(ws, l, 0, u.pm), 32u); }
    DI void done(const pg8::Unit&) const {}
};
struct SchedRows {
    int G, c, pm0, nN;
    DI bool next(int i, pg8::Unit& u) const { const int tl = i * G + c; if (tl >= (68 - pm0) * nN) return false; u.pm = pm0 + tl / nN; u.pn = tl % nN; return true; }
    DI void a_ready(const pg8::Unit&) const {}
    DI void done(const pg8::Unit&) const {}
};
struct EpiWo {
    static constexpr bool PERM = false, AFTER_DRAIN = false;
    unsigned char* ws; int l; int rd;
    DI void operator()(const f32x4 (&acc)[2][2][4][2], const pg8::Unit& u, int wr, int wc, int fr, int fq) const {
        const float* X = (const float*)(ws + WS_X); float* XO = rd ? (float*)(ws + WS_GPRE) : (float*)(ws + WS_X);
        const float* mg = (const float*)(ws + WS_MODS) + (size_t)(l * 5 + unit_set(u.pm)) * 6144 + 2 * 1024;
        const int row0 = u.pm * 256 + wr * 64 + fr, col0 = u.pn * 256 + wc * 32 + 4 * fq;
        f32x4 gv[2][2];
#pragma unroll
        for (int bj = 0; bj < 2; ++bj)
#pragma unroll
            for (int n = 0; n < 2; ++n) gv[bj][n] = *(const f32x4*)(mg + col0 + bj * 128 + n * 16);
        f32x4 xc[2][2], xn[2][2];
        { const float* rowp = X + (size_t)row0 * 1024 + col0;
#pragma unroll
          for (int bj = 0; bj < 2; ++bj)
#pragma unroll
              for (int n = 0; n < 2; ++n) xn[bj][n] = *(const f32x4*)(rowp + bj * 128 + n * 16); }
#pragma unroll
        for (int s = 0; s < 8; ++s) {
            const int ai = s >> 2, m = s & 3;
#pragma unroll
            for (int bj = 0; bj < 2; ++bj)
#pragma unroll
                for (int n = 0; n < 2; ++n) xc[bj][n] = xn[bj][n];
            if (s < 7) { const int ai1 = (s + 1) >> 2, m1 = (s + 1) & 3; const float* rp = X + (size_t)(row0 + ai1 * 128 + m1 * 16) * 1024 + col0;
#pragma unroll
                for (int bj = 0; bj < 2; ++bj)
#pragma unroll
                    for (int n = 0; n < 2; ++n) xn[bj][n] = *(const f32x4*)(rp + bj * 128 + n * 16); }
            float* rowp = XO + (size_t)(row0 + ai * 128 + m * 16) * 1024 + col0;
#pragma unroll
            for (int bj = 0; bj < 2; ++bj)
#pragma unroll
                for (int n = 0; n < 2; ++n) *(f32x4*)(rowp + bj * 128 + n * 16) = ALPHA * xc[bj][n] + gv[bj][n] * acc[ai][bj][m][n];
        }
    }
};
struct SchedMoe {
    int G, c, ntiles; const int* tile_e; unsigned char* ws; int l, mode;
    DI bool next(int i, pg8::Unit& u) const {
        int x;
        if (mode != 2 || G != 256) x = i * G + c;
        else {
            if (c < 64) { if (i > 0) return false; x = c; }
            else if (c < 192) { if (i > 2) return false; x = c + 128 * i; }
            else x = 448 + (c - 192) + 64 * i;
        }
        if (x >= ntiles * 4) return false;
        u.pm = x >> 2; u.pn = tile_e[x >> 2] * 4 + (x & 3); return true;
    }
    DI void a_ready(const pg8::Unit& u) const { if (mode == 2) panel_wait(panel_word(ws, l, 1, u.pm), 32u); }
    DI void done(const pg8::Unit& u) const { if (mode == 1) panel_publish(panel_word(ws, l, 1, u.pm)); }
};
struct EpiUp {
    static constexpr bool PERM = true, AFTER_DRAIN = false;
    unsigned char* ws;
    DI void operator()(const f32x4 (&acc)[2][2][4][2], const pg8::Unit& u, int wr, int wc, int fr, int fq) const {
        bf16_t* ACT = (bf16_t*)(ws + WS_ACT);
        const int j = u.pn & 3; const int row0 = u.pm * 256 + wr * 64 + fr; const int col = j * 128 + wc * 32 + 8 * fq;
#pragma unroll
        for (int ai = 0; ai < 2; ++ai)
#pragma unroll
            for (int m = 0; m < 4; ++m) {
                float v[8];
#pragma unroll
                for (int n = 0; n < 2; ++n)
#pragma unroll
                    for (int i = 0; i < 4; ++i) v[4 * n + i] = siluf_(acc[ai][0][m][n][i]) * acc[ai][1][m][n][i];
                u32x4 w; w.x = pk2(v[0], v[1]); w.y = pk2(v[2], v[3]); w.z = pk2(v[4], v[5]); w.w = pk2(v[6], v[7]);
                store16_wt(ACT + (size_t)(row0 + ai * 128 + m * 16) * 512 + col, w);
            }
    }
};
struct EpiDown {
    static constexpr bool PERM = true, AFTER_DRAIN = false;
    unsigned char* ws;
    DI void operator()(const f32x4 (&acc)[2][2][4][2], const pg8::Unit& u, int wr, int wc, int fr, int fq) const {
        bf16_t* YS = (bf16_t*)(ws + WS_YS); const int* SLOTA = (const int*)(ws + WS_SLOTA);
        const int j = u.pn & 3; const int row0 = u.pm * 256 + wr * 64 + fr;
        int asv[2][4];
#pragma unroll
        for (int ai = 0; ai < 2; ++ai)
#pragma unroll
            for (int m = 0; m < 4; ++m) asv[ai][m] = SLOTA[row0 + ai * 128 + m * 16];
#pragma unroll
        for (int ai = 0; ai < 2; ++ai)
#pragma unroll
            for (int m = 0; m < 4; ++m) {
                const int as = asv[ai][m];
                if (as >= 0) {
#pragma unroll
                    for (int bj = 0; bj < 2; ++bj) {
                        const f32x4 v0 = acc[ai][bj][m][0], v1 = acc[ai][bj][m][1];
                        u32x4 w; w.x = pk2(v0[0], v0[1]); w.y = pk2(v0[2], v0[3]); w.z = pk2(v1[0], v1[1]); w.w = pk2(v1[2], v1[3]);
                        *(u32x4*)(YS + (size_t)as * 1024 + j * 256 + bj * 128 + wc * 32 + 8 * fq) = w;
                    }
                }
            }
    }
};


typedef short s16x4 __attribute__((ext_vector_type(4)));
#define MFMA32(a, b, c) __builtin_amdgcn_mfma_f32_32x32x16_bf16((a), (b), (c), 0, 0, 0)
DI int crow(int i, int hl) { return (i & 3) + 8 * (i >> 2) + 4 * hl; }
DI bf16x8 pack8(const f32x16& x, int s) {
    u32x4 p; p.x = pk2(x[8 * s], x[8 * s + 1]); p.y = pk2(x[8 * s + 2], x[8 * s + 3]); p.z = pk2(x[8 * s + 4], x[8 * s + 5]); p.w = pk2(x[8 * s + 6], x[8 * s + 7]);
    return __builtin_bit_cast(bf16x8, p);
}
DI s16x4 tr_read(const LAS unsigned char* p) { return __builtin_bit_cast(s16x4, __builtin_amdgcn_ds_read_tr16_b64_v4i16((LAS s16x4*)p)); }
constexpr int AT_KB = 9216, AT_VB = 16384, AT_K0 = 0, AT_V0 = 2 * AT_KB, AT_ST = 65536;

struct AttnIt { const bf16_t* kp; const bf16_t* vp; int kc0, kl0, nT; unsigned kdst, vdst0, kread, vread; };
template <int FAKE> DI void attn_iter(int t, const AttnIt& g, LAS unsigned char* lds, unsigned kA, unsigned kB, unsigned vA, unsigned vB, u32x4& rk, u32x4& rv0, u32x4& rv1,
                  f32x16 (&st)[2], f32x16 (&sn)[2], f32x16 (&o)[4], float& mrun, float& lrun, const bf16x8 (&qf)[4]) {
    const int kc0 = g.kc0, kl0 = g.kl0, nT = g.nT;
#define KROW(t_) ((t_) < 4 ? kc0 + 64 * (t_) : kl0 + 64 * ((t_) - 4))
    *(LAS u32x4*)(lds + kB + g.kdst) = rk; *(LAS u32x4*)(lds + vB + g.vdst0) = rv0; *(LAS u32x4*)(lds + vB + g.vdst0 + 2048) = rv1;
    { const int tk = (t + 3 < nT) ? t + 3 : nT - 1, tv = (t + 2 < nT) ? t + 2 : nT - 1;
      const int krk = KROW(tk), krv = KROW(tv);
      if (FAKE != 4) { rk = *(const u32x4*)(g.kp + (size_t)krk * 512); rv0 = *(const u32x4*)(g.vp + (size_t)krv * 512); rv1 = *(const u32x4*)(g.vp + (size_t)(krv + 32) * 512); } }
#undef KROW
    const LAS unsigned char* kb = lds + kA + g.kread;
    const LAS unsigned char* vb = lds + vA + g.vread;
    bf16x8 kf[4];
#pragma unroll
    for (int x = 0; x < 4; ++x) kf[x] = *(const LAS bf16x8*)(kb + (x & 1) * 32 * 144 + (x >> 1) * 32);
    s16x4 lo[2][2], hi[2][2];
#pragma unroll
    for (int k2 = 0; k2 < 2; ++k2) { lo[0][k2] = tr_read(vb + k2 * 4096); hi[0][k2] = tr_read(vb + k2 * 4096 + 512); }
    float mx = fmaxf(fmaxf(st[0][0], st[0][1]), st[0][2]);
#pragma unroll
    for (int i = 3; i < 15; i += 2) mx = fmaxf(fmaxf(mx, st[0][i]), st[0][i + 1]);
    mx = fmaxf(mx, st[0][15]);
#pragma unroll
    for (int i = 0; i < 16; i += 2) mx = fmaxf(fmaxf(mx, st[1][i]), st[1][i + 1]);
    { auto rr = __builtin_amdgcn_permlane32_swap(__float_as_uint(mx), __float_as_uint(mx), false, false); mx = fmaxf(__uint_as_float(rr[0]), __uint_as_float(rr[1])); }
    const float mnew = fmaxf(mrun, mx), alpha = __builtin_amdgcn_exp2f(mrun - mnew);
    mrun = mnew;
    float ps = 0.f;
    __builtin_amdgcn_sched_barrier(0);
#pragma unroll
    for (int x = 0; x < 8; ++x) {
        if (FAKE == 5) { sn[x & 1] = st[x & 1]; } else
        if (x < 2) { f32x16 z;
#pragma unroll
            for (int i = 0; i < 16; ++i) z[i] = 0.f;
            sn[x & 1] = MFMA32(kf[x & 3], qf[x >> 1], z); }
        else sn[x & 1] = MFMA32(kf[x & 3], qf[x >> 1], sn[x & 1]);
        if (x < 4) kf[x] = *(const LAS bf16x8*)(kb + (x & 1) * 32 * 144 + ((x + 4) >> 1) * 32);
#pragma unroll
        for (int e = 0; e < 4; ++e) { const int i = 4 * (x & 3) + e, kt = x >> 2; const float p = FAKE == 2 ? (st[kt][i] - mnew) : __builtin_amdgcn_exp2f(st[kt][i] - mnew); st[kt][i] = p; ps += p; }
        __builtin_amdgcn_sched_barrier(0);
    }
    lrun = lrun * alpha + ps;
    bf16x8 pb[4];
#pragma unroll
    for (int ks = 0; ks < 4; ++ks) pb[ks] = pack8(st[ks >> 1], ks & 1);
#pragma unroll
    for (int i = 0; i < 16; ++i) { if (FAKE != 7) { o[0][i] *= alpha; o[1][i] *= alpha; } }
    __builtin_amdgcn_sched_barrier(0);
#pragma unroll
    for (int u = 0; u < (FAKE == 3 ? 0 : 8); ++u) {
        const int ks = u >> 1, dp = u & 1;
        if (u < 7) {
            const int ks1 = (u + 1) >> 1, dp1 = (u + 1) & 1;
#pragma unroll
            for (int k2 = 0; k2 < 2; ++k2) { lo[(u + 1) & 1][k2] = tr_read(vb + (2 * dp1 + k2) * 4096 + ks1 * 1024); hi[(u + 1) & 1][k2] = tr_read(vb + (2 * dp1 + k2) * 4096 + ks1 * 1024 + 512); }
        }
#pragma unroll
        for (int k2 = 0; k2 < 2; ++k2) {
            const int d = 2 * dp + k2;
            const bf16x8 vf = (bf16x8){lo[u & 1][k2][0], lo[u & 1][k2][1], lo[u & 1][k2][2], lo[u & 1][k2][3], hi[u & 1][k2][0], hi[u & 1][k2][1], hi[u & 1][k2][2], hi[u & 1][k2][3]};
            o[d] = MFMA32(vf, pb[ks], o[d]);
            if (u == 0 && FAKE != 7) {
#pragma unroll
                for (int e = 0; e < 16; ++e) o[2 + k2][e] *= alpha;
            }
        }
        __builtin_amdgcn_sched_barrier(0);
    }
    if (FAKE != 6) __syncthreads();
}
constexpr int AT3_K = 0, AT3_V = 3 * AT_KB;
template <int FAKE> DI void attn_unit(const Args& a, int l, int h, int qrow0, int nT, int kc0, int kl0, float lam, LAS unsigned char* lds) {
    const int tid = tidx(), lane = tid & 63, wid = tid >> 6, r = lane & 31, hl = lane >> 5;
    const bf16_t* QA = (const bf16_t*)(a.ws + WS_QA); const bf16_t* KA = (const bf16_t*)(a.ws + WS_KA); const bf16_t* VA = (const bf16_t*)(a.ws + WS_VA);
    const int qrow = qrow0 + 32 * wid + r;
    const int kkey = tid >> 3, kch = tid & 7;
    const unsigned kdst = (unsigned)(kkey * 144 + kch * 16);
    const int vkey0 = tid >> 4, vch = tid & 15;
    const unsigned vdst0 = (unsigned)((vch >> 2) * 4096 + vkey0 * 64 + (vch & 3) * 16);
    const unsigned kread = (unsigned)(r * 144 + hl * 16);
    const unsigned vread = (unsigned)(((lane >> 4) & 1) * 32 + (lane & 3) * 8 + (4 * hl + ((lane & 15) >> 2)) * 64);
#define KROW(t_) ((t_) < 4 ? kc0 + 64 * (t_) : kl0 + 64 * ((t_) - 4))
#pragma unroll 1
    for (int comp = 0; comp < 2; ++comp) {
        bf16x8 qf[4];
#pragma unroll
        for (int s = 0; s < 4; ++s) qf[s] = *(const bf16x8*)(QA + (size_t)qrow * 512 + h * 128 + comp * 64 + 16 * s + 8 * hl);
        f32x16 o[4];
#pragma unroll
        for (int d = 0; d < 4; ++d)
#pragma unroll
            for (int i = 0; i < 16; ++i) o[d][i] = 0.f;
        float mrun = -1e30f, lrun = 0.f;
        const bf16_t* kp = KA + (size_t)kkey * 512 + h * 128 + comp * 64 + kch * 8;
        const bf16_t* vp = VA + (size_t)vkey0 * 512 + h * 128 + vch * 8;
        u32x4 rk, rv0, rv1;
        {
            const int kr0 = KROW(0), kr1 = KROW(1), kr2 = KROW(2);
            const u32x4 k0 = *(const u32x4*)(kp + (size_t)kr0 * 512), k1 = *(const u32x4*)(kp + (size_t)kr1 * 512);
            const u32x4 v0 = *(const u32x4*)(vp + (size_t)kr0 * 512), v1 = *(const u32x4*)(vp + (size_t)(kr0 + 32) * 512);
            rk = *(const u32x4*)(kp + (size_t)kr2 * 512); rv0 = *(const u32x4*)(vp + (size_t)kr1 * 512); rv1 = *(const u32x4*)(vp + (size_t)(kr1 + 32) * 512);
            *(LAS u32x4*)(lds + AT3_K + kdst) = k0; *(LAS u32x4*)(lds + AT3_K + AT_KB + kdst) = k1;
            *(LAS u32x4*)(lds + AT3_V + vdst0) = v0; *(LAS u32x4*)(lds + AT3_V + vdst0 + 2048) = v1;
        }
        __syncthreads();
        f32x16 st[2];
#pragma unroll
        for (int kt = 0; kt < 2; ++kt) {
#pragma unroll
            for (int i = 0; i < 16; ++i) st[kt][i] = 0.f;
#pragma unroll
            for (int s = 0; s < 4; ++s) st[kt] = MFMA32(*(const LAS bf16x8*)(lds + AT3_K + kread + kt * 32 * 144 + s * 32), qf[s], st[kt]);
        }
        unsigned kA = AT3_K + AT_KB, kB = AT3_K + 2 * AT_KB, kC = AT3_K;
        unsigned vA = AT3_V, vB = AT3_V + AT_VB, vC = AT3_V + 2 * AT_VB;
        const AttnIt geo{kp, vp, kc0, kl0, nT, kdst, vdst0, kread, vread};
        f32x16 sn[2];
#pragma unroll 1
        for (int t = 0; t < nT; t += 2) {
            attn_iter<FAKE>(t, geo, lds, kA, kB, vA, vB, rk, rv0, rv1, st, sn, o, mrun, lrun, qf);
            attn_iter<FAKE>(t + 1, geo, lds, kB, kC, vB, vC, rk, rv0, rv1, sn, st, o, mrun, lrun, qf);
            { const unsigned tk_ = kC; kC = kB; kB = kA; kA = tk_; const unsigned tv_ = vC; vC = vB; vB = vA; vA = tv_; }
        }
        const float ltot = lrun + __shfl_xor(lrun, 32);
        const float inv = 1.f / ltot;
        const int tid2 = tidx(), lane2 = tid2 & 63, wid2 = tid2 >> 6, hl2 = lane2 >> 5;
        const int qrow2 = qrow0 + 32 * wid2 + (lane2 & 31);
        unsigned char* stash = a.ws + WS_M + (size_t)blockIdx.x * 65536 + wid2 * 8192 + lane2 * 16;
        if (comp == 0) {
#pragma unroll
            for (int d = 0; d < 4; ++d) {
                u32x4 w0, w1;
                w0.x = pk2(o[d][0] * inv, o[d][1] * inv); w0.y = pk2(o[d][2] * inv, o[d][3] * inv); w0.z = pk2(o[d][4] * inv, o[d][5] * inv); w0.w = pk2(o[d][6] * inv, o[d][7] * inv);
                w1.x = pk2(o[d][8] * inv, o[d][9] * inv); w1.y = pk2(o[d][10] * inv, o[d][11] * inv); w1.z = pk2(o[d][12] * inv, o[d][13] * inv); w1.w = pk2(o[d][14] * inv, o[d][15] * inv);
                *(u32x4*)(stash + (2 * d) * 1024) = w0; *(u32x4*)(stash + (2 * d + 1) * 1024) = w1;
            }
        } else {
            bf16_t* YA = FAKE ? (bf16_t*)(a.ws + WS_GPRE) : (bf16_t*)(a.ws + WS_YAB);
            int l2_ = l; asm volatile("" : "+v"(l2_));
            const float li = lam_init_of(l2_);
            float ss = 0.f;
#pragma unroll
            for (int d = 0; d < 4; ++d) {
                const u32x4 on0 = *(const u32x4*)(stash + (2 * d) * 1024), on1s = *(const u32x4*)(stash + (2 * d + 1) * 1024);
#pragma unroll
                for (int k = 0; k < 4; ++k) {
                    const unsigned wa = on0[k], wb = on1s[k];
                    const float a0 = __uint_as_float(wa << 16), a1 = __uint_as_float(wa & 0xffff0000u), b0 = __uint_as_float(wb << 16), b1 = __uint_as_float(wb & 0xffff0000u);
                    o[d][2 * k] = a0 - lam * o[d][2 * k] * inv; o[d][2 * k + 1] = a1 - lam * o[d][2 * k + 1] * inv;
                    o[d][8 + 2 * k] = b0 - lam * o[d][8 + 2 * k] * inv; o[d][8 + 2 * k + 1] = b1 - lam * o[d][8 + 2 * k + 1] * inv;
                    ss += o[d][2 * k] * o[d][2 * k] + o[d][2 * k + 1] * o[d][2 * k + 1] + o[d][8 + 2 * k] * o[d][8 + 2 * k] + o[d][8 + 2 * k + 1] * o[d][8 + 2 * k + 1];
                }
            }
            ss += __shfl_xor(ss, 32);
            const float rs = rsqrtf(ss * (1.f / 128.f) + EPS) * (1.f - li);
            const float* sg = a.in[12] + l * 128;
#pragma unroll
            for (int d = 0; d < 4; ++d)
#pragma unroll
                for (int ig = 0; ig < 4; ++ig) {
                    const int dv0 = 32 * d + 8 * ig + 4 * hl2;
                    const f32x4 g4 = *(const f32x4*)(sg + dv0);
                    u32x2 w; w.x = pk2(o[d][4 * ig] * rs * g4[0], o[d][4 * ig + 1] * rs * g4[1]); w.y = pk2(o[d][4 * ig + 2] * rs * g4[2], o[d][4 * ig + 3] * rs * g4[3]);
                    *(u32x2*)(YA + (size_t)qrow2 * 512 + h * 128 + dv0) = w;
                }
        }
    }
#undef KROW
}
template <int FAKE> DI void ph_attn(const Args& a, int l, LAS unsigned char* lds) {
    const int ln_ = tidx() & 63;
    const float s1 = wave_sum(a.in[8][l * 64 + ln_] * a.in[9][l * 64 + ln_]), s2 = wave_sum(a.in[10][l * 64 + ln_] * a.in[11][l * 64 + ln_]);
    int l3_ = l; asm volatile("" : "+v"(l3_));
    const float lam = expf(s1) - expf(s2) + lam_init_of(l3_);
    const int G = gridDim.x, bx = blockIdx.x;
    const int vcu = (G % 8 == 0) ? (bx % 8) * (G / 8) + bx / 8 : bx;
    for (int u = vcu; u < 256; u += G) {
        const int bh = u >> 4, qt = u & 15, b = bh >> 2, h = bh & 3;
        attn_unit<FAKE>(a, l, h, NCTX + b * SEQ + qt * 256, 68, b * CTX, NCTX + b * SEQ, lam, lds);
    }
    if (l < DEPTH - 1) {
        if (G >= 80) { if (bx >= 64 && bx < 80) { const int u = bx - 64, b = u >> 2, h = u & 3; attn_unit<FAKE>(a, l, h, b * CTX, 4, b * CTX, 0, lam, lds); } }
        else for (int u = vcu; u < 16; u += G) { const int b = u >> 2, h = u & 3; attn_unit<FAKE>(a, l, h, b * CTX, 4, b * CTX, 0, lam, lds); }
    }
}


constexpr int GP_WN = 0, GP_QD = 8192, GP_KDT = 16384, GP_QK = 24576, GP_U = 28672, GP_REC = 36864;
DI int swap23(int p) { return (p & ~12) | ((p & 4) << 1) | ((p & 8) >> 1); }
DI int chunk_index(int dir, int b, int h, int cc) { return ((dir * 4 + b) * 4 + h) * 68 + cc; }
constexpr int G1_XS = 71680, G1_XST = 832, G1_WS = 71680 + 68 * 832;
constexpr int G1_QS = 0, G1_KS = 17408, G1_VS = 34816  , G1_GS = 71680, G1_QKS = 88064, G1_AT = 104448  , G1_SM = LDS_MISC + 256;
DI float* g1_sm(unsigned char* lds, int dir, int kind) { return (float*)(lds + G1_SM) + (dir * 5 + kind) * 64; }

#ifndef G1REP1
#define G1REP1 1
#endif
#ifndef G1REP6
#define G1REP6 1
#endif
#ifndef G1REP7
#define G1REP7 1
#endif
DI void g1_task(const Args& a, int l, int b, int h, int cc, unsigned char* lds, int cut = 0) {
    const int tid = tidx(), lane = tid & 63, wid = tid >> 6, r = lane & 31, hl = lane >> 5;
    const int s0 = cc < 4 ? b * CTX : NCTX + b * SEQ, len = cc < 4 ? CTX : SEQ, t0 = cc < 4 ? cc * 64 : (cc - 4) * 64;
    const bf16_t* QKV = (const bf16_t*)(a.ws + WS_QKV);
    const float* cw = a.in[7] + (size_t)l * 5 * 1536;
    if (wid < 2) {
        const int dir = wid, row = s0 + t0 + lane;
        const float* AB = (const float*)(a.ws + WS_AB);
        const float nal = -expf(a.in[13][l * 8 + dir * 4 + h]), dtb = a.in[14][l * 8 + dir * 4 + h];
        const float g = nal * softplusf_(AB[(size_t)row * 16 + dir * 4 + h] + dtb);
        const float beta = sigmoidf_(AB[(size_t)row * 16 + 8 + dir * 4 + h]);
        float c = g;
        if (dir == 0) {
#pragma unroll
            for (int o = 1; o < 64; o <<= 1) { const float v = __shfl_up(c, o); if (lane >= o) c += v; }
        } else {
#pragma unroll
            for (int o = 1; o < 64; o <<= 1) { const float v = __shfl_down(c, o); if (lane + o < 64) c += v; }
        }
        const float glref = __shfl(c, dir == 0 ? 63 : 0);
        const float eg = __expf(c);
        g1_sm(lds, dir, 0)[lane] = c; g1_sm(lds, dir, 1)[lane] = beta; g1_sm(lds, dir, 2)[lane] = beta * eg; g1_sm(lds, dir, 3)[lane] = __expf(glref - c); g1_sm(lds, dir, 4)[lane] = eg;
        if (lane == 0) ((float*)(a.ws + WS_GL))[chunk_index(dir, b, h, cc)] = __expf(glref);
    }
#pragma unroll 1
    for (int rep1_ = 0; rep1_ < G1REP1; ++rep1_) {
    {
        unsigned char* xs = lds + G1_XS; float* wsm = (float*)(lds + G1_WS);
        u32x4 xv[7];
#pragma unroll
        for (int it = 0; it < 7; ++it) {
            const int p = tid + 512 * it; const int pc = p < 68 * 48 ? p : 68 * 48 - 1;
            const int rr = pc / 48, q = pc - rr * 48, part = q >> 4, c8 = q & 15;
            const int tt = t0 + rr - 2; const int ttc = tt < 0 ? 0 : (tt >= len ? len - 1 : tt);
            xv[it] = *(const u32x4*)(QKV + (size_t)(s0 + ttc) * 1536 + part * 512 + h * 128 + c8 * 8);
            if (tt != ttc) xv[it] = (u32x4){0u, 0u, 0u, 0u};
        }
#pragma unroll
        for (int it = 0; it < 7; ++it) {
            const int p = tid + 512 * it;
            if (p < 68 * 48) { const int rr = p / 48, q = p - rr * 48, part = q >> 4, c8 = q & 15; *(u32x4*)(xs + rr * G1_XST + part * 256 + c8 * 16) = xv[it]; }
        }
        if (tid < 480) { const int j = tid / 96, q = tid - j * 96, part = q >> 5, c4 = q & 31;
            *(f32x4*)(wsm + j * 384 + part * 128 + c4 * 4) = *(const f32x4*)(cw + j * 1536 + part * 512 + h * 128 + c4 * 4); }
    }
    __syncthreads();
    if (cut == 3) return;
    {
        const int i = tid >> 3, sub = tid & 7;
        const unsigned char* xs = lds + G1_XS; const float* wsm = (const float*)(lds + G1_WS);
#pragma unroll
        for (int part = 0; part < 3; ++part) {
            float val[16];
#pragma unroll
            for (int cg = 0; cg < 2; ++cg) {
                const int d = cg * 64 + sub * 8;
                float acc[8];
#pragma unroll
                for (int e = 0; e < 8; ++e) acc[e] = 0.f;
#pragma unroll
                for (int j = 0; j < 5; ++j) {
                    {
                        const u32x4 x = *(const u32x4*)(xs + (i + j) * G1_XST + part * 256 + d * 2);
                        const f32x4 w0 = *(const f32x4*)(wsm + j * 384 + part * 128 + d), w1 = *(const f32x4*)(wsm + j * 384 + part * 128 + d + 4);
                        acc[0] += w0[0] * __uint_as_float(x[0] << 16); acc[1] += w0[1] * __uint_as_float(x[0] & 0xffff0000u);
                        acc[2] += w0[2] * __uint_as_float(x[1] << 16); acc[3] += w0[3] * __uint_as_float(x[1] & 0xffff0000u);
                        acc[4] += w1[0] * __uint_as_float(x[2] << 16); acc[5] += w1[1] * __uint_as_float(x[2] & 0xffff0000u);
                        acc[6] += w1[2] * __uint_as_float(x[3] << 16); acc[7] += w1[3] * __uint_as_float(x[3] & 0xffff0000u);
                    }
                }
#pragma unroll
                for (int e = 0; e < 8; ++e) val[cg * 8 + e] = (cut == 5) ? acc[e] : siluf_(acc[e]);
            }
            float scale = 1.f;
            if (part < 2) {
                float ss = 0.f;
#pragma unroll
                for (int e = 0; e < 16; ++e) ss += val[e] * val[e];
                ss += __shfl_xor(ss, 1); ss += __shfl_xor(ss, 2); ss += __shfl_xor(ss, 4);
                scale = rsqrtf(ss + EPS) * (part == 0 ? 0.08838834764831845f : 1.f);
            }
#pragma unroll
            for (int cg = 0; cg < 2; ++cg) {
                const int d = cg * 64 + sub * 8;
                bf16_t hv[8];
#pragma unroll
                for (int e = 0; e < 8; ++e) hv[e] = f2bf(val[cg * 8 + e] * scale);
                if (cut != 4 || scale == 123456.789f) {
                    u32x4 w; w.x = hv[0] | ((unsigned)hv[1] << 16); w.y = hv[2] | ((unsigned)hv[3] << 16); w.z = hv[4] | ((unsigned)hv[5] << 16); w.w = hv[6] | ((unsigned)hv[7] << 16);
                    *(u32x4*)(lds + (part == 0 ? G1_QS : (part == 1 ? G1_KS : G1_VS)) + i * 272 + d * 2) = w;
                }
            }
        }
    }
    }
    __syncthreads();
    if (cut == 1 || cut == 4 || cut == 5) return;
    {
        const int which = wid >> 2, mi = (wid >> 1) & 1, ni = wid & 1;
        const unsigned char* Ab = lds + (which ? G1_QS : G1_KS) + (32 * mi + r) * 272 + hl * 16;
        const unsigned char* Bb = lds + G1_KS + (32 * ni + r) * 272 + hl * 16;
        f32x16 acc;
#pragma unroll
        for (int i = 0; i < 16; ++i) acc[i] = 0.f;
#pragma unroll
        for (int s = 0; s < 8; ++s) acc = MFMA32(*(const bf16x8*)(Ab + s * 32), *(const bf16x8*)(Bb + s * 32), acc);
        float* O = (float*)(lds + (which ? G1_QKS : G1_GS));
#pragma unroll
        for (int i = 0; i < 16; ++i) O[(32 * mi + crow(i, hl)) * 64 + 32 * ni + r] = acc[i];
    }
    __syncthreads();
    {
        const float* GS = (const float*)(lds + G1_GS);
#pragma unroll 4
        for (int x = tid; x < 2 * 4096; x += 512) {
            const int dir = x >> 12, i = (x >> 6) & 63, j = x & 63;
            const float* gc = g1_sm(lds, dir, 0);
            const bool before = dir == 0 ? (j < i) : (j > i);
            const float v = before ? g1_sm(lds, dir, 1)[i] * GS[i * 64 + j] * __expf(gc[i] - gc[j]) : 0.f;
            if (dir == 0) ((float*)(lds + G1_AT))[i * 68 + j] = v; else ((float*)(lds + G1_AT + 17408))[(63 - i) * 68 + (63 - j)] = v;
        }
    }
    __syncthreads();
    if (cut == 2) return;
    if (wid < 2) {
        float* T = (float*)(lds + G1_AT + wid * 17408);
        float t[64];
        f32x4 ra[2][16];
        t[0] = (lane == 0) ? 1.f : 0.f;
        ra[1][0] = *(const f32x4*)(T + 1 * 68);
#pragma unroll
        for (int i = 1; i < 64; ++i) {
            const int c = i & 1, nx = c ^ 1;
            if (i < 63) {
#pragma unroll
                for (int j4 = 0; j4 * 4 < i + 1; ++j4) ra[nx][j4] = *(const f32x4*)(T + (i + 1) * 68 + 4 * j4);
            }
            float ac[4] = {(lane == i) ? 1.f : 0.f, 0.f, 0.f, 0.f};
#pragma unroll
            for (int j4 = 0; j4 * 4 < i; ++j4) {
#pragma unroll
                for (int e = 0; e < 4; ++e) if (4 * j4 + e < i) ac[e] -= ra[c][j4][e] * t[4 * j4 + e];
            }
            t[i] = (ac[0] + ac[1]) + (ac[2] + ac[3]);
        }
#pragma unroll
        for (int i = 0; i < 64; ++i) T[i * 68 + lane] = t[i];
    } else {
        bf16_t* rec0e = (bf16_t*)(a.ws + WS_GPRE);
#pragma unroll
        for (int it2 = 0; it2 < 12; ++it2) {
            const int kind = it2 >> 1, x = (tid - 128) + 384 * (it2 & 1), dir = kind >= 3 ? 1 : 0, kk = kind - 3 * dir;
            if (x >= 512) continue;
            bf16_t* rec = rec0e + (size_t)chunk_index(dir, b, h, cc) * GP_REC;
            const float* gc = g1_sm(lds, dir, 0); const float* ekd = g1_sm(lds, dir, 3); const float* eg = g1_sm(lds, dir, 4);
            if (kk == 0) {
                const int c = x >> 3, g16 = x & 7;
                const u32x4 x0 = *(const u32x4*)(lds + G1_QS + c * 272 + g16 * 32), x1 = *(const u32x4*)(lds + G1_QS + c * 272 + g16 * 32 + 16);
                const unsigned pm[8] = {x0.x, x0.y, x1.x, x1.y, x0.z, x0.w, x1.z, x1.w};
                const float sc = eg[c];
                u32x4 o0, o1;
                o0.x = pk2(__uint_as_float(pm[0] << 16) * sc, __uint_as_float(pm[0] & 0xffff0000u) * sc); o0.y = pk2(__uint_as_float(pm[1] << 16) * sc, __uint_as_float(pm[1] & 0xffff0000u) * sc);
                o0.z = pk2(__uint_as_float(pm[2] << 16) * sc, __uint_as_float(pm[2] & 0xffff0000u) * sc); o0.w = pk2(__uint_as_float(pm[3] << 16) * sc, __uint_as_float(pm[3] & 0xffff0000u) * sc);
                o1.x = pk2(__uint_as_float(pm[4] << 16) * sc, __uint_as_float(pm[4] & 0xffff0000u) * sc); o1.y = pk2(__uint_as_float(pm[5] << 16) * sc, __uint_as_float(pm[5] & 0xffff0000u) * sc);
                o1.z = pk2(__uint_as_float(pm[6] << 16) * sc, __uint_as_float(pm[6] & 0xffff0000u) * sc); o1.w = pk2(__uint_as_float(pm[7] << 16) * sc, __uint_as_float(pm[7] & 0xffff0000u) * sc);
                u32x4* dp = (u32x4*)(rec + GP_QD + c * 128 + g16 * 16); dp[0] = o0; dp[1] = o1;
            } else if (kk == 1) {
                const int dk = x >> 2, g16 = x & 3;
                const bf16_t* kp = (const bf16_t*)(lds + G1_KS) + dk + (g16 * 16) * 136;
                unsigned ow[8];
#pragma unroll
                for (int q = 0; q < 8; ++q) {
                    const int p0 = 2 * q, p1 = 2 * q + 1; const int c0 = swap23(p0), c1 = swap23(p1);
                    ow[q] = pk2(bf2f(kp[c0 * 136]) * ekd[16 * g16 + c0], bf2f(kp[c1 * 136]) * ekd[16 * g16 + c1]);
                }
                u32x4* dp = (u32x4*)(rec + GP_KDT + dk * 64 + g16 * 16);
                dp[0] = (u32x4){ow[0], ow[1], ow[2], ow[3]}; dp[1] = (u32x4){ow[4], ow[5], ow[6], ow[7]};
            } else {
                const int i = x >> 3, sub = x & 7;
                const float* QKm = (const float*)(lds + G1_QKS) + i * 64;
                const float gi = gc[i];
                unsigned ow[4];
#pragma unroll
                for (int q = 0; q < 4; ++q) {
                    float v[2];
#pragma unroll
                    for (int e = 0; e < 2; ++e) {
                        const int jp = 8 * sub + 2 * q + e, j = (jp & ~15) + swap23(jp & 15);
                        const bool ok = dir == 0 ? (j <= i) : (j >= i);
                        v[e] = ok ? QKm[j] * __expf(gi - gc[j]) : 0.f;
                    }
                    ow[q] = pk2(v[0], v[1]);
                }
                *(u32x4*)(rec + GP_QK + i * 64 + 8 * sub) = (u32x4){ow[0], ow[1], ow[2], ow[3]};
            }
        }
    }
    __syncthreads();
    bf16_t* rec0 = (bf16_t*)(a.ws + WS_GPRE);
#pragma unroll 1
    for (int rep6_ = 0; rep6_ < G1REP6; ++rep6_) {
    {
        const int dir = wid >> 2, n = wid & 3;
        bf16_t* rec = rec0 + (size_t)chunk_index(dir, b, h, cc) * GP_REC;
        const float* T = (const float*)(lds + G1_AT + dir * 17408);
        f32x4 tq[2][4][2];
        f32x4 c1[4][2], c2[4][2];
        bf16x8 bv[4], bk[4];
#pragma unroll
        for (int s = 0; s < 4; ++s) {
            const float* p1 = g1_sm(lds, dir, 1) + 16 * s + 8 * hl; const float* p2 = g1_sm(lds, dir, 2) + 16 * s + 8 * hl;
            c1[s][0] = *(const f32x4*)p1; c1[s][1] = *(const f32x4*)(p1 + 4); c2[s][0] = *(const f32x4*)p2; c2[s][1] = *(const f32x4*)(p2 + 4);
            {
                const unsigned toff = (unsigned)((16 * s + 8 * hl + ((lane & 15) >> 2)) * 272 + (32 * n + 16 * ((lane >> 4) & 1)) * 2 + 8 * (lane & 3));
                const s16x4 v0 = tr_read((const LAS unsigned char*)lds + G1_VS + toff), v1 = tr_read((const LAS unsigned char*)lds + G1_VS + toff + 4 * 272);
                const s16x4 k0 = tr_read((const LAS unsigned char*)lds + G1_KS + toff), k1 = tr_read((const LAS unsigned char*)lds + G1_KS + toff + 4 * 272);
                bv[s] = (bf16x8){v0[0], v0[1], v0[2], v0[3], v1[0], v1[1], v1[2], v1[3]};
                bk[s] = (bf16x8){k0[0], k0[1], k0[2], k0[3], k1[0], k1[1], k1[2], k1[3]};
            }
#pragma unroll
            for (int m = 0; m < 2; ++m) {
                if (dir == 0) { const float* tp = T + (32 * m + r) * 68 + 16 * s + 8 * hl; tq[m][s][0] = *(const f32x4*)tp; tq[m][s][1] = *(const f32x4*)(tp + 4); }
                else { const float* tp = T + (63 - (32 * m + r)) * 68 + 56 - 16 * s - 8 * hl; const f32x4 x0 = *(const f32x4*)tp, x1 = *(const f32x4*)(tp + 4);
                       tq[m][s][0] = (f32x4){x1[3], x1[2], x1[1], x1[0]}; tq[m][s][1] = (f32x4){x0[3], x0[2], x0[1], x0[0]}; }
            }
        }
#pragma unroll
        for (int prod = 0; prod < 2; ++prod) {
#pragma unroll
            for (int m = 0; m < 2; ++m) {
                f32x16 acc;
#pragma unroll
                for (int i = 0; i < 16; ++i) acc[i] = 0.f;
#pragma unroll
                for (int s = 0; s < 4; ++s) {
                    const f32x4 ta = tq[m][s][0], tb = tq[m][s][1];
                    const f32x4 ca = prod == 0 ? c1[s][0] : c2[s][0], cb = prod == 0 ? c1[s][1] : c2[s][1];
                    u32x4 aw; aw.x = pk2(ta[0] * ca[0], ta[1] * ca[1]); aw.y = pk2(ta[2] * ca[2], ta[3] * ca[3]); aw.z = pk2(tb[0] * cb[0], tb[1] * cb[1]); aw.w = pk2(tb[2] * cb[2], tb[3] * cb[3]);
                    acc = MFMA32(__builtin_bit_cast(bf16x8, aw), prod == 0 ? bv[s] : bk[s], acc);
                }
                if (prod == 0) {
                    u32x4 w0, w1;
                    w0.x = pk2(acc[0], acc[1]); w0.y = pk2(acc[2], acc[3]); w0.z = pk2(acc[4], acc[5]); w0.w = pk2(acc[6], acc[7]);
                    w1.x = pk2(acc[8], acc[9]); w1.y = pk2(acc[10], acc[11]); w1.z = pk2(acc[12], acc[13]); w1.w = pk2(acc[14], acc[15]);
                    u32x4* up = (u32x4*)(rec + GP_U + ((m * 4 + n) * 64 + lane) * 16);
                    up[0] = w0; up[1] = w1;
                } else {
                    const int dkp = 32 * n + (r & 16) + swap23(r & 15);
#pragma unroll
                    for (int i = 0; i < 16; ++i) rec[GP_WN + (32 * m + crow(i, hl)) * 128 + dkp] = f2bf(-acc[i]);
                }
            }
        }
    }
    }
    __syncthreads();
}
DI void ph_g1(const Args& a, int l, unsigned char* lds, int cut = 0) {
#pragma unroll 1
    for (int task = blockIdx.x; task < 16 * 68; task += gridDim.x) {
        const int bh = task / 68, cc = task % 68;
        g1_task(a, l, bh >> 2, bh & 3, cc, lds, cut);
    }
}

#ifndef PROBE_SCAN_FAKE
#define PROBE_SCAN_FAKE 0
#endif
constexpr int SC_WN = 0, SC_QD = 16384, SC_KDT = 32768, SC_QK = 49152, SC_BUF = 57344, SC_GL = 2 * SC_BUF;
DI int scan_cc(int dir, int step) { return dir == 0 ? step : (step < 4 ? 3 - step : 71 - step); }
DI unsigned scan_src_off(int p) {
    if (p < 2048) { const int row = (p & 1023) >> 4, s16 = p & 15; return (unsigned)((p >> 10) * 16384 + row * 256 + ((s16 ^ (row & 15)) << 4)); }
    const int q = p - 2048, row = q >> 3, s8 = q & 7;
    return (unsigned)(32768 + row * 128 + ((s8 ^ ((row >> 1) & 7)) << 4));
}
#define SCAN_BAR() asm volatile("s_barrier" ::: "memory")
DI void scan_block(const Args& a, int l, int dir, int b, int h, unsigned char* lds, int fake = 0) {
    const int tid = tidx(), lane = tid & 63, wid = tid >> 6, r = lane & 31, hl = lane >> 5;
    const bf16_t* rec0 = (const bf16_t*)(a.ws + WS_GPRE);
    const float* GL = (const float*)(a.ws + WS_GL);
    const bool loader = wid >= 4;
    const int n = wid & 3, lw = __builtin_amdgcn_readfirstlane(wid) - 4;
    bf16_t* OD = (bf16_t*)(a.ws + (dir ? WS_OB : WS_OF));
    f32x16 st[4];
#pragma unroll
    for (int t = 0; t < 4; ++t)
#pragma unroll
        for (int i = 0; i < 16; ++i) st[t][i] = 0.f;
    u32x4 un[4]; float gln = 0.f;
    unsigned swq[8], skq[6];
    if (loader) {
#pragma unroll
        for (int j = 0; j < 8; ++j) swq[j] = scan_src_off((lw * 8 + j) * 64 + lane);
#pragma unroll
        for (int j = 0; j < 6; ++j) skq[j] = scan_src_off(2048 + (lw * 6 + j) * 64 + lane);
    }
#define DMA_WQ(chunk_, bufsel_) do { const int c_ = (chunk_) < 68 ? (chunk_) : 67; const unsigned char* src_ = (const unsigned char*)(rec0 + (size_t)chunk_index(dir, b, h, scan_cc(dir, c_)) * GP_REC); \
        LAS unsigned char* nb_ = (LAS unsigned char*)lds + (bufsel_) * SC_BUF; \
        _Pragma("unroll") for (int j = 0; j < 8; ++j) __builtin_amdgcn_global_load_lds((const unsigned*)(src_ + swq[j]), (LAS unsigned*)(nb_ + (lw * 8 + j) * 1024), 16, 0, 0); } while (0)
#define DMA_KQ(chunk_, bufsel_) do { const int c_ = (chunk_) < 68 ? (chunk_) : 67; const unsigned char* src_ = (const unsigned char*)(rec0 + (size_t)chunk_index(dir, b, h, scan_cc(dir, c_)) * GP_REC); \
        LAS unsigned char* nb_ = (LAS unsigned char*)lds + (bufsel_) * SC_BUF; \
        _Pragma("unroll") for (int j = 0; j < 6; ++j) __builtin_amdgcn_global_load_lds((const unsigned*)(src_ + skq[j]), (LAS unsigned*)(nb_ + 32768 + (lw * 6 + j) * 1024), 16, 0, 0); } while (0)
    if (loader) {
        DMA_WQ(0, 0); DMA_KQ(0, 0); DMA_WQ(1, 1);
        asm volatile("s_waitcnt vmcnt(8)" ::: "memory");
    } else {
        const int ci = chunk_index(dir, b, h, scan_cc(dir, 0));
        const bf16_t* rec = rec0 + (size_t)ci * GP_REC;
#pragma unroll
        for (int m = 0; m < 2; ++m) { const u32x4* up = (const u32x4*)(rec + GP_U + ((m * 4 + n) * 64 + lane) * 16); un[2 * m] = up[0]; un[2 * m + 1] = up[1]; }
        gln = GL[ci];
    }
    SCAN_BAR();
#pragma unroll 1
    for (int step = 0; step < 68; ++step) {
        const int cur = step & 1;
        if (loader) {
            if (fake != 1) {
                DMA_KQ(step + 1, cur ^ 1);
                asm volatile("s_waitcnt vmcnt(14)" ::: "memory");
                SCAN_BAR();
                DMA_WQ(step + 2, cur);
                asm volatile("s_waitcnt vmcnt(14)" ::: "memory");
                SCAN_BAR();
            } else { SCAN_BAR(); SCAN_BAR(); }
        } else {
            if (fake != 2) {
            const int cc = scan_cc(dir, step);
            const int row0 = cc < 4 ? b * CTX + cc * 64 : NCTX + b * SEQ + (cc - 4) * 64;
            const unsigned char* buf = lds + cur * SC_BUF;
            const float gl = gln;
            const unsigned char* pwn = buf + SC_WN + r * 256;
            const unsigned char* pqd = buf + SC_QD + r * 256;
            const unsigned char* pqk = buf + SC_QK + r * 128;
            const unsigned char* pkd = buf + SC_KDT + r * 128;
            const int x16 = r & 15, x8 = (r >> 1) & 7;
#define FR256(base, tile, blk) (*(const bf16x8*)((base) + (tile) * 32 * 256 + ((((blk) ^ x16)) << 4)))
#define FR128(base, tile, blk) (*(const bf16x8*)((base) + (tile) * 32 * 128 + ((((blk) ^ x8)) << 4)))
            bf16x8 fa[2][4];
#pragma unroll
            for (int m = 0; m < 2; ++m) { fa[0][m] = FR256(pwn, m, hl); fa[0][2 + m] = FR256(pqd, m, hl); }
            f32x16 vn[2];
#pragma unroll
            for (int m = 0; m < 2; ++m) {
                const u32x4 u0 = un[2 * m], u1 = un[2 * m + 1];
#pragma unroll
                for (int k = 0; k < 4; ++k) { vn[m][2 * k] = __uint_as_float(u0[k] << 16); vn[m][2 * k + 1] = __uint_as_float(u0[k] & 0xffff0000u); vn[m][8 + 2 * k] = __uint_as_float(u1[k] << 16); vn[m][8 + 2 * k + 1] = __uint_as_float(u1[k] & 0xffff0000u); }
            }
            if (step + 1 < 68) {
                const int ci1 = chunk_index(dir, b, h, scan_cc(dir, step + 1));
                const bf16_t* rec = rec0 + (size_t)ci1 * GP_REC;
#pragma unroll
                for (int m = 0; m < 2; ++m) { const u32x4* up = (const u32x4*)(rec + GP_U + ((m * 4 + n) * 64 + lane) * 16); un[2 * m] = up[0]; un[2 * m + 1] = up[1]; }
                gln = GL[ci1];
            }
            f32x16 o[2];
#pragma unroll
            for (int m = 0; m < 2; ++m)
#pragma unroll
                for (int i = 0; i < 16; ++i) o[m][i] = 0.f;
#pragma unroll
            for (int kk = 0; kk < 8; ++kk) {
                const int c = kk & 1, nx = c ^ 1;
                if (kk < 7) {
#pragma unroll
                    for (int m = 0; m < 2; ++m) { fa[nx][m] = FR256(pwn, m, 2 * (kk + 1) + hl); fa[nx][2 + m] = FR256(pqd, m, 2 * (kk + 1) + hl); }
                }
                const bf16x8 sbk = pack8(st[kk >> 1], kk & 1);
#pragma unroll
                for (int m = 0; m < 2; ++m) { vn[m] = MFMA32(fa[c][m], sbk, vn[m]); o[m] = MFMA32(fa[c][2 + m], sbk, o[m]); }
            }
            asm volatile("s_waitcnt lgkmcnt(0)" ::: "memory");
            SCAN_BAR();
            bf16x8 fb[2][3];
            fb[0][0] = FR128(pqk, 0, hl); fb[0][1] = FR128(pqk, 1, hl); fb[0][2] = FR128(pkd, 0, hl);
#pragma unroll
            for (int t = 0; t < 4; ++t)
#pragma unroll
                for (int i = 0; i < 16; ++i) st[t][i] *= gl;
#pragma unroll
            for (int h2 = 0; h2 < 8; ++h2) {
                const int kk = h2 >> 1, part = h2 & 1, c = h2 & 1, nx = c ^ 1;
                if (h2 < 7) {
                    const int k1 = (h2 + 1) >> 1;
                    if (part == 0) {
#pragma unroll
                        for (int t = 1; t < 4; ++t) fb[nx][t - 1] = FR128(pkd, t, 2 * k1 + hl);
                    } else { fb[nx][0] = FR128(pqk, 0, 2 * k1 + hl); fb[nx][1] = FR128(pqk, 1, 2 * k1 + hl); fb[nx][2] = FR128(pkd, 0, 2 * k1 + hl); }
                }
                const bf16x8 vbk = pack8(vn[kk >> 1], kk & 1);
                if (part == 0) { o[0] = MFMA32(fb[c][0], vbk, o[0]); o[1] = MFMA32(fb[c][1], vbk, o[1]); st[0] = MFMA32(fb[c][2], vbk, st[0]); }
                else { st[1] = MFMA32(fb[c][0], vbk, st[1]); st[2] = MFMA32(fb[c][1], vbk, st[2]); st[3] = MFMA32(fb[c][2], vbk, st[3]); }
            }
#undef FR256
#undef FR128
#pragma unroll
            for (int m = 0; m < 2; ++m)
#pragma unroll
                for (int i = 0; i < 16; ++i) OD[(size_t)(row0 + 32 * m + crow(i, hl)) * 512 + h * 128 + 32 * n + r] = f2bf(o[m][i]);
            asm volatile("s_waitcnt lgkmcnt(0)" ::: "memory");
            SCAN_BAR();
            } else { SCAN_BAR(); SCAN_BAR(); }
        }
    }
    if (loader) asm volatile("s_waitcnt vmcnt(0)" ::: "memory");
    __syncthreads();
#undef DMA_WQ
#undef DMA_KQ
}
#undef SCAN_BAR
DI void ph_scan(const Args& a, int l, unsigned char* lds) {
    const int x = blockIdx.x;
#if PROBE_SCAN_FAKE
    scan_block(a, l, x >> 4, (x >> 2) & 3, x & 3, lds, PROBE_SCAN_FAKE); __syncthreads();
#endif
    scan_block(a, l, x >> 4, (x >> 2) & 3, x & 3, lds);
}


__global__ void __launch_bounds__(256) nv_inproj(Args a) {
    const int l = a.layer;
    const int row = blockIdx.y, cd = blockIdx.x * 256 + threadIdx.x;
    const int cs = cd < 3584 ? cd : cd + 16;
    const float* w = a.in[6] + (size_t)l * 1024 * N_IN;
    const bf16_t* hr = (const bf16_t*)(a.ws + WS_H) + (size_t)row * 1024;
    const bool isrope = (cd < 1024) && (row >= NCTX);
    const int cs2 = cs ^ 16;
    float acc = 0.f, acc2 = 0.f;
    for (int k = 0; k < 1024; ++k) { const float h = bf2f(hr[k]); acc += h * w[(size_t)k * N_IN + cs]; if (isrope) acc2 += h * w[(size_t)k * N_IN + cs2]; }
    if (cd < 1024) {
        float v = acc;
        if (isrope) {
            const float* rope = (const float*)(a.ws + WS_ROPE);
            const int t = (row - NCTX) & 4095, d = cd & 63, axis = (d >> 5) & 1, half = (d >> 4) & 1, f = d & 15;
            const int pos = axis ? (t & 63) : (t >> 6);
            const float c = rope[(pos * 16 + f) * 2], s = rope[(pos * 16 + f) * 2 + 1];
            v = half == 0 ? acc * c - acc2 * s : acc * c + acc2 * s;
        }
        if (cd < 512) ((bf16_t*)(a.ws + WS_QA))[(size_t)row * 512 + cd] = f2bf(v * QSCALE);
        else ((bf16_t*)(a.ws + WS_KA))[(size_t)row * 512 + cd - 512] = f2bf(v);
    } else if (cd < 1536) ((bf16_t*)(a.ws + WS_VA))[(size_t)row * 512 + cd - 1024] = f2bf(acc);
    else if (cd < 3072) ((bf16_t*)(a.ws + WS_QKV))[(size_t)row * 1536 + cd - 1536] = f2bf(acc);
    else if (cd < 3584) ((bf16_t*)(a.ws + WS_Z))[(size_t)row * 512 + cd - 3072] = f2bf(acc);
    else ((bf16_t*)(a.ws + WS_SG))[(size_t)row * 2048 + cd - 3584] = f2bf(sigmoidf_(acc));
}

__global__ void __launch_bounds__(256) nv_attn(Args a) {
    const int row = blockIdx.x * 256 + threadIdx.x;
    const int h = blockIdx.y >> 2, comp = (blockIdx.y >> 1) & 1, dh = blockIdx.y & 1;
    const bf16_t* QA = (const bf16_t*)(a.ws + WS_QA); const bf16_t* KA = (const bf16_t*)(a.ws + WS_KA); const bf16_t* VA = (const bf16_t*)(a.ws + WS_VA);
    float* ON = (float*)(a.ws + WS_ON);
    const bool isctx = row < NCTX;
    const int b = isctx ? (row >> 8) : ((row - NCTX) >> 12);
    float q[64];
    { const bf16_t* qp = QA + (size_t)row * 512 + h * 128 + comp * 64;
#pragma unroll
      for (int i = 0; i < 64; ++i) q[i] = bf2f(qp[i]); }
    float acc[64];
#pragma unroll
    for (int i = 0; i < 64; ++i) acc[i] = 0.f;
    float m = -1e30f, lsum = 0.f;
    const int nkeys = isctx ? CTX : CTX + SEQ;
    for (int kk = 0; kk < nkeys; ++kk) {
        const int kr = kk < CTX ? b * CTX + kk : NCTX + b * SEQ + (kk - CTX);
        const bf16_t* kp = KA + (size_t)kr * 512 + h * 128 + comp * 64;
        float s = 0.f;
#pragma unroll
        for (int i = 0; i < 64; ++i) s += q[i] * bf2f(kp[i]);
        const float mn = fmaxf(m, s), corr = exp2f(m - mn), p = exp2f(s - mn);
        lsum = lsum * corr + p; m = mn;
        const bf16_t* vp = VA + (size_t)kr * 512 + h * 128 + dh * 64;
#pragma unroll
        for (int i = 0; i < 64; ++i) acc[i] = acc[i] * corr + p * bf2f(vp[i]);
    }
    const float inv = 1.f / lsum;
    float* op = ON + ((size_t)comp * TT + row) * 512 + h * 128 + dh * 64;
#pragma unroll
    for (int i = 0; i < 64; ++i) op[i] = acc[i] * inv;
}
DI float lam_of(const Args& a, int l) {
    float s1 = 0.f, s2 = 0.f;
    for (int i = 0; i < 64; ++i) { s1 += a.in[8][l * 64 + i] * a.in[9][l * 64 + i]; s2 += a.in[10][l * 64 + i] * a.in[11][l * 64 + i]; }
    return expf(s1) - expf(s2) + lam_init_of(l);
}
__global__ void __launch_bounds__(256) nv_attn_combine(Args a) {
    const int l = a.layer;
    const int idx = blockIdx.x * 256 + threadIdx.x; if (idx >= TT * 4) return;
    const int row = idx >> 2, h = idx & 3;
    const float lam = lam_of(a, l), li = lam_init_of(l);
    const float* ON = (const float*)(a.ws + WS_ON);
    const float* o0 = ON + (size_t)row * 512 + h * 128; const float* o1 = ON + ((size_t)TT + row) * 512 + h * 128;
    float ss = 0.f;
    for (int i = 0; i < 128; ++i) { const float o = o0[i] - lam * o1[i]; ss += o * o; }
    const float r = rsqrtf(ss * (1.f / 128.f) + EPS) * (1.f - li);
    bf16_t* ya = (bf16_t*)(a.ws + WS_YAB) + (size_t)row * 512 + h * 128;
    const float* sg = a.in[12] + l * 128;
    for (int i = 0; i < 128; ++i) ya[i] = f2bf((o0[i] - lam * o1[i]) * r * sg[i]);
}
__global__ void __launch_bounds__(256) nv_conv(Args a) {
    const int l = a.layer;
    const int row = blockIdx.y, ch = blockIdx.x * 256 + threadIdx.x;
    const bf16_t* QKV = (const bf16_t*)(a.ws + WS_QKV); float* CO = (float*)(a.ws + WS_CONVO);
    const float* cw = a.in[7] + l * 5 * 1536;
    int s0, len; if (row < NCTX) { s0 = (row >> 8) << 8; len = CTX; } else { s0 = NCTX + (((row - NCTX) >> 12) << 12); len = SEQ; }
    const int t = row - s0; float acc = 0.f;
    for (int j = 0; j < 5; ++j) { const int tt = t + j - 2; if (tt >= 0 && tt < len) acc += cw[j * 1536 + ch] * bf2f(QKV[(size_t)(s0 + tt) * 1536 + ch]); }
    CO[(size_t)row * 1536 + ch] = siluf_(acc);
}
__global__ void __launch_bounds__(256) nv_norm(Args a) {
    const int idx = blockIdx.x * 256 + threadIdx.x; if (idx >= TT * 8) return;
    const int row = idx >> 3, h = (idx >> 1) & 3, which = idx & 1;
    float* p = (float*)(a.ws + WS_CONVO) + (size_t)row * 1536 + which * 512 + h * 128;
    float ss = 0.f; for (int i = 0; i < 128; ++i) ss += p[i] * p[i];
    const float r = rsqrtf(ss + EPS) * (which == 0 ? 0.08838834764831845f : 1.f);
    for (int i = 0; i < 128; ++i) p[i] *= r;
}
__global__ void __launch_bounds__(128) nv_scan(Args a) {
    const int l = a.layer;
    const int dir = blockIdx.x >> 4, b = (blockIdx.x >> 2) & 3, h = blockIdx.x & 3, e = threadIdx.x;
    __shared__ float sq[128], sk[128];
    const float* CO = (const float*)(a.ws + WS_CONVO); const float* AB = (const float*)(a.ws + WS_AB);
    bf16_t* OD = (bf16_t*)(a.ws + (dir ? WS_OB : WS_OF));
    const float nal = -expf(a.in[13][l * 8 + dir * 4 + h]), dtb = a.in[14][l * 8 + dir * 4 + h];
    float s[128];
#pragma unroll
    for (int d = 0; d < 128; ++d) s[d] = 0.f;
    for (int step = 0; step < CTX + SEQ; ++step) {
        int row;
        if (step < CTX) { const int t = dir ? (CTX - 1 - step) : step; row = b * CTX + t; }
        else { const int t = dir ? (SEQ - 1 - (step - CTX)) : (step - CTX); row = NCTX + b * SEQ + t; }
        __syncthreads();
        sq[e] = CO[(size_t)row * 1536 + h * 128 + e]; sk[e] = CO[(size_t)row * 1536 + 512 + h * 128 + e];
        const float v = CO[(size_t)row * 1536 + 1024 + h * 128 + e];
        __syncthreads();
        const float g = nal * softplusf_(AB[(size_t)row * 16 + dir * 4 + h] + dtb);
        const float av = expf(g), beta = sigmoidf_(AB[(size_t)row * 16 + 8 + dir * 4 + h]);
        float r = 0.f, qs = 0.f, qk = 0.f;
#pragma unroll
        for (int d = 0; d < 128; ++d) { r += sk[d] * s[d]; qs += sq[d] * s[d]; qk += sq[d] * sk[d]; }
        const float vn = beta * (v - av * r);
        const float o = av * qs + qk * vn;
#pragma unroll
        for (int d = 0; d < 128; ++d) s[d] = av * s[d] + sk[d] * vn;
        OD[(size_t)row * 512 + h * 128 + e] = f2bf(o);
    }
}
__global__ void __launch_bounds__(256) nv_merge1(Args a) {
    const int l = a.layer;
    const int row = blockIdx.y, c = blockIdx.x * 256 + threadIdx.x;
    const bf16_t* YA = (const bf16_t*)(a.ws + WS_YAB) + (size_t)row * 512; const bf16_t* YB = (const bf16_t*)(a.ws + WS_YAB) + ((size_t)TT + row) * 512;
    const float* wpa = a.in[16] + (size_t)l * 512 * 1024; const float* wpb = a.in[17] + (size_t)l * 512 * 1024;
    float pa = 0.f, pb = 0.f;
    for (int k = 0; k < 512; ++k) { pa += bf2f(YA[k]) * wpa[(size_t)k * 1024 + c]; pb += bf2f(YB[k]) * wpb[(size_t)k * 1024 + c]; }
    const bf16_t* SG = (const bf16_t*)(a.ws + WS_SG) + (size_t)row * 2048;
    ((bf16_t*)(a.ws + WS_M))[(size_t)row * 1024 + c] = f2bf(bf2f(SG[c]) * pa + bf2f(SG[1024 + c]) * pb);
}
__global__ void __launch_bounds__(256) nv_wo(Args a) {
    const int l = a.layer;
    const int row = blockIdx.y, c = blockIdx.x * 256 + threadIdx.x;
    const bf16_t* M = (const bf16_t*)(a.ws + WS_M) + (size_t)row * 1024; const float* wo = a.in[18] + (size_t)l * 1024 * 1024;
    float acc = 0.f;
    for (int k = 0; k < 1024; ++k) acc += bf2f(M[k]) * wo[(size_t)k * 1024 + c];
    float* X = (float*)(a.ws + WS_X) + (size_t)row * 1024 + c;
    const float* m = (const float*)(a.ws + WS_MODS) + (size_t)(l * 5 + mod_set(row)) * 6144;
    *X = ALPHA * *X + m[2 * 1024 + c] * acc;
}
__global__ void __launch_bounds__(256) nv_moe1(Args a) {
    const int l = a.layer;
    const int as = blockIdx.y, j = blockIdx.x * 256 + threadIdx.x;
    const int row = as >> 1; if (l == DEPTH - 1 && row < NCTX) return;
    const int e = ((const int*)(a.ws + WS_ROUTE_E))[as];
    const bf16_t* hr = (const bf16_t*)(a.ws + WS_H) + (size_t)row * 1024;
    const float* w1 = a.in[23] + ((size_t)l * 16 + e) * 1024 * 512; const float* w3 = a.in[24] + ((size_t)l * 16 + e) * 1024 * 512;
    float g = 0.f, u = 0.f;
    for (int k = 0; k < 1024; ++k) { const float hv = bf2f(hr[k]); g += hv * w1[(size_t)k * 512 + j]; u += hv * w3[(size_t)k * 512 + j]; }
    ((bf16_t*)(a.ws + WS_ACT))[(size_t)as * 512 + j] = f2bf(siluf_(g) * u);
}
__global__ void __launch_bounds__(256) nv_moe2(Args a) {
    const int l = a.layer;
    const int as = blockIdx.y, c = blockIdx.x * 256 + threadIdx.x;
    const int row = as >> 1; if (l == DEPTH - 1 && row < NCTX) return;
    const int e = ((const int*)(a.ws + WS_ROUTE_E))[as];
    const bf16_t* ar = (const bf16_t*)(a.ws + WS_ACT) + (size_t)as * 512;
    const float* w2 = a.in[25] + ((size_t)l * 16 + e) * 512 * 1024;
    float acc = 0.f;
    for (int k = 0; k < 512; ++k) acc += bf2f(ar[k]) * w2[(size_t)k * 1024 + c];
    ((bf16_t*)(a.ws + WS_YS))[(size_t)as * 1024 + c] = f2bf(acc);
}


enum Op { OP_MODS = 0, OP_CONVERT, OP_PREP0, OP_INPROJ, OP_ATTN_G1, OP_SCAN, OP_YB, OP_MERGE1, OP_WO, OP_LN1, OP_SLOT, OP_UP, OP_DOWN, OP_COMBINE, OP_NONE };
constexpr int NSTEP_PRE = 2, NSTEP_LAYER = 11, NSTEPS = NSTEP_PRE + NSTEP_LAYER * DEPTH;
__host__ __device__ inline void decode_step(int step, int& op, int& l) {
    if (step < NSTEP_PRE) { l = 0; op = step == 0 ? OP_MODS : OP_PREP0; return; }
    const int s = step - NSTEP_PRE; l = s / NSTEP_LAYER; op = OP_INPROJ + s % NSTEP_LAYER;
}

#ifndef PROBE_XBAR
#define PROBE_XBAR 0
#define XCD_RELABEL 1
#endif
#ifndef PROBE_WO2
#define PROBE_WO2 0
#endif
#ifndef PROBE_LN12
#define PROBE_LN12 0
#endif
#ifndef PROBE_CMB2
#define PROBE_CMB2 0
#endif
#ifndef PROBE_ATT2
#define PROBE_ATT2 0
#endif
#ifndef PROBE_G12
#define PROBE_G12 0
#endif
#ifndef PROBE_OP
#define PROBE_OP -1
#endif
#ifndef PROBE_N
#define PROBE_N 1
#endif
#ifndef PROBE_PAD
#define PROBE_PAD 7
#endif
#ifndef ONLY_OP
#define ONLY_OP -1
#endif
#define EN(o) (ONLY_OP < 0 || ONLY_OP == (o))
__global__ void __launch_bounds__(512, 2) mk(Args a_in) {
    extern __shared__ __attribute__((aligned(16))) unsigned char lds[];
    const int tid = threadIdx.x;
    volatile LAS unsigned* MISC = (volatile LAS unsigned*)((LAS unsigned char*)lds + LDS_MISC);
    if (tid < 64) MISC[tid] = 0u;
    __syncthreads();
    XcdBarrier bar; bar.bar = (unsigned*)(a_in.ws + WS_CTL) + 4096; bar.x = 0; bar.st = nullptr;
    if (a_in.hi - a_in.lo > 1) bar = xcd_barrier_post((unsigned*)(a_in.ws + WS_CTL) + 4096, MISC + 8);
    const int G = gridDim.x;
#pragma unroll 1
    for (int step = a_in.lo; step < a_in.hi; ++step) {
        int op, l; decode_step(step, op, l);
        if ((op == OP_WO || op == OP_DOWN) && (a_in.hi - a_in.lo > 1)) continue;
        Args a = a_in;
        { unsigned z; asm volatile("s_mov_b32 %0, 0" : "=s"(z)); a.ws = a_in.ws + z; a.out = a_in.out + z;
#pragma unroll
          for (int i = 0; i < 28; ++i) a.in[i] = a_in.in[i] + z; }
#if PROBE_OP >= 0
        const int nrep_ = (op == PROBE_OP) ? 1 + PROBE_N : 1;
#pragma unroll 1
        for (int rep_ = 0; rep_ < nrep_; ++rep_) {
        const int padm_ = (rep_ > 0) ? PROBE_PAD : 7;
        if (rep_ > 0) xcd_barrier(bar);
#else
        const int padm_ = 7;
        {
#endif
        const int vcu_ = (G == 256 && XCD_RELABEL) ? (((int)blockIdx.x & 7) * 32 + ((int)blockIdx.x >> 3)) : (int)blockIdx.x;
        if (EN(OP_MODS) && op == OP_MODS) {
            ph_mods(a, lds);
            { const int t_ = tidx(); convert_run(a, 0, -1, blockIdx.x * 8 + (t_ >> 6), G * 8, (float*)(lds + 40960 + (t_ >> 6) * 8704), t_ & 63); }
            __syncthreads();
        }
        else if (EN(OP_PREP0) && op == OP_PREP0) ph_prep0(a, lds);
        else if (EN(OP_INPROJ) && op == OP_INPROJ) {
            pg8::Gemm g{(const bf16_t*)(a.ws + WS_H), (const bf16_t*)(a.ws + WS_WIN), TT, NPROJ, 1024};
            pg8::StaticOrder S; S.init(TT, NPROJ, G, (int)blockIdx.x);
            EpiInproj E{a.ws};
            pg8::gemm_phase<EpiInproj, pg8::StaticOrder, true, true>((LAS unsigned char*)lds, g, S, E);
        }
        else if (EN(OP_ATTN_G1) && op == OP_ATTN_G1) {
            if (a_in.pad & padm_ & 1) {
#if PROBE_ATT2
                ph_attn<PROBE_ATT2>(a, l, (LAS unsigned char*)lds); __syncthreads();
#endif
                ph_attn<0>(a, l, (LAS unsigned char*)lds);
            }
            if (a_in.pad & padm_ & 2) {
#if PROBE_G12
                ph_g1(a, l, lds, PROBE_G12 - 1); __syncthreads();
#endif
                ph_g1(a, l, lds);
            }
        }
        else if (EN(OP_SCAN) && op == OP_SCAN) {
            const int t_ = tidx(), w_ = t_ >> 6;
            const bool scanner = (a_in.pad & 4) && blockIdx.x < 32;
            const bool do_conv_ = (padm_ & 8) || (padm_ == 7);
            if (scanner) { if (padm_ & 4) ph_scan(a, l, lds); }
            else {
                const int nscan = (a_in.pad & 4) ? 32 : 0;
                const int rank = ((int)blockIdx.x - nscan) * 8 + w_;
                if (do_conv_) convert_run(a, l + 1, l, rank, (G - nscan) * 8, (float*)(lds + w_ * 16384), t_ & 63);
            }
            __syncthreads();
        }
        else if (EN(OP_YB) && op == OP_YB) ph_yb(a, l);
        else if (EN(OP_MERGE1) && op == OP_MERGE1) {
            {
                pg8::Gemm g{(const bf16_t*)(a.ws + WS_YAB), (const bf16_t*)(a.ws + WS_WPAB), 2 * TT, 2048, 512};
                SchedMerge1 S{G, vcu_, l == DEPTH - 1 ? 4 : 0, a.ws, l};
                EpiMerge1 E{a.ws};
                pg8::gemm_phase<EpiMerge1, SchedMerge1, true, true>((LAS unsigned char*)lds, g, S, E);
            }
            {
                pg8::Gemm g{(const bf16_t*)(a.ws + WS_M), (const bf16_t*)(a.ws + WS_WO), TT, 1024, 1024};
                SchedWoWait S{G, vcu_, l == DEPTH - 1 ? 4 : 0, a.ws, l};
                EpiWo E{a.ws, l, 0};
                pg8::gemm_phase<EpiWo, SchedWoWait, true, true>((LAS unsigned char*)lds, g, S, E);
            }
        }
        else if (EN(OP_LN1) && op == OP_LN1) {
#if PROBE_LN12
            ph_ln1_router(a, l, lds, PROBE_LN12); __syncthreads();
#endif
            ph_ln1_router(a, l, lds);
        }
        else if (EN(OP_SLOT) && op == OP_SLOT) ph_slot(a, l, lds);
        else if (EN(OP_UP) && op == OP_UP) {
            const int* meta = (const int*)(a.ws + WS_META);
            const int ntl = meta[META_NT];
            {
                pg8::Gemm g{(const bf16_t*)(a.ws + WS_XS), (const bf16_t*)(a.ws + WS_W13), NSLOT, 16384, 1024};
                SchedMoe S{G, vcu_, ntl, meta + META_TE, a.ws, l, 1};
                EpiUp E{a.ws};
                pg8::gemm_phase<EpiUp, SchedMoe, true, true>((LAS unsigned char*)lds, g, S, E);
            }
            {
                pg8::Gemm g{(const bf16_t*)(a.ws + WS_ACT), (const bf16_t*)(a.ws + WS_W2), NSLOT, 16384, 512};
                SchedMoe S{G, vcu_, ntl, meta + META_TE, a.ws, l, 2};
                EpiDown E{a.ws};
                pg8::gemm_phase<EpiDown, SchedMoe, true, true>((LAS unsigned char*)lds, g, S, E);
            }
        }
        else if (EN(OP_COMBINE) && op == OP_COMBINE) {
#if PROBE_CMB2
            ph_combine_ln2(a, l, lds, 1); __syncthreads();
#endif
            ph_combine_ln2(a, l, lds);
        }
        }
        if (step + 1 < a_in.hi) { xcd_barrier(bar);
#if PROBE_XBAR
            for (int xb_ = 0; xb_ < PROBE_XBAR; ++xb_) xcd_barrier(bar);
#endif
        }
    }
}


#ifndef FAST_MASK
#define FAST_MASK 0xffffffffu
#endif
#ifndef MK_SINGLE
#define MK_SINGLE 1
#endif
#ifndef FAST_ATTN
#define FAST_ATTN 1
#endif
#ifndef FAST_G1
#define FAST_G1 1
#endif
#ifndef FAST_SCAN
#define FAST_SCAN 1
#endif
static bool op_fast(int op) {
    if (op == OP_ATTN_G1) return false;
    if (op == OP_SCAN) return FAST_SCAN != 0;
    return (FAST_MASK >> op) & 1u;
}
extern "C" void kernel_launch(void* const* d_in, const int* in_sizes, int n_in, void* d_out, int out_size, void* d_ws, size_t ws_size, hipStream_t stream) {
    if (n_in != 28 || ws_size < WS_END) { fprintf(stderr, "kernel_launch: unexpected n_in %d / ws_size %zu (need %zu)\n", n_in, ws_size, (size_t)WS_END); return; }
    Args a{};
    for (int i = 0; i < 28; ++i) a.in[i] = (const float*)d_in[i];
    a.out = (float*)d_out; a.ws = (unsigned char*)d_ws;
    static bool attr_done = false;
    if (!attr_done) {
        if (hipFuncSetAttribute((const void*)mk, hipFuncAttributeMaxDynamicSharedMemorySize, LDS_BYTES) != hipSuccess) fprintf(stderr, "hipFuncSetAttribute failed\n");
        attr_done = true;
    }
    hipMemsetAsync((char*)d_ws + WS_CTL, 0, 1 * MiB, stream);
#if MK_SINGLE
    a.lo = 0; a.hi = NSTEPS; a.pad = 7;
    hipLaunchKernelGGL(mk, dim3(256), dim3(512), LDS_BYTES, stream, a);
#else
    for (int step = 0; step < NSTEPS; ++step) {
        int op, l; decode_step(step, op, l);
        a.layer = l;
        if (op == OP_ATTN_G1) {
            if (FAST_ATTN || FAST_G1) { a.lo = step; a.hi = step + 1; a.pad = (FAST_ATTN ? 1 : 0) | (FAST_G1 ? 2 : 0); hipLaunchKernelGGL(mk, dim3(256), dim3(512), LDS_BYTES, stream, a); a.pad = 0; a.lo = 0; a.hi = 0; }
            if (!FAST_ATTN) {
                hipLaunchKernelGGL(nv_attn, dim3(TT / 256, 16), dim3(256), 0, stream, a);
                hipLaunchKernelGGL(nv_attn_combine, dim3(TT * 4 / 256), dim3(256), 0, stream, a);
            }
            if (!FAST_G1) {
                hipLaunchKernelGGL(nv_conv, dim3(1536 / 256, TT), dim3(256), 0, stream, a);
                hipLaunchKernelGGL(nv_norm, dim3(TT * 8 / 256), dim3(256), 0, stream, a);
            }
            continue;
        }
        if (op == OP_SCAN) {
            a.lo = step; a.hi = step + 1; a.pad = FAST_SCAN ? 4 : 0; hipLaunchKernelGGL(mk, dim3(256), dim3(512), LDS_BYTES, stream, a); a.pad = 0; a.lo = 0; a.hi = 0;
            if (!FAST_SCAN) hipLaunchKernelGGL(nv_scan, dim3(32), dim3(128), 0, stream, a);
            continue;
        }
        if (op_fast(op)) { a.lo = step; a.hi = step + 1; hipLaunchKernelGGL(mk, dim3(256), dim3(512), LDS_BYTES, stream, a); continue; }
        a.lo = 0; a.hi = 0;
        switch (op) {
        case OP_INPROJ: hipLaunchKernelGGL(nv_inproj, dim3(NPROJ / 256, TT), dim3(256), 0, stream, a); break;
        case OP_MERGE1: hipLaunchKernelGGL(nv_merge1, dim3(4, TT), dim3(256), 0, stream, a); break;
        case OP_WO: hipLaunchKernelGGL(nv_wo, dim3(4, TT), dim3(256), 0, stream, a); break;
        case OP_SLOT: break;
        case OP_UP: hipLaunchKernelGGL(nv_moe1, dim3(2, NASSIGN), dim3(256), 0, stream, a); break;
        case OP_DOWN: hipLaunchKernelGGL(nv_moe2, dim3(4, NASSIGN), dim3(256), 0, stream, a); break;
        default: fprintf(stderr, "no naive kernel for op %d\n", op); break;
        }
    }
#endif
}
```

```cpp
#include <hip/hip_runtime.h>
#include <cstdio>
#include <cstdint>

#define DI __device__ __forceinline__
typedef unsigned short bf16_t;
typedef short bf16x8 __attribute__((ext_vector_type(8)));
typedef float f32x4 __attribute__((ext_vector_type(4)));
typedef float f32x2 __attribute__((ext_vector_type(2)));
typedef float f32x16 __attribute__((ext_vector_type(16)));
typedef unsigned u32x4 __attribute__((ext_vector_type(4)));
typedef unsigned u32x2 __attribute__((ext_vector_type(2)));
typedef __bf16 bf16x2_t __attribute__((ext_vector_type(2)));

constexpr int D = 1024, NB = 4, SEQ = 4096, CTX = 256, DEPTH = 4;
constexpr int NCTX = NB * CTX;
constexpr int TT = NCTX + NB * SEQ;
constexpr int N_IN = 5648, NPROJ = 5632;
constexpr int NE = 16;
constexpr float EPS = 1e-6f;
constexpr float ALPHA = 1.681792830507429f;
constexpr float QSCALE = 0.125f * 1.4426950408889634f;
constexpr int NASSIGN = TT * 2;
constexpr int NSLOT = NASSIGN + NE * 256;

constexpr size_t MiB = 1u << 20;
constexpr size_t WS_CTL = 0;
constexpr size_t WS_MODS = 1 * MiB;
constexpr size_t WS_ROPE = 2 * MiB;
constexpr size_t WS_META = 2 * MiB + 65536;
constexpr size_t WS_ROUTE_E = 3 * MiB;
constexpr size_t WS_ROUTE_W = 3 * MiB + 262144;
constexpr size_t WS_DEST = 3 * MiB + 524288;
constexpr size_t WS_SLOTA = 3 * MiB + 786432;
constexpr size_t WS_AB = 4 * MiB;
constexpr size_t WS_GL = 6 * MiB;
constexpr size_t WS_WIN = 8 * MiB;
constexpr size_t WS_WPAB = 20 * MiB;
constexpr size_t WS_WO = 22 * MiB;
constexpr size_t WS_W13 = 24 * MiB;
constexpr size_t WS_W2 = 56 * MiB;
constexpr size_t WS_X = 72 * MiB;
constexpr size_t WS_H = 140 * MiB;
constexpr size_t WS_QA = 174 * MiB;
constexpr size_t WS_KA = 191 * MiB;
constexpr size_t WS_VA = 208 * MiB;
constexpr size_t WS_QKV = 225 * MiB;
constexpr size_t WS_Z = 276 * MiB;
constexpr size_t WS_SG = 293 * MiB;
constexpr size_t WS_GPRE = 361 * MiB;
constexpr size_t WS_OF = 514 * MiB;
constexpr size_t WS_OB = 531 * MiB;
constexpr size_t WS_YAB = 548 * MiB;
constexpr size_t WS_M = 582 * MiB;
constexpr size_t WS_END = 616 * MiB;
constexpr size_t WS_XS = 174 * MiB;
constexpr size_t WS_ACT = 250 * MiB;
constexpr size_t WS_YS = 288 * MiB;
constexpr size_t WS_ON = 361 * MiB;
constexpr size_t WS_CONVO = 361 * MiB;

DI float bf2f(bf16_t v) { return __uint_as_float(((unsigned)v) << 16); }
DI unsigned pk2(float lo, float hi) { f32x2 v = {lo, hi}; bf16x2_t b = __builtin_convertvector(v, bf16x2_t); return __builtin_bit_cast(unsigned, b); }
DI bf16_t f2bf(float f) { return (bf16_t)(pk2(f, 0.f) & 0xffffu); }
DI float sigmoidf_(float x) { return __builtin_amdgcn_rcpf(1.f + __builtin_amdgcn_exp2f(-1.4426950408889634f * x)); }
DI float siluf_(float x) { return x * __builtin_amdgcn_rcpf(1.f + __builtin_amdgcn_exp2f(-1.4426950408889634f * x)); }
DI float softplusf_(float x) { return fmaxf(x, 0.f) + log1pf(__expf(-fabsf(x))); }
template <int CTRL> DI float dppmov(float v) { return __uint_as_float(__builtin_amdgcn_update_dpp(0u, __float_as_uint(v), CTRL, 0xf, 0xf, true)); }
DI float xor32(float x, bool hi32) { auto rr = __builtin_amdgcn_permlane32_swap(__float_as_uint(x), __float_as_uint(x), false, false); return __uint_as_float(hi32 ? rr[0] : rr[1]); }
DI float xor16(float x, bool odd16) { auto rr = __builtin_amdgcn_permlane16_swap(__float_as_uint(x), __float_as_uint(x), false, false); return __uint_as_float(odd16 ? rr[0] : rr[1]); }
DI float wave_sum(float v) {
    v += dppmov<0xB1>(v); v += dppmov<0x4E>(v); v += dppmov<0x124>(v); v += dppmov<0x128>(v);
    { auto rr = __builtin_amdgcn_permlane16_swap(__float_as_uint(v), __float_as_uint(v), false, false); v = __uint_as_float(rr[0]) + __uint_as_float(rr[1]); }
    { auto rr = __builtin_amdgcn_permlane32_swap(__float_as_uint(v), __float_as_uint(v), false, false); v = __uint_as_float(rr[0]) + __uint_as_float(rr[1]); }
    return v;
}
DI int jj16_of_lane(int lane) { return ((lane >> 5) & 1) * 8 + ((lane >> 4) & 1) * 4 + ((lane >> 3) & 1) * 2 + ((lane >> 2) & 1); }
DI int lane_of_jj16(int jj) { return 32 * (jj >> 3) + 16 * ((jj >> 2) & 1) + 8 * ((jj >> 1) & 1) + 4 * (jj & 1); }
DI float reduce16(const float (&p)[16], int lane) {
    const bool b5 = lane & 32, b4 = lane & 16, b3 = lane & 8, b2 = lane & 4;
    float q8[8], q4[4], q2[2];
#pragma unroll
    for (int j = 0; j < 8; ++j) { const float keep = b5 ? p[j + 8] : p[j], send = b5 ? p[j] : p[j + 8]; q8[j] = keep + xor32(send, b5); }
#pragma unroll
    for (int j = 0; j < 4; ++j) { const float keep = b4 ? q8[j + 4] : q8[j], send = b4 ? q8[j] : q8[j + 4]; q4[j] = keep + xor16(send, b4); }
#pragma unroll
    for (int j = 0; j < 2; ++j) { const float keep = b3 ? q4[j + 2] : q4[j], send = b3 ? q4[j] : q4[j + 2]; q2[j] = keep + dppmov<0x128>(send); }
    float q1;
    { const float keep = b2 ? q2[1] : q2[0], send = b2 ? q2[0] : q2[1]; const float pa = dppmov<0x124>(send), pb = dppmov<0x12C>(send); q1 = keep + (b2 ? pa : pb); }
    q1 += dppmov<0x4E>(q1); q1 += dppmov<0xB1>(q1);
    return q1;
}
DI int mod_set(int row) { return row < NCTX ? 4 : ((row - NCTX) >> 12); }
DI float lam_init_of(int l) { return 0.8f - 0.6f * __expf(-0.3f * (float)l); }

DI int tidx() { int t = threadIdx.x; asm volatile("" : "+v"(t)); return t; }

struct Args {
    const float* in[28];
    float* out;
    unsigned char* ws;
    int lo, hi, layer, pad;
};


namespace pg8 {
#define PG8_LAS __attribute__((address_space(3)))
typedef unsigned short bf16_t;
typedef short bf16x8 __attribute__((ext_vector_type(8)));
typedef float f32x4 __attribute__((ext_vector_type(4)));
typedef unsigned u32x4 __attribute__((ext_vector_type(4)));
constexpr int BM = 256, BK = 64, HALF = 128, HTB = HALF * BK * 2  , STAGE_BYTES = 8 * HTB, NXCD = 8, WGM = 8;

__host__ __device__ __forceinline__ int lds_byte(int r, int c) { const int st = (r >> 4) * 2 + (c >> 5), rr = r & 15, cc = c & 31, ob = rr * 64 + cc * 2; return st * 1024 + (ob ^ (((ob >> 9) & 1) << 5)); }
__host__ __device__ __forceinline__ void stage_rc(int b, int& R, int& C) { const int st = b / 1024, sb = b % 1024, swz = sb ^ (((sb >> 9) & 1) << 5); R = (st >> 1) * 16 + swz / 64; C = (st & 1) * 32 + (swz % 64) / 2; }
__host__ __device__ __forceinline__ int perm32(int rho) { const int n = rho >> 4, i = rho & 15; return 8 * (i >> 2) + 4 * n + (i & 3); }

struct Unit { int pm, pn; };
struct Gemm { const bf16_t* A; const bf16_t* Bt; int M, N, K; };

struct StaticOrder {
    int nM, nN, nwg, G, c;
    __host__ __device__ void init(int M, int N, int G_, int c_) { nM = M / BM; nN = N / BM; nwg = nM * nN; G = G_; c = c_; }
    __host__ __device__ bool next(int i, Unit& u) const {
        const long L = (long)i * G + c; if (L >= nwg) return false;
        int wgid = (int)L; { const int q = nwg / NXCD, r = nwg % NXCD, xcd = wgid % NXCD, off = wgid / NXCD; wgid = (xcd < r ? xcd * (q + 1) : r * (q + 1) + (xcd - r) * q) + off; }
        const int nig = WGM * nN, gid = wgid / nig, fm = gid * WGM, gsz = (nM - fm) < WGM ? (nM - fm) : WGM;
        u.pm = fm + ((wgid % nig) % gsz); u.pn = (wgid % nig) / gsz; return true;
    }
    __device__ __forceinline__ void a_ready(const Unit&) const {}
    __device__ __forceinline__ void done(const Unit&) const {}
};

template <class Epi, class Sched, bool ALIGN_EPI = false, bool SP2 = false>
__device__ __forceinline__ void gemm_phase(PG8_LAS unsigned char* lds, const Gemm g, const Sched& S, const Epi& E) {
    const int tid = tidx(), wid = __builtin_amdgcn_readfirstlane(tid >> 6), lane = tid & 63, wr = wid >> 2, wc = wid & 3, fr = lane & 15, fq = lane >> 4;
    const int K = g.K, nt = K / BK;
    unsigned voffA[2], voffB[2];
#pragma unroll
    for (int i = 0; i < 2; ++i) { int R, C; stage_rc(tid * 16 + i * 8192, R, C); const int Rb = Epi::PERM ? ((R & ~31) + perm32(R & 31)) : R;
        voffA[i] = (unsigned)(R * K + C) * 2u; voffB[i] = (unsigned)(Rb * K + C) * 2u; }
    const size_t kstep = (size_t)(BK * 2);
    const size_t hstep = (size_t)HALF * K * 2;
    const size_t tstep = 2 * hstep;
    const unsigned ldsw = (unsigned)wid * 1024u;
    const int aoff = lds_byte(wr * 64 + fr, fq * 8), boff = lds_byte(wc * 32 + fr, fq * 8);
#define PG8_SA(b, h) (((b) * 2 + (h)) * HTB)
#define PG8_SB(b, h) ((4 + (b) * 2 + (h)) * HTB)
#define PG8_STAGE(bufoff, gbase, voff) do { _Pragma("unroll") for (int _i = 0; _i < 2; ++_i) \
        __builtin_amdgcn_global_load_lds((const unsigned*)((const char*)(gbase) + (voff)[_i]), (PG8_LAS unsigned*)(lds + (bufoff) + ldsw + _i * 8192), 16, 0, 0); } while (0)
#define PG8_LDA(dst, b, h) do { _Pragma("unroll") for (int m = 0; m < 4; ++m) _Pragma("unroll") for (int k = 0; k < 2; ++k) dst[m][k] = *(const PG8_LAS bf16x8*)(lds + PG8_SA(b, h) + aoff + m * 2048 + k * 1024); } while (0)
#define PG8_LDB(dst, b, h) do { _Pragma("unroll") for (int n = 0; n < 2; ++n) _Pragma("unroll") for (int k = 0; k < 2; ++k) dst[n][k] = *(const PG8_LAS bf16x8*)(lds + PG8_SB(b, h) + boff + n * 2048 + k * 1024); } while (0)
#define PG8_MMA(ai, bj, At, Bt) do { __builtin_amdgcn_s_setprio(1); _Pragma("unroll") for (int m = 0; m < 4; ++m) _Pragma("unroll") for (int n = 0; n < 2; ++n) _Pragma("unroll") for (int k = 0; k < 2; ++k) \
        acc[ai][bj][m][n] = __builtin_amdgcn_mfma_f32_16x16x32_bf16(Bt[n][k], At[m][k], acc[ai][bj][m][n], 0, 0, 0); __builtin_amdgcn_s_setprio(0); } while (0)
#define PG8_WAIT_V(n) asm volatile("s_waitcnt vmcnt(" #n ")" ::: "memory")
#define PG8_WAIT_L(n) asm volatile("s_waitcnt lgkmcnt(" #n ")" ::: "memory")
#define PG8_BAR __builtin_amdgcn_s_barrier()
#define PG8_SCHED __builtin_amdgcn_sched_barrier(0)
    Unit cur, nxt; int ui = 0;
    if (!S.next(0, cur)) return;
    f32x4 acc[2][2][4][2];
#pragma unroll
    for (int a = 0; a < 2; ++a)
#pragma unroll
        for (int b = 0; b < 2; ++b)
#pragma unroll
            for (int m = 0; m < 4; ++m)
#pragma unroll
                for (int n = 0; n < 2; ++n) acc[a][b][m][n] = (f32x4){0.f, 0.f, 0.f, 0.f};
    bf16x8 At[4][2], B0[2][2], B1[2][2];
    const char* cA = (const char*)g.A + (size_t)cur.pm * tstep; const char* cB = (const char*)g.Bt + (size_t)cur.pn * tstep;
    S.a_ready(cur);
    if constexpr (SP2) {
        PG8_STAGE(PG8_SB(0, 0), cB, voffB); PG8_STAGE(PG8_SB(0, 1), cB + hstep, voffB); PG8_STAGE(PG8_SA(0, 0), cA, voffA); PG8_STAGE(PG8_SA(0, 1), cA + hstep, voffA);
        if (wr == 1) PG8_BAR;
        PG8_WAIT_V(2); PG8_BAR;
        PG8_STAGE(PG8_SB(1, 0), cB + kstep, voffB); PG8_STAGE(PG8_SA(1, 0), cA + kstep, voffA); PG8_STAGE(PG8_SB(1, 1), cB + hstep + kstep, voffB);
        PG8_WAIT_V(6); PG8_BAR;
    } else {
        PG8_STAGE(PG8_SB(0, 0), cB, voffB); PG8_STAGE(PG8_SA(0, 0), cA, voffA); PG8_STAGE(PG8_SB(0, 1), cB + hstep, voffB); PG8_STAGE(PG8_SA(0, 1), cA + hstep, voffA);
        if (wr == 1) PG8_BAR;
        PG8_WAIT_V(4); PG8_BAR;
        PG8_STAGE(PG8_SB(1, 0), cB + kstep, voffB); PG8_STAGE(PG8_SA(1, 0), cA + kstep, voffA); PG8_STAGE(PG8_SB(1, 1), cB + hstep + kstep, voffB);
        PG8_WAIT_V(6); PG8_BAR;
    }
    for (;;) {
        const bool has_next = S.next(ui + 1, nxt);
        const char* nA = has_next ? (const char*)g.A + (size_t)nxt.pm * tstep : cA; const char* nB = has_next ? (const char*)g.Bt + (size_t)nxt.pn * tstep : cB;
        for (int t = 0; t < nt; t += 2) {
            const bool last = (t == nt - 2);
            const char* a1 = cA + (size_t)(t + 1) * kstep;
            const char* a2 = last ? nA : cA + (size_t)(t + 2) * kstep; const char* b2 = last ? nB : cB + (size_t)(t + 2) * kstep;
            const char* a3 = a2 + kstep; const char* b3 = b2 + kstep;
            if (last && has_next) S.a_ready(nxt);
            if constexpr (SP2) {
            PG8_LDB(B0, 0, 0); PG8_LDB(B1, 0, 1); PG8_SCHED; PG8_LDA(At, 0, 0); PG8_STAGE(PG8_SA(1, 1), a1 + hstep, voffA);
            PG8_WAIT_V(8); PG8_WAIT_L(0); PG8_BAR; PG8_MMA(0, 0, At, B0); PG8_MMA(0, 1, At, B1); PG8_BAR; PG8_SCHED;
            PG8_LDA(At, 0, 1); PG8_STAGE(PG8_SB(0, 0), b2, voffB); PG8_STAGE(PG8_SB(0, 1), b2 + hstep, voffB); PG8_STAGE(PG8_SA(0, 0), a2, voffA);
            PG8_WAIT_V(8); PG8_WAIT_L(0); PG8_BAR; PG8_MMA(1, 0, At, B0); PG8_MMA(1, 1, At, B1); PG8_BAR; PG8_SCHED;
            PG8_LDB(B0, 1, 0); PG8_LDB(B1, 1, 1); PG8_SCHED; PG8_LDA(At, 1, 0); PG8_STAGE(PG8_SA(0, 1), a2 + hstep, voffA);
            PG8_WAIT_V(8); PG8_WAIT_L(0); PG8_BAR; PG8_MMA(0, 0, At, B0); PG8_MMA(0, 1, At, B1); PG8_BAR; PG8_SCHED;
            PG8_LDA(At, 1, 1); PG8_STAGE(PG8_SB(1, 0), b3, voffB); PG8_STAGE(PG8_SB(1, 1), b3 + hstep, voffB); PG8_STAGE(PG8_SA(1, 0), a3, voffA);
            PG8_WAIT_V(8); PG8_WAIT_L(0); PG8_BAR; PG8_MMA(1, 0, At, B0); PG8_MMA(1, 1, At, B1); PG8_BAR; PG8_SCHED;
            } else {
            PG8_LDB(B0, 0, 0); PG8_SCHED; PG8_LDA(At, 0, 0); PG8_STAGE(PG8_SA(1, 1), a1 + hstep, voffA);
            PG8_WAIT_L(8); PG8_BAR; PG8_WAIT_L(0); PG8_MMA(0, 0, At, B0); PG8_BAR; PG8_SCHED;
            PG8_LDB(B1, 0, 1); PG8_STAGE(PG8_SB(0, 0), b2, voffB);
            PG8_BAR; PG8_WAIT_L(0); PG8_MMA(0, 1, At, B1); PG8_BAR;
            PG8_LDA(At, 0, 1); PG8_STAGE(PG8_SA(0, 0), a2, voffA);
            PG8_BAR; PG8_WAIT_L(0); PG8_MMA(1, 0, At, B0); PG8_BAR; PG8_SCHED;
            PG8_STAGE(PG8_SB(0, 1), b2 + hstep, voffB);
            PG8_WAIT_V(6); PG8_BAR; PG8_MMA(1, 1, At, B1); PG8_BAR;
            PG8_LDB(B0, 1, 0); PG8_SCHED; PG8_LDA(At, 1, 0); PG8_STAGE(PG8_SA(0, 1), a2 + hstep, voffA);
            PG8_WAIT_L(8); PG8_BAR; PG8_WAIT_L(0); PG8_MMA(0, 0, At, B0); PG8_BAR; PG8_SCHED;
            PG8_LDB(B1, 1, 1); PG8_STAGE(PG8_SB(1, 0), b3, voffB);
            PG8_BAR; PG8_WAIT_L(0); PG8_MMA(0, 1, At, B1); PG8_BAR;
            PG8_LDA(At, 1, 1); PG8_STAGE(PG8_SA(1, 0), a3, voffA);
            PG8_BAR; PG8_WAIT_L(0); PG8_MMA(1, 0, At, B0); PG8_BAR; PG8_SCHED;
            PG8_STAGE(PG8_SB(1, 1), b3 + hstep, voffB);
            PG8_WAIT_V(6); PG8_BAR; PG8_MMA(1, 1, At, B1); PG8_BAR;
            }
        }
        if constexpr (ALIGN_EPI) { if (wr == 0) PG8_BAR; }
        if constexpr (!Epi::AFTER_DRAIN) { E(acc, cur, wr, wc, fr, fq); S.done(cur); }
        if (!has_next) break;
#pragma unroll
        for (int a = 0; a < 2; ++a)
#pragma unroll
            for (int b = 0; b < 2; ++b)
#pragma unroll
                for (int m = 0; m < 4; ++m)
#pragma unroll
                    for (int n = 0; n < 2; ++n) acc[a][b][m][n] = (f32x4){0.f, 0.f, 0.f, 0.f};
        cur = nxt; cA = nA; cB = nB; ++ui;
        if constexpr (ALIGN_EPI) { if (wr == 1) PG8_BAR; }
    }
    PG8_WAIT_V(0);
    if constexpr (!ALIGN_EPI) { if (wr == 0) PG8_BAR; }
    PG8_BAR;
    if constexpr (Epi::AFTER_DRAIN) { E.fused(acc, cur, wr, wc, fr, fq, lds, wid, lane); S.done(cur); }
#undef PG8_SA
#undef PG8_SB
#undef PG8_STAGE
#undef PG8_LDA
#undef PG8_LDB
#undef PG8_MMA
#undef PG8_WAIT_V
#undef PG8_WAIT_L
#undef PG8_BAR
#undef PG8_SCHED
}
}


#define LAS __attribute__((address_space(3)))
constexpr int LDS_BYTES = 147456;
constexpr int LDS_MISC = 131072 + 8192;

DI void ph_mods(const Args& a, unsigned char* lds) {
    float (*sc)[1024] = (float (*)[1024])lds;
    float (*red)[5][128] = (float (*)[5][128])(lds + 20480);
    const float* c = a.in[1]; const float* cctx = a.in[3]; const float* mod_w = a.in[4]; const float* mod_b = a.in[5];
    float* mods = (float*)(a.ws + WS_MODS);
    const int tid = tidx(), lane = tid & 63, wid = tid >> 6;
    for (int i = tid; i < 5 * 1024; i += 512) { int s = i >> 10, k = i & 1023; float v = s < 4 ? c[s * 1024 + k] : cctx[k]; sc[s][k] = siluf_(v); }
    __syncthreads();
    for (int item = blockIdx.x; item < DEPTH * 48; item += gridDim.x) {
        const int l = item / 48, c0 = (item % 48) * 128;
        const int half = lane >> 5, cg = lane & 31;
        f32x4 acc[5];
#pragma unroll
        for (int s = 0; s < 5; ++s) acc[s] = (f32x4){0.f, 0.f, 0.f, 0.f};
        const float* wp = mod_w + (size_t)l * 1024 * 6144 + c0 + 4 * cg;
#pragma unroll 4
        for (int kk = 0; kk < 64; ++kk) {
            const int k = wid * 128 + 2 * kk + half;
            const f32x4 w = *(const f32x4*)(wp + (size_t)k * 6144);
#pragma unroll
            for (int s = 0; s < 5; ++s) acc[s] += w * sc[s][k];
        }
#pragma unroll
        for (int s = 0; s < 5; ++s) {
#pragma unroll
            for (int j = 0; j < 4; ++j) { float v = acc[s][j]; v += __shfl_xor(v, 32); acc[s][j] = v; }
            if (half == 0) {
#pragma unroll
                for (int j = 0; j < 4; ++j) red[wid][s][4 * cg + j] = acc[s][j];
            }
        }
        __syncthreads();
        for (int i = tid; i < 5 * 128; i += 512) {
            const int s = i >> 7, cc = i & 127; float v = 0.f;
#pragma unroll
            for (int w = 0; w < 8; ++w) v += red[w][s][cc];
            mods[((size_t)l * 5 + s) * 6144 + c0 + cc] = v + mod_b[l * 6144 + c0 + cc];
        }
        __syncthreads();
    }
    if (blockIdx.x == gridDim.x - 1) {
        float* rope = (float*)(a.ws + WS_ROPE);
        for (int i = tid; i < 64 * 16; i += 512) {
            const int pos = i >> 4, f = i & 15;
            const float inv = powf(10000.0f, -(float)f / 16.0f);
            const float ang = (float)pos * inv;
            rope[2 * i] = cosf(ang); rope[2 * i + 1] = sinf(ang);
        }
    }
}

DI void row_ln(f32x4 (&v)[4], const float* g, const float* b, int lane) {
    float s = 0.f;
#pragma unroll
    for (int j = 0; j < 4; ++j) s += (v[j][0] + v[j][1]) + (v[j][2] + v[j][3]);
    const float mean = wave_sum(s) * (1.f / 1024.f);
    float q = 0.f;
#pragma unroll
    for (int j = 0; j < 4; ++j) { v[j] = v[j] - mean; q += (v[j][0] * v[j][0] + v[j][1] * v[j][1]) + (v[j][2] * v[j][2] + v[j][3] * v[j][3]); }
    const float rstd = rsqrtf(wave_sum(q) * (1.f / 1024.f) + EPS);
#pragma unroll
    for (int j = 0; j < 4; ++j) {
        const f32x4 gg = *(const f32x4*)(g + 256 * j + 4 * lane), bb = *(const f32x4*)(b + 256 * j + 4 * lane);
        v[j] = v[j] * rstd * gg + bb;
    }
}
DI void row_ln_r(f32x4 (&v)[4], const f32x4 (&gg)[4], const f32x4 (&bb)[4]) {
    float s = 0.f;
#pragma unroll
    for (int j = 0; j < 4; ++j) s += (v[j][0] + v[j][1]) + (v[j][2] + v[j][3]);
    const float mean = wave_sum(s) * (1.f / 1024.f);
    float q = 0.f;
#pragma unroll
    for (int j = 0; j < 4; ++j) { v[j] = v[j] - mean; q += (v[j][0] * v[j][0] + v[j][1] * v[j][1]) + (v[j][2] * v[j][2] + v[j][3] * v[j][3]); }
    const float rstd = rsqrtf(wave_sum(q) * (1.f / 1024.f) + EPS);
#pragma unroll
    for (int j = 0; j < 4; ++j) v[j] = v[j] * rstd * gg[j] + bb[j];
}
DI void row_modulate(f32x4 (&h)[4], const f32x4 (&x)[4], const float* shift, const float* scale, int lane) {
#pragma unroll
    for (int j = 0; j < 4; ++j) {
        const f32x4 sh = *(const f32x4*)(shift + 256 * j + 4 * lane), scl = *(const f32x4*)(scale + 256 * j + 4 * lane);
        h[j] = x[j] * (1.f + scl) + sh;
    }
}
DI void row_store_bf16(bf16_t* dst, const f32x4 (&h)[4], int lane) {
#pragma unroll
    for (int j = 0; j < 4; ++j) { u32x2 w; w.x = pk2(h[j][0], h[j][1]); w.y = pk2(h[j][2], h[j][3]); *(u32x2*)(dst + 256 * j + 4 * lane) = w; }
}
DI float row_gemv16(const f32x4 (&h)[4], const float* WT, int lane) {
    float p[16];
#pragma unroll
    for (int jj = 0; jj < 16; ++jj) {
        float acc = 0.f;
#pragma unroll
        for (int j = 0; j < 4; ++j) { const f32x4 w = *(const f32x4*)(WT + jj * 1024 + 256 * j + 4 * lane); acc += (h[j][0] * w[0] + h[j][1] * w[1]) + (h[j][2] * w[2] + h[j][3] * w[3]); }
        asm volatile("" : "+v"(acc));
        p[jj] = acc;
    }
    return reduce16(p, lane);
}
DI void stage_wt16(float* WT, const float* W, int ld, int col0, int tid) {
    for (int c = tid; c < 1024; c += 512) {
        const float* p = W + (size_t)c * ld + col0;
#pragma unroll
        for (int q = 0; q < 4; ++q) { const f32x4 w = *(const f32x4*)(p + 4 * q);
#pragma unroll
            for (int i = 0; i < 4; ++i) WT[(4 * q + i) * 1024 + c] = w[i]; }
    }
}

DI void ph_prep0(const Args& a, unsigned char* lds) {
    float* WT = (float*)lds;
    const int tid = tidx(), lane = tid & 63, wid = tid >> 6;
    stage_wt16(WT, a.in[6], N_IN, 3584, tid);
    __syncthreads();
    const float* mods = (const float*)(a.ws + WS_MODS);
    float* X = (float*)(a.ws + WS_X); bf16_t* H = (bf16_t*)(a.ws + WS_H); float* AB = (float*)(a.ws + WS_AB);
    const int rstride = gridDim.x * 8;
    f32x4 xn[4];
    { const int row = blockIdx.x * 8 + wid; const float* src = row < NCTX ? a.in[2] + (size_t)row * 1024 : a.in[0] + (size_t)(row - NCTX) * 1024;
#pragma unroll
      for (int j = 0; j < 4; ++j) xn[j] = *(const f32x4*)(src + 256 * j + 4 * lane); }
#pragma unroll 1
    for (int row = blockIdx.x * 8 + wid; row < TT; row += rstride) {
        f32x4 x[4], h[4];
#pragma unroll
        for (int j = 0; j < 4; ++j) x[j] = xn[j];
        { const int rn = row + rstride; if (rn < TT) { const float* src = rn < NCTX ? a.in[2] + (size_t)rn * 1024 : a.in[0] + (size_t)(rn - NCTX) * 1024;
#pragma unroll
            for (int j = 0; j < 4; ++j) xn[j] = *(const f32x4*)(src + 256 * j + 4 * lane); } }
#pragma unroll
        for (int j = 0; j < 4; ++j) *(f32x4*)(X + (size_t)row * 1024 + 256 * j + 4 * lane) = x[j];
        const float* m = mods + (size_t)(0 * 5 + mod_set(row)) * 6144;
        row_modulate(h, x, m, m + 1024, lane);
        row_store_bf16(H + (size_t)row * 1024, h, lane);
        { const float abv = row_gemv16(h, WT, lane); if ((lane & 3) == 0) AB[(size_t)row * 16 + jj16_of_lane(lane)] = abv; }
    }
    __syncthreads();
}

DI void ph_yb(const Args& a, int l) {
    const int tid = tidx(), lane = tid & 63, wid = tid >> 6;
    const bf16_t* OF = (const bf16_t*)(a.ws + WS_OF); const bf16_t* OB = (const bf16_t*)(a.ws + WS_OB); const bf16_t* Z = (const bf16_t*)(a.ws + WS_Z);
    bf16_t* YB = (bf16_t*)(a.ws + WS_YAB) + (size_t)TT * 512;
    const float* ogp = a.in[15] + l * 128 + ((8 * lane) & 127);
    float og[8];
#pragma unroll
    for (int i = 0; i < 8; ++i) og[i] = ogp[i];
    const int rstride = gridDim.x * 8;
    int row0 = blockIdx.x * 8 + wid; if (l == DEPTH - 1) { while (row0 < NCTX) row0 += rstride; }
    u32x4 fn = (u32x4){0u, 0u, 0u, 0u}, bn = fn, zn = fn;
    if (row0 < TT) { const size_t o0 = (size_t)row0 * 512 + 8 * lane; fn = *(const u32x4*)(OF + o0); bn = *(const u32x4*)(OB + o0); zn = *(const u32x4*)(Z + o0); }
#pragma unroll 1
    for (int row = row0; row < TT; row += rstride) {
        const size_t off = (size_t)row * 512 + 8 * lane;
        const u32x4 f = fn, b = bn, z = zn;
        if (row + rstride < TT) { const size_t o1 = (size_t)(row + rstride) * 512 + 8 * lane; fn = *(const u32x4*)(OF + o1); bn = *(const u32x4*)(OB + o1); zn = *(const u32x4*)(Z + o1); }
        float o[8]; float ss = 0.f;
#pragma unroll
        for (int i = 0; i < 4; ++i) {
            o[2 * i] = __uint_as_float(f[i] << 16) + __uint_as_float(b[i] << 16);
            o[2 * i + 1] = __uint_as_float(f[i] & 0xffff0000u) + __uint_as_float(b[i] & 0xffff0000u);
            ss += o[2 * i] * o[2 * i] + o[2 * i + 1] * o[2 * i + 1];
        }
        ss += __shfl_xor(ss, 1); ss += __shfl_xor(ss, 2); ss += __shfl_xor(ss, 4); ss += __shfl_xor(ss, 8);
        const float r = rsqrtf(ss * (1.f / 128.f) + EPS);
        u32x4 w;
#pragma unroll
        for (int i = 0; i < 4; ++i) {
            const float z0 = __uint_as_float(z[i] << 16), z1 = __uint_as_float(z[i] & 0xffff0000u);
            const float y0 = o[2 * i] * r * og[2 * i] * siluf_(z0), y1 = o[2 * i + 1] * r * og[2 * i + 1] * siluf_(z1);
            w[i] = pk2(y0, y1);
        }
        *(u32x4*)(YB + off) = w;
    }
}

constexpr int LOCAL_ASSIGN = 9 * 8 * 2;
DI void ln1_row(int k, int kfirst, f32x4 (&xb)[4], const f32x4 (&lg4)[4], const f32x4 (&lb4)[4], const float* X, const float* mods, int l, bf16_t* H, const float* WT, const float* rb,
                int* RE, float* RW, int* le, int lane, int wid, int rd) {
    const int row = blockIdx.x * 8 + wid + 2048 * k;
    if (k < kfirst || row >= TT) return;
    f32x4 x[4], h[4], msh[4], msc[4];
#pragma unroll
    for (int j = 0; j < 4; ++j) x[j] = xb[j];
    const float* m = mods + (size_t)(l * 5 + mod_set(row)) * 6144;
#pragma unroll
    for (int j = 0; j < 4; ++j) { msh[j] = *(const f32x4*)(m + 3 * 1024 + 256 * j + 4 * lane); msc[j] = *(const f32x4*)(m + 4 * 1024 + 256 * j + 4 * lane); }
    if (k + 3 < 9 && row + 3 * 2048 < TT) {
#pragma unroll
        for (int j = 0; j < 4; ++j) xb[j] = *(const f32x4*)(X + (size_t)(row + 3 * 2048) * 1024 + 256 * j + 4 * lane);
    }
    row_ln_r(x, lg4, lb4);
#pragma unroll
    for (int j = 0; j < 4; ++j) h[j] = x[j] * (1.f + msc[j]) + msh[j];
    row_store_bf16(H + (size_t)row * 1024, h, lane);
    if (rd >= 2) return;
    const float lgv = row_gemv16(h, WT, lane);
    float sc[16], sel[16];
#pragma unroll
    for (int e = 0; e < 16; ++e) { const float lg = __uint_as_float(__builtin_amdgcn_readlane(__float_as_uint(lgv), lane_of_jj16(e))); sc[e] = __builtin_amdgcn_rcpf(1.f + __builtin_amdgcn_exp2f(-1.4426950408889634f * lg)); sel[e] = sc[e] + rb[e]; }
    float best_gs = -1e30f; int best = 0;
#pragma unroll
    for (int gI = 0; gI < 4; ++gI) {
        const float v0 = sel[4 * gI], v1 = sel[4 * gI + 1], v2 = sel[4 * gI + 2], v3 = sel[4 * gI + 3];
        const float mx = fmaxf(fmaxf(v0, v1), fmaxf(v2, v3));
        float second;
        if (v0 == mx) second = fmaxf(v1, fmaxf(v2, v3));
        else if (v1 == mx) second = fmaxf(v0, fmaxf(v2, v3));
        else if (v2 == mx) second = fmaxf(fmaxf(v0, v1), v3);
        else second = fmaxf(fmaxf(v0, v1), v2);
        const float gs = mx + second;
        if (gs > best_gs) { best_gs = gs; best = gI; }
    }
    float i0 = 0.f, i1 = 0.f, i2 = 0.f, i3 = 0.f, s0 = 0.f, s1 = 0.f, s2 = 0.f, s3 = 0.f;
#pragma unroll
    for (int gI = 0; gI < 4; ++gI) if (gI == best) { i0 = sel[4 * gI]; i1 = sel[4 * gI + 1]; i2 = sel[4 * gI + 2]; i3 = sel[4 * gI + 3]; s0 = sc[4 * gI]; s1 = sc[4 * gI + 1]; s2 = sc[4 * gI + 2]; s3 = sc[4 * gI + 3]; }
    int a0 = 0; float m0 = i0, w0 = s0;
    if (i1 > m0) { a0 = 1; m0 = i1; w0 = s1; }
    if (i2 > m0) { a0 = 2; m0 = i2; w0 = s2; }
    if (i3 > m0) { a0 = 3; m0 = i3; w0 = s3; }
    int a1 = -1; float m1 = -1e30f, w1 = 0.f;
    if (a0 != 0 && i0 > m1) { a1 = 0; m1 = i0; w1 = s0; }
    if (a0 != 1 && i1 > m1) { a1 = 1; m1 = i1; w1 = s1; }
    if (a0 != 2 && i2 > m1) { a1 = 2; m1 = i2; w1 = s2; }
    if (a0 != 3 && i3 > m1) { a1 = 3; m1 = i3; w1 = s3; }
    if (lane == 0) {
        const float inv = 1.f / (w0 + w1);
        RE[2 * row] = best * 4 + a0; RE[2 * row + 1] = best * 4 + a1;
        RW[2 * row] = w0 * inv; RW[2 * row + 1] = w1 * inv;
        le[(k * 8 + wid) * 2] = best * 4 + a0; le[(k * 8 + wid) * 2 + 1] = best * 4 + a1;
    }
}
DI void ph_ln1_router(const Args& a, int l, unsigned char* lds, int rd = 0) {
    float* WT = (float*)lds;
    int* le = (int*)(lds + 65536);
    const int tid = tidx(), lane = tid & 63, wid = tid >> 6;
    stage_wt16(WT, a.in[21], 16, 0, tid);
    if (tid < LOCAL_ASSIGN) le[tid] = -1;
    __syncthreads();
    const float* mods = (const float*)(a.ws + WS_MODS);
    const float* X = (const float*)(a.ws + WS_X); bf16_t* H = rd ? (bf16_t*)(a.ws + WS_GPRE + 72 * MiB) : (bf16_t*)(a.ws + WS_H);
    int* RE = rd ? (int*)(a.ws + WS_GPRE + 110 * MiB) : (int*)(a.ws + WS_ROUTE_E); float* RW = rd ? (float*)(a.ws + WS_GPRE + 111 * MiB) : (float*)(a.ws + WS_ROUTE_W);
    const float* g = a.in[19] + l * 1024; const float* bb = a.in[20] + l * 1024; const float* rb = a.in[22];
    const int kfirst = (l == DEPTH - 1 && (int)(blockIdx.x * 8 + wid) < NCTX) ? 1 : 0;
    f32x4 lg4[4], lb4[4];
#pragma unroll
    for (int j = 0; j < 4; ++j) { lg4[j] = *(const f32x4*)(g + 256 * j + 4 * lane); lb4[j] = *(const f32x4*)(bb + 256 * j + 4 * lane); }
    f32x4 xa[4], xb[4], xc[4];
    { const int r0 = blockIdx.x * 8 + wid;
      const int ra = r0 + (kfirst ? 3 * 2048 : 0), rb_ = r0 + 2048, rc = r0 + 2 * 2048;
#pragma unroll
      for (int j = 0; j < 4; ++j) { xa[j] = *(const f32x4*)(X + (size_t)ra * 1024 + 256 * j + 4 * lane); xb[j] = *(const f32x4*)(X + (size_t)rb_ * 1024 + 256 * j + 4 * lane); xc[j] = *(const f32x4*)(X + (size_t)rc * 1024 + 256 * j + 4 * lane); } }
#pragma unroll 1
    for (int k = 0; k < 9; k += 3) {
        ln1_row(k, kfirst, xa, lg4, lb4, X, mods, l, H, WT, rb, RE, RW, le, lane, wid, rd);
        ln1_row(k + 1, kfirst, xb, lg4, lb4, X, mods, l, H, WT, rb, RE, RW, le, lane, wid, rd);
        ln1_row(k + 2, kfirst, xc, lg4, lb4, X, mods, l, H, WT, rb, RE, RW, le, lane, wid, rd);
    }
    __syncthreads();
    if (tid < 16) {
        int cnt = 0;
        for (int i = 0; i < LOCAL_ASSIGN; ++i) cnt += (le[i] == tid) ? 1 : 0;
        ((int*)(a.ws + (rd ? WS_GPRE + 112 * MiB : WS_META)))[blockIdx.x * 16 + tid] = cnt;
    }
    __syncthreads();
}

constexpr int META_NT = 4096, META_TE = 4096 + 16;
DI void ph_slot(const Args& a, int l, unsigned char* lds) {
    int* bc = (int*)lds;
    int* tot = (int*)(lds + 16384);
    int* ls = (int*)(lds + 16384 + 1024);
    const int tid = tidx(), lane = tid & 63, wid = tid >> 6;
    const int* meta = (const int*)(a.ws + WS_META);
    int* metaw = (int*)(a.ws + WS_META);
    const int G = gridDim.x;
    for (int i = tid; i < G * 16; i += 512) bc[i] = meta[i];
    if (tid < LOCAL_ASSIGN) ls[tid] = -1;
    __syncthreads();
    {
        int* part = (int*)(lds + 16384 + 4096);
        const int e = tid & 15, pr = tid >> 4; int t = 0, before = 0;
#pragma unroll
        for (int q = 0; q < 8; ++q) { const int b = pr * 8 + q; if (b < G) { const int c = bc[b * 16 + e]; t += c; if (b < (int)blockIdx.x) before += c; } }
        part[pr * 16 + e] = t; part[512 + pr * 16 + e] = before;
        __syncthreads();
        if (tid < 16) { int tt = 0, bb = 0;
#pragma unroll
            for (int q = 0; q < 32; ++q) { tt += part[q * 16 + tid]; bb += part[512 + q * 16 + tid]; }
            tot[tid] = tt; tot[16 + tid] = bb; }
    }
    __syncthreads();
    if (tid == 0) {
        int ps = 0, nt = 0;
#pragma unroll 1
        for (int e = 0; e < 16; ++e) {
            tot[32 + e] = ps; tot[64 + e] = nt; const int tiles = (tot[e] + 255) >> 8;
            nt += tiles; ps += tiles * 256;
        }
        tot[48] = ps; tot[80] = nt;
    }
    __syncthreads();
    if (blockIdx.x == 0) {
        const int nt = tot[80];
        if (tid == 0) metaw[META_NT] = nt;
        if (tid < nt) { int e = 0;
#pragma unroll 1
            for (int q = 1; q < 16; ++q) e += (tot[64 + q] <= tid) ? 1 : 0;
            metaw[META_TE + tid] = e; }
    }
    const int* RE = (const int*)(a.ws + WS_ROUTE_E);
    int* DEST = (int*)(a.ws + WS_DEST); int* SLOTA = (int*)(a.ws + WS_SLOTA);
    int* le2 = (int*)(lds + 16384 + 2048);
    int my_row = -1, my_kk = 0;
    if (tid < LOCAL_ASSIGN) {
        const int row = blockIdx.x * 8 + ((tid >> 1) & 7) + 2048 * (tid >> 4); my_kk = tid & 1;
        int e = -1;
        if (row < TT && !(l == DEPTH - 1 && row < NCTX)) { e = RE[2 * row + my_kk]; my_row = row; }
        le2[tid] = e;
    }
    __syncthreads();
    if (tid < 16) {
        int pos = tot[32 + tid] + tot[16 + tid];
        for (int li = 0; li < LOCAL_ASSIGN; ++li) if (le2[li] == tid) { ls[li] = pos; ++pos; }
    }
    __syncthreads();
    if (tid < LOCAL_ASSIGN && my_row >= 0) { const int pos = ls[tid]; DEST[2 * my_row + my_kk] = pos; SLOTA[pos] = 2 * my_row + my_kk; }
    if (blockIdx.x < 16) {
        const int e = blockIdx.x; const int s0 = tot[32 + e] + tot[e], s1 = tot[32 + e] + (((tot[e] + 255) >> 8) << 8);
        for (int s = s0 + tid; s < s1; s += 512) SLOTA[s] = -1;
    }
    __syncthreads();
    const bf16_t* H = (const bf16_t*)(a.ws + WS_H); bf16_t* XS = (bf16_t*)(a.ws + WS_XS);
#pragma unroll 1
    for (int b0 = 0; b0 < 18; b0 += 6) {
        u32x4 r0[6], r1[6]; int sl[6];
#pragma unroll
        for (int q = 0; q < 6; ++q) {
            const int li = wid + 8 * (b0 + q); sl[q] = ls[li];
            const int row = blockIdx.x * 8 + ((li >> 1) & 7) + 2048 * (li >> 4);
            if (sl[q] >= 0) { const u32x4* sp = (const u32x4*)(H + (size_t)row * 1024); r0[q] = sp[lane]; r1[q] = sp[lane + 64]; }
        }
#pragma unroll
        for (int q = 0; q < 6; ++q) if (sl[q] >= 0) { u32x4* d = (u32x4*)(XS + (size_t)sl[q] * 1024); d[lane] = r0[q]; d[lane + 64] = r1[q]; }
    }
    __syncthreads();
}

DI void ph_combine_ln2(const Args& a, int l, unsigned char* lds, int rd = 0) {
    float* WT = (float*)lds;
    const bool last = (l == DEPTH - 1);
    const int tid = tidx(), lane = tid & 63, wid = tid >> 6;
    if (!last) { stage_wt16(WT, a.in[6] + (size_t)(l + 1) * 1024 * N_IN, N_IN, 3584, tid); }
    __syncthreads();
    const float* mods = (const float*)(a.ws + WS_MODS);
    const float* X = (const float*)(a.ws + WS_X); float* XO = rd ? (float*)(a.ws + WS_GPRE) : (float*)(a.ws + WS_X); bf16_t* H = rd ? (bf16_t*)(a.ws + WS_GPRE + 72 * MiB) : (bf16_t*)(a.ws + WS_H); float* AB = rd ? (float*)(a.ws + WS_GPRE + 110 * MiB) : (float*)(a.ws + WS_AB);
    float* OUT = rd ? (float*)(a.ws + WS_GPRE) : a.out;
    const bf16_t* YS = (const bf16_t*)(a.ws + WS_YS); const float* RW = (const float*)(a.ws + WS_ROUTE_W);
    const float* g = a.in[26] + l * 1024; const float* bb = a.in[27] + l * 1024;
    const int rstride = gridDim.x * 8;
    int row0 = blockIdx.x * 8 + wid; if (last) { while (row0 < NCTX) row0 += rstride; }
    f32x4 xn[4]; u32x2 yn0[4], yn1[4]; float wn0 = 0.f, wn1 = 0.f;
    if (row0 < TT) {
        wn0 = RW[2 * row0]; wn1 = RW[2 * row0 + 1];
#pragma unroll
        for (int j = 0; j < 4; ++j) { const int c = 256 * j + 4 * lane; xn[j] = *(const f32x4*)(X + (size_t)row0 * 1024 + c);
            yn0[j] = *(const u32x2*)(YS + (size_t)(2 * row0) * 1024 + c); yn1[j] = *(const u32x2*)(YS + (size_t)(2 * row0 + 1) * 1024 + c); }
    }
    f32x4 lg4[4], lb4[4], l1g[4], l1b[4];
#pragma unroll
    for (int j = 0; j < 4; ++j) { lg4[j] = *(const f32x4*)(g + 256 * j + 4 * lane); lb4[j] = *(const f32x4*)(bb + 256 * j + 4 * lane);
        l1g[j] = *(const f32x4*)(a.in[19] + l * 1024 + 256 * j + 4 * lane); l1b[j] = *(const f32x4*)(a.in[20] + l * 1024 + 256 * j + 4 * lane); }
#pragma unroll 1
    for (int row = row0; row < TT; row += rstride) {
        const float w0 = wn0, w1 = wn1;
        const float* m = mods + (size_t)(l * 5 + mod_set(row)) * 6144;
        const float* mn = mods + (size_t)((last ? l : l + 1) * 5 + mod_set(row)) * 6144;
        f32x4 x[4], h[4], gt[4], msh[4], msc[4]; u32x2 ya[4], yb[4];
#pragma unroll
        for (int j = 0; j < 4; ++j) { x[j] = xn[j]; ya[j] = yn0[j]; yb[j] = yn1[j]; }
#pragma unroll
        for (int j = 0; j < 4; ++j) { const int c = 256 * j + 4 * lane; gt[j] = *(const f32x4*)(m + 5 * 1024 + c); msh[j] = *(const f32x4*)(mn + c); msc[j] = *(const f32x4*)(mn + 1024 + c); }
        { const int rn = row + rstride;
          if (rn < TT) {
            wn0 = RW[2 * rn]; wn1 = RW[2 * rn + 1];
#pragma unroll
            for (int j = 0; j < 4; ++j) { const int c = 256 * j + 4 * lane; xn[j] = *(const f32x4*)(X + (size_t)rn * 1024 + c);
                yn0[j] = *(const u32x2*)(YS + (size_t)(2 * rn) * 1024 + c); yn1[j] = *(const u32x2*)(YS + (size_t)(2 * rn + 1) * 1024 + c); }
          } }
        row_ln_r(x, l1g, l1b);
#pragma unroll
        for (int j = 0; j < 4; ++j) {
            const u32x2 y0 = ya[j], y1 = yb[j];
            f32x4 y;
            y[0] = w0 * __uint_as_float(y0.x << 16) + w1 * __uint_as_float(y1.x << 16);
            y[1] = w0 * __uint_as_float(y0.x & 0xffff0000u) + w1 * __uint_as_float(y1.x & 0xffff0000u);
            y[2] = w0 * __uint_as_float(y0.y << 16) + w1 * __uint_as_float(y1.y << 16);
            y[3] = w0 * __uint_as_float(y0.y & 0xffff0000u) + w1 * __uint_as_float(y1.y & 0xffff0000u);
            x[j] = ALPHA * x[j] + gt[j] * y;
        }
        row_ln_r(x, lg4, lb4);
        if (last) {
#pragma unroll
            for (int j = 0; j < 4; ++j) *(f32x4*)(OUT + (size_t)(row - NCTX) * 1024 + 256 * j + 4 * lane) = x[j];
        } else {
#pragma unroll
            for (int j = 0; j < 4; ++j) *(f32x4*)(XO + (size_t)row * 1024 + 256 * j + 4 * lane) = x[j];
#pragma unroll
            for (int j = 0; j < 4; ++j) h[j] = x[j] * (1.f + msc[j]) + msh[j];
            row_store_bf16(H + (size_t)row * 1024, h, lane);
            { const float abv = row_gemv16(h, WT, lane); if ((lane & 3) == 0) AB[(size_t)row * 16 + jj16_of_lane(lane)] = abv; }
        }
    }
    __syncthreads();
}

DI void transpose_item(const float* W, int ldw, int K, int ncols, bf16_t* WT, int item, float* scr, int lane) {
    const int nblk = ncols >> 5, kb = item / nblk, nb = item - kb * nblk, k0 = 64 * kb, n0 = 32 * nb;
#pragma unroll 8
    for (int i = 0; i < 32; ++i) { const int kk = 2 * i + (lane >> 5); scr[kk * 33 + (lane & 31)] = W[(size_t)(k0 + kk) * ldw + n0 + (lane & 31)]; }
    asm volatile("s_waitcnt lgkmcnt(0)" ::: "memory");
    const int c = lane & 7;
#pragma unroll
    for (int j = 0; j < 4; ++j) { const int n = (lane >> 3) + 8 * j; const float* s = scr + (8 * c) * 33 + n;
        u32x4 o; o.x = pk2(s[0 * 33], s[1 * 33]); o.y = pk2(s[2 * 33], s[3 * 33]); o.z = pk2(s[4 * 33], s[5 * 33]); o.w = pk2(s[6 * 33], s[7 * 33]);
        *(u32x4*)(WT + (size_t)(n0 + n) * K + k0 + 8 * c) = o; }
    asm volatile("s_waitcnt lgkmcnt(0)" ::: "memory");
}
constexpr int CV_A = 2816, CV_B = 13312;
DI void convert_A(const Args& a, int l, int item, float* scr, int lane) {
    const float* w = a.in[6] + (size_t)l * 1024 * N_IN; bf16_t* wt = (bf16_t*)(a.ws + WS_WIN);
    if (item < 1792) transpose_item(w, N_IN, 1024, 3584, wt, item, scr, lane);
    else transpose_item(w + 3600, N_IN, 1024, 2048, wt + (size_t)3584 * 1024, item - 1792, scr, lane);
}
DI void convert_B(const Args& a, int l, int item, float* scr, int lane) {
    if (item < 256) { transpose_item(a.in[16] + (size_t)l * 512 * 1024, 1024, 512, 1024, (bf16_t*)(a.ws + WS_WPAB), item, scr, lane); return; }
    item -= 256;
    if (item < 256) { transpose_item(a.in[17] + (size_t)l * 512 * 1024, 1024, 512, 1024, (bf16_t*)(a.ws + WS_WPAB) + (size_t)1024 * 512, item, scr, lane); return; }
    item -= 256;
    if (item < 512) { transpose_item(a.in[18] + (size_t)l * 1024 * 1024, 1024, 1024, 1024, (bf16_t*)(a.ws + WS_WO), item, scr, lane); return; }
    item -= 512;
    if (item < 8192) {
        const int job = item >> 6, it = item & 63; const int e = job >> 3, t = (job >> 1) & 3, which = job & 1;
        const float* w = (which ? a.in[24] : a.in[23]) + ((size_t)l * 16 + e) * 1024 * 512 + 128 * t;
        transpose_item(w, 512, 1024, 128, (bf16_t*)(a.ws + WS_W13) + ((size_t)e * 1024 + 256 * t + 128 * which) * 1024, it, scr, lane); return;
    }
    item -= 8192;
    { const int e = item >> 8, it = item & 255;
      transpose_item(a.in[25] + ((size_t)l * 16 + e) * 512 * 1024, 1024, 512, 1024, (bf16_t*)(a.ws + WS_W2) + (size_t)e * 1024 * 512, it, scr, lane); }
}
DI void convert_run(const Args& a, int lA, int lB, int rank, int nw, float* scr, int lane) {
    const int nA = (lA >= 0 && lA < DEPTH) ? CV_A : 0, nB = (lB >= 0 && lB < DEPTH) ? CV_B : 0;
#pragma unroll 1
    for (int it = rank; it < nA + nB; it += nw) { if (it < nA) convert_A(a, lA, it, scr, lane); else convert_B(a, lB, it - nA, scr, lane); }
}


#define XB_TMO      128
#define XB_XCNT(j)  (256  + 64 * (j))
#define XB_XSUB(j)  (1280 + 64 * (j))
#define XB_XGEN(j)  (2304 + 64 * (j))
#define XB_TOP      3328
#define XB_TOPGEN   3392
#define XCD_BAR_WORDS 3456
#define XB_SPIN_CAP (1u << 18)

__device__ __forceinline__ unsigned xb_ld(unsigned* p)              { return __hip_atomic_load(p, __ATOMIC_RELAXED, __HIP_MEMORY_SCOPE_AGENT); }
__device__ __forceinline__ unsigned xb_add(unsigned* p, unsigned v) { return __hip_atomic_fetch_add(p, v, __ATOMIC_RELAXED, __HIP_MEMORY_SCOPE_AGENT); }
__device__ __forceinline__ unsigned xb_xcc_id() { return (unsigned)__builtin_amdgcn_s_getreg((3 << 11) | 20) & 0xFu; }
#define XB_SPIN(cond, bar) do { unsigned _sp = 0; while (cond) { __builtin_amdgcn_s_sleep(1); \
    if ((++_sp & 255u) == 0u) { if (xb_ld(&(bar)[XB_TMO])) break; if (_sp > XB_SPIN_CAP) { atomicAdd(&(bar)[XB_TMO], 1u); break; } } } } while (0)

struct XcdBarrier {
    unsigned* bar; unsigned x;
    volatile LAS unsigned* st;
};

__device__ __forceinline__ XcdBarrier xcd_barrier_post(unsigned* bar, volatile LAS unsigned* st) {
    XcdBarrier b; b.bar = bar; b.x = xb_xcc_id(); b.st = st;
    if (tidx() == 0) (void)xb_add(&bar[XB_XCNT(b.x)], 1u);
    return b;
}
__device__ __forceinline__ void xcd_barrier_complete(unsigned* bar, unsigned x, unsigned& nloc, unsigned& nx) {
    const unsigned G = gridDim.x * gridDim.y * gridDim.z;
    unsigned sum, cnt, mine, sp = 0u;
    for (;;) {
        sum = 0u; cnt = 0u; mine = 0u;
#pragma unroll
        for (unsigned j = 0; j < 16; ++j) { const unsigned c = xb_ld(&bar[XB_XCNT(j)]); sum += c; cnt += (c > 0u) ? 1u : 0u; mine = (j == x) ? c : mine; }
        if (sum == G) break;
        __builtin_amdgcn_s_sleep(1);
        if ((++sp & 255u) == 0u) { if (xb_ld(&bar[XB_TMO])) break; if (sp > XB_SPIN_CAP) { atomicAdd(&bar[XB_TMO], 1u); break; } }
    }
    nloc = mine > 0u ? mine : 1u; nx = cnt > 0u ? cnt : 1u;
}

__device__ __forceinline__ void xcd_barrier(const XcdBarrier& b) {
    asm volatile("s_waitcnt vmcnt(0)" ::: "memory");
    __syncthreads();
    if (tidx() == 0) {
        unsigned* bar = b.bar;
        __builtin_amdgcn_s_waitcnt(0);
        unsigned nloc = b.st[0], nx = b.st[1];
        if (nloc == 0u) { xcd_barrier_complete(bar, b.x, nloc, nx); b.st[0] = nloc; b.st[1] = nx; }
        const unsigned old = xb_add(&bar[XB_XSUB(b.x)], 1u);
        const unsigned gen = old / nloc;
        if (old + 1u == (gen + 1u) * nloc) {
            __builtin_amdgcn_fence(__ATOMIC_RELEASE, "agent");
            asm volatile("s_waitcnt vmcnt(0)" ::: "memory");
            const unsigned og = xb_add(&bar[XB_TOP], 1u);
            const unsigned tg = og / nx;
            if (og + 1u == (tg + 1u) * nx) xb_add(&bar[XB_TOPGEN], 1u);
            else XB_SPIN(xb_ld(&bar[XB_TOPGEN]) == tg, bar);
            __builtin_amdgcn_fence(__ATOMIC_ACQUIRE, "agent");
            xb_add(&bar[XB_XGEN(b.x)], 1u);
            asm volatile("s_waitcnt vmcnt(0)" ::: "memory");
        } else {
            XB_SPIN(xb_ld(&bar[XB_XGEN(b.x)]) == gen, bar);
            __builtin_amdgcn_fence(__ATOMIC_ACQUIRE, "agent");
            asm volatile("s_waitcnt vmcnt(0)" ::: "memory");
        }
    }
    __syncthreads();
}


constexpr int CW_PANEL = 16384;
DI unsigned* panel_word(unsigned char* ws, int l, int kind, int p) { return (unsigned*)(ws + WS_CTL) + CW_PANEL + ((l * 2 + kind) * 160 + p) * 64; }
DI void store16_wt(void* p, u32x4 v) { asm volatile("global_store_dwordx4 %0, %1, off sc1\n\ts_nop 1" :: "v"(p), "v"(v) : "memory"); }
DI void panel_publish(unsigned* w) {
    asm volatile("s_waitcnt vmcnt(0)" ::: "memory");
    if ((tidx() & 63) == 0) __hip_atomic_fetch_add(w, 1u, __ATOMIC_RELAXED, __HIP_MEMORY_SCOPE_AGENT);
}
DI void panel_wait(unsigned* w, unsigned need) {
    if (tidx() < 64) {
        unsigned spins = 0;
        while ((unsigned)__builtin_amdgcn_readfirstlane(__hip_atomic_load(w, __ATOMIC_RELAXED, __HIP_MEMORY_SCOPE_AGENT)) < need) { __builtin_amdgcn_s_sleep(2); if (++spins > (1u << 22)) break; }
        __builtin_amdgcn_fence(__ATOMIC_ACQUIRE, "agent");
        asm volatile("s_waitcnt vmcnt(0)" ::: "memory");
    }
    asm volatile("" ::: "memory"); __builtin_amdgcn_s_barrier(); asm volatile("" ::: "memory");
}
DI int unit_set(int pm) { return pm < 4 ? 4 : ((pm - 4) >> 4); }
struct EpiInproj {
    static constexpr bool PERM = true, AFTER_DRAIN = false;
    unsigned char* ws;
    DI void operator()(const f32x4 (&acc)[2][2][4][2], const pg8::Unit& u, int wr, int wc, int fr, int fq) const {
        const int pn = u.pn; bf16_t* dst; int ld, colt, mode;
        if (pn < 2) { dst = (bf16_t*)(ws + WS_QA); ld = 512; colt = pn * 256; mode = 1; }
        else if (pn < 4) { dst = (bf16_t*)(ws + WS_KA); ld = 512; colt = (pn - 2) * 256; mode = 2; }
        else if (pn < 6) { dst = (bf16_t*)(ws + WS_VA); ld = 512; colt = (pn - 4) * 256; mode = 0; }
        else if (pn < 12) { dst = (bf16_t*)(ws + WS_QKV); ld = 1536; colt = (pn - 6) * 256; mode = 0; }
        else if (pn < 14) { dst = (bf16_t*)(ws + WS_Z); ld = 512; colt = (pn - 12) * 256; mode = 0; }
        else { dst = (bf16_t*)(ws + WS_SG); ld = 2048; colt = (pn - 14) * 256; mode = 3; }
        const bool rope = (mode == 1 || mode == 2) && u.pm >= 4;
        const float qs = (mode == 1) ? QSCALE : 1.f;
        const float* rtab = (const float*)(ws + WS_ROPE);
        const int row0 = u.pm * 256 + wr * 64 + fr;
        const float sgn = (fq >> 1) ? 1.f : -1.f;
        f32x4 csn[2][2];
        if (rope) {
            const int t = (row0 - NCTX) & 4095; const int pos = (wc & 1) ? (t & 63) : (t >> 6);
            const float* rp = rtab + (pos * 16 + 8 * (fq & 1)) * 2;
#pragma unroll
            for (int n = 0; n < 2; ++n) { csn[n][0] = *(const f32x4*)(rp + 8 * n); csn[n][1] = *(const f32x4*)(rp + 8 * n + 4); }
        }
#pragma unroll
        for (int s = 0; s < 8; ++s) {
            const int ai = s >> 2, m = s & 3;
            const int row = row0 + ai * 128 + m * 16;
            f32x4 cs[2][2];
            if (rope) {
#pragma unroll
                for (int n = 0; n < 2; ++n) { cs[n][0] = csn[n][0]; cs[n][1] = csn[n][1]; }
                if (s < 7) {
                    const int r1 = row0 + ((s + 1) >> 2) * 128 + ((s + 1) & 3) * 16;
                    const int t = (r1 - NCTX) & 4095; const int pos = (wc & 1) ? (t & 63) : (t >> 6);
                    const float* rp = rtab + (pos * 16 + 8 * (fq & 1)) * 2;
#pragma unroll
                    for (int n = 0; n < 2; ++n) { csn[n][0] = *(const f32x4*)(rp + 8 * n); csn[n][1] = *(const f32x4*)(rp + 8 * n + 4); }
                }
            }
#pragma unroll
            for (int bj = 0; bj < 2; ++bj) {
                f32x4 v[2] = {acc[ai][bj][m][0], acc[ai][bj][m][1]};
                if (rope) {
#pragma unroll
                    for (int n = 0; n < 2; ++n)
#pragma unroll
                        for (int j = 0; j < 4; ++j) {
                            const float x = v[n][j], xp = __shfl_xor(x, 32);
                            const float c = cs[n][j >> 1][(j & 1) * 2], sv = cs[n][j >> 1][(j & 1) * 2 + 1];
                            v[n][j] = x * c + sgn * xp * sv;
                        }
                }
                if (mode == 3) {
#pragma unroll
                    for (int n = 0; n < 2; ++n)
#pragma unroll
                        for (int j = 0; j < 4; ++j) v[n][j] = sigmoidf_(v[n][j]);
                }
                u32x4 w; w.x = pk2(v[0][0] * qs, v[0][1] * qs); w.y = pk2(v[0][2] * qs, v[0][3] * qs); w.z = pk2(v[1][0] * qs, v[1][1] * qs); w.w = pk2(v[1][2] * qs, v[1][3] * qs);
                *(u32x4*)(dst + (size_t)row * ld + colt + bj * 128 + wc * 32 + 8 * fq) = w;
            }
        }
    }
};
struct EpiMerge1 {
    static constexpr bool PERM = true, AFTER_DRAIN = false;
    unsigned char* ws;
    DI void operator()(const f32x4 (&acc)[2][2][4][2], const pg8::Unit& u, int wr, int wc, int fr, int fq) const {
        const int which = u.pm >= 68 ? 1 : 0; const int pm = u.pm - 68 * which, pn = u.pn - 4 * which;
        const bf16_t* SG = (const bf16_t*)(ws + WS_SG); bf16_t* M = (bf16_t*)(ws + WS_M); bf16_t* MP = (bf16_t*)(ws + WS_GPRE);
        const int row0 = pm * 256 + wr * 64 + fr, colb = pn * 256 + wc * 32 + 8 * fq;
        u32x4 gn[2], on[2], gc[2], oc[2];
#pragma unroll
        for (int bj = 0; bj < 2; ++bj) { gn[bj] = *(const u32x4*)(SG + (size_t)row0 * 2048 + which * 1024 + colb + bj * 128); on[bj] = (u32x4){0u, 0u, 0u, 0u};
            if (which) on[bj] = *(const u32x4*)(MP + (size_t)row0 * 1024 + colb + bj * 128); }
#pragma unroll
        for (int s = 0; s < 8; ++s) {
            const int ai = s >> 2, m = s & 3, row = row0 + ai * 128 + m * 16;
#pragma unroll
            for (int bj = 0; bj < 2; ++bj) { gc[bj] = gn[bj]; oc[bj] = on[bj]; }
            if (s < 7) { const int r1 = row0 + ((s + 1) >> 2) * 128 + ((s + 1) & 3) * 16;
#pragma unroll
                for (int bj = 0; bj < 2; ++bj) { gn[bj] = *(const u32x4*)(SG + (size_t)r1 * 2048 + which * 1024 + colb + bj * 128);
                    if (which) on[bj] = *(const u32x4*)(MP + (size_t)r1 * 1024 + colb + bj * 128); } }
#pragma unroll
            for (int bj = 0; bj < 2; ++bj) {
                float v[8];
#pragma unroll
                for (int i = 0; i < 4; ++i) {
                    v[2 * i] = __uint_as_float(gc[bj][i] << 16) * acc[ai][bj][m][i >> 1][(i & 1) * 2] + __uint_as_float(oc[bj][i] << 16);
                    v[2 * i + 1] = __uint_as_float(gc[bj][i] & 0xffff0000u) * acc[ai][bj][m][i >> 1][(i & 1) * 2 + 1] + __uint_as_float(oc[bj][i] & 0xffff0000u);
                }
                u32x4 w; w.x = pk2(v[0], v[1]); w.y = pk2(v[2], v[3]); w.z = pk2(v[4], v[5]); w.w = pk2(v[6], v[7]);
                if (which) store16_wt(M + (size_t)row * 1024 + colb + bj * 128, w); else *(u32x4*)(MP + (size_t)row * 1024 + colb + bj * 128) = w;
            }
        }
    }
};
struct SchedMerge1 {
    int G, c, pm0; unsigned char* ws; int l;
    DI bool next(int i, pg8::Unit& u) const {
        const int tl = (i >> 1) * G + c; if (tl >= (68 - pm0) * 4) return false;
        const int which = i & 1; u.pm = pm0 + (tl >> 2) + 68 * which; u.pn = (tl & 3) + 4 * which; return true;
    }
    DI void a_ready(const pg8::Unit&) const {}
    DI void done(const pg8::Unit& u) const { if (u.pm >= 68) panel_publish(panel_word(ws, l, 0, u.pm - 68)); }
};
struct SchedWoWait {
    int G, c, pm0; unsigned char* ws; int l;
    DI bool next(int i, pg8::Unit& u) const {
        int tl;
        if (i == 0) tl = c; else if (i == 1 && c >= 16 && c < 32) tl = G + (c - 16); else return false;
        if (tl >= (68 - pm0) * 4) return false;
        u.pm = pm0 + (tl >> 2); u.pn = tl & 3; return true;
    }
    DI void a_ready(const pg8::Unit& u) const { panel_wait(panel_word(ws, l, 0, u.pm), 32u); }
    DI void done(const pg8::Unit&) const {}
};
struct SchedRows {
    int G, c, pm0, nN;
    DI bool next(int i, pg8::Unit& u) const { const int tl = i * G + c; if (tl >= (68 - pm0) * nN) return false; u.pm = pm0 + tl / nN; u.pn = tl % nN; return true; }
    DI void a_ready(const pg8::Unit&) const {}
    DI void done(const pg8::Unit&) const {}
};
struct EpiWo {
    static constexpr bool PERM = false, AFTER_DRAIN = false;
    unsigned char* ws; int l; int rd;
    DI void operator()(const f32x4 (&acc)[2][2][4][2], const pg8::Unit& u, int wr, int wc, int fr, int fq) const {
        const float* X = (const float*)(ws + WS_X); float* XO = rd ? (float*)(ws + WS_GPRE) : (float*)(ws + WS_X);
        const float* mg = (const float*)(ws + WS_MODS) + (size_t)(l * 5 + unit_set(u.pm)) * 6144 + 2 * 1024;
        const int row0 = u.pm * 256 + wr * 64 + fr, col0 = u.pn * 256 + wc * 32 + 4 * fq;
        f32x4 gv[2][2];
#pragma unroll
        for (int bj = 0; bj < 2; ++bj)
#pragma unroll
            for (int n = 0; n < 2; ++n) gv[bj][n] = *(const f32x4*)(mg + col0 + bj * 128 + n * 16);
        f32x4 xc[2][2], xn[2][2];
        { const float* rowp = X + (size_t)row0 * 1024 + col0;
#pragma unroll
          for (int bj = 0; bj < 2; ++bj)
#pragma unroll
              for (int n = 0; n < 2; ++n) xn[bj][n] = *(const f32x4*)(rowp + bj * 128 + n * 16); }
#pragma unroll
        for (int s = 0; s < 8; ++s) {
            const int ai = s >> 2, m = s & 3;
#pragma unroll
            for (int bj = 0; bj < 2; ++bj)
#pragma unroll
                for (int n = 0; n < 2; ++n) xc[bj][n] = xn[bj][n];
            if (s < 7) { const int ai1 = (s + 1) >> 2, m1 = (s + 1) & 3; const float* rp = X + (size_t)(row0 + ai1 * 128 + m1 * 16) * 1024 + col0;
#pragma unroll
                for (int bj = 0; bj < 2; ++bj)
#pragma unroll
                    for (int n = 0; n < 2; ++n) xn[bj][n] = *(const f32x4*)(rp + bj * 128 + n * 16); }
            float* rowp = XO + (size_t)(row0 + ai * 128 + m * 16) * 1024 + col0;
#pragma unroll
            for (int bj = 0; bj < 2; ++bj)
#pragma unroll
                for (int n = 0; n < 2; ++n) *(f32x4*)(rowp + bj * 128 + n * 16) = ALPHA * xc[bj][n] + gv[bj][n] * acc[ai][bj][m][n];
        }
    }
};
struct SchedMoe {
    int G, c, ntiles; const int* tile_e; unsigned char* ws; int l, mode;
    DI bool next(int i, pg8::Unit& u) const {
        int x;
        if (mode != 2 || G != 256) x = i * G + c;
        else {
            if (c < 64) { if (i > 0) return false; x = c; }
            else if (c < 192) { if (i > 2) return false; x = c + 128 * i; }
            else x = 448 + (c - 192) + 64 * i;
        }
        if (x >= ntiles * 4) return false;
        u.pm = x >> 2; u.pn = tile_e[x >> 2] * 4 + (x & 3); return true;
    }
    DI void a_ready(const pg8::Unit& u) const { if (mode == 2) panel_wait(panel_word(ws, l, 1, u.pm), 32u); }
    DI void done(const pg8::Unit& u) const { if (mode == 1) panel_publish(panel_word(ws, l, 1, u.pm)); }
};
struct EpiUp {
    static constexpr bool PERM = true, AFTER_DRAIN = false;
    unsigned char* ws;
    DI void operator()(const f32x4 (&acc)[2][2][4][2], const pg8::Unit& u, int wr, int wc, int fr, int fq) const {
        bf16_t* ACT = (bf16_t*)(ws + WS_ACT);
        const int j = u.pn & 3; const int row0 = u.pm * 256 + wr * 64 + fr; const int col = j * 128 + wc * 32 + 8 * fq;
#pragma unroll
        for (int ai = 0; ai < 2; ++ai)
#pragma unroll
            for (int m = 0; m < 4; ++m) {
                float v[8];
#pragma unroll
                for (int n = 0; n < 2; ++n)
#pragma unroll
                    for (int i = 0; i < 4; ++i) v[4 * n + i] = siluf_(acc[ai][0][m][n][i]) * acc[ai][1][m][n][i];
                u32x4 w; w.x = pk2(v[0], v[1]); w.y = pk2(v[2], v[3]); w.z = pk2(v[4], v[5]); w.w = pk2(v[6], v[7]);
                store16_wt(ACT + (size_t)(row0 + ai * 128 + m * 16) * 512 + col, w);
            }
    }
};
struct EpiDown {
    static constexpr bool PERM = true, AFTER_DRAIN = false;
    unsigned char* ws;
    DI void operator()(const f32x4 (&acc)[2][2][4][2], const pg8::Unit& u, int wr, int wc, int fr, int fq) const {
        bf16_t* YS = (bf16_t*)(ws + WS_YS); const int* SLOTA = (const int*)(ws + WS_SLOTA);
        const int j = u.pn & 3; const int row0 = u.pm * 256 + wr * 64 + fr;
        int asv[2][4];
#pragma unroll
        for (int ai = 0; ai < 2; ++ai)
#pragma unroll
            for (int m = 0; m < 4; ++m) asv[ai][m] = SLOTA[row0 + ai * 128 + m * 16];
#pragma unroll
        for (int ai = 0; ai < 2; ++ai)
#pragma unroll
            for (int m = 0; m < 4; ++m) {
                const int as = asv[ai][m];
                if (as >= 0) {
#pragma unroll
                    for (int bj = 0; bj < 2; ++bj) {
                        const f32x4 v0 = acc[ai][bj][m][0], v1 = acc[ai][bj][m][1];
                        u32x4 w; w.x = pk2(v0[0], v0[1]); w.y = pk2(v0[2], v0[3]); w.z = pk2(v1[0], v1[1]); w.w = pk2(v1[2], v1[3]);
                        *(u32x4*)(YS + (size_t)as * 1024 + j * 256 + bj * 128 + wc * 32 + 8 * fq) = w;
                    }
                }
            }
    }
};


typedef short s16x4 __attribute__((ext_vector_type(4)));
#define MFMA32(a, b, c) __builtin_amdgcn_mfma_f32_32x32x16_bf16((a), (b), (c), 0, 0, 0)
DI int crow(int i, int hl) { return (i & 3) + 8 * (i >> 2) + 4 * hl; }
DI bf16x8 pack8(const f32x16& x, int s) {
    u32x4 p; p.x = pk2(x[8 * s], x[8 * s + 1]); p.y = pk2(x[8 * s + 2], x[8 * s + 3]); p.z = pk2(x[8 * s + 4], x[8 * s + 5]); p.w = pk2(x[8 * s + 6], x[8 * s + 7]);
    return __builtin_bit_cast(bf16x8, p);
}
DI s16x4 tr_read(const LAS unsigned char* p) { return __builtin_bit_cast(s16x4, __builtin_amdgcn_ds_read_tr16_b64_v4i16((LAS s16x4*)p)); }
constexpr int AT_KB = 9216, AT_VB = 16384, AT_K0 = 0, AT_V0 = 2 * AT_KB, AT_ST = 65536;

struct AttnIt { const bf16_t* kp; const bf16_t* vp; int kc0, kl0, nT; unsigned kdst, vdst0, kread, vread; };
template <int FAKE> DI void attn_iter(int t, const AttnIt& g, LAS unsigned char* lds, unsigned kA, unsigned kB, unsigned vA, unsigned vB, u32x4& rk, u32x4& rv0, u32x4& rv1,
                  f32x16 (&st)[2], f32x16 (&sn)[2], f32x16 (&o)[4], float& mrun, float& lrun, const bf16x8 (&qf)[4]) {
    const int kc0 = g.kc0, kl0 = g.kl0, nT = g.nT;
#define KROW(t_) ((t_) < 4 ? kc0 + 64 * (t_) : kl0 + 64 * ((t_) - 4))
    *(LAS u32x4*)(lds + kB + g.kdst) = rk; *(LAS u32x4*)(lds + vB + g.vdst0) = rv0; *(LAS u32x4*)(lds + vB + g.vdst0 + 2048) = rv1;
    { const int tk = (t + 3 < nT) ? t + 3 : nT - 1, tv = (t + 2 < nT) ? t + 2 : nT - 1;
      const int krk = KROW(tk), krv = KROW(tv);
      if (FAKE != 4) { rk = *(const u32x4*)(g.kp + (size_t)krk * 512); rv0 = *(const u32x4*)(g.vp + (size_t)krv * 512); rv1 = *(const u32x4*)(g.vp + (size_t)(krv + 32) * 512); } }
#undef KROW
    const LAS unsigned char* kb = lds + kA + g.kread;
    const LAS unsigned char* vb = lds + vA + g.vread;
    bf16x8 kf[4];
#pragma unroll
    for (int x = 0; x < 4; ++x) kf[x] = *(const LAS bf16x8*)(kb + (x & 1) * 32 * 144 + (x >> 1) * 32);
    s16x4 lo[2][2], hi[2][2];
#pragma unroll
    for (int k2 = 0; k2 < 2; ++k2) { lo[0][k2] = tr_read(vb + k2 * 4096); hi[0][k2] = tr_read(vb + k2 * 4096 + 512); }
    float mx = fmaxf(fmaxf(st[0][0], st[0][1]), st[0][2]);
#pragma unroll
    for (int i = 3; i < 15; i += 2) mx = fmaxf(fmaxf(mx, st[0][i]), st[0][i + 1]);
    mx = fmaxf(mx, st[0][15]);
#pragma unroll
    for (int i = 0; i < 16; i += 2) mx = fmaxf(fmaxf(mx, st[1][i]), st[1][i + 1]);
    { auto rr = __builtin_amdgcn_permlane32_swap(__float_as_uint(mx), __float_as_uint(mx), false, false); mx = fmaxf(__uint_as_float(rr[0]), __uint_as_float(rr[1])); }
    const float mnew = fmaxf(mrun, mx), alpha = __builtin_amdgcn_exp2f(mrun - mnew);
    mrun = mnew;
    float ps = 0.f;
    __builtin_amdgcn_sched_barrier(0);
#pragma unroll
    for (int x = 0; x < 8; ++x) {
        if (FAKE == 5) { sn[x & 1] = st[x & 1]; } else
        if (x < 2) { f32x16 z;
#pragma unroll
            for (int i = 0; i < 16; ++i) z[i] = 0.f;
            sn[x & 1] = MFMA32(kf[x & 3], qf[x >> 1], z); }
        else sn[x & 1] = MFMA32(kf[x & 3], qf[x >> 1], sn[x & 1]);
        if (x < 4) kf[x] = *(const LAS bf16x8*)(kb + (x & 1) * 32 * 144 + ((x + 4) >> 1) * 32);
#pragma unroll
        for (int e = 0; e < 4; ++e) { const int i = 4 * (x & 3) + e, kt = x >> 2; const float p = FAKE == 2 ? (st[kt][i] - mnew) : __builtin_amdgcn_exp2f(st[kt][i] - mnew); st[kt][i] = p; ps += p; }
        __builtin_amdgcn_sched_barrier(0);
    }
    lrun = lrun * alpha + ps;
    bf16x8 pb[4];
#pragma unroll
    for (int ks = 0; ks < 4; ++ks) pb[ks] = pack8(st[ks >> 1], ks & 1);
#pragma unroll
    for (int i = 0; i < 16; ++i) { if (FAKE != 7) { o[0][i] *= alpha; o[1][i] *= alpha; } }
    __builtin_amdgcn_sched_barrier(0);
#pragma unroll
    for (int u = 0; u < (FAKE == 3 ? 0 : 8); ++u) {
        const int ks = u >> 1, dp = u & 1;
        if (u < 7) {
            const int ks1 = (u + 1) >> 1, dp1 = (u + 1) & 1;
#pragma unroll
            for (int k2 = 0; k2 < 2; ++k2) { lo[(u + 1) & 1][k2] = tr_read(vb + (2 * dp1 + k2) * 4096 + ks1 * 1024); hi[(u + 1) & 1][k2] = tr_read(vb + (2 * dp1 + k2) * 4096 + ks1 * 1024 + 512); }
        }
#pragma unroll
        for (int k2 = 0; k2 < 2; ++k2) {
            const int d = 2 * dp + k2;
            const bf16x8 vf = (bf16x8){lo[u & 1][k2][0], lo[u & 1][k2][1], lo[u & 1][k2][2], lo[u & 1][k2][3], hi[u & 1][k2][0], hi[u & 1][k2][1], hi[u & 1][k2][2], hi[u & 1][k2][3]};
            o[d] = MFMA32(vf, pb[ks], o[d]);
            if (u == 0 && FAKE != 7) {
#pragma unroll
                for (int e = 0; e < 16; ++e) o[2 + k2][e] *= alpha;
            }
        }
        __builtin_amdgcn_sched_barrier(0);
    }
    if (FAKE != 6) __syncthreads();
}
constexpr int AT3_K = 0, AT3_V = 3 * AT_KB;
template <int FAKE> DI void attn_unit(const Args& a, int l, int h, int qrow0, int nT, int kc0, int kl0, float lam, LAS unsigned char* lds) {
    const int tid = tidx(), lane = tid & 63, wid = tid >> 6, r = lane & 31, hl = lane >> 5;
    const bf16_t* QA = (const bf16_t*)(a.ws + WS_QA); const bf16_t* KA = (const bf16_t*)(a.ws + WS_KA); const bf16_t* VA = (const bf16_t*)(a.ws + WS_VA);
    const int qrow = qrow0 + 32 * wid + r;
    const int kkey = tid >> 3, kch = tid & 7;
    const unsigned kdst = (unsigned)(kkey * 144 + kch * 16);
    const int vkey0 = tid >> 4, vch = tid & 15;
    const unsigned vdst0 = (unsigned)((vch >> 2) * 4096 + vkey0 * 64 + (vch & 3) * 16);
    const unsigned kread = (unsigned)(r * 144 + hl * 16);
    const unsigned vread = (unsigned)(((lane >> 4) & 1) * 32 + (lane & 3) * 8 + (4 * hl + ((lane & 15) >> 2)) * 64);
#define KROW(t_) ((t_) < 4 ? kc0 + 64 * (t_) : kl0 + 64 * ((t_) - 4))
#pragma unroll 1
    for (int comp = 0; comp < 2; ++comp) {
        bf16x8 qf[4];
#pragma unroll
        for (int s = 0; s < 4; ++s) qf[s] = *(const bf16x8*)(QA + (size_t)qrow * 512 + h * 128 + comp * 64 + 16 * s + 8 * hl);
        f32x16 o[4];
#pragma unroll
        for (int d = 0; d < 4; ++d)
#pragma unroll
            for (int i = 0; i < 16; ++i) o[d][i] = 0.f;
        float mrun = -1e30f, lrun = 0.f;
        const bf16_t* kp = KA + (size_t)kkey * 512 + h * 128 + comp * 64 + kch * 8;
        const bf16_t* vp = VA + (size_t)vkey0 * 512 + h * 128 + vch * 8;
        u32x4 rk, rv0, rv1;
        {
            const int kr0 = KROW(0), kr1 = KROW(1), kr2 = KROW(2);
            const u32x4 k0 = *(const u32x4*)(kp + (size_t)kr0 * 512), k1 = *(const u32x4*)(kp + (size_t)kr1 * 512);
            const u32x4 v0 = *(const u32x4*)(vp + (size_t)kr0 * 512), v1 = *(const u32x4*)(vp + (size_t)(kr0 + 32) * 512);
            rk = *(const u32x4*)(kp + (size_t)kr2 * 512); rv0 = *(const u32x4*)(vp + (size_t)kr1 * 512); rv1 = *(const u32x4*)(vp + (size_t)(kr1 + 32) * 512);
            *(LAS u32x4*)(lds + AT3_K + kdst) = k0; *(LAS u32x4*)(lds + AT3_K + AT_KB + kdst) = k1;
            *(LAS u32x4*)(lds + AT3_V + vdst0) = v0; *(LAS u32x4*)(lds + AT3_V + vdst0 + 2048) = v1;
        }
        __syncthreads();
        f32x16 st[2];
#pragma unroll
        for (int kt = 0; kt < 2; ++kt) {
#pragma unroll
            for (int i = 0; i < 16; ++i) st[kt][i] = 0.f;
#pragma unroll
            for (int s = 0; s < 4; ++s) st[kt] = MFMA32(*(const LAS bf16x8*)(lds + AT3_K + kread + kt * 32 * 144 + s * 32), qf[s], st[kt]);
        }
        unsigned kA = AT3_K + AT_KB, kB = AT3_K + 2 * AT_KB, kC = AT3_K;
        unsigned vA = AT3_V, vB = AT3_V + AT_VB, vC = AT3_V + 2 * AT_VB;
        const AttnIt geo{kp, vp, kc0, kl0, nT, kdst, vdst0, kread, vread};
        f32x16 sn[2];
#pragma unroll 1
        for (int t = 0; t < nT; t += 2) {
            attn_iter<FAKE>(t, geo, lds, kA, kB, vA, vB, rk, rv0, rv1, st, sn, o, mrun, lrun, qf);
            attn_iter<FAKE>(t + 1, geo, lds, kB, kC, vB, vC, rk, rv0, rv1, sn, st, o, mrun, lrun, qf);
            { const unsigned tk_ = kC; kC = kB; kB = kA; kA = tk_; const unsigned tv_ = vC; vC = vB; vB = vA; vA = tv_; }
        }
        const float ltot = lrun + __shfl_xor(lrun, 32);
        const float inv = 1.f / ltot;
        const int tid2 = tidx(), lane2 = tid2 & 63, wid2 = tid2 >> 6, hl2 = lane2 >> 5;
        const int qrow2 = qrow0 + 32 * wid2 + (lane2 & 31);
        unsigned char* stash = a.ws + WS_M + (size_t)blockIdx.x * 65536 + wid2 * 8192 + lane2 * 16;
        if (comp == 0) {
#pragma unroll
            for (int d = 0; d < 4; ++d) {
                u32x4 w0, w1;
                w0.x = pk2(o[d][0] * inv, o[d][1] * inv); w0.y = pk2(o[d][2] * inv, o[d][3] * inv); w0.z = pk2(o[d][4] * inv, o[d][5] * inv); w0.w = pk2(o[d][6] * inv, o[d][7] * inv);
                w1.x = pk2(o[d][8] * inv, o[d][9] * inv); w1.y = pk2(o[d][10] * inv, o[d][11] * inv); w1.z = pk2(o[d][12] * inv, o[d][13] * inv); w1.w = pk2(o[d][14] * inv, o[d][15] * inv);
                *(u32x4*)(stash + (2 * d) * 1024) = w0; *(u32x4*)(stash + (2 * d + 1) * 1024) = w1;
            }
        } else {
            bf16_t* YA = FAKE ? (bf16_t*)(a.ws + WS_GPRE) : (bf16_t*)(a.ws + WS_YAB);
            int l2_ = l; asm volatile("" : "+v"(l2_));
            const float li = lam_init_of(l2_);
            float ss = 0.f;
#pragma unroll
            for (int d = 0; d < 4; ++d) {
                const u32x4 on0 = *(const u32x4*)(stash + (2 * d) * 1024), on1s = *(const u32x4*)(stash + (2 * d + 1) * 1024);
#pragma unroll
                for (int k = 0; k < 4; ++k) {
                    const unsigned wa = on0[k], wb = on1s[k];
                    const float a0 = __uint_as_float(wa << 16), a1 = __uint_as_float(wa & 0xffff0000u), b0 = __uint_as_float(wb << 16), b1 = __uint_as_float(wb & 0xffff0000u);
                    o[d][2 * k] = a0 - lam * o[d][2 * k] * inv; o[d][2 * k + 1] = a1 - lam * o[d][2 * k + 1] * inv;
                    o[d][8 + 2 * k] = b0 - lam * o[d][8 + 2 * k] * inv; o[d][8 + 2 * k + 1] = b1 - lam * o[d][8 + 2 * k + 1] * inv;
                    ss += o[d][2 * k] * o[d][2 * k] + o[d][2 * k + 1] * o[d][2 * k + 1] + o[d][8 + 2 * k] * o[d][8 + 2 * k] + o[d][8 + 2 * k + 1] * o[d][8 + 2 * k + 1];
                }
            }
            ss += __shfl_xor(ss, 32);
            const float rs = rsqrtf(ss * (1.f / 128.f) + EPS) * (1.f - li);
            const float* sg = a.in[12] + l * 128;
#pragma unroll
            for (int d = 0; d < 4; ++d)
#pragma unroll
                for (int ig = 0; ig < 4; ++ig) {
                    const int dv0 = 32 * d + 8 * ig + 4 * hl2;
                    const f32x4 g4 = *(const f32x4*)(sg + dv0);
                    u32x2 w; w.x = pk2(o[d][4 * ig] * rs * g4[0], o[d][4 * ig + 1] * rs * g4[1]); w.y = pk2(o[d][4 * ig + 2] * rs * g4[2], o[d][4 * ig + 3] * rs * g4[3]);
                    *(u32x2*)(YA + (size_t)qrow2 * 512 + h * 128 + dv0) = w;
                }
        }
    }
#undef KROW
}
template <int FAKE> DI void ph_attn(const Args& a, int l, LAS unsigned char* lds) {
    const int ln_ = tidx() & 63;
    const float s1 = wave_sum(a.in[8][l * 64 + ln_] * a.in[9][l * 64 + ln_]), s2 = wave_sum(a.in[10][l * 64 + ln_] * a.in[11][l * 64 + ln_]);
    int l3_ = l; asm volatile("" : "+v"(l3_));
    const float lam = expf(s1) - expf(s2) + lam_init_of(l3_);
    const int G = gridDim.x, bx = blockIdx.x;
    const int vcu = (G % 8 == 0) ? (bx % 8) * (G / 8) + bx / 8 : bx;
    for (int u = vcu; u < 256; u += G) {
        const int bh = u >> 4, qt = u & 15, b = bh >> 2, h = bh & 3;
        attn_unit<FAKE>(a, l, h, NCTX + b * SEQ + qt * 256, 68, b * CTX, NCTX + b * SEQ, lam, lds);
    }
    if (l < DEPTH - 1) {
        if (G >= 80) { if (bx >= 64 && bx < 80) { const int u = bx - 64, b = u >> 2, h = u & 3; attn_unit<FAKE>(a, l, h, b * CTX, 4, b * CTX, 0, lam, lds); } }
        else for (int u = vcu; u < 16; u += G) { const int b = u >> 2, h = u & 3; attn_unit<FAKE>(a, l, h, b * CTX, 4, b * CTX, 0, lam, lds); }
    }
}


constexpr int GP_WN = 0, GP_QD = 8192, GP_KDT = 16384, GP_QK = 24576, GP_U = 28672, GP_REC = 36864;
DI int swap23(int p) { return (p & ~12) | ((p & 4) << 1) | ((p & 8) >> 1); }
DI int chunk_index(int dir, int b, int h, int cc) { return ((dir * 4 + b) * 4 + h) * 68 + cc; }
constexpr int G1_XS = 71680, G1_XST = 832, G1_WS = 71680 + 68 * 832;
constexpr int G1_QS = 0, G1_KS = 17408, G1_VS = 34816  , G1_GS = 71680, G1_QKS = 88064, G1_AT = 104448  , G1_SM = LDS_MISC + 256;
DI float* g1_sm(unsigned char* lds, int dir, int kind) { return (float*)(lds + G1_SM) + (dir * 5 + kind) * 64; }

#ifndef G1REP1
#define G1REP1 1
#endif
#ifndef G1REP6
#define G1REP6 1
#endif
#ifndef G1REP7
#define G1REP7 1
#endif
DI void g1_task(const Args& a, int l, int b, int h, int cc, unsigned char* lds, int cut = 0) {
    const int tid = tidx(), lane = tid & 63, wid = tid >> 6, r = lane & 31, hl = lane >> 5;
    const int s0 = cc < 4 ? b * CTX : NCTX + b * SEQ, len = cc < 4 ? CTX : SEQ, t0 = cc < 4 ? cc * 64 : (cc - 4) * 64;
    const bf16_t* QKV = (const bf16_t*)(a.ws + WS_QKV);
    const float* cw = a.in[7] + (size_t)l * 5 * 1536;
    if (wid < 2) {
        const int dir = wid, row = s0 + t0 + lane;
        const float* AB = (const float*)(a.ws + WS_AB);
        const float nal = -expf(a.in[13][l * 8 + dir * 4 + h]), dtb = a.in[14][l * 8 + dir * 4 + h];
        const float g = nal * softplusf_(AB[(size_t)row * 16 + dir * 4 + h] + dtb);
        const float beta = sigmoidf_(AB[(size_t)row * 16 + 8 + dir * 4 + h]);
        float c = g;
        if (dir == 0) {
#pragma unroll
            for (int o = 1; o < 64; o <<= 1) { const float v = __shfl_up(c, o); if (lane >= o) c += v; }
        } else {
#pragma unroll
            for (int o = 1; o < 64; o <<= 1) { const float v = __shfl_down(c, o); if (lane + o < 64) c += v; }
        }
        const float glref = __shfl(c, dir == 0 ? 63 : 0);
        const float eg = __expf(c);
        g1_sm(lds, dir, 0)[lane] = c; g1_sm(lds, dir, 1)[lane] = beta; g1_sm(lds, dir, 2)[lane] = beta * eg; g1_sm(lds, dir, 3)[lane] = __expf(glref - c); g1_sm(lds, dir, 4)[lane] = eg;
        if (lane == 0) ((float*)(a.ws + WS_GL))[chunk_index(dir, b, h, cc)] = __expf(glref);
    }
#pragma unroll 1
    for (int rep1_ = 0; rep1_ < G1REP1; ++rep1_) {
    {
        unsigned char* xs = lds + G1_XS; float* wsm = (float*)(lds + G1_WS);
        u32x4 xv[7];
#pragma unroll
        for (int it = 0; it < 7; ++it) {
            const int p = tid + 512 * it; const int pc = p < 68 * 48 ? p : 68 * 48 - 1;
            const int rr = pc / 48, q = pc - rr * 48, part = q >> 4, c8 = q & 15;
            const int tt = t0 + rr - 2; const int ttc = tt < 0 ? 0 : (tt >= len ? len - 1 : tt);
            xv[it] = *(const u32x4*)(QKV + (size_t)(s0 + ttc) * 1536 + part * 512 + h * 128 + c8 * 8);
            if (tt != ttc) xv[it] = (u32x4){0u, 0u, 0u, 0u};
        }
#pragma unroll
        for (int it = 0; it < 7; ++it) {
            const int p = tid + 512 * it;
            if (p < 68 * 48) { const int rr = p / 48, q = p - rr * 48, part = q >> 4, c8 = q & 15; *(u32x4*)(xs + rr * G1_XST + part * 256 + c8 * 16) = xv[it]; }
        }
        if (tid < 480) { const int j = tid / 96, q = tid - j * 96, part = q >> 5, c4 = q & 31;
            *(f32x4*)(wsm + j * 384 + part * 128 + c4 * 4) = *(const f32x4*)(cw + j * 1536 + part * 512 + h * 128 + c4 * 4); }
    }
    __syncthreads();
    if (cut == 3) return;
    {
        const int i = tid >> 3, sub = tid & 7;
        const unsigned char* xs = lds + G1_XS; const float* wsm = (const float*)(lds + G1_WS);
#pragma unroll
        for (int part = 0; part < 3; ++part) {
            float val[16];
#pragma unroll
            for (int cg = 0; cg < 2; ++cg) {
                const int d = cg * 64 + sub * 8;
                float acc[8];
#pragma unroll
                for (int e = 0; e < 8; ++e) acc[e] = 0.f;
#pragma unroll
                for (int j = 0; j < 5; ++j) {
                    {
                        const u32x4 x = *(const u32x4*)(xs + (i + j) * G1_XST + part * 256 + d * 2);
                        const f32x4 w0 = *(const f32x4*)(wsm + j * 384 + part * 128 + d), w1 = *(const f32x4*)(wsm + j * 384 + part * 128 + d + 4);
                        acc[0] += w0[0] * __uint_as_float(x[0] << 16); acc[1] += w0[1] * __uint_as_float(x[0] & 0xffff0000u);
                        acc[2] += w0[2] * __uint_as_float(x[1] << 16); acc[3] += w0[3] * __uint_as_float(x[1] & 0xffff0000u);
                        acc[4] += w1[0] * __uint_as_float(x[2] << 16); acc[5] += w1[1] * __uint_as_float(x[2] & 0xffff0000u);
                        acc[6] += w1[2] * __uint_as_float(x[3] << 16); acc[7] += w1[3] * __uint_as_float(x[3] & 0xffff0000u);
                    }
                }
#pragma unroll
                for (int e = 0; e < 8; ++e) val[cg * 8 + e] = (cut == 5) ? acc[e] : siluf_(acc[e]);
            }
            float scale = 1.f;
            if (part < 2) {
                float ss = 0.f;
#pragma unroll
                for (int e = 0; e < 16; ++e) ss += val[e] * val[e];
                ss += __shfl_xor(ss, 1); ss += __shfl_xor(ss, 2); ss += __shfl_xor(ss, 4);
                scale = rsqrtf(ss + EPS) * (part == 0 ? 0.08838834764831845f : 1.f);
            }
#pragma unroll
            for (int cg = 0; cg < 2; ++cg) {
                const int d = cg * 64 + sub * 8;
                bf16_t hv[8];
#pragma unroll
                for (int e = 0; e < 8; ++e) hv[e] = f2bf(val[cg * 8 + e] * scale);
                if (cut != 4 || scale == 123456.789f) {
                    u32x4 w; w.x = hv[0] | ((unsigned)hv[1] << 16); w.y = hv[2] | ((unsigned)hv[3] << 16); w.z = hv[4] | ((unsigned)hv[5] << 16); w.w = hv[6] | ((unsigned)hv[7] << 16);
                    *(u32x4*)(lds + (part == 0 ? G1_QS : (part == 1 ? G1_KS : G1_VS)) + i * 272 + d * 2) = w;
                }
            }
        }
    }
    }
    __syncthreads();
    if (cut == 1 || cut == 4 || cut == 5) return;
    {
        const int which = wid >> 2, mi = (wid >> 1) & 1, ni = wid & 1;
        const unsigned char* Ab = lds + (which ? G1_QS : G1_KS) + (32 * mi + r) * 272 + hl * 16;
        const unsigned char* Bb = lds + G1_KS + (32 * ni + r) * 272 + hl * 16;
        f32x16 acc;
#pragma unroll
        for (int i = 0; i < 16; ++i) acc[i] = 0.f;
#pragma unroll
        for (int s = 0; s < 8; ++s) acc = MFMA32(*(const bf16x8*)(Ab + s * 32), *(const bf16x8*)(Bb + s * 32), acc);
        float* O = (float*)(lds + (which ? G1_QKS : G1_GS));
#pragma unroll
        for (int i = 0; i < 16; ++i) O[(32 * mi + crow(i, hl)) * 64 + 32 * ni + r] = acc[i];
    }
    __syncthreads();
    {
        const float* GS = (const float*)(lds + G1_GS);
#pragma unroll 4
        for (int x = tid; x < 2 * 4096; x += 512) {
            const int dir = x >> 12, i = (x >> 6) & 63, j = x & 63;
            const float* gc = g1_sm(lds, dir, 0);
            const bool before = dir == 0 ? (j < i) : (j > i);
            const float v = before ? g1_sm(lds, dir, 1)[i] * GS[i * 64 + j] * __expf(gc[i] - gc[j]) : 0.f;
            if (dir == 0) ((float*)(lds + G1_AT))[i * 68 + j] = v; else ((float*)(lds + G1_AT + 17408))[(63 - i) * 68 + (63 - j)] = v;
        }
    }
    __syncthreads();
    if (cut == 2) return;
    if (wid < 2) {
        float* T = (float*)(lds + G1_AT + wid * 17408);
        float t[64];
        f32x4 ra[2][16];
        t[0] = (lane == 0) ? 1.f : 0.f;
        ra[1][0] = *(const f32x4*)(T + 1 * 68);
#pragma unroll
        for (int i = 1; i < 64; ++i) {
            const int c = i & 1, nx = c ^ 1;
            if (i < 63) {
#pragma unroll
                for (int j4 = 0; j4 * 4 < i + 1; ++j4) ra[nx][j4] = *(const f32x4*)(T + (i + 1) * 68 + 4 * j4);
            }
            float ac[4] = {(lane == i) ? 1.f : 0.f, 0.f, 0.f, 0.f};
#pragma unroll
            for (int j4 = 0; j4 * 4 < i; ++j4) {
#pragma unroll
                for (int e = 0; e < 4; ++e) if (4 * j4 + e < i) ac[e] -= ra[c][j4][e] * t[4 * j4 + e];
            }
            t[i] = (ac[0] + ac[1]) + (ac[2] + ac[3]);
        }
#pragma unroll
        for (int i = 0; i < 64; ++i) T[i * 68 + lane] = t[i];
    } else {
        bf16_t* rec0e = (bf16_t*)(a.ws + WS_GPRE);
#pragma unroll
        for (int it2 = 0; it2 < 12; ++it2) {
            const int kind = it2 >> 1, x = (tid - 128) + 384 * (it2 & 1), dir = kind >= 3 ? 1 : 0, kk = kind - 3 * dir;
            if (x >= 512) continue;
            bf16_t* rec = rec0e + (size_t)chunk_index(dir, b, h, cc) * GP_REC;
            const float* gc = g1_sm(lds, dir, 0); const float* ekd = g1_sm(lds, dir, 3); const float* eg = g1_sm(lds, dir, 4);
            if (kk == 0) {
                const int c = x >> 3, g16 = x & 7;
                const u32x4 x0 = *(const u32x4*)(lds + G1_QS + c * 272 + g16 * 32), x1 = *(const u32x4*)(lds + G1_QS + c * 272 + g16 * 32 + 16);
                const unsigned pm[8] = {x0.x, x0.y, x1.x, x1.y, x0.z, x0.w, x1.z, x1.w};
                const float sc = eg[c];
                u32x4 o0, o1;
                o0.x = pk2(__uint_as_float(pm[0] << 16) * sc, __uint_as_float(pm[0] & 0xffff0000u) * sc); o0.y = pk2(__uint_as_float(pm[1] << 16) * sc, __uint_as_float(pm[1] & 0xffff0000u) * sc);
                o0.z = pk2(__uint_as_float(pm[2] << 16) * sc, __uint_as_float(pm[2] & 0xffff0000u) * sc); o0.w = pk2(__uint_as_float(pm[3] << 16) * sc, __uint_as_float(pm[3] & 0xffff0000u) * sc);
                o1.x = pk2(__uint_as_float(pm[4] << 16) * sc, __uint_as_float(pm[4] & 0xffff0000u) * sc); o1.y = pk2(__uint_as_float(pm[5] << 16) * sc, __uint_as_float(pm[5] & 0xffff0000u) * sc);
                o1.z = pk2(__uint_as_float(pm[6] << 16) * sc, __uint_as_float(pm[6] & 0xffff0000u) * sc); o1.w = pk2(__uint_as_float(pm[7] << 16) * sc, __uint_as_float(pm[7] & 0xffff0000u) * sc);
                u32x4* dp = (u32x4*)(rec + GP_QD + c * 128 + g16 * 16); dp[0] = o0; dp[1] = o1;
            } else if (kk == 1) {
                const int dk = x >> 2, g16 = x & 3;
                const bf16_t* kp = (const bf16_t*)(lds + G1_KS) + dk + (g16 * 16) * 136;
                unsigned ow[8];
#pragma unroll
                for (int q = 0; q < 8; ++q) {
                    const int p0 = 2 * q, p1 = 2 * q + 1; const int c0 = swap23(p0), c1 = swap23(p1);
                    ow[q] = pk2(bf2f(kp[c0 * 136]) * ekd[16 * g16 + c0], bf2f(kp[c1 * 136]) * ekd[16 * g16 + c1]);
                }
                u32x4* dp = (u32x4*)(rec + GP_KDT + dk * 64 + g16 * 16);
                dp[0] = (u32x4){ow[0], ow[1], ow[2], ow[3]}; dp[1] = (u32x4){ow[4], ow[5], ow[6], ow[7]};
            } else {
                const int i = x >> 3, sub = x & 7;
                const float* QKm = (const float*)(lds + G1_QKS) + i * 64;
                const float gi = gc[i];
                unsigned ow[4];
#pragma unroll
                for (int q = 0; q < 4; ++q) {
                    float v[2];
#pragma unroll
                    for (int e = 0; e < 2; ++e) {
                        const int jp = 8 * sub + 2 * q + e, j = (jp & ~15) + swap23(jp & 15);
                        const bool ok = dir == 0 ? (j <= i) : (j >= i);
                        v[e] = ok ? QKm[j] * __expf(gi - gc[j]) : 0.f;
                    }
                    ow[q] = pk2(v[0], v[1]);
                }
                *(u32x4*)(rec + GP_QK + i * 64 + 8 * sub) = (u32x4){ow[0], ow[1], ow[2], ow[3]};
            }
        }
    }
    __syncthreads();
    bf16_t* rec0 = (bf16_t*)(a.ws + WS_GPRE);
#pragma unroll 1
    for (int rep6_ = 0; rep6_ < G1REP6; ++rep6_) {
    {
        const int dir = wid >> 2, n = wid & 3;
        bf16_t* rec = rec0 + (size_t)chunk_index(dir, b, h, cc) * GP_REC;
        const float* T = (const float*)(lds + G1_AT + dir * 17408);
        f32x4 tq[2][4][2];
        f32x4 c1[4][2], c2[4][2];
        bf16x8 bv[4], bk[4];
#pragma unroll
        for (int s = 0; s < 4; ++s) {
            const float* p1 = g1_sm(lds, dir, 1) + 16 * s + 8 * hl; const float* p2 = g1_sm(lds, dir, 2) + 16 * s + 8 * hl;
            c1[s][0] = *(const f32x4*)p1; c1[s][1] = *(const f32x4*)(p1 + 4); c2[s][0] = *(const f32x4*)p2; c2[s][1] = *(const f32x4*)(p2 + 4);
            {
                const unsigned toff = (unsigned)((16 * s + 8 * hl + ((lane & 15) >> 2)) * 272 + (32 * n + 16 * ((lane >> 4) & 1)) * 2 + 8 * (lane & 3));
                const s16x4 v0 = tr_read((const LAS unsigned char*)lds + G1_VS + toff), v1 = tr_read((const LAS unsigned char*)lds + G1_VS + toff + 4 * 272);
                const s16x4 k0 = tr_read((const LAS unsigned char*)lds + G1_KS + toff), k1 = tr_read((const LAS unsigned char*)lds + G1_KS + toff + 4 * 272);
                bv[s] = (bf16x8){v0[0], v0[1], v0[2], v0[3], v1[0], v1[1], v1[2], v1[3]};
                bk[s] = (bf16x8){k0[0], k0[1], k0[2], k0[3], k1[0], k1[1], k1[2], k1[3]};
            }
#pragma unroll
            for (int m = 0; m < 2; ++m) {
                if (dir == 0) { const float* tp = T + (32 * m + r) * 68 + 16 * s + 8 * hl; tq[m][s][0] = *(const f32x4*)tp; tq[m][s][1] = *(const f32x4*)(tp + 4); }
                else { const float* tp = T + (63 - (32 * m + r)) * 68 + 56 - 16 * s - 8 * hl; const f32x4 x0 = *(const f32x4*)tp, x1 = *(const f32x4*)(tp + 4);
                       tq[m][s][0] = (f32x4){x1[3], x1[2], x1[1], x1[0]}; tq[m][s][1] = (f32x4){x0[3], x0[2], x0[1], x0[0]}; }
            }
        }
#pragma unroll
        for (int prod = 0; prod < 2; ++prod) {
#pragma unroll
            for (int m = 0; m < 2; ++m) {
                f32x16 acc;
#pragma unroll
                for (int i = 0; i < 16; ++i) acc[i] = 0.f;
#pragma unroll
                for (int s = 0; s < 4; ++s) {
                    const f32x4 ta = tq[m][s][0], tb = tq[m][s][1];
                    const f32x4 ca = prod == 0 ? c1[s][0] : c2[s][0], cb = prod == 0 ? c1[s][1] : c2[s][1];
                    u32x4 aw; aw.x = pk2(ta[0] * ca[0], ta[1] * ca[1]); aw.y = pk2(ta[2] * ca[2], ta[3] * ca[3]); aw.z = pk2(tb[0] * cb[0], tb[1] * cb[1]); aw.w = pk2(tb[2] * cb[2], tb[3] * cb[3]);
                    acc = MFMA32(__builtin_bit_cast(bf16x8, aw), prod == 0 ? bv[s] : bk[s], acc);
                }
                if (prod == 0) {
                    u32x4 w0, w1;
                    w0.x = pk2(acc[0], acc[1]); w0.y = pk2(acc[2], acc[3]); w0.z = pk2(acc[4], acc[5]); w0.w = pk2(acc[6], acc[7]);
                    w1.x = pk2(acc[8], acc[9]); w1.y = pk2(acc[10], acc[11]); w1.z = pk2(acc[12], acc[13]); w1.w = pk2(acc[14], acc[15]);
                    u32x4* up = (u32x4*)(rec + GP_U + ((m * 4 + n) * 64 + lane) * 16);
                    up[0] = w0; up[1] = w1;
                } else {
                    const int dkp = 32 * n + (r & 16) + swap23(r & 15);
#pragma unroll
                    for (int i = 0; i < 16; ++i) rec[GP_WN + (32 * m + crow(i, hl)) * 128 + dkp] = f2bf(-acc[i]);
                }
            }
        }
    }
    }
    __syncthreads();
}
DI void ph_g1(const Args& a, int l, unsigned char* lds, int cut = 0) {
#pragma unroll 1
    for (int task = blockIdx.x; task < 16 * 68; task += gridDim.x) {
        const int bh = task / 68, cc = task % 68;
        g1_task(a, l, bh >> 2, bh & 3, cc, lds, cut);
    }
}

#ifndef PROBE_SCAN_FAKE
#define PROBE_SCAN_FAKE 0
#endif
constexpr int SC_WN = 0, SC_QD = 16384, SC_KDT = 32768, SC_QK = 49152, SC_BUF = 57344, SC_GL = 2 * SC_BUF;
DI int scan_cc(int dir, int step) { return dir == 0 ? step : (step < 4 ? 3 - step : 71 - step); }
DI unsigned scan_src_off(int p) {
    if (p < 2048) { const int row = (p & 1023) >> 4, s16 = p & 15; return (unsigned)((p >> 10) * 16384 + row * 256 + ((s16 ^ (row & 15)) << 4)); }
    const int q = p - 2048, row = q >> 3, s8 = q & 7;
    return (unsigned)(32768 + row * 128 + ((s8 ^ ((row >> 1) & 7)) << 4));
}
#define SCAN_BAR() asm volatile("s_barrier" ::: "memory")
DI void scan_block(const Args& a, int l, int dir, int b, int h, unsigned char* lds, int fake = 0) {
    const int tid = tidx(), lane = tid & 63, wid = tid >> 6, r = lane & 31, hl = lane >> 5;
    const bf16_t* rec0 = (const bf16_t*)(a.ws + WS_GPRE);
    const float* GL = (const float*)(a.ws + WS_GL);
    const bool loader = wid >= 4;
    const int n = wid & 3, lw = __builtin_amdgcn_readfirstlane(wid) - 4;
    bf16_t* OD = (bf16_t*)(a.ws + (dir ? WS_OB : WS_OF));
    f32x16 st[4];
#pragma unroll
    for (int t = 0; t < 4; ++t)
#pragma unroll
        for (int i = 0; i < 16; ++i) st[t][i] = 0.f;
    u32x4 un[4]; float gln = 0.f;
    unsigned swq[8], skq[6];
    if (loader) {
#pragma unroll
        for (int j = 0; j < 8; ++j) swq[j] = scan_src_off((lw * 8 + j) * 64 + lane);
#pragma unroll
        for (int j = 0; j < 6; ++j) skq[j] = scan_src_off(2048 + (lw * 6 + j) * 64 + lane);
    }
#define DMA_WQ(chunk_, bufsel_) do { const int c_ = (chunk_) < 68 ? (chunk_) : 67; const unsigned char* src_ = (const unsigned char*)(rec0 + (size_t)chunk_index(dir, b, h, scan_cc(dir, c_)) * GP_REC); \
        LAS unsigned char* nb_ = (LAS unsigned char*)lds + (bufsel_) * SC_BUF; \
        _Pragma("unroll") for (int j = 0; j < 8; ++j) __builtin_amdgcn_global_load_lds((const unsigned*)(src_ + swq[j]), (LAS unsigned*)(nb_ + (lw * 8 + j) * 1024), 16, 0, 0); } while (0)
#define DMA_KQ(chunk_, bufsel_) do { const int c_ = (chunk_) < 68 ? (chunk_) : 67; const unsigned char* src_ = (const unsigned char*)(rec0 + (size_t)chunk_index(dir, b, h, scan_cc(dir, c_)) * GP_REC); \
        LAS unsigned char* nb_ = (LAS unsigned char*)lds + (bufsel_) * SC_BUF; \
        _Pragma("unroll") for (int j = 0; j < 6; ++j) __builtin_amdgcn_global_load_lds((const unsigned*)(src_ + skq[j]), (LAS unsigned*)(nb_ + 32768 + (lw * 6 + j) * 1024), 16, 0, 0); } while (0)
    if (loader) {
        DMA_WQ(0, 0); DMA_KQ(0, 0); DMA_WQ(1, 1);
        asm volatile("s_waitcnt vmcnt(8)" ::: "memory");
    } else {
        const int ci = chunk_index(dir, b, h, scan_cc(dir, 0));
        const bf16_t* rec = rec0 + (size_t)ci * GP_REC;
#pragma unroll
        for (int m = 0; m < 2; ++m) { const u32x4* up = (const u32x4*)(rec + GP_U + ((m * 4 + n) * 64 + lane) * 16); un[2 * m] = up[0]; un[2 * m + 1] = up[1]; }
        gln = GL[ci];
    }
    SCAN_BAR();
#pragma unroll 1
    for (int step = 0; step < 68; ++step) {
        const int cur = step & 1;
        if (loader) {
            if (fake != 1) {
                DMA_KQ(step + 1, cur ^ 1);
                asm volatile("s_waitcnt vmcnt(14)" ::: "memory");
                SCAN_BAR();
                DMA_WQ(step + 2, cur);
                asm volatile("s_waitcnt vmcnt(14)" ::: "memory");
                SCAN_BAR();
            } else { SCAN_BAR(); SCAN_BAR(); }
        } else {
            if (fake != 2) {
            const int cc = scan_cc(dir, step);
            const int row0 = cc < 4 ? b * CTX + cc * 64 : NCTX + b * SEQ + (cc - 4) * 64;
            const unsigned char* buf = lds + cur * SC_BUF;
            const float gl = gln;
            const unsigned char* pwn = buf + SC_WN + r * 256;
            const unsigned char* pqd = buf + SC_QD + r * 256;
            const unsigned char* pqk = buf + SC_QK + r * 128;
            const unsigned char* pkd = buf + SC_KDT + r * 128;
            const int x16 = r & 15, x8 = (r >> 1) & 7;
#define FR256(base, tile, blk) (*(const bf16x8*)((base) + (tile) * 32 * 256 + ((((blk) ^ x16)) << 4)))
#define FR128(base, tile, blk) (*(const bf16x8*)((base) + (tile) * 32 * 128 + ((((blk) ^ x8)) << 4)))
            bf16x8 fa[2][4];
#pragma unroll
            for (int m = 0; m < 2; ++m) { fa[0][m] = FR256(pwn, m, hl); fa[0][2 + m] = FR256(pqd, m, hl); }
            f32x16 vn[2];
#pragma unroll
            for (int m = 0; m < 2; ++m) {
                const u32x4 u0 = un[2 * m], u1 = un[2 * m + 1];
#pragma unroll
                for (int k = 0; k < 4; ++k) { vn[m][2 * k] = __uint_as_float(u0[k] << 16); vn[m][2 * k + 1] = __uint_as_float(u0[k] & 0xffff0000u); vn[m][8 + 2 * k] = __uint_as_float(u1[k] << 16); vn[m][8 + 2 * k + 1] = __uint_as_float(u1[k] & 0xffff0000u); }
            }
            if (step + 1 < 68) {
                const int ci1 = chunk_index(dir, b, h, scan_cc(dir, step + 1));
                const bf16_t* rec = rec0 + (size_t)ci1 * GP_REC;
#pragma unroll
                for (int m = 0; m < 2; ++m) { const u32x4* up = (const u32x4*)(rec + GP_U + ((m * 4 + n) * 64 + lane) * 16); un[2 * m] = up[0]; un[2 * m + 1] = up[1]; }
                gln = GL[ci1];
            }
            f32x16 o[2];
#pragma unroll
            for (int m = 0; m < 2; ++m)
#pragma unroll
                for (int i = 0; i < 16; ++i) o[m][i] = 0.f;
#pragma unroll
            for (int kk = 0; kk < 8; ++kk) {
                const int c = kk & 1, nx = c ^ 1;
                if (kk < 7) {
#pragma unroll
                    for (int m = 0; m < 2; ++m) { fa[nx][m] = FR256(pwn, m, 2 * (kk + 1) + hl); fa[nx][2 + m] = FR256(pqd, m, 2 * (kk + 1) + hl); }
                }
                const bf16x8 sbk = pack8(st[kk >> 1], kk & 1);
#pragma unroll
                for (int m = 0; m < 2; ++m) { vn[m] = MFMA32(fa[c][m], sbk, vn[m]); o[m] = MFMA32(fa[c][2 + m], sbk, o[m]); }
            }
            asm volatile("s_waitcnt lgkmcnt(0)" ::: "memory");
            SCAN_BAR();
            bf16x8 fb[2][3];
            fb[0][0] = FR128(pqk, 0, hl); fb[0][1] = FR128(pqk, 1, hl); fb[0][2] = FR128(pkd, 0, hl);
#pragma unroll
            for (int t = 0; t < 4; ++t)
#pragma unroll
                for (int i = 0; i < 16; ++i) st[t][i] *= gl;
#pragma unroll
            for (int h2 = 0; h2 < 8; ++h2) {
                const int kk = h2 >> 1, part = h2 & 1, c = h2 & 1, nx = c ^ 1;
                if (h2 < 7) {
                    const int k1 = (h2 + 1) >> 1;
                    if (part == 0) {
#pragma unroll
                        for (int t = 1; t < 4; ++t) fb[nx][t - 1] = FR128(pkd, t, 2 * k1 + hl);
                    } else { fb[nx][0] = FR128(pqk, 0, 2 * k1 + hl); fb[nx][1] = FR128(pqk, 1, 2 * k1 + hl); fb[nx][2] = FR128(pkd, 0, 2 * k1 + hl); }
                }
                const bf16x8 vbk = pack8(vn[kk >> 1], kk & 1);
                if (part == 0) { o[0] = MFMA32(fb[c][0], vbk, o[0]); o[1] = MFMA32(fb[c][1], vbk, o[1]); st[0] = MFMA32(fb[c][2], vbk, st[0]); }
                else { st[1] = MFMA32(fb[c][0], vbk, st[1]); st[2] = MFMA32(fb[c][1], vbk, st[2]); st[3] = MFMA32(fb[c][2], vbk, st[3]); }
            }
#undef FR256
#undef FR128
#pragma unroll
            for (int m = 0; m < 2; ++m)
#pragma unroll
                for (int i = 0; i < 16; ++i) OD[(size_t)(row0 + 32 * m + crow(i, hl)) * 512 + h * 128 + 32 * n + r] = f2bf(o[m][i]);
            asm volatile("s_waitcnt lgkmcnt(0)" ::: "memory");
            SCAN_BAR();
            } else { SCAN_BAR(); SCAN_BAR(); }
        }
    }
    if (loader) asm volatile("s_waitcnt vmcnt(0)" ::: "memory");
    __syncthreads();
#undef DMA_WQ
#undef DMA_KQ
}
#undef SCAN_BAR
DI void ph_scan(const Args& a, int l, unsigned char* lds) {
    const int x = blockIdx.x;
#if PROBE_SCAN_FAKE
    scan_block(a, l, x >> 4, (x >> 2) & 3, x & 3, lds, PROBE_SCAN_FAKE); __syncthreads();
#endif
    scan_block(a, l, x >> 4, (x >> 2) & 3, x & 3, lds);
}


__global__ void __launch_bounds__(256) nv_inproj(Args a) {
    const int l = a.layer;
    const int row = blockIdx.y, cd = blockIdx.x * 256 + threadIdx.x;
    const int cs = cd < 3584 ? cd : cd + 16;
    const float* w = a.in[6] + (size_t)l * 1024 * N_IN;
    const bf16_t* hr = (const bf16_t*)(a.ws + WS_H) + (size_t)row * 1024;
    const bool isrope = (cd < 1024) && (row >= NCTX);
    const int cs2 = cs ^ 16;
    float acc = 0.f, acc2 = 0.f;
    for (int k = 0; k < 1024; ++k) { const float h = bf2f(hr[k]); acc += h * w[(size_t)k * N_IN + cs]; if (isrope) acc2 += h * w[(size_t)k * N_IN + cs2]; }
    if (cd < 1024) {
        float v = acc;
        if (isrope) {
            const float* rope = (const float*)(a.ws + WS_ROPE);
            const int t = (row - NCTX) & 4095, d = cd & 63, axis = (d >> 5) & 1, half = (d >> 4) & 1, f = d & 15;
            const int pos = axis ? (t & 63) : (t >> 6);
            const float c = rope[(pos * 16 + f) * 2], s = rope[(pos * 16 + f) * 2 + 1];
            v = half == 0 ? acc * c - acc2 * s : acc * c + acc2 * s;
        }
        if (cd < 512) ((bf16_t*)(a.ws + WS_QA))[(size_t)row * 512 + cd] = f2bf(v * QSCALE);
        else ((bf16_t*)(a.ws + WS_KA))[(size_t)row * 512 + cd - 512] = f2bf(v);
    } else if (cd < 1536) ((bf16_t*)(a.ws + WS_VA))[(size_t)row * 512 + cd - 1024] = f2bf(acc);
    else if (cd < 3072) ((bf16_t*)(a.ws + WS_QKV))[(size_t)row * 1536 + cd - 1536] = f2bf(acc);
    else if (cd < 3584) ((bf16_t*)(a.ws + WS_Z))[(size_t)row * 512 + cd - 3072] = f2bf(acc);
    else ((bf16_t*)(a.ws + WS_SG))[(size_t)row * 2048 + cd - 3584] = f2bf(sigmoidf_(acc));
}

__global__ void __launch_bounds__(256) nv_attn(Args a) {
    const int row = blockIdx.x * 256 + threadIdx.x;
    const int h = blockIdx.y >> 2, comp = (blockIdx.y >> 1) & 1, dh = blockIdx.y & 1;
    const bf16_t* QA = (const bf16_t*)(a.ws + WS_QA); const bf16_t* KA = (const bf16_t*)(a.ws + WS_KA); const bf16_t* VA = (const bf16_t*)(a.ws + WS_VA);
    float* ON = (float*)(a.ws + WS_ON);
    const bool isctx = row < NCTX;
    const int b = isctx ? (row >> 8) : ((row - NCTX) >> 12);
    float q[64];
    { const bf16_t* qp = QA + (size_t)row * 512 + h * 128 + comp * 64;
#pragma unroll
      for (int i = 0; i < 64; ++i) q[i] = bf2f(qp[i]); }
    float acc[64];
#pragma unroll
    for (int i = 0; i < 64; ++i) acc[i] = 0.f;
    float m = -1e30f, lsum = 0.f;
    const int nkeys = isctx ? CTX : CTX + SEQ;
    for (int kk = 0; kk < nkeys; ++kk) {
        const int kr = kk < CTX ? b * CTX + kk : NCTX + b * SEQ + (kk - CTX);
        const bf16_t* kp = KA + (size_t)kr * 512 + h * 128 + comp * 64;
        float s = 0.f;
#pragma unroll
        for (int i = 0; i < 64; ++i) s += q[i] * bf2f(kp[i]);
        const float mn = fmaxf(m, s), corr = exp2f(m - mn), p = exp2f(s - mn);
        lsum = lsum * corr + p; m = mn;
        const bf16_t* vp = VA + (size_t)kr * 512 + h * 128 + dh * 64;
#pragma unroll
        for (int i = 0; i < 64; ++i) acc[i] = acc[i] * corr + p * bf2f(vp[i]);
    }
    const float inv = 1.f / lsum;
    float* op = ON + ((size_t)comp * TT + row) * 512 + h * 128 + dh * 64;
#pragma unroll
    for (int i = 0; i < 64; ++i) op[i] = acc[i] * inv;
}
DI float lam_of(const Args& a, int l) {
    float s1 = 0.f, s2 = 0.f;
    for (int i = 0; i < 64; ++i) { s1 += a.in[8][l * 64 + i] * a.in[9][l * 64 + i]; s2 += a.in[10][l * 64 + i] * a.in[11][l * 64 + i]; }
    return expf(s1) - expf(s2) + lam_init_of(l);
}
__global__ void __launch_bounds__(256) nv_attn_combine(Args a) {
    const int l = a.layer;
    const int idx = blockIdx.x * 256 + threadIdx.x; if (idx >= TT * 4) return;
    const int row = idx >> 2, h = idx & 3;
    const float lam = lam_of(a, l), li = lam_init_of(l);
    const float* ON = (const float*)(a.ws + WS_ON);
    const float* o0 = ON + (size_t)row * 512 + h * 128; const float* o1 = ON + ((size_t)TT + row) * 512 + h * 128;
    float ss = 0.f;
    for (int i = 0; i < 128; ++i) { const float o = o0[i] - lam * o1[i]; ss += o * o; }
    const float r = rsqrtf(ss * (1.f / 128.f) + EPS) * (1.f - li);
    bf16_t* ya = (bf16_t*)(a.ws + WS_YAB) + (size_t)row * 512 + h * 128;
    const float* sg = a.in[12] + l * 128;
    for (int i = 0; i < 128; ++i) ya[i] = f2bf((o0[i] - lam * o1[i]) * r * sg[i]);
}
__global__ void __launch_bounds__(256) nv_conv(Args a) {
    const int l = a.layer;
    const int row = blockIdx.y, ch = blockIdx.x * 256 + threadIdx.x;
    const bf16_t* QKV = (const bf16_t*)(a.ws + WS_QKV); float* CO = (float*)(a.ws + WS_CONVO);
    const float* cw = a.in[7] + l * 5 * 1536;
    int s0, len; if (row < NCTX) { s0 = (row >> 8) << 8; len = CTX; } else { s0 = NCTX + (((row - NCTX) >> 12) << 12); len = SEQ; }
    const int t = row - s0; float acc = 0.f;
    for (int j = 0; j < 5; ++j) { const int tt = t + j - 2; if (tt >= 0 && tt < len) acc += cw[j * 1536 + ch] * bf2f(QKV[(size_t)(s0 + tt) * 1536 + ch]); }
    CO[(size_t)row * 1536 + ch] = siluf_(acc);
}
__global__ void __launch_bounds__(256) nv_norm(Args a) {
    const int idx = blockIdx.x * 256 + threadIdx.x; if (idx >= TT * 8) return;
    const int row = idx >> 3, h = (idx >> 1) & 3, which = idx & 1;
    float* p = (float*)(a.ws + WS_CONVO) + (size_t)row * 1536 + which * 512 + h * 128;
    float ss = 0.f; for (int i = 0; i < 128; ++i) ss += p[i] * p[i];
    const float r = rsqrtf(ss + EPS) * (which == 0 ? 0.08838834764831845f : 1.f);
    for (int i = 0; i < 128; ++i) p[i] *= r;
}
__global__ void __launch_bounds__(128) nv_scan(Args a) {
    const int l = a.layer;
    const int dir = blockIdx.x >> 4, b = (blockIdx.x >> 2) & 3, h = blockIdx.x & 3, e = threadIdx.x;
    __shared__ float sq[128], sk[128];
    const float* CO = (const float*)(a.ws + WS_CONVO); const float* AB = (const float*)(a.ws + WS_AB);
    bf16_t* OD = (bf16_t*)(a.ws + (dir ? WS_OB : WS_OF));
    const float nal = -expf(a.in[13][l * 8 + dir * 4 + h]), dtb = a.in[14][l * 8 + dir * 4 + h];
    float s[128];
#pragma unroll
    for (int d = 0; d < 128; ++d) s[d] = 0.f;
    for (int step = 0; step < CTX + SEQ; ++step) {
        int row;
        if (step < CTX) { const int t = dir ? (CTX - 1 - step) : step; row = b * CTX + t; }
        else { const int t = dir ? (SEQ - 1 - (step - CTX)) : (step - CTX); row = NCTX + b * SEQ + t; }
        __syncthreads();
        sq[e] = CO[(size_t)row * 1536 + h * 128 + e]; sk[e] = CO[(size_t)row * 1536 + 512 + h * 128 + e];
        const float v = CO[(size_t)row * 1536 + 1024 + h * 128 + e];
        __syncthreads();
        const float g = nal * softplusf_(AB[(size_t)row * 16 + dir * 4 + h] + dtb);
        const float av = expf(g), beta = sigmoidf_(AB[(size_t)row * 16 + 8 + dir * 4 + h]);
        float r = 0.f, qs = 0.f, qk = 0.f;
#pragma unroll
        for (int d = 0; d < 128; ++d) { r += sk[d] * s[d]; qs += sq[d] * s[d]; qk += sq[d] * sk[d]; }
        const float vn = beta * (v - av * r);
        const float o = av * qs + qk * vn;
#pragma unroll
        for (int d = 0; d < 128; ++d) s[d] = av * s[d] + sk[d] * vn;
        OD[(size_t)row * 512 + h * 128 + e] = f2bf(o);
    }
}
__global__ void __launch_bounds__(256) nv_merge1(Args a) {
    const int l = a.layer;
    const int row = blockIdx.y, c = blockIdx.x * 256 + threadIdx.x;
    const bf16_t* YA = (const bf16_t*)(a.ws + WS_YAB) + (size_t)row * 512; const bf16_t* YB = (const bf16_t*)(a.ws + WS_YAB) + ((size_t)TT + row) * 512;
    const float* wpa = a.in[16] + (size_t)l * 512 * 1024; const float* wpb = a.in[17] + (size_t)l * 512 * 1024;
    float pa = 0.f, pb = 0.f;
    for (int k = 0; k < 512; ++k) { pa += bf2f(YA[k]) * wpa[(size_t)k * 1024 + c]; pb += bf2f(YB[k]) * wpb[(size_t)k * 1024 + c]; }
    const bf16_t* SG = (const bf16_t*)(a.ws + WS_SG) + (size_t)row * 2048;
    ((bf16_t*)(a.ws + WS_M))[(size_t)row * 1024 + c] = f2bf(bf2f(SG[c]) * pa + bf2f(SG[1024 + c]) * pb);
}
__global__ void __launch_bounds__(256) nv_wo(Args a) {
    const int l = a.layer;
    const int row = blockIdx.y, c = blockIdx.x * 256 + threadIdx.x;
    const bf16_t* M = (const bf16_t*)(a.ws + WS_M) + (size_t)row * 1024; const float* wo = a.in[18] + (size_t)l * 1024 * 1024;
    float acc = 0.f;
    for (int k = 0; k < 1024; ++k) acc += bf2f(M[k]) * wo[(size_t)k * 1024 + c];
    float* X = (float*)(a.ws + WS_X) + (size_t)row * 1024 + c;
    const float* m = (const float*)(a.ws + WS_MODS) + (size_t)(l * 5 + mod_set(row)) * 6144;
    *X = ALPHA * *X + m[2 * 1024 + c] * acc;
}
__global__ void __launch_bounds__(256) nv_moe1(Args a) {
    const int l = a.layer;
    const int as = blockIdx.y, j = blockIdx.x * 256 + threadIdx.x;
    const int row = as >> 1; if (l == DEPTH - 1 && row < NCTX) return;
    const int e = ((const int*)(a.ws + WS_ROUTE_E))[as];
    const bf16_t* hr = (const bf16_t*)(a.ws + WS_H) + (size_t)row * 1024;
    const float* w1 = a.in[23] + ((size_t)l * 16 + e) * 1024 * 512; const float* w3 = a.in[24] + ((size_t)l * 16 + e) * 1024 * 512;
    float g = 0.f, u = 0.f;
    for (int k = 0; k < 1024; ++k) { const float hv = bf2f(hr[k]); g += hv * w1[(size_t)k * 512 + j]; u += hv * w3[(size_t)k * 512 + j]; }
    ((bf16_t*)(a.ws + WS_ACT))[(size_t)as * 512 + j] = f2bf(siluf_(g) * u);
}
__global__ void __launch_bounds__(256) nv_moe2(Args a) {
    const int l = a.layer;
    const int as = blockIdx.y, c = blockIdx.x * 256 + threadIdx.x;
    const int row = as >> 1; if (l == DEPTH - 1 && row < NCTX) return;
    const int e = ((const int*)(a.ws + WS_ROUTE_E))[as];
    const bf16_t* ar = (const bf16_t*)(a.ws + WS_ACT) + (size_t)as * 512;
    const float* w2 = a.in[25] + ((size_t)l * 16 + e) * 512 * 1024;
    float acc = 0.f;
    for (int k = 0; k < 512; ++k) acc += bf2f(ar[k]) * w2[(size_t)k * 1024 + c];
    ((bf16_t*)(a.ws + WS_YS))[(size_t)as * 1024 + c] = f2bf(acc);
}


enum Op { OP_MODS = 0, OP_CONVERT, OP_PREP0, OP_INPROJ, OP_ATTN_G1, OP_SCAN, OP_YB, OP_MERGE1, OP_WO, OP_LN1, OP_SLOT, OP_UP, OP_DOWN, OP_COMBINE, OP_NONE };
constexpr int NSTEP_PRE = 2, NSTEP_LAYER = 11, NSTEPS = NSTEP_PRE + NSTEP_LAYER * DEPTH;
__host__ __device__ inline void decode_step(int step, int& op, int& l) {
    if (step < NSTEP_PRE) { l = 0; op = step == 0 ? OP_MODS : OP_PREP0; return; }
    const int s = step - NSTEP_PRE; l = s / NSTEP_LAYER; op = OP_INPROJ + s % NSTEP_LAYER;
}

#ifndef PROBE_XBAR
#define PROBE_XBAR 0
#define XCD_RELABEL 1
#endif
#ifndef PROBE_WO2
#define PROBE_WO2 0
#endif
#ifndef PROBE_LN12
#define PROBE_LN12 0
#endif
#ifndef PROBE_CMB2
#define PROBE_CMB2 0
#endif
#ifndef PROBE_ATT2
#define PROBE_ATT2 0
#endif
#ifndef PROBE_G12
#define PROBE_G12 0
#endif
#ifndef PROBE_OP
#define PROBE_OP -1
#endif
#ifndef PROBE_N
#define PROBE_N 1
#endif
#ifndef PROBE_PAD
#define PROBE_PAD 7
#endif
#ifndef ONLY_OP
#define ONLY_OP -1
#endif
#define EN(o) (ONLY_OP < 0 || ONLY_OP == (o))
__global__ void __launch_bounds__(512, 2) mk(Args a_in) {
    extern __shared__ __attribute__((aligned(16))) unsigned char lds[];
    const int tid = threadIdx.x;
    volatile LAS unsigned* MISC = (volatile LAS unsigned*)((LAS unsigned char*)lds + LDS_MISC);
    if (tid < 64) MISC[tid] = 0u;
    __syncthreads();
    XcdBarrier bar; bar.bar = (unsigned*)(a_in.ws + WS_CTL) + 4096; bar.x = 0; bar.st = nullptr;
    if (a_in.hi - a_in.lo > 1) bar = xcd_barrier_post((unsigned*)(a_in.ws + WS_CTL) + 4096, MISC + 8);
    const int G = gridDim.x;
#pragma unroll 1
    for (int step = a_in.lo; step < a_in.hi; ++step) {
        int op, l; decode_step(step, op, l);
        if ((op == OP_WO || op == OP_DOWN) && (a_in.hi - a_in.lo > 1)) continue;
        Args a = a_in;
        { unsigned z; asm volatile("s_mov_b32 %0, 0" : "=s"(z)); a.ws = a_in.ws + z; a.out = a_in.out + z;
#pragma unroll
          for (int i = 0; i < 28; ++i) a.in[i] = a_in.in[i] + z; }
#if PROBE_OP >= 0
        const int nrep_ = (op == PROBE_OP) ? 1 + PROBE_N : 1;
#pragma unroll 1
        for (int rep_ = 0; rep_ < nrep_; ++rep_) {
        const int padm_ = (rep_ > 0) ? PROBE_PAD : 7;
        if (rep_ > 0) xcd_barrier(bar);
#else
        const int padm_ = 7;
        {
#endif
        const int vcu_ = (G == 256 && XCD_RELABEL) ? (((int)blockIdx.x & 7) * 32 + ((int)blockIdx.x >> 3)) : (int)blockIdx.x;
        if (EN(OP_MODS) && op == OP_MODS) {
            ph_mods(a, lds);
            { const int t_ = tidx(); convert_run(a, 0, -1, blockIdx.x * 8 + (t_ >> 6), G * 8, (float*)(lds + 40960 + (t_ >> 6) * 8704), t_ & 63); }
            __syncthreads();
        }
        else if (EN(OP_PREP0) && op == OP_PREP0) ph_prep0(a, lds);
        else if (EN(OP_INPROJ) && op == OP_INPROJ) {
            pg8::Gemm g{(const bf16_t*)(a.ws + WS_H), (const bf16_t*)(a.ws + WS_WIN), TT, NPROJ, 1024};
            pg8::StaticOrder S; S.init(TT, NPROJ, G, (int)blockIdx.x);
            EpiInproj E{a.ws};
            pg8::gemm_phase<EpiInproj, pg8::StaticOrder, true, true>((LAS unsigned char*)lds, g, S, E);
        }
        else if (EN(OP_ATTN_G1) && op == OP_ATTN_G1) {
            if (a_in.pad & padm_ & 1) {
#if PROBE_ATT2
                ph_attn<PROBE_ATT2>(a, l, (LAS unsigned char*)lds); __syncthreads();
#endif
                ph_attn<0>(a, l, (LAS unsigned char*)lds);
            }
            if (a_in.pad & padm_ & 2) {
#if PROBE_G12
                ph_g1(a, l, lds, PROBE_G12 - 1); __syncthreads();
#endif
                ph_g1(a, l, lds);
            }
        }
        else if (EN(OP_SCAN) && op == OP_SCAN) {
            const int t_ = tidx(), w_ = t_ >> 6;
            const bool scanner = (a_in.pad & 4) && blockIdx.x < 32;
            const bool do_conv_ = (padm_ & 8) || (padm_ == 7);
            if (scanner) { if (padm_ & 4) ph_scan(a, l, lds); }
            else {
                const int nscan = (a_in.pad & 4) ? 32 : 0;
                const int rank = ((int)blockIdx.x - nscan) * 8 + w_;
                if (do_conv_) convert_run(a, l + 1, l, rank, (G - nscan) * 8, (float*)(lds + w_ * 16384), t_ & 63);
            }
            __syncthreads();
        }
        else if (EN(OP_YB) && op == OP_YB) ph_yb(a, l);
        else if (EN(OP_MERGE1) && op == OP_MERGE1) {
            {
                pg8::Gemm g{(const bf16_t*)(a.ws + WS_YAB), (const bf16_t*)(a.ws + WS_WPAB), 2 * TT, 2048, 512};
                SchedMerge1 S{G, vcu_, l == DEPTH - 1 ? 4 : 0, a.ws, l};
                EpiMerge1 E{a.ws};
                pg8::gemm_phase<EpiMerge1, SchedMerge1, true, true>((LAS unsigned char*)lds, g, S, E);
            }
            {
                pg8::Gemm g{(const bf16_t*)(a.ws + WS_M), (const bf16_t*)(a.ws + WS_WO), TT, 1024, 1024};
                SchedWoWait S{G, vcu_, l == DEPTH - 1 ? 4 : 0, a.ws, l};
                EpiWo E{a.ws, l, 0};
                pg8::gemm_phase<EpiWo, SchedWoWait, true, true>((LAS unsigned char*)lds, g, S, E);
            }
        }
        else if (EN(OP_LN1) && op == OP_LN1) {
#if PROBE_LN12
            ph_ln1_router(a, l, lds, PROBE_LN12); __syncthreads();
#endif
            ph_ln1_router(a, l, lds);
        }
        else if (EN(OP_SLOT) && op == OP_SLOT) ph_slot(a, l, lds);
        else if (EN(OP_UP) && op == OP_UP) {
            const int* meta = (const int*)(a.ws + WS_META);
            const int ntl = meta[META_NT];
            {
                pg8::Gemm g{(const bf16_t*)(a.ws + WS_XS), (const bf16_t*)(a.ws + WS_W13), NSLOT, 16384, 1024};
                SchedMoe S{G, vcu_, ntl, meta + META_TE, a.ws, l, 1};
                EpiUp E{a.ws};
                pg8::gemm_phase<EpiUp, SchedMoe, true, true>((LAS unsigned char*)lds, g, S, E);
            }
            {
                pg8::Gemm g{(const bf16_t*)(a.ws + WS_ACT), (const bf16_t*)(a.ws + WS_W2), NSLOT, 16384, 512};
                SchedMoe S{G, vcu_, ntl, meta + META_TE, a.ws, l, 2};
                EpiDown E{a.ws};
                pg8::gemm_phase<EpiDown, SchedMoe, true, true>((LAS unsigned char*)lds, g, S, E);
            }
        }
        else if (EN(OP_COMBINE) && op == OP_COMBINE) {
#if PROBE_CMB2
            ph_combine_ln2(a, l, lds, 1); __syncthreads();
#endif
            ph_combine_ln2(a, l, lds);
        }
        }
        if (step + 1 < a_in.hi) { xcd_barrier(bar);
#if PROBE_XBAR
            for (int xb_ = 0; xb_ < PROBE_XBAR; ++xb_) xcd_barrier(bar);
#endif
        }
    }
}


#ifndef FAST_MASK
#define FAST_MASK 0xffffffffu
#endif
#ifndef MK_SINGLE
#define MK_SINGLE 1
#endif
#ifndef FAST_ATTN
#define FAST_ATTN 1
#endif
#ifndef FAST_G1
#define FAST_G1 1
#endif
#ifndef FAST_SCAN
#define FAST_SCAN 1
#endif
static bool op_fast(int op) {
    if (op == OP_ATTN_G1) return false;
    if (op == OP_SCAN) return FAST_SCAN != 0;
    return (FAST_MASK >> op) & 1u;
}
extern "C" void kernel_launch(void* const* d_in, const int* in_sizes, int n_in, void* d_out, int out_size, void* d_ws, size_t ws_size, hipStream_t stream) {
    if (n_in != 28 || ws_size < WS_END) { fprintf(stderr, "kernel_launch: unexpected n_in %d / ws_size %zu (need %zu)\n", n_in, ws_size, (size_t)WS_END); return; }
    Args a{};
    for (int i = 0; i < 28; ++i) a.in[i] = (const float*)d_in[i];
    a.out = (float*)d_out; a.ws = (unsigned char*)d_ws;
    static bool attr_done = false;
    if (!attr_done) {
        if (hipFuncSetAttribute((const void*)mk, hipFuncAttributeMaxDynamicSharedMemorySize, LDS_BYTES) != hipSuccess) fprintf(stderr, "hipFuncSetAttribute failed\n");
        attr_done = true;
    }
    hipMemsetAsync((char*)d_ws + WS_CTL, 0, 1 * MiB, stream);
#if MK_SINGLE
    a.lo = 0; a.hi = NSTEPS; a.pad = 7;
    hipLaunchKernelGGL(mk, dim3(256), dim3(512), LDS_BYTES, stream, a);
#else
    for (int step = 0; step < NSTEPS; ++step) {
        int op, l; decode_step(step, op, l);
        a.layer = l;
        if (op == OP_ATTN_G1) {
            if (FAST_ATTN || FAST_G1) { a.lo = step; a.hi = step + 1; a.pad = (FAST_ATTN ? 1 : 0) | (FAST_G1 ? 2 : 0); hipLaunchKernelGGL(mk, dim3(256), dim3(512), LDS_BYTES, stream, a); a.pad = 0; a.lo = 0; a.hi = 0; }
            if (!FAST_ATTN) {
                hipLaunchKernelGGL(nv_attn, dim3(TT / 256, 16), dim3(256), 0, stream, a);
                hipLaunchKernelGGL(nv_attn_combine, dim3(TT * 4 / 256), dim3(256), 0, stream, a);
            }
            if (!FAST_G1) {
                hipLaunchKernelGGL(nv_conv, dim3(1536 / 256, TT), dim3(256), 0, stream, a);
                hipLaunchKernelGGL(nv_norm, dim3(TT * 8 / 256), dim3(256), 0, stream, a);
            }
            continue;
        }
        if (op == OP_SCAN) {
            a.lo = step; a.hi = step + 1; a.pad = FAST_SCAN ? 4 : 0; hipLaunchKernelGGL(mk, dim3(256), dim3(512), LDS_BYTES, stream, a); a.pad = 0; a.lo = 0; a.hi = 0;
            if (!FAST_SCAN) hipLaunchKernelGGL(nv_scan, dim3(32), dim3(128), 0, stream, a);
            continue;
        }
        if (op_fast(op)) { a.lo = step; a.hi = step + 1; hipLaunchKernelGGL(mk, dim3(256), dim3(512), LDS_BYTES, stream, a); continue; }
        a.lo = 0; a.hi = 0;
        switch (op) {
        case OP_INPROJ: hipLaunchKernelGGL(nv_inproj, dim3(NPROJ / 256, TT), dim3(256), 0, stream, a); break;
        case OP_MERGE1: hipLaunchKernelGGL(nv_merge1, dim3(4, TT), dim3(256), 0, stream, a); break;
        case OP_WO: hipLaunchKernelGGL(nv_wo, dim3(4, TT), dim3(256), 0, stream, a); break;
        case OP_SLOT: break;
        case OP_UP: hipLaunchKernelGGL(nv_moe1, dim3(2, NASSIGN), dim3(256), 0, stream, a); break;
        case OP_DOWN: hipLaunchKernelGGL(nv_moe2, dim3(4, NASSIGN), dim3(256), 0, stream, a); break;
        default: fprintf(stderr, "no naive kernel for op %d\n", op); break;
        }
    }
#endif
}
```

```cpp
#include <hip/hip_runtime.h>
#include <cstdio>
#include <cstdint>

#define DI __device__ __forceinline__
typedef unsigned short bf16_t;
typedef short bf16x8 __attribute__((ext_vector_type(8)));
typedef float f32x4 __attribute__((ext_vector_type(4)));
typedef float f32x2 __attribute__((ext_vector_type(2)));
typedef float f32x16 __attribute__((ext_vector_type(16)));
typedef unsigned u32x4 __attribute__((ext_vector_type(4)));
typedef unsigned u32x2 __attribute__((ext_vector_type(2)));
typedef __bf16 bf16x2_t __attribute__((ext_vector_type(2)));

constexpr int D = 1024, NB = 4, SEQ = 4096, CTX = 256, DEPTH = 4;
constexpr int NCTX = NB * CTX;
constexpr int TT = NCTX + NB * SEQ;
constexpr int N_IN = 5648, NPROJ = 5632;
constexpr int NE = 16;
constexpr float EPS = 1e-6f;
constexpr float ALPHA = 1.681792830507429f;
constexpr float QSCALE = 0.125f * 1.4426950408889634f;
constexpr int NASSIGN = TT * 2;
constexpr int NSLOT = NASSIGN + NE * 256;

constexpr size_t MiB = 1u << 20;
constexpr size_t WS_CTL = 0;
constexpr size_t WS_MODS = 1 * MiB;
constexpr size_t WS_ROPE = 2 * MiB;
constexpr size_t WS_META = 2 * MiB + 65536;
constexpr size_t WS_ROUTE_E = 3 * MiB;
constexpr size_t WS_ROUTE_W = 3 * MiB + 262144;
constexpr size_t WS_DEST = 3 * MiB + 524288;
constexpr size_t WS_SLOTA = 3 * MiB + 786432;
constexpr size_t WS_AB = 4 * MiB;
constexpr size_t WS_GL = 6 * MiB;
constexpr size_t WS_WIN = 8 * MiB;
constexpr size_t WS_WPAB = 20 * MiB;
constexpr size_t WS_WO = 22 * MiB;
constexpr size_t WS_W13 = 24 * MiB;
constexpr size_t WS_W2 = 56 * MiB;
constexpr size_t WS_X = 72 * MiB;
constexpr size_t WS_H = 140 * MiB;
constexpr size_t WS_QA = 174 * MiB;
constexpr size_t WS_KA = 191 * MiB;
constexpr size_t WS_VA = 208 * MiB;
constexpr size_t WS_QKV = 225 * MiB;
constexpr size_t WS_Z = 276 * MiB;
constexpr size_t WS_SG = 293 * MiB;
constexpr size_t WS_GPRE = 361 * MiB;
constexpr size_t WS_OF = 514 * MiB;
constexpr size_t WS_OB = 531 * MiB;
constexpr size_t WS_YAB = 548 * MiB;
constexpr size_t WS_M = 582 * MiB;
constexpr size_t WS_END = 616 * MiB;
constexpr size_t WS_XS = 174 * MiB;
constexpr size_t WS_ACT = 250 * MiB;
constexpr size_t WS_YS = 288 * MiB;
constexpr size_t WS_ON = 361 * MiB;
constexpr size_t WS_CONVO = 361 * MiB;

DI float bf2f(bf16_t v) { return __uint_as_float(((unsigned)v) << 16); }
DI unsigned pk2(float lo, float hi) { f32x2 v = {lo, hi}; bf16x2_t b = __builtin_convertvector(v, bf16x2_t); return __builtin_bit_cast(unsigned, b); }
DI bf16_t f2bf(float f) { return (bf16_t)(pk2(f, 0.f) & 0xffffu); }
DI float sigmoidf_(float x) { return __builtin_amdgcn_rcpf(1.f + __builtin_amdgcn_exp2f(-1.4426950408889634f * x)); }
DI float siluf_(float x) { return x * __builtin_amdgcn_rcpf(1.f + __builtin_amdgcn_exp2f(-1.4426950408889634f * x)); }
DI float softplusf_(float x) { return fmaxf(x, 0.f) + log1pf(__expf(-fabsf(x))); }
template <int CTRL> DI float dppmov(float v) { return __uint_as_float(__builtin_amdgcn_update_dpp(0u, __float_as_uint(v), CTRL, 0xf, 0xf, true)); }
DI float xor32(float x, bool hi32) { auto rr = __builtin_amdgcn_permlane32_swap(__float_as_uint(x), __float_as_uint(x), false, false); return __uint_as_float(hi32 ? rr[0] : rr[1]); }
DI float xor16(float x, bool odd16) { auto rr = __builtin_amdgcn_permlane16_swap(__float_as_uint(x), __float_as_uint(x), false, false); return __uint_as_float(odd16 ? rr[0] : rr[1]); }
DI float wave_sum(float v) {
    v += dppmov<0xB1>(v); v += dppmov<0x4E>(v); v += dppmov<0x124>(v); v += dppmov<0x128>(v);
    { auto rr = __builtin_amdgcn_permlane16_swap(__float_as_uint(v), __float_as_uint(v), false, false); v = __uint_as_float(rr[0]) + __uint_as_float(rr[1]); }
    { auto rr = __builtin_amdgcn_permlane32_swap(__float_as_uint(v), __float_as_uint(v), false, false); v = __uint_as_float(rr[0]) + __uint_as_float(rr[1]); }
    return v;
}
DI int jj16_of_lane(int lane) { return ((lane >> 5) & 1) * 8 + ((lane >> 4) & 1) * 4 + ((lane >> 3) & 1) * 2 + ((lane >> 2) & 1); }
DI int lane_of_jj16(int jj) { return 32 * (jj >> 3) + 16 * ((jj >> 2) & 1) + 8 * ((jj >> 1) & 1) + 4 * (jj & 1); }
DI float reduce16(const float (&p)[16], int lane) {
    const bool b5 = lane & 32, b4 = lane & 16, b3 = lane & 8, b2 = lane & 4;
    float q8[8], q4[4], q2[2];
#pragma unroll
    for (int j = 0; j < 8; ++j) { const float keep = b5 ? p[j + 8] : p[j], send = b5 ? p[j] : p[j + 8]; q8[j] = keep + xor32(send, b5); }
#pragma unroll
    for (int j = 0; j < 4; ++j) { const float keep = b4 ? q8[j + 4] : q8[j], send = b4 ? q8[j] : q8[j + 4]; q4[j] = keep + xor16(send, b4); }
#pragma unroll
    for (int j = 0; j < 2; ++j) { const float keep = b3 ? q4[j + 2] : q4[j], send = b3 ? q4[j] : q4[j + 2]; q2[j] = keep + dppmov<0x128>(send); }
    float q1;
    { const float keep = b2 ? q2[1] : q2[0], send = b2 ? q2[0] : q2[1]; const float pa = dppmov<0x124>(send), pb = dppmov<0x12C>(send); q1 = keep + (b2 ? pa : pb); }
    q1 += dppmov<0x4E>(q1); q1 += dppmov<0xB1>(q1);
    return q1;
}
typedef _Float16 f16x4 __attribute__((ext_vector_type(4)));
typedef _Float16 f16x8 __attribute__((ext_vector_type(8)));
DI float xclamp(float v) { return v; }
DI f32x4 bf4_f32(u32x2 v) { return __builtin_convertvector(__builtin_bit_cast(f16x4, v), f32x4); }
DI u32x2 f32_bf4(const f32x4& x) { f32x4 c; c[0] = xclamp(x[0]); c[1] = xclamp(x[1]); c[2] = xclamp(x[2]); c[3] = xclamp(x[3]); return __builtin_bit_cast(u32x2, __builtin_convertvector(c, f16x4)); }
DI int mod_set(int row) { return row < NCTX ? 4 : ((row - NCTX) >> 12); }
DI float lam_init_of(int l) { return 0.8f - 0.6f * __expf(-0.3f * (float)l); }

DI int tidx() { int t = threadIdx.x; asm volatile("" : "+v"(t)); return t; }

DI void store16_wt(void* p, u32x4 v) { asm volatile("global_store_dwordx4 %0, %1, off sc1\n\ts_nop 1" :: "v"(p), "v"(v) : "memory"); }

constexpr int CW_PANEL = 16384, CW_WO = 98304, CW_CVT = 200000;
DI unsigned* panel_word(unsigned char* ws, int l, int kind, int p) { return (unsigned*)(ws + WS_CTL) + CW_PANEL + ((l * 2 + kind) * 160 + p) * 64; }
DI unsigned* wo_word(unsigned char* ws, int l, int p) { return (unsigned*)(ws + WS_CTL) + CW_WO + (l * 160 + p) * 64; }
DI void panel_publish(unsigned* w) {
    asm volatile("s_waitcnt vmcnt(0)" ::: "memory");
    if ((tidx() & 63) == 0) __hip_atomic_fetch_add(w, 1u, __ATOMIC_RELAXED, __HIP_MEMORY_SCOPE_AGENT);
}
DI void panel_wait(unsigned* w, unsigned need) {
    if (tidx() < 64) {
        unsigned spins = 0;
        while ((unsigned)__builtin_amdgcn_readfirstlane(__hip_atomic_load(w, __ATOMIC_RELAXED, __HIP_MEMORY_SCOPE_AGENT)) < need) { __builtin_amdgcn_s_sleep(2); if (++spins > (1u << 22)) break; }
        __builtin_amdgcn_fence(__ATOMIC_ACQUIRE, "agent");
        asm volatile("s_waitcnt vmcnt(0)" ::: "memory");
    }
    asm volatile("" ::: "memory"); __builtin_amdgcn_s_barrier(); asm volatile("" ::: "memory");
}

#define XCD_RELABEL 1

struct Args {
    const float* in[28];
    float* out;
    unsigned char* ws;
    int lo, hi, layer, pad;
};


namespace pg8 {
#define PG8_LAS __attribute__((address_space(3)))
typedef unsigned short bf16_t;
typedef short bf16x8 __attribute__((ext_vector_type(8)));
typedef float f32x4 __attribute__((ext_vector_type(4)));
typedef unsigned u32x4 __attribute__((ext_vector_type(4)));
constexpr int BM = 256, BK = 64, HALF = 128, HTB = HALF * BK * 2  , STAGE_BYTES = 8 * HTB, NXCD = 8, WGM = 2;

__host__ __device__ __forceinline__ int lds_byte(int r, int c) { const int st = (r >> 4) * 2 + (c >> 5), rr = r & 15, cc = c & 31, ob = rr * 64 + cc * 2; return st * 1024 + (ob ^ (((ob >> 9) & 1) << 5)); }
__host__ __device__ __forceinline__ void stage_rc(int b, int& R, int& C) { const int st = b / 1024, sb = b % 1024, swz = sb ^ (((sb >> 9) & 1) << 5); R = (st >> 1) * 16 + swz / 64; C = (st & 1) * 32 + (swz % 64) / 2; }
__host__ __device__ __forceinline__ int perm32(int rho) { const int n = rho >> 4, i = rho & 15; return 8 * (i >> 2) + 4 * n + (i & 3); }

struct Unit { int pm, pn; };
struct Gemm { const bf16_t* A; const bf16_t* Bt; int M, N, K; };

struct StaticOrder {
    int nM, nN, nwg, G, c;
    __host__ __device__ void init(int M, int N, int G_, int c_) { nM = M / BM; nN = N / BM; nwg = nM * nN; G = G_; c = c_; }
    __host__ __device__ bool next(int i, Unit& u) const {
        const long L = (long)i * G + c; if (L >= nwg) return false;
        int wgid = (int)L; { const int q = nwg / NXCD, r = nwg % NXCD, xcd = wgid % NXCD, off = wgid / NXCD; wgid = (xcd < r ? xcd * (q + 1) : r * (q + 1) + (xcd - r) * q) + off; }
        const int nig = WGM * nN, gid = wgid / nig, fm = gid * WGM, gsz = (nM - fm) < WGM ? (nM - fm) : WGM;
        u.pm = fm + ((wgid % nig) % gsz); u.pn = (wgid % nig) / gsz; return true;
    }
    __device__ __forceinline__ void a_ready(const Unit&) const {}
    __device__ __forceinline__ void done(const Unit&) const {}
};

template <class Epi, class Sched, bool ALIGN_EPI = false, bool SP2 = false>
__device__ __forceinline__ void gemm_phase(PG8_LAS unsigned char* lds, const Gemm g, const Sched& S, const Epi& E) {
    const int tid = tidx(), wid = __builtin_amdgcn_readfirstlane(tid >> 6), lane = tid & 63, wr = wid >> 2, wc = wid & 3, fr = lane & 15, fq = lane >> 4;
    const int K = g.K, nt = K / BK;
    unsigned voffA[2], voffB[2];
    constexpr bool GA = Epi::GATHER_A;
    static_assert(!GA || SP2, "gathered A is wired into the SP2 loop only");
    int rowA[2]; unsigned colA[2]; unsigned vC[2][2], vN[2][2];
#pragma unroll
    for (int i = 0; i < 2; ++i) { int R, C; stage_rc(tid * 16 + i * 8192, R, C); const int Rb = Epi::PERM ? ((R & ~31) + perm32(R & 31)) : R;
        voffA[i] = (unsigned)(R * K + C) * 2u; voffB[i] = (unsigned)(Rb * K + C) * 2u; rowA[i] = R; colA[i] = (unsigned)C * 2u; }
#define PG8_GATHER(u_, v_) do { _Pragma("unroll") for (int _h = 0; _h < 2; ++_h) _Pragma("unroll") for (int _i = 0; _i < 2; ++_i) \
        v_[_h][_i] = (unsigned)E.arow((u_).pm * 256 + _h * HALF + rowA[_i]) * (unsigned)(K * 2) + colA[_i]; } while (0)
    const size_t kstep = (size_t)(BK * 2);
    const size_t hstep = (size_t)HALF * K * 2;
    const size_t tstep = 2 * hstep;
    const unsigned ldsw = (unsigned)wid * 1024u;
    const int aoff = lds_byte(wr * 64 + fr, fq * 8), boff = lds_byte(wc * 32 + fr, fq * 8);
#define PG8_SA(b, h) (((b) * 2 + (h)) * HTB)
#define PG8_SB(b, h) ((4 + (b) * 2 + (h)) * HTB)
#define PG8_STAGE(bufoff, gbase, voff) do { _Pragma("unroll") for (int _i = 0; _i < 2; ++_i) \
        __builtin_amdgcn_global_load_lds((const unsigned*)((const char*)(gbase) + (voff)[_i]), (PG8_LAS unsigned*)(lds + (bufoff) + ldsw + _i * 8192), 16, 0, 0); } while (0)
#define PG8_STAGE_A(bufoff, kb, h, nx) do { if constexpr (GA) { _Pragma("unroll") for (int _i = 0; _i < 2; ++_i) \
        __builtin_amdgcn_global_load_lds((const unsigned*)((const char*)(kb) + ((nx) ? vN[h][_i] : vC[h][_i])), (PG8_LAS unsigned*)(lds + (bufoff) + ldsw + _i * 8192), 16, 0, 0); } \
        else PG8_STAGE(bufoff, (kb) + (h) * hstep, voffA); } while (0)
#define PG8_LDA(dst, b, h) do { _Pragma("unroll") for (int m = 0; m < 4; ++m) _Pragma("unroll") for (int k = 0; k < 2; ++k) dst[m][k] = *(const PG8_LAS bf16x8*)(lds + PG8_SA(b, h) + aoff + m * 2048 + k * 1024); } while (0)
#define PG8_LDB(dst, b, h) do { _Pragma("unroll") for (int n = 0; n < 2; ++n) _Pragma("unroll") for (int k = 0; k < 2; ++k) dst[n][k] = *(const PG8_LAS bf16x8*)(lds + PG8_SB(b, h) + boff + n * 2048 + k * 1024); } while (0)
#define PG8_MMA(ai, bj, At, Bt) do { __builtin_amdgcn_s_setprio(1); _Pragma("unroll") for (int m = 0; m < 4; ++m) _Pragma("unroll") for (int n = 0; n < 2; ++n) _Pragma("unroll") for (int k = 0; k < 2; ++k) \
        acc[ai][bj][m][n] = __builtin_amdgcn_mfma_f32_16x16x32_bf16(Bt[n][k], At[m][k], acc[ai][bj][m][n], 0, 0, 0); __builtin_amdgcn_s_setprio(0); } while (0)
#define PG8_WAIT_V(n) asm volatile("s_waitcnt vmcnt(" #n ")" ::: "memory")
#define PG8_WAIT_L(n) asm volatile("s_waitcnt lgkmcnt(" #n ")" ::: "memory")
#define PG8_BAR __builtin_amdgcn_s_barrier()
#define PG8_SCHED __builtin_amdgcn_sched_barrier(0)
    Unit cur, nxt; int ui = 0;
    if (!S.next(0, cur)) return;
    f32x4 acc[2][2][4][2];
#pragma unroll
    for (int a = 0; a < 2; ++a)
#pragma unroll
        for (int b = 0; b < 2; ++b)
#pragma unroll
            for (int m = 0; m < 4; ++m)
#pragma unroll
                for (int n = 0; n < 2; ++n) acc[a][b][m][n] = (f32x4){0.f, 0.f, 0.f, 0.f};
    bf16x8 At[4][2], B0[2][2], B1[2][2];
    const char* cA = GA ? (const char*)g.A : (const char*)g.A + (size_t)cur.pm * tstep; const char* cB = (const char*)g.Bt + (size_t)cur.pn * tstep;
    if constexpr (GA) PG8_GATHER(cur, vC);
    S.a_ready(cur);
    if constexpr (SP2) {
        PG8_STAGE(PG8_SB(0, 0), cB, voffB); PG8_STAGE(PG8_SB(0, 1), cB + hstep, voffB); PG8_STAGE_A(PG8_SA(0, 0), cA, 0, false); PG8_STAGE_A(PG8_SA(0, 1), cA, 1, false);
        if (wr == 1) PG8_BAR;
        PG8_WAIT_V(2); PG8_BAR;
        PG8_STAGE(PG8_SB(1, 0), cB + kstep, voffB); PG8_STAGE_A(PG8_SA(1, 0), cA + kstep, 0, false); PG8_STAGE(PG8_SB(1, 1), cB + hstep + kstep, voffB);
        PG8_WAIT_V(6); PG8_BAR;
    } else {
        PG8_STAGE(PG8_SB(0, 0), cB, voffB); PG8_STAGE(PG8_SA(0, 0), cA, voffA); PG8_STAGE(PG8_SB(0, 1), cB + hstep, voffB); PG8_STAGE(PG8_SA(0, 1), cA + hstep, voffA);
        if (wr == 1) PG8_BAR;
        PG8_WAIT_V(4); PG8_BAR;
        PG8_STAGE(PG8_SB(1, 0), cB + kstep, voffB); PG8_STAGE(PG8_SA(1, 0), cA + kstep, voffA); PG8_STAGE(PG8_SB(1, 1), cB + hstep + kstep, voffB);
        PG8_WAIT_V(6); PG8_BAR;
    }
    for (;;) {
        const bool has_next = S.next(ui + 1, nxt);
        const char* nA = (has_next && !GA) ? (const char*)g.A + (size_t)nxt.pm * tstep : cA; const char* nB = has_next ? (const char*)g.Bt + (size_t)nxt.pn * tstep : cB;
        if constexpr (GA) {
            if (has_next) PG8_GATHER(nxt, vN);
            else { _Pragma("unroll") for (int _h = 0; _h < 2; ++_h) _Pragma("unroll") for (int _i = 0; _i < 2; ++_i) vN[_h][_i] = vC[_h][_i]; }
            asm volatile("" : "+v"(vN[0][0]), "+v"(vN[0][1]), "+v"(vN[1][0]), "+v"(vN[1][1]));
        }
        for (int t = 0; t < nt; t += 2) {
            const bool last = (t == nt - 2);
            const char* a1 = cA + (size_t)(t + 1) * kstep;
            const char* a2 = last ? nA : cA + (size_t)(t + 2) * kstep; const char* b2 = last ? nB : cB + (size_t)(t + 2) * kstep;
            const char* a3 = a2 + kstep; const char* b3 = b2 + kstep;
            if (last && has_next) S.a_ready(nxt);
            if constexpr (SP2) {
            PG8_LDB(B0, 0, 0); PG8_LDB(B1, 0, 1); PG8_SCHED; PG8_LDA(At, 0, 0); PG8_STAGE_A(PG8_SA(1, 1), a1, 1, false);
            PG8_WAIT_V(8); PG8_WAIT_L(0); PG8_BAR; PG8_MMA(0, 0, At, B0); PG8_MMA(0, 1, At, B1); PG8_BAR; PG8_SCHED;
            PG8_LDA(At, 0, 1); PG8_STAGE(PG8_SB(0, 0), b2, voffB); PG8_STAGE(PG8_SB(0, 1), b2 + hstep, voffB); PG8_STAGE_A(PG8_SA(0, 0), a2, 0, last);
            PG8_WAIT_V(8); PG8_WAIT_L(0); PG8_BAR; PG8_MMA(1, 0, At, B0); PG8_MMA(1, 1, At, B1); PG8_BAR; PG8_SCHED;
            PG8_LDB(B0, 1, 0); PG8_LDB(B1, 1, 1); PG8_SCHED; PG8_LDA(At, 1, 0); PG8_STAGE_A(PG8_SA(0, 1), a2, 1, last);
            PG8_WAIT_V(8); PG8_WAIT_L(0); PG8_BAR; PG8_MMA(0, 0, At, B0); PG8_MMA(0, 1, At, B1); PG8_BAR; PG8_SCHED;
            PG8_LDA(At, 1, 1); PG8_STAGE(PG8_SB(1, 0), b3, voffB); PG8_STAGE(PG8_SB(1, 1), b3 + hstep, voffB); PG8_STAGE_A(PG8_SA(1, 0), a3, 0, last);
            PG8_WAIT_V(8); PG8_WAIT_L(0); PG8_BAR; PG8_MMA(1, 0, At, B0); PG8_MMA(1, 1, At, B1); PG8_BAR; PG8_SCHED;
            } else {
            PG8_LDB(B0, 0, 0); PG8_SCHED; PG8_LDA(At, 0, 0); PG8_STAGE(PG8_SA(1, 1), a1 + hstep, voffA);
            PG8_WAIT_L(8); PG8_BAR; PG8_WAIT_L(0); PG8_MMA(0, 0, At, B0); PG8_BAR; PG8_SCHED;
            PG8_LDB(B1, 0, 1); PG8_STAGE(PG8_SB(0, 0), b2, voffB);
            PG8_BAR; PG8_WAIT_L(0); PG8_MMA(0, 1, At, B1); PG8_BAR;
            PG8_LDA(At, 0, 1); PG8_STAGE(PG8_SA(0, 0), a2, voffA);
            PG8_BAR; PG8_WAIT_L(0); PG8_MMA(1, 0, At, B0); PG8_BAR; PG8_SCHED;
            PG8_STAGE(PG8_SB(0, 1), b2 + hstep, voffB);
            PG8_WAIT_V(6); PG8_BAR; PG8_MMA(1, 1, At, B1); PG8_BAR;
            PG8_LDB(B0, 1, 0); PG8_SCHED; PG8_LDA(At, 1, 0); PG8_STAGE(PG8_SA(0, 1), a2 + hstep, voffA);
            PG8_WAIT_L(8); PG8_BAR; PG8_WAIT_L(0); PG8_MMA(0, 0, At, B0); PG8_BAR; PG8_SCHED;
            PG8_LDB(B1, 1, 1); PG8_STAGE(PG8_SB(1, 0), b3, voffB);
            PG8_BAR; PG8_WAIT_L(0); PG8_MMA(0, 1, At, B1); PG8_BAR;
            PG8_LDA(At, 1, 1); PG8_STAGE(PG8_SA(1, 0), a3, voffA);
            PG8_BAR; PG8_WAIT_L(0); PG8_MMA(1, 0, At, B0); PG8_BAR; PG8_SCHED;
            PG8_STAGE(PG8_SB(1, 1), b3 + hstep, voffB);
            PG8_WAIT_V(6); PG8_BAR; PG8_MMA(1, 1, At, B1); PG8_BAR;
            }
        }
        if constexpr (ALIGN_EPI) { if (wr == 0) PG8_BAR; }
        if constexpr (!Epi::AFTER_DRAIN) { E(acc, cur, wr, wc, fr, fq); S.done(cur); }
        if (!has_next) break;
#pragma unroll
        for (int a = 0; a < 2; ++a)
#pragma unroll
            for (int b = 0; b < 2; ++b)
#pragma unroll
                for (int m = 0; m < 4; ++m)
#pragma unroll
                    for (int n = 0; n < 2; ++n) acc[a][b][m][n] = (f32x4){0.f, 0.f, 0.f, 0.f};
        cur = nxt; cA = nA; cB = nB; ++ui;
        if constexpr (GA) { _Pragma("unroll") for (int _h = 0; _h < 2; ++_h) _Pragma("unroll") for (int _i = 0; _i < 2; ++_i) vC[_h][_i] = vN[_h][_i]; }
        if constexpr (ALIGN_EPI) { if (wr == 1) PG8_BAR; }
    }
    PG8_WAIT_V(0);
    if constexpr (!ALIGN_EPI) { if (wr == 0) PG8_BAR; }
    PG8_BAR;
    if constexpr (Epi::AFTER_DRAIN) { E.fused(acc, cur, wr, wc, fr, fq, lds, wid, lane); S.done(cur); }
#undef PG8_SA
#undef PG8_SB
#undef PG8_STAGE
#undef PG8_STAGE_A
#undef PG8_GATHER
#undef PG8_LDA
#undef PG8_LDB
#undef PG8_MMA
#undef PG8_WAIT_V
#undef PG8_WAIT_L
#undef PG8_BAR
#undef PG8_SCHED
}
}


#define LAS __attribute__((address_space(3)))
constexpr int LDS_BYTES = 147456;
constexpr int LDS_MISC = 131072 + 8192;

DI void ph_mods(const Args& a, unsigned char* lds) {
    float (*sc)[1024] = (float (*)[1024])lds;
    float (*red)[5][128] = (float (*)[5][128])(lds + 20480);
    const float* c = a.in[1]; const float* cctx = a.in[3]; const float* mod_w = a.in[4]; const float* mod_b = a.in[5];
    float* mods = (float*)(a.ws + WS_MODS);
    const int tid = tidx(), lane = tid & 63, wid = tid >> 6;
    for (int i = tid; i < 5 * 1024; i += 512) { int s = i >> 10, k = i & 1023; float v = s < 4 ? c[s * 1024 + k] : cctx[k]; sc[s][k] = siluf_(v); }
    __syncthreads();
    for (int item = blockIdx.x; item < DEPTH * 48; item += gridDim.x) {
        const int l = item / 48, c0 = (item % 48) * 128;
        const int half = lane >> 5, cg = lane & 31;
        f32x4 acc[5];
#pragma unroll
        for (int s = 0; s < 5; ++s) acc[s] = (f32x4){0.f, 0.f, 0.f, 0.f};
        const float* wp = mod_w + (size_t)l * 1024 * 6144 + c0 + 4 * cg;
#pragma unroll 16
        for (int kk = 0; kk < 64; ++kk) {
            const int k = wid * 128 + 2 * kk + half;
            const f32x4 w = *(const f32x4*)(wp + (size_t)k * 6144);
#pragma unroll
            for (int s = 0; s < 5; ++s) acc[s] += w * sc[s][k];
        }
#pragma unroll
        for (int s = 0; s < 5; ++s) {
#pragma unroll
            for (int j = 0; j < 4; ++j) { float v = acc[s][j]; v += __shfl_xor(v, 32); acc[s][j] = v; }
            if (half == 0) {
#pragma unroll
                for (int j = 0; j < 4; ++j) red[wid][s][4 * cg + j] = acc[s][j];
            }
        }
        __syncthreads();
        for (int i = tid; i < 5 * 128; i += 512) {
            const int s = i >> 7, cc = i & 127; float v = 0.f;
#pragma unroll
            for (int w = 0; w < 8; ++w) v += red[w][s][cc];
            mods[((size_t)l * 5 + s) * 6144 + c0 + cc] = v + mod_b[l * 6144 + c0 + cc];
        }
        __syncthreads();
    }
    if (blockIdx.x == gridDim.x - 1) {
        float* rope = (float*)(a.ws + WS_ROPE);
        for (int i = tid; i < 64 * 16; i += 512) {
            const int pos = i >> 4, f = i & 15;
            const float inv = powf(10000.0f, -(float)f / 16.0f);
            const float ang = (float)pos * inv;
            rope[2 * i] = cosf(ang); rope[2 * i + 1] = sinf(ang);
        }
    }
}

DI void row_ln(f32x4 (&v)[4], const float* g, const float* b, int lane) {
    float s = 0.f;
#pragma unroll
    for (int j = 0; j < 4; ++j) s += (v[j][0] + v[j][1]) + (v[j][2] + v[j][3]);
    const float mean = wave_sum(s) * (1.f / 1024.f);
    float q = 0.f;
#pragma unroll
    for (int j = 0; j < 4; ++j) { v[j] = v[j] - mean; q += (v[j][0] * v[j][0] + v[j][1] * v[j][1]) + (v[j][2] * v[j][2] + v[j][3] * v[j][3]); }
    const float rstd = rsqrtf(wave_sum(q) * (1.f / 1024.f) + EPS);
#pragma unroll
    for (int j = 0; j < 4; ++j) {
        const f32x4 gg = *(const f32x4*)(g + 256 * j + 4 * lane), bb = *(const f32x4*)(b + 256 * j + 4 * lane);
        v[j] = v[j] * rstd * gg + bb;
    }
}
DI void row_ln_r(f32x4 (&v)[4], const f32x4 (&gg)[4], const f32x4 (&bb)[4]) {
    float s = 0.f;
#pragma unroll
    for (int j = 0; j < 4; ++j) s += (v[j][0] + v[j][1]) + (v[j][2] + v[j][3]);
    const float mean = wave_sum(s) * (1.f / 1024.f);
    float q = 0.f;
#pragma unroll
    for (int j = 0; j < 4; ++j) { v[j] = v[j] - mean; q += (v[j][0] * v[j][0] + v[j][1] * v[j][1]) + (v[j][2] * v[j][2] + v[j][3] * v[j][3]); }
    const float rstd = rsqrtf(wave_sum(q) * (1.f / 1024.f) + EPS);
#pragma unroll
    for (int j = 0; j < 4; ++j) v[j] = v[j] * rstd * gg[j] + bb[j];
}
DI void row_modulate(f32x4 (&h)[4], const f32x4 (&x)[4], const float* shift, const float* scale, int lane) {
#pragma unroll
    for (int j = 0; j < 4; ++j) {
        const f32x4 sh = *(const f32x4*)(shift + 256 * j + 4 * lane), scl = *(const f32x4*)(scale + 256 * j + 4 * lane);
        h[j] = x[j] * (1.f + scl) + sh;
    }
}
DI void row_store_bf16(bf16_t* dst, const f32x4 (&h)[4], int lane) {
#pragma unroll
    for (int j = 0; j < 4; ++j) { u32x2 w; w.x = pk2(h[j][0], h[j][1]); w.y = pk2(h[j][2], h[j][3]); *(u32x2*)(dst + 256 * j + 4 * lane) = w; }
}
DI float row_gemv16(const f32x4 (&h)[4], const float* WT, int lane) {
    float p[16];
#pragma unroll
    for (int jj = 0; jj < 16; ++jj) {
        float acc = 0.f;
#pragma unroll
        for (int j = 0; j < 4; ++j) { const f32x4 w = *(const f32x4*)(WT + jj * 1024 + 256 * j + 4 * lane); acc += (h[j][0] * w[0] + h[j][1] * w[1]) + (h[j][2] * w[2] + h[j][3] * w[3]); }
        asm volatile("" : "+v"(acc));
        p[jj] = acc;
    }
    return reduce16(p, lane);
}
DI void stage_wt16(float* WT, const float* W, int ld, int col0, int tid) {
    for (int c = tid; c < 1024; c += 512) {
        const float* p = W + (size_t)c * ld + col0;
#pragma unroll
        for (int q = 0; q < 4; ++q) { const f32x4 w = *(const f32x4*)(p + 4 * q);
#pragma unroll
            for (int i = 0; i < 4; ++i) WT[(4 * q + i) * 1024 + c] = w[i]; }
    }
}

DI const float* prep0_src(const Args& a, int row) { return row < NCTX ? a.in[2] + (size_t)row * 1024 : a.in[0] + (size_t)(row - NCTX) * 1024; }
DI void prep0_row(const Args& a, int row, f32x4 (&xb)[4], const float* mods, bf16_t* X, bf16_t* H, float* AB, const float* WT, int lane, int rstride) {
    if (row >= TT) return;
    f32x4 x[4], h[4], sh[4], scl[4];
#pragma unroll
    for (int j = 0; j < 4; ++j) x[j] = xb[j];
    const float* m = mods + (size_t)(0 * 5 + mod_set(row)) * 6144;
#pragma unroll
    for (int j = 0; j < 4; ++j) { sh[j] = *(const f32x4*)(m + 256 * j + 4 * lane); scl[j] = *(const f32x4*)(m + 1024 + 256 * j + 4 * lane); }
    { const int rn = row + 3 * rstride; if (rn < TT) { const float* src = prep0_src(a, rn);
#pragma unroll
        for (int j = 0; j < 4; ++j) xb[j] = *(const f32x4*)(src + 256 * j + 4 * lane); } }
#pragma unroll
    for (int j = 0; j < 4; ++j) *(u32x2*)(X + (size_t)row * 1024 + 256 * j + 4 * lane) = f32_bf4(x[j]);
#pragma unroll
    for (int j = 0; j < 4; ++j) h[j] = x[j] * (1.f + scl[j]) + sh[j];
    row_store_bf16(H + (size_t)row * 1024, h, lane);
    { const float abv = row_gemv16(h, WT, lane); if ((lane & 3) == 0) AB[(size_t)row * 16 + jj16_of_lane(lane)] = abv; }
}
DI void ph_prep0(const Args& a, unsigned char* lds) {
    float* WT = (float*)lds;
    const int tid = tidx(), lane = tid & 63, wid = tid >> 6;
    stage_wt16(WT, a.in[6], N_IN, 3584, tid);
    __syncthreads();
    const float* mods = (const float*)(a.ws + WS_MODS);
    bf16_t* X = (bf16_t*)(a.ws + WS_X); bf16_t* H = (bf16_t*)(a.ws + WS_H); float* AB = (float*)(a.ws + WS_AB);
    const int rstride = gridDim.x * 8;
    const int row0 = blockIdx.x * 8 + wid;
    f32x4 xa[4], xb[4], xc[4];
    { const float* s0 = prep0_src(a, row0); const float* s1 = prep0_src(a, row0 + rstride); const float* s2 = prep0_src(a, row0 + 2 * rstride);
#pragma unroll
      for (int j = 0; j < 4; ++j) { xa[j] = *(const f32x4*)(s0 + 256 * j + 4 * lane); xb[j] = *(const f32x4*)(s1 + 256 * j + 4 * lane); xc[j] = *(const f32x4*)(s2 + 256 * j + 4 * lane); } }
#pragma unroll 1
    for (int row = row0; row < TT; row += 3 * rstride) {
        prep0_row(a, row, xa, mods, X, H, AB, WT, lane, rstride);
        prep0_row(a, row + rstride, xb, mods, X, H, AB, WT, lane, rstride);
        prep0_row(a, row + 2 * rstride, xc, mods, X, H, AB, WT, lane, rstride);
    }
    __syncthreads();
}

DI void ph_yb(const Args& a, int l) {
    const int tid = tidx(), lane = tid & 63, wid = tid >> 6;
    const bf16_t* OF = (const bf16_t*)(a.ws + WS_OF); const bf16_t* OB = (const bf16_t*)(a.ws + WS_OB); const bf16_t* Z = (const bf16_t*)(a.ws + WS_Z);
    bf16_t* YB = (bf16_t*)(a.ws + WS_YAB) + (size_t)TT * 512;
    const float* ogp = a.in[15] + l * 128 + ((8 * lane) & 127);
    float og[8];
#pragma unroll
    for (int i = 0; i < 8; ++i) og[i] = ogp[i];
    const int rstride = gridDim.x * 8;
    int row0 = blockIdx.x * 8 + wid; if (l == DEPTH - 1) { while (row0 < NCTX) row0 += rstride; }
    u32x4 fn = (u32x4){0u, 0u, 0u, 0u}, bn = fn, zn = fn;
    if (row0 < TT) { const size_t o0 = (size_t)row0 * 512 + 8 * lane; fn = *(const u32x4*)(OF + o0); bn = *(const u32x4*)(OB + o0); zn = *(const u32x4*)(Z + o0); }
#pragma unroll 1
    for (int row = row0; row < TT; row += rstride) {
        const size_t off = (size_t)row * 512 + 8 * lane;
        const u32x4 f = fn, b = bn, z = zn;
        if (row + rstride < TT) { const size_t o1 = (size_t)(row + rstride) * 512 + 8 * lane; fn = *(const u32x4*)(OF + o1); bn = *(const u32x4*)(OB + o1); zn = *(const u32x4*)(Z + o1); }
        float o[8]; float ss = 0.f;
#pragma unroll
        for (int i = 0; i < 4; ++i) {
            o[2 * i] = __uint_as_float(f[i] << 16) + __uint_as_float(b[i] << 16);
            o[2 * i + 1] = __uint_as_float(f[i] & 0xffff0000u) + __uint_as_float(b[i] & 0xffff0000u);
            ss += o[2 * i] * o[2 * i] + o[2 * i + 1] * o[2 * i + 1];
        }
        ss += __shfl_xor(ss, 1); ss += __shfl_xor(ss, 2); ss += __shfl_xor(ss, 4); ss += __shfl_xor(ss, 8);
        const float r = rsqrtf(ss * (1.f / 128.f) + EPS);
        u32x4 w;
#pragma unroll
        for (int i = 0; i < 4; ++i) {
            const float z0 = __uint_as_float(z[i] << 16), z1 = __uint_as_float(z[i] & 0xffff0000u);
            const float y0 = o[2 * i] * r * og[2 * i] * siluf_(z0), y1 = o[2 * i + 1] * r * og[2 * i + 1] * siluf_(z1);
            w[i] = pk2(y0, y1);
        }
        *(u32x4*)(YB + off) = w;
    }
}

constexpr int LN1_NB = 240, LN1_K = 10, LN1_LATE = 2048;
constexpr int LOCAL_ASSIGN = LN1_K * 8 * 2;
DI int ln1_vcu() { const int bx = blockIdx.x; return (gridDim.x == 256 && XCD_RELABEL) ? ((bx & 7) * 32 + (bx >> 3)) : bx; }
DI int ln1_octet(int c, int k) { const int r = c < 16 ? c : (c < 32 ? -1 : c - 16); if (r < 0) return -1; const int q = r + LN1_NB * k; return q < TT / 8 ? q : -1; }
DI int ln1_rowof(int c, int k, int w, bool last) { const int q = ln1_octet(c, k); if (q < 0) return -1; const int row = 8 * q + w; return (last && row < NCTX) ? -1 : row; }
DI void ln1_row(int k, int row, int rnext, u32x2 (&xb)[4], const f32x4 (&lg4)[4], const f32x4 (&lb4)[4], const bf16_t* X, const float* mods, int l, bf16_t* H, const float* WT, float* lgb, int lane, int rd) {
    if (row < 0) {
        if (rnext >= 0) {
#pragma unroll
            for (int j = 0; j < 4; ++j) xb[j] = *(const u32x2*)(X + (size_t)rnext * 1024 + 256 * j + 4 * lane);
        }
        return;
    }
    f32x4 x[4], h[4], msh[4], msc[4];
#pragma unroll
    for (int j = 0; j < 4; ++j) x[j] = bf4_f32(xb[j]);
    const float* m = mods + (size_t)(l * 5 + mod_set(row)) * 6144;
#pragma unroll
    for (int j = 0; j < 4; ++j) { msh[j] = *(const f32x4*)(m + 3 * 1024 + 256 * j + 4 * lane); msc[j] = *(const f32x4*)(m + 4 * 1024 + 256 * j + 4 * lane); }
    if (rnext >= 0) {
#pragma unroll
        for (int j = 0; j < 4; ++j) xb[j] = *(const u32x2*)(X + (size_t)rnext * 1024 + 256 * j + 4 * lane);
    }
    row_ln_r(x, lg4, lb4);
#pragma unroll
    for (int j = 0; j < 4; ++j) h[j] = x[j] * (1.f + msc[j]) + msh[j];
    row_store_bf16(H + (size_t)row * 1024, h, lane);
    if (rd >= 2) return;
    const float lgv = row_gemv16(h, WT, lane);
    if ((lane & 3) == 0) lgb[k * 16 + jj16_of_lane(lane)] = lgv;
}
DI void ln1_route(const float* lgb, int c, bool last, int nT, const float* rb, int* RE, float* RW, int* le, int lane, int wid) {
    const int k = lane;
    const int row = (k < nT) ? ln1_rowof(c, k, wid, last) : -1;
    if (row < 0) return;
    float sc[16], sel[16];
#pragma unroll
    for (int e4 = 0; e4 < 4; ++e4) { const f32x4 lg4 = *(const f32x4*)(lgb + k * 16 + 4 * e4);
#pragma unroll
        for (int i = 0; i < 4; ++i) { const int e = 4 * e4 + i; sc[e] = __builtin_amdgcn_rcpf(1.f + __builtin_amdgcn_exp2f(-1.4426950408889634f * lg4[i])); sel[e] = sc[e] + rb[e]; } }
    float best_gs = -1e30f; int best = 0;
#pragma unroll
    for (int gI = 0; gI < 4; ++gI) {
        const float v0 = sel[4 * gI], v1 = sel[4 * gI + 1], v2 = sel[4 * gI + 2], v3 = sel[4 * gI + 3];
        const float mx = fmaxf(fmaxf(v0, v1), fmaxf(v2, v3));
        float second;
        if (v0 == mx) second = fmaxf(v1, fmaxf(v2, v3));
        else if (v1 == mx) second = fmaxf(v0, fmaxf(v2, v3));
        else if (v2 == mx) second = fmaxf(fmaxf(v0, v1), v3);
        else second = fmaxf(fmaxf(v0, v1), v2);
        const float gs = mx + second;
        if (gs > best_gs) { best_gs = gs; best = gI; }
    }
    float i0 = 0.f, i1 = 0.f, i2 = 0.f, i3 = 0.f, s0 = 0.f, s1 = 0.f, s2 = 0.f, s3 = 0.f;
#pragma unroll
    for (int gI = 0; gI < 4; ++gI) if (gI == best) { i0 = sel[4 * gI]; i1 = sel[4 * gI + 1]; i2 = sel[4 * gI + 2]; i3 = sel[4 * gI + 3]; s0 = sc[4 * gI]; s1 = sc[4 * gI + 1]; s2 = sc[4 * gI + 2]; s3 = sc[4 * gI + 3]; }
    int a0 = 0; float m0 = i0, w0 = s0;
    if (i1 > m0) { a0 = 1; m0 = i1; w0 = s1; }
    if (i2 > m0) { a0 = 2; m0 = i2; w0 = s2; }
    if (i3 > m0) { a0 = 3; m0 = i3; w0 = s3; }
    int a1 = -1; float m1 = -1e30f, w1 = 0.f;
    if (a0 != 0 && i0 > m1) { a1 = 0; m1 = i0; w1 = s0; }
    if (a0 != 1 && i1 > m1) { a1 = 1; m1 = i1; w1 = s1; }
    if (a0 != 2 && i2 > m1) { a1 = 2; m1 = i2; w1 = s2; }
    if (a0 != 3 && i3 > m1) { a1 = 3; m1 = i3; w1 = s3; }
    const float inv = 1.f / (w0 + w1);
    RE[2 * row] = best * 4 + a0; RE[2 * row + 1] = best * 4 + a1;
    RW[2 * row] = w0 * inv; RW[2 * row + 1] = w1 * inv;
    le[(k * 8 + wid) * 2] = best * 4 + a0; le[(k * 8 + wid) * 2 + 1] = best * 4 + a1;
}
DI void ph_ln1_router(const Args& a, int l, unsigned char* lds, int rd = 0) {
    float* WT = (float*)lds;
    int* le = (int*)(lds + 65536);
    const int tid = tidx(), lane = tid & 63, wid = tid >> 6;
    stage_wt16(WT, a.in[21], 16, 0, tid);
    if (tid < LOCAL_ASSIGN) le[tid] = -1;
    __syncthreads();
    const float* mods = (const float*)(a.ws + WS_MODS);
    const bf16_t* X = (const bf16_t*)(a.ws + WS_X); bf16_t* H = rd ? (bf16_t*)(a.ws + WS_GPRE + 72 * MiB) : (bf16_t*)(a.ws + WS_H);
    int* RE = rd ? (int*)(a.ws + WS_GPRE + 110 * MiB) : (int*)(a.ws + WS_ROUTE_E); float* RW = rd ? (float*)(a.ws + WS_GPRE + 111 * MiB) : (float*)(a.ws + WS_ROUTE_W);
    const float* g = a.in[19] + l * 1024; const float* bb = a.in[20] + l * 1024; const float* rb = a.in[22];
    const bool last = (l == DEPTH - 1);
    float* lgb = (float*)(lds + 66560 + wid * 640);
    const int c = ln1_vcu();
    f32x4 lg4[4], lb4[4];
#pragma unroll
    for (int j = 0; j < 4; ++j) { lg4[j] = *(const f32x4*)(g + 256 * j + 4 * lane); lb4[j] = *(const f32x4*)(bb + 256 * j + 4 * lane); }
    int nE = 0, nT = 0;
#pragma unroll 1
    for (int k = 0; k < LN1_K; ++k) { const int q = ln1_octet(c, k); if (q >= 0) { nT = k + 1; if (q < LN1_LATE) nE = k + 1; } }
#pragma unroll 1
    for (int k = 0; k < nE; ++k) { const int q = ln1_octet(c, k); if (!(last && q < NCTX / 8)) panel_wait(wo_word(a.ws, l, q >> 5), 32u); }
#define LN1_R(k_) (((k_) < nE) ? ln1_rowof(c, (k_), wid, last) : -1)
    u32x2 xa[4], xb[4], xc[4];
    { const int ra = LN1_R(0), rb_ = LN1_R(1), rc = LN1_R(2);
#pragma unroll
      for (int j = 0; j < 4; ++j) {
          if (ra >= 0) xa[j] = *(const u32x2*)(X + (size_t)ra * 1024 + 256 * j + 4 * lane);
          if (rb_ >= 0) xb[j] = *(const u32x2*)(X + (size_t)rb_ * 1024 + 256 * j + 4 * lane);
          if (rc >= 0) xc[j] = *(const u32x2*)(X + (size_t)rc * 1024 + 256 * j + 4 * lane); } }
#pragma unroll 1
    for (int k = 0; k < 9; k += 3) {
        ln1_row(k, LN1_R(k), LN1_R(k + 3), xa, lg4, lb4, X, mods, l, H, WT, lgb, lane, rd);
        ln1_row(k + 1, LN1_R(k + 1), LN1_R(k + 4), xb, lg4, lb4, X, mods, l, H, WT, lgb, lane, rd);
        ln1_row(k + 2, LN1_R(k + 2), LN1_R(k + 5), xc, lg4, lb4, X, mods, l, H, WT, lgb, lane, rd);
    }
#undef LN1_R
#pragma unroll 1
    for (int k = nE; k < nT; ++k) {
        const int q = ln1_octet(c, k);
        panel_wait(wo_word(a.ws, l, q >> 5), 32u);
        const int row = ln1_rowof(c, k, wid, last);
        if (row >= 0) {
#pragma unroll
            for (int j = 0; j < 4; ++j) xa[j] = *(const u32x2*)(X + (size_t)row * 1024 + 256 * j + 4 * lane);
        }
        ln1_row(k, row, -1, xa, lg4, lb4, X, mods, l, H, WT, lgb, lane, rd);
    }
    if (rd < 2) ln1_route(lgb, c, last, nT, rb, RE, RW, le, lane, wid);
    __syncthreads();
    if (tid < 16) {
        int cnt = 0;
        for (int i = 0; i < LOCAL_ASSIGN; ++i) cnt += (le[i] == tid) ? 1 : 0;
        ((int*)(a.ws + (rd ? WS_GPRE + 112 * MiB : WS_META)))[blockIdx.x * 16 + tid] = cnt;
    }
    __syncthreads();
}

constexpr int META_NT = 4096, META_TE = 4096 + 16;
DI void ph_slot(const Args& a, int l, unsigned char* lds) {
    int* bc = (int*)lds;
    int* tot = (int*)(lds + 16384);
    int* ls = (int*)(lds + 16384 + 1024);
    const int tid = tidx(), lane = tid & 63, wid = tid >> 6;
    const int* meta = (const int*)(a.ws + WS_META);
    int* metaw = (int*)(a.ws + WS_META);
    const int G = gridDim.x;
    for (int i = tid; i < G * 16; i += 512) bc[i] = meta[i];
    if (tid < LOCAL_ASSIGN) ls[tid] = -1;
    __syncthreads();
    {
        int* part = (int*)(lds + 16384 + 4096);
        const int e = tid & 15, pr = tid >> 4; int t = 0, before = 0;
#pragma unroll
        for (int q = 0; q < 8; ++q) { const int b = pr * 8 + q; if (b < G) { const int c = bc[b * 16 + e]; t += c; if (b < (int)blockIdx.x) before += c; } }
        part[pr * 16 + e] = t; part[512 + pr * 16 + e] = before;
        __syncthreads();
        if (tid < 16) { int tt = 0, bb = 0;
#pragma unroll
            for (int q = 0; q < 32; ++q) { tt += part[q * 16 + tid]; bb += part[512 + q * 16 + tid]; }
            tot[tid] = tt; tot[16 + tid] = bb; }
    }
    __syncthreads();
    if (tid == 0) {
        int ps = 0, nt = 0;
#pragma unroll 1
        for (int e = 0; e < 16; ++e) {
            tot[32 + e] = ps; tot[64 + e] = nt; const int tiles = (tot[e] + 255) >> 8;
            nt += tiles; ps += tiles * 256;
        }
        tot[48] = ps; tot[80] = nt;
    }
    __syncthreads();
    if (blockIdx.x == 0) {
        const int nt = tot[80];
        if (tid == 0) metaw[META_NT] = nt;
        if (tid < nt) { int e = 0;
#pragma unroll 1
            for (int q = 1; q < 16; ++q) e += (tot[64 + q] <= tid) ? 1 : 0;
            metaw[META_TE + tid] = e; }
    }
    const int* RE = (const int*)(a.ws + WS_ROUTE_E);
    int* DEST = (int*)(a.ws + WS_DEST); int* SLOTA = (int*)(a.ws + WS_SLOTA);
    int* le2 = (int*)(lds + 16384 + 2048);
    int my_row = -1, my_kk = 0;
    if (tid < LOCAL_ASSIGN) {
        const int row = ln1_rowof(ln1_vcu(), tid >> 4, (tid >> 1) & 7, l == DEPTH - 1); my_kk = tid & 1;
        int e = -1;
        if (row >= 0) { e = RE[2 * row + my_kk]; my_row = row; }
        le2[tid] = e;
    }
    __syncthreads();
    if (tid < 16) {
        int pos = tot[32 + tid] + tot[16 + tid];
        for (int li = 0; li < LOCAL_ASSIGN; ++li) if (le2[li] == tid) { ls[li] = pos; ++pos; }
    }
    __syncthreads();
    if (tid < LOCAL_ASSIGN && my_row >= 0) { const int pos = ls[tid]; DEST[2 * my_row + my_kk] = pos; SLOTA[pos] = 2 * my_row + my_kk; }
    if (blockIdx.x < 16) {
        const int e = blockIdx.x; const int s0 = tot[32 + e] + tot[e], s1 = tot[32 + e] + (((tot[e] + 255) >> 8) << 8);
        for (int s = s0 + tid; s < s1; s += 512) SLOTA[s] = -1;
    }
    __syncthreads();
    __syncthreads();
}

DI void ph_combine_ln2(const Args& a, int l, unsigned char* lds, int rd = 0) {
    float* WT = (float*)lds;
    const bool last = (l == DEPTH - 1);
    const int tid = tidx(), lane = tid & 63, wid = tid >> 6;
    if (!last) { stage_wt16(WT, a.in[6] + (size_t)(l + 1) * 1024 * N_IN, N_IN, 3584, tid); }
    __syncthreads();
    const float* mods = (const float*)(a.ws + WS_MODS);
    const bf16_t* X = (const bf16_t*)(a.ws + WS_X); bf16_t* XO = rd ? (bf16_t*)(a.ws + WS_GPRE) : (bf16_t*)(a.ws + WS_X); bf16_t* H = rd ? (bf16_t*)(a.ws + WS_GPRE + 72 * MiB) : (bf16_t*)(a.ws + WS_H); float* AB = rd ? (float*)(a.ws + WS_GPRE + 110 * MiB) : (float*)(a.ws + WS_AB);
    float* OUT = rd ? (float*)(a.ws + WS_GPRE) : a.out;
    const bf16_t* YS = (const bf16_t*)(a.ws + WS_YS); const float* RW = (const float*)(a.ws + WS_ROUTE_W);
    const float* g = a.in[26] + l * 1024; const float* bb = a.in[27] + l * 1024;
    const int rstride = gridDim.x * 8;
    int row0 = blockIdx.x * 8 + wid; if (last) { while (row0 < NCTX) row0 += rstride; }
    u32x2 xn[4], yn0[4], yn1[4]; float wn0 = 0.f, wn1 = 0.f;
    if (row0 < TT) {
        wn0 = RW[2 * row0]; wn1 = RW[2 * row0 + 1];
#pragma unroll
        for (int j = 0; j < 4; ++j) { const int c = 256 * j + 4 * lane; xn[j] = *(const u32x2*)(X + (size_t)row0 * 1024 + c);
            yn0[j] = *(const u32x2*)(YS + (size_t)(2 * row0) * 1024 + c); yn1[j] = *(const u32x2*)(YS + (size_t)(2 * row0 + 1) * 1024 + c); }
    }
    f32x4 lg4[4], lb4[4], l1g[4], l1b[4];
#pragma unroll
    for (int j = 0; j < 4; ++j) { lg4[j] = *(const f32x4*)(g + 256 * j + 4 * lane); lb4[j] = *(const f32x4*)(bb + 256 * j + 4 * lane);
        l1g[j] = *(const f32x4*)(a.in[19] + l * 1024 + 256 * j + 4 * lane); l1b[j] = *(const f32x4*)(a.in[20] + l * 1024 + 256 * j + 4 * lane); }
#pragma unroll 1
    for (int row = row0; row < TT; row += rstride) {
        const float w0 = wn0, w1 = wn1;
        const float* m = mods + (size_t)(l * 5 + mod_set(row)) * 6144;
        const float* mn = mods + (size_t)((last ? l : l + 1) * 5 + mod_set(row)) * 6144;
        f32x4 x[4], h[4], gt[4], msh[4], msc[4]; u32x2 ya[4], yb[4];
#pragma unroll
        for (int j = 0; j < 4; ++j) { x[j] = bf4_f32(xn[j]); ya[j] = yn0[j]; yb[j] = yn1[j]; }
#pragma unroll
        for (int j = 0; j < 4; ++j) { const int c = 256 * j + 4 * lane; gt[j] = *(const f32x4*)(m + 5 * 1024 + c); msh[j] = *(const f32x4*)(mn + c); msc[j] = *(const f32x4*)(mn + 1024 + c); }
        { const int rn = row + rstride;
          if (rn < TT) {
            wn0 = RW[2 * rn]; wn1 = RW[2 * rn + 1];
#pragma unroll
            for (int j = 0; j < 4; ++j) { const int c = 256 * j + 4 * lane; xn[j] = *(const u32x2*)(X + (size_t)rn * 1024 + c);
                yn0[j] = *(const u32x2*)(YS + (size_t)(2 * rn) * 1024 + c); yn1[j] = *(const u32x2*)(YS + (size_t)(2 * rn + 1) * 1024 + c); }
          } }
        row_ln_r(x, l1g, l1b);
#pragma unroll
        for (int j = 0; j < 4; ++j) {
            const u32x2 y0 = ya[j], y1 = yb[j];
            f32x4 y;
            y[0] = w0 * __uint_as_float(y0.x << 16) + w1 * __uint_as_float(y1.x << 16);
            y[1] = w0 * __uint_as_float(y0.x & 0xffff0000u) + w1 * __uint_as_float(y1.x & 0xffff0000u);
            y[2] = w0 * __uint_as_float(y0.y << 16) + w1 * __uint_as_float(y1.y << 16);
            y[3] = w0 * __uint_as_float(y0.y & 0xffff0000u) + w1 * __uint_as_float(y1.y & 0xffff0000u);
            x[j] = ALPHA * x[j] + gt[j] * y;
        }
        row_ln_r(x, lg4, lb4);
        if (last) {
#pragma unroll
            for (int j = 0; j < 4; ++j) *(f32x4*)(OUT + (size_t)(row - NCTX) * 1024 + 256 * j + 4 * lane) = x[j];
        } else {
#pragma unroll
            for (int j = 0; j < 4; ++j) *(u32x2*)(XO + (size_t)row * 1024 + 256 * j + 4 * lane) = f32_bf4(x[j]);
#pragma unroll
            for (int j = 0; j < 4; ++j) h[j] = x[j] * (1.f + msc[j]) + msh[j];
            row_store_bf16(H + (size_t)row * 1024, h, lane);
            { const float abv = row_gemv16(h, WT, lane); if ((lane & 3) == 0) AB[(size_t)row * 16 + jj16_of_lane(lane)] = abv; }
        }
    }
    __syncthreads();
}

DI void transpose_item(const float* W, int ldw, int K, int ncols, bf16_t* WT, int item, float* scr, int lane, bool wt = false) {
    const int nblk = ncols >> 5, kb = item / nblk, nb = item - kb * nblk, k0 = 64 * kb, n0 = 32 * nb;
#pragma unroll 8
    for (int i = 0; i < 32; ++i) { const int kk = 2 * i + (lane >> 5); scr[kk * 33 + (lane & 31)] = W[(size_t)(k0 + kk) * ldw + n0 + (lane & 31)]; }
    asm volatile("s_waitcnt lgkmcnt(0)" ::: "memory");
    const int c = lane & 7;
#pragma unroll
    for (int j = 0; j < 4; ++j) { const int n = (lane >> 3) + 8 * j; const float* s = scr + (8 * c) * 33 + n;
        u32x4 o; o.x = pk2(s[0 * 33], s[1 * 33]); o.y = pk2(s[2 * 33], s[3 * 33]); o.z = pk2(s[4 * 33], s[5 * 33]); o.w = pk2(s[6 * 33], s[7 * 33]);
        if (wt) store16_wt(WT + (size_t)(n0 + n) * K + k0 + 8 * c, o); else *(u32x4*)(WT + (size_t)(n0 + n) * K + k0 + 8 * c) = o; }
    asm volatile("s_waitcnt lgkmcnt(0)" ::: "memory");
}
constexpr int CV_A = 2816, CV_B = 13312;
DI void convert_A(const Args& a, int l, int item, float* scr, int lane) {
    const float* w = a.in[6] + (size_t)l * 1024 * N_IN; bf16_t* wt = (bf16_t*)(a.ws + WS_WIN);
    if (item < 1792) transpose_item(w, N_IN, 1024, 3584, wt, item, scr, lane);
    else transpose_item(w + 3600, N_IN, 1024, 2048, wt + (size_t)3584 * 1024, item - 1792, scr, lane);
}
DI void convert_B(const Args& a, int l, int item, float* scr, int lane) {
    if (item < 256) {
        transpose_item(a.in[16] + (size_t)l * 512 * 1024, 1024, 512, 1024, (bf16_t*)(a.ws + WS_WPAB), item, scr, lane, true);
        asm volatile("s_waitcnt vmcnt(0)" ::: "memory");
        if (lane == 0) __hip_atomic_fetch_add((unsigned*)(a.ws + WS_CTL) + CW_CVT + l * 64, 1u, __ATOMIC_RELAXED, __HIP_MEMORY_SCOPE_AGENT);
        return; }
    item -= 256;
    if (item < 256) { transpose_item(a.in[17] + (size_t)l * 512 * 1024, 1024, 512, 1024, (bf16_t*)(a.ws + WS_WPAB) + (size_t)1024 * 512, item, scr, lane); return; }
    item -= 256;
    if (item < 512) { transpose_item(a.in[18] + (size_t)l * 1024 * 1024, 1024, 1024, 1024, (bf16_t*)(a.ws + WS_WO), item, scr, lane); return; }
    item -= 512;
    if (item < 8192) {
        const int job = item >> 6, it = item & 63; const int e = job >> 3, t = (job >> 1) & 3, which = job & 1;
        const float* w = (which ? a.in[24] : a.in[23]) + ((size_t)l * 16 + e) * 1024 * 512 + 128 * t;
        transpose_item(w, 512, 1024, 128, (bf16_t*)(a.ws + WS_W13) + ((size_t)e * 1024 + 256 * t + 128 * which) * 1024, it, scr, lane); return;
    }
    item -= 8192;
    { const int e = item >> 8, it = item & 255;
      transpose_item(a.in[25] + ((size_t)l * 16 + e) * 512 * 1024, 1024, 512, 1024, (bf16_t*)(a.ws + WS_W2) + (size_t)e * 1024 * 512, it, scr, lane); }
}
DI void convert_run(const Args& a, int lA, int lB, int rank, int nw, float* scr, int lane) {
    const int nA = (lA >= 0 && lA < DEPTH) ? CV_A : 0, nB = (lB >= 0 && lB < DEPTH) ? CV_B : 0;
    const int nP = nB ? 256 : 0;
#pragma unroll 1
    for (int it = rank; it < nA + nB; it += nw) { if (it < nP) convert_B(a, lB, it, scr, lane); else if (it < nP + nA) convert_A(a, lA, it - nP, scr, lane); else convert_B(a, lB, it - nA, scr, lane); }
}


#define XB_TMO      128
#define XB_XCNT(j)  (256  + 64 * (j))
#define XB_XSUB(j)  (1280 + 64 * (j))
#define XB_XGEN(j)  (2304 + 64 * (j))
#define XB_TOP      3328
#define XB_TOPGEN   3392
#define XCD_BAR_WORDS 3456
#define XB_SPIN_CAP (1u << 18)

__device__ __forceinline__ unsigned xb_ld(unsigned* p)              { return __hip_atomic_load(p, __ATOMIC_RELAXED, __HIP_MEMORY_SCOPE_AGENT); }
__device__ __forceinline__ unsigned xb_add(unsigned* p, unsigned v) { return __hip_atomic_fetch_add(p, v, __ATOMIC_RELAXED, __HIP_MEMORY_SCOPE_AGENT); }
__device__ __forceinline__ unsigned xb_xcc_id() { return (unsigned)__builtin_amdgcn_s_getreg((3 << 11) | 20) & 0xFu; }
#define XB_SPIN(cond, bar) do { unsigned _sp = 0; while (cond) { __builtin_amdgcn_s_sleep(1); \
    if ((++_sp & 255u) == 0u) { if (xb_ld(&(bar)[XB_TMO])) break; if (_sp > XB_SPIN_CAP) { atomicAdd(&(bar)[XB_TMO], 1u); break; } } } } while (0)

struct XcdBarrier {
    unsigned* bar; unsigned x;
    volatile LAS unsigned* st;
};

__device__ __forceinline__ XcdBarrier xcd_barrier_post(unsigned* bar, volatile LAS unsigned* st) {
    XcdBarrier b; b.bar = bar; b.x = xb_xcc_id(); b.st = st;
    if (tidx() == 0) (void)xb_add(&bar[XB_XCNT(b.x)], 1u);
    return b;
}
__device__ __forceinline__ void xcd_barrier_complete(unsigned* bar, unsigned x, unsigned& nloc, unsigned& nx) {
    const unsigned G = gridDim.x * gridDim.y * gridDim.z;
    unsigned sum, cnt, mine, sp = 0u;
    for (;;) {
        sum = 0u; cnt = 0u; mine = 0u;
#pragma unroll
        for (unsigned j = 0; j < 16; ++j) { const unsigned c = xb_ld(&bar[XB_XCNT(j)]); sum += c; cnt += (c > 0u) ? 1u : 0u; mine = (j == x) ? c : mine; }
        if (sum == G) break;
        __builtin_amdgcn_s_sleep(1);
        if ((++sp & 255u) == 0u) { if (xb_ld(&bar[XB_TMO])) break; if (sp > XB_SPIN_CAP) { atomicAdd(&bar[XB_TMO], 1u); break; } }
    }
    nloc = mine > 0u ? mine : 1u; nx = cnt > 0u ? cnt : 1u;
}

__device__ __forceinline__ void xcd_barrier(const XcdBarrier& b) {
    asm volatile("s_waitcnt vmcnt(0)" ::: "memory");
    __syncthreads();
    if (tidx() == 0) {
        unsigned* bar = b.bar;
        __builtin_amdgcn_s_waitcnt(0);
        unsigned nloc = b.st[0], nx = b.st[1];
        if (nloc == 0u) { xcd_barrier_complete(bar, b.x, nloc, nx); b.st[0] = nloc; b.st[1] = nx; }
        const unsigned old = xb_add(&bar[XB_XSUB(b.x)], 1u);
        const unsigned gen = old / nloc;
        if (old + 1u == (gen + 1u) * nloc) {
            __builtin_amdgcn_fence(__ATOMIC_RELEASE, "agent");
            asm volatile("s_waitcnt vmcnt(0)" ::: "memory");
            const unsigned og = xb_add(&bar[XB_TOP], 1u);
            const unsigned tg = og / nx;
            if (og + 1u == (tg + 1u) * nx) xb_add(&bar[XB_TOPGEN], 1u);
            else XB_SPIN(xb_ld(&bar[XB_TOPGEN]) == tg, bar);
            __builtin_amdgcn_fence(__ATOMIC_ACQUIRE, "agent");
            xb_add(&bar[XB_XGEN(b.x)], 1u);
            asm volatile("s_waitcnt vmcnt(0)" ::: "memory");
        } else {
            XB_SPIN(xb_ld(&bar[XB_XGEN(b.x)]) == gen, bar);
            __builtin_amdgcn_fence(__ATOMIC_ACQUIRE, "agent");
            asm volatile("s_waitcnt vmcnt(0)" ::: "memory");
        }
    }
    __syncthreads();
}


DI int unit_set(int pm) { return pm < 4 ? 4 : ((pm - 4) >> 4); }
struct EpiInproj {
    static constexpr bool PERM = true, AFTER_DRAIN = false, GATHER_A = false;
    unsigned char* ws;
    DI void operator()(const f32x4 (&acc)[2][2][4][2], const pg8::Unit& u, int wr, int wc, int fr, int fq) const {
        const int pn = u.pn; bf16_t* dst; int ld, colt, mode;
        if (pn < 2) { dst = (bf16_t*)(ws + WS_QA); ld = 512; colt = pn * 256; mode = 1; }
        else if (pn < 4) { dst = (bf16_t*)(ws + WS_KA); ld = 512; colt = (pn - 2) * 256; mode = 2; }
        else if (pn < 6) { dst = (bf16_t*)(ws + WS_VA); ld = 512; colt = (pn - 4) * 256; mode = 0; }
        else if (pn < 12) { dst = (bf16_t*)(ws + WS_QKV); ld = 1536; colt = (pn - 6) * 256; mode = 0; }
        else if (pn < 14) { dst = (bf16_t*)(ws + WS_Z); ld = 512; colt = (pn - 12) * 256; mode = 0; }
        else { dst = (bf16_t*)(ws + WS_SG); ld = 2048; colt = (pn - 14) * 256; mode = 3; }
        const bool rope = (mode == 1 || mode == 2) && u.pm >= 4;
        const float qs = (mode == 1) ? QSCALE : 1.f;
        const float* rtab = (const float*)(ws + WS_ROPE);
        const int row0 = u.pm * 256 + wr * 64 + fr;
        const float sgn = (fq >> 1) ? 1.f : -1.f;
        f32x4 csn[2][2];
        if (rope) {
            const int t = (row0 - NCTX) & 4095; const int pos = (wc & 1) ? (t & 63) : (t >> 6);
            const float* rp = rtab + (pos * 16 + 8 * (fq & 1)) * 2;
#pragma unroll
            for (int n = 0; n < 2; ++n) { csn[n][0] = *(const f32x4*)(rp + 8 * n); csn[n][1] = *(const f32x4*)(rp + 8 * n + 4); }
        }
#pragma unroll
        for (int s = 0; s < 8; ++s) {
            const int ai = s >> 2, m = s & 3;
            const int row = row0 + ai * 128 + m * 16;
            f32x4 cs[2][2];
            if (rope) {
#pragma unroll
                for (int n = 0; n < 2; ++n) { cs[n][0] = csn[n][0]; cs[n][1] = csn[n][1]; }
                if (s < 7) {
                    const int r1 = row0 + ((s + 1) >> 2) * 128 + ((s + 1) & 3) * 16;
                    const int t = (r1 - NCTX) & 4095; const int pos = (wc & 1) ? (t & 63) : (t >> 6);
                    const float* rp = rtab + (pos * 16 + 8 * (fq & 1)) * 2;
#pragma unroll
                    for (int n = 0; n < 2; ++n) { csn[n][0] = *(const f32x4*)(rp + 8 * n); csn[n][1] = *(const f32x4*)(rp + 8 * n + 4); }
                }
            }
#pragma unroll
            for (int bj = 0; bj < 2; ++bj) {
                f32x4 v[2] = {acc[ai][bj][m][0], acc[ai][bj][m][1]};
                if (rope) {
#pragma unroll
                    for (int n = 0; n < 2; ++n)
#pragma unroll
                        for (int j = 0; j < 4; ++j) {
                            const float x = v[n][j], xp = __shfl_xor(x, 32);
                            const float c = cs[n][j >> 1][(j & 1) * 2], sv = cs[n][j >> 1][(j & 1) * 2 + 1];
                            v[n][j] = x * c + sgn * xp * sv;
                        }
                }
                if (mode == 3) {
#pragma unroll
                    for (int n = 0; n < 2; ++n)
#pragma unroll
                        for (int j = 0; j < 4; ++j) v[n][j] = sigmoidf_(v[n][j]);
                }
                u32x4 w; w.x = pk2(v[0][0] * qs, v[0][1] * qs); w.y = pk2(v[0][2] * qs, v[0][3] * qs); w.z = pk2(v[1][0] * qs, v[1][1] * qs); w.w = pk2(v[1][2] * qs, v[1][3] * qs);
                *(u32x4*)(dst + (size_t)row * ld + colt + bj * 128 + wc * 32 + 8 * fq) = w;
            }
        }
    }
};
struct EpiMerge1 {
    static constexpr bool PERM = true, AFTER_DRAIN = false, GATHER_A = false;
    unsigned char* ws;
    DI void operator()(const f32x4 (&acc)[2][2][4][2], const pg8::Unit& u, int wr, int wc, int fr, int fq) const {
        const int which = u.pm >= 68 ? 1 : 0; const int pm = u.pm - 68 * which, pn = u.pn - 4 * which;
        const bf16_t* SG = (const bf16_t*)(ws + WS_SG); bf16_t* M = (bf16_t*)(ws + WS_M); bf16_t* MP = (bf16_t*)(ws + WS_QA);
        const int row0 = pm * 256 + wr * 64 + fr, colb = pn * 256 + wc * 32 + 8 * fq;
        u32x4 gn[2], on[2], gc[2], oc[2];
#pragma unroll
        for (int bj = 0; bj < 2; ++bj) { gn[bj] = *(const u32x4*)(SG + (size_t)row0 * 2048 + which * 1024 + colb + bj * 128); on[bj] = (u32x4){0u, 0u, 0u, 0u};
            if (which) on[bj] = *(const u32x4*)(MP + (size_t)row0 * 1024 + colb + bj * 128); }
#pragma unroll
        for (int s = 0; s < 8; ++s) {
            const int ai = s >> 2, m = s & 3, row = row0 + ai * 128 + m * 16;
#pragma unroll
            for (int bj = 0; bj < 2; ++bj) { gc[bj] = gn[bj]; oc[bj] = on[bj]; }
            if (s < 7) { const int r1 = row0 + ((s + 1) >> 2) * 128 + ((s + 1) & 3) * 16;
#pragma unroll
                for (int bj = 0; bj < 2; ++bj) { gn[bj] = *(const u32x4*)(SG + (size_t)r1 * 2048 + which * 1024 + colb + bj * 128);
                    if (which) on[bj] = *(const u32x4*)(MP + (size_t)r1 * 1024 + colb + bj * 128); } }
#pragma unroll
            for (int bj = 0; bj < 2; ++bj) {
                float v[8];
#pragma unroll
                for (int i = 0; i < 4; ++i) {
                    v[2 * i] = __uint_as_float(gc[bj][i] << 16) * acc[ai][bj][m][i >> 1][(i & 1) * 2] + __uint_as_float(oc[bj][i] << 16);
                    v[2 * i + 1] = __uint_as_float(gc[bj][i] & 0xffff0000u) * acc[ai][bj][m][i >> 1][(i & 1) * 2 + 1] + __uint_as_float(oc[bj][i] & 0xffff0000u);
                }
                u32x4 w; w.x = pk2(v[0], v[1]); w.y = pk2(v[2], v[3]); w.z = pk2(v[4], v[5]); w.w = pk2(v[6], v[7]);
                if (which) store16_wt(M + (size_t)row * 1024 + colb + bj * 128, w); else *(u32x4*)(MP + (size_t)row * 1024 + colb + bj * 128) = w;
            }
        }
    }
};
DI unsigned* cvt_word(unsigned char* ws, int l) { return (unsigned*)(ws + WS_CTL) + CW_CVT + l * 64; }
struct SchedMergeA {
    int G, c, pm0; unsigned char* ws; int l;
    DI bool next(int i, pg8::Unit& u) const { const int tl = i * G + c; if (tl >= (68 - pm0) * 4) return false; u.pm = pm0 + (tl >> 2); u.pn = tl & 3; return true; }
    DI void a_ready(const pg8::Unit&) const { panel_wait(cvt_word(ws, l), 256u); }
    DI void done(const pg8::Unit&) const {}
};
struct SchedMerge1 {
    int G, c, pm0; unsigned char* ws; int l;
    DI bool next(int i, pg8::Unit& u) const {
        const int tl = i * G + c; if (tl >= (68 - pm0) * 4) return false;
        u.pm = pm0 + (tl >> 2) + 68; u.pn = (tl & 3) + 4; return true;
    }
    DI void a_ready(const pg8::Unit&) const {}
    DI void done(const pg8::Unit& u) const { panel_publish(panel_word(ws, l, 0, u.pm - 68)); }
};
struct SchedWoWait {
    int G, c, pm0; unsigned char* ws; int l;
    DI bool next(int i, pg8::Unit& u) const {
        int tl;
        if (i == 0) tl = c; else if (i == 1 && c >= 16 && c < 32) tl = G + (c - 16); else return false;
        if (tl >= (68 - pm0) * 4) return false;
        u.pm = pm0 + (tl >> 2); u.pn = tl & 3; return true;
    }
    DI void a_ready(const pg8::Unit& u) const { panel_wait(panel_word(ws, l, 0, u.pm), 32u); }
    DI void done(const pg8::Unit& u) const { panel_publish(wo_word(ws, l, u.pm)); }
};
struct SchedRows {
    int G, c, pm0, nN;
    DI bool next(int i, pg8::Unit& u) const { const int tl = i * G + c; if (tl >= (68 - pm0) * nN) return false; u.pm = pm0 + tl / nN; u.pn = tl % nN; return true; }
    DI void a_ready(const pg8::Unit&) const {}
    DI void done(const pg8::Unit&) const {}
};
struct EpiWo {
    static constexpr bool PERM = true, AFTER_DRAIN = false, GATHER_A = false;
    unsigned char* ws; int l; int rd;
    DI void operator()(const f32x4 (&acc)[2][2][4][2], const pg8::Unit& u, int wr, int wc, int fr, int fq) const {
        const bf16_t* X = (const bf16_t*)(ws + WS_X); bf16_t* XO = rd ? (bf16_t*)(ws + WS_GPRE) : (bf16_t*)(ws + WS_X);
        const float* mg = (const float*)(ws + WS_MODS) + (size_t)(l * 5 + unit_set(u.pm)) * 6144 + 2 * 1024;
        const int row0 = u.pm * 256 + wr * 64 + fr, col0 = u.pn * 256 + wc * 32 + 8 * fq;
        f32x4 gv[2][2];
#pragma unroll
        for (int bj = 0; bj < 2; ++bj)
#pragma unroll
            for (int n = 0; n < 2; ++n) gv[bj][n] = *(const f32x4*)(mg + col0 + bj * 128 + 4 * n);
        u32x4 xc[2], xn[2];
        { const bf16_t* rowp = X + (size_t)row0 * 1024 + col0;
#pragma unroll
          for (int bj = 0; bj < 2; ++bj) xn[bj] = *(const u32x4*)(rowp + bj * 128); }
#pragma unroll
        for (int s = 0; s < 8; ++s) {
            const int ai = s >> 2, m = s & 3;
#pragma unroll
            for (int bj = 0; bj < 2; ++bj) xc[bj] = xn[bj];
            if (s < 7) { const int ai1 = (s + 1) >> 2, m1 = (s + 1) & 3; const bf16_t* rp = X + (size_t)(row0 + ai1 * 128 + m1 * 16) * 1024 + col0;
#pragma unroll
                for (int bj = 0; bj < 2; ++bj) xn[bj] = *(const u32x4*)(rp + bj * 128); }
            bf16_t* rowp = XO + (size_t)(row0 + ai * 128 + m * 16) * 1024 + col0;
#pragma unroll
            for (int bj = 0; bj < 2; ++bj) {
                const f16x8 xh = __builtin_bit_cast(f16x8, xc[bj]);
                f16x8 oh;
#pragma unroll
                for (int n = 0; n < 2; ++n) {
                    const f32x4 av = acc[ai][bj][m][n], g4 = gv[bj][n];
#pragma unroll
                    for (int i = 0; i < 4; ++i) oh[4 * n + i] = (_Float16)xclamp(ALPHA * (float)xh[4 * n + i] + g4[i] * av[i]);
                }
                const u32x4 w = __builtin_bit_cast(u32x4, oh);
                if (rd) *(u32x4*)(rowp + bj * 128) = w; else store16_wt(rowp + bj * 128, w);
            }
        }
    }
};
struct SchedMoe {
    int G, c, ntiles; const int* tile_e; unsigned char* ws; int l, mode;
    DI bool next(int i, pg8::Unit& u) const {
        int x;
        const int U = ntiles * 4;
        if (mode != 2 || G != 256) x = i * G + c;
        else {
            const int h = U & 255, E = U & ~255;
            if (c < h) { if (i > 0) return false; x = E + c; }
            else { x = (c - h) + (256 - h) * i; if (x >= E) return false; }
        }
        if (x >= U) return false;
        u.pm = x >> 2; u.pn = tile_e[x >> 2] * 4 + (x & 3); return true;
    }
    DI void a_ready(const pg8::Unit& u) const { if (mode == 2) panel_wait(panel_word(ws, l, 1, u.pm), 32u); }
    DI void done(const pg8::Unit& u) const { if (mode == 1) panel_publish(panel_word(ws, l, 1, u.pm)); }
};
struct EpiUp {
    static constexpr bool PERM = true, AFTER_DRAIN = false, GATHER_A = true;
    unsigned char* ws;
    DI int arow(int slot) const { const int s = ((const int*)(ws + WS_SLOTA))[slot]; return s < 0 ? 0 : (s >> 1); }
    DI void operator()(const f32x4 (&acc)[2][2][4][2], const pg8::Unit& u, int wr, int wc, int fr, int fq) const {
        bf16_t* ACT = (bf16_t*)(ws + WS_ACT);
        const int j = u.pn & 3; const int row0 = u.pm * 256 + wr * 64 + fr; const int col = j * 128 + wc * 32 + 8 * fq;
#pragma unroll
        for (int ai = 0; ai < 2; ++ai)
#pragma unroll
            for (int m = 0; m < 4; ++m) {
                float v[8];
#pragma unroll
                for (int n = 0; n < 2; ++n)
#pragma unroll
                    for (int i = 0; i < 4; ++i) v[4 * n + i] = siluf_(acc[ai][0][m][n][i]) * acc[ai][1][m][n][i];
                u32x4 w; w.x = pk2(v[0], v[1]); w.y = pk2(v[2], v[3]); w.z = pk2(v[4], v[5]); w.w = pk2(v[6], v[7]);
                store16_wt(ACT + (size_t)(row0 + ai * 128 + m * 16) * 512 + col, w);
            }
    }
};
struct EpiDown {
    static constexpr bool PERM = true, AFTER_DRAIN = false, GATHER_A = false;
    unsigned char* ws;
    DI void operator()(const f32x4 (&acc)[2][2][4][2], const pg8::Unit& u, int wr, int wc, int fr, int fq) const {
        bf16_t* YS = (bf16_t*)(ws + WS_YS); const int* SLOTA = (const int*)(ws + WS_SLOTA);
        const int j = u.pn & 3; const int row0 = u.pm * 256 + wr * 64 + fr;
        int asv[2][4];
#pragma unroll
        for (int ai = 0; ai < 2; ++ai)
#pragma unroll
            for (int m = 0; m < 4; ++m) asv[ai][m] = SLOTA[row0 + ai * 128 + m * 16];
#pragma unroll
        for (int ai = 0; ai < 2; ++ai)
#pragma unroll
            for (int m = 0; m < 4; ++m) {
                const int as = asv[ai][m];
                if (as >= 0) {
#pragma unroll
                    for (int bj = 0; bj < 2; ++bj) {
                        const f32x4 v0 = acc[ai][bj][m][0], v1 = acc[ai][bj][m][1];
                        u32x4 w; w.x = pk2(v0[0], v0[1]); w.y = pk2(v0[2], v0[3]); w.z = pk2(v1[0], v1[1]); w.w = pk2(v1[2], v1[3]);
                        *(u32x4*)(YS + (size_t)as * 1024 + j * 256 + bj * 128 + wc * 32 + 8 * fq) = w;
                    }
                }
            }
    }
};


#ifndef ATT_THR
#define ATT_THR 8.0f
#endif
#ifndef ATT_STAGGER
#define ATT_STAGGER 0
#endif
typedef short s16x4 __attribute__((ext_vector_type(4)));
#define MFMA32(a, b, c) __builtin_amdgcn_mfma_f32_32x32x16_bf16((a), (b), (c), 0, 0, 0)
DI int crow(int i, int hl) { return (i & 3) + 8 * (i >> 2) + 4 * hl; }
DI bf16x8 pack8(const f32x16& x, int s) {
    u32x4 p; p.x = pk2(x[8 * s], x[8 * s + 1]); p.y = pk2(x[8 * s + 2], x[8 * s + 3]); p.z = pk2(x[8 * s + 4], x[8 * s + 5]); p.w = pk2(x[8 * s + 6], x[8 * s + 7]);
    return __builtin_bit_cast(bf16x8, p);
}
DI s16x4 tr_read(const LAS unsigned char* p) { return __builtin_bit_cast(s16x4, __builtin_amdgcn_ds_read_tr16_b64_v4i16((LAS s16x4*)p)); }
constexpr int AT_KB = 9216, AT_VB = 16384, AT_K0 = 0, AT_V0 = 2 * AT_KB, AT_ST = 65536;

struct AttnIt { const bf16_t* kp; const bf16_t* vp; int kc0, kl0, nT; unsigned kdst, vdst0, kread, vread; };
template <int FAKE, bool BAR> DI void attn_iter(int t, const AttnIt& g, LAS unsigned char* lds, unsigned kA, unsigned kB, unsigned vA, unsigned vB, u32x4& rk, u32x4& rv0, u32x4& rv1,
                  f32x16 (&st)[2], f32x16 (&sn)[2], f32x16 (&o)[4], f32x16& negm, float& lrun, const bf16x8 (&qf)[4]) {
    const int kc0 = g.kc0, kl0 = g.kl0, nT = g.nT;
#define KROW(t_) ((t_) < 4 ? kc0 + 64 * (t_) : kl0 + 64 * ((t_) - 4))
    *(LAS u32x4*)(lds + kB + g.kdst) = rk; *(LAS u32x4*)(lds + vB + g.vdst0) = rv0; *(LAS u32x4*)(lds + vB + g.vdst0 + 2048) = rv1;
    { const int tk = (t + 4 < nT) ? t + 4 : nT - 1, tv = (t + 3 < nT) ? t + 3 : nT - 1;
      const int krk = KROW(tk), krv = KROW(tv);
      if (FAKE != 4) { rk = *(const u32x4*)(g.kp + (size_t)krk * 512); rv0 = *(const u32x4*)(g.vp + (size_t)krv * 512); rv1 = *(const u32x4*)(g.vp + (size_t)(krv + 32) * 512); } }
#undef KROW
    const LAS unsigned char* kb = lds + kA + g.kread;
    const LAS unsigned char* vb = lds + vA + g.vread;
    bf16x8 kf[4];
#pragma unroll
    for (int x = 0; x < 4; ++x) kf[x] = *(const LAS bf16x8*)(kb + (x & 1) * 32 * 144 + (x >> 1) * 32);
    s16x4 lo[2][2], hi[2][2];
#pragma unroll
    for (int k2 = 0; k2 < 2; ++k2) { lo[0][k2] = tr_read(vb + k2 * 4096); hi[0][k2] = tr_read(vb + k2 * 4096 + 512); }
    float mx = fmaxf(fmaxf(st[0][0], st[0][1]), st[0][2]);
#pragma unroll
    for (int i = 3; i < 15; i += 2) mx = fmaxf(fmaxf(mx, st[0][i]), st[0][i + 1]);
    mx = fmaxf(mx, st[0][15]);
#pragma unroll
    for (int i = 0; i < 16; i += 2) mx = fmaxf(fmaxf(mx, st[1][i]), st[1][i + 1]);
    { auto rr = __builtin_amdgcn_permlane32_swap(__float_as_uint(mx), __float_as_uint(mx), false, false); mx = fmaxf(__uint_as_float(rr[0]), __uint_as_float(rr[1])); }
    const bool need = mx > ATT_THR;
    if (__builtin_amdgcn_ballot_w64(need) != 0) {
        const float delta = need ? mx : 0.f, alpha = __builtin_amdgcn_exp2f(-delta);
        lrun *= alpha;
#pragma unroll
        for (int d = 0; d < 4; ++d)
#pragma unroll
            for (int i = 0; i < 16; ++i) o[d][i] *= alpha;
#pragma unroll
        for (int i = 0; i < 16; ++i) { negm[i] -= delta; st[0][i] -= delta; st[1][i] -= delta; }
    }
    float ps = 0.f;
    __builtin_amdgcn_sched_barrier(0);
#pragma unroll
    for (int x = 0; x < 8; ++x) {
        if (FAKE == 5) { sn[x & 1] = st[x & 1]; } else
        if (x < 2) sn[x & 1] = MFMA32(kf[x & 3], qf[x >> 1], negm);
        else sn[x & 1] = MFMA32(kf[x & 3], qf[x >> 1], sn[x & 1]);
        if (x < 4) kf[x] = *(const LAS bf16x8*)(kb + (x & 1) * 32 * 144 + ((x + 4) >> 1) * 32);
#pragma unroll
        for (int e = 0; e < 4; ++e) { const int i = 4 * (x & 3) + e, kt = x >> 2; const float p = __builtin_amdgcn_exp2f(st[kt][i]); st[kt][i] = p; ps += p; }
        __builtin_amdgcn_sched_barrier(0);
    }
    lrun += ps;
    bf16x8 pb[4];
#pragma unroll
    for (int ks = 0; ks < 4; ++ks) pb[ks] = pack8(st[ks >> 1], ks & 1);
    __builtin_amdgcn_sched_barrier(0);
    if (ATT_STAGGER && FAKE != 6) __syncthreads();
#pragma unroll
    for (int u = 0; u < (FAKE == 3 ? 0 : 8); ++u) {
        const int ks = u >> 1, dp = u & 1;
        if (u < 7) {
            const int ks1 = (u + 1) >> 1, dp1 = (u + 1) & 1;
#pragma unroll
            for (int k2 = 0; k2 < 2; ++k2) { lo[(u + 1) & 1][k2] = tr_read(vb + (2 * dp1 + k2) * 4096 + ks1 * 1024); hi[(u + 1) & 1][k2] = tr_read(vb + (2 * dp1 + k2) * 4096 + ks1 * 1024 + 512); }
        }
#pragma unroll
        for (int k2 = 0; k2 < 2; ++k2) {
            const int d = 2 * dp + k2;
            const bf16x8 vf = (bf16x8){lo[u & 1][k2][0], lo[u & 1][k2][1], lo[u & 1][k2][2], lo[u & 1][k2][3], hi[u & 1][k2][0], hi[u & 1][k2][1], hi[u & 1][k2][2], hi[u & 1][k2][3]};
            o[d] = MFMA32(vf, pb[ks], o[d]);
        }
        __builtin_amdgcn_sched_barrier(0);
    }
    if (BAR) __syncthreads();
}
constexpr int AT3_K = 0, AT3_V = 4 * AT_KB;
template <int FAKE> DI void attn_unit(const Args& a, int l, int h, int qrow0, int nT, int kc0, int kl0, float lam, LAS unsigned char* lds) {
    const int tid = tidx(), lane = tid & 63, wid = tid >> 6, r = lane & 31, hl = lane >> 5;
    const bf16_t* QA = (const bf16_t*)(a.ws + WS_QA); const bf16_t* KA = (const bf16_t*)(a.ws + WS_KA); const bf16_t* VA = (const bf16_t*)(a.ws + WS_VA);
    const int qrow = qrow0 + 32 * wid + r;
    const int kkey = tid >> 3, kch = tid & 7;
    const unsigned kdst = (unsigned)(kkey * 144 + kch * 16);
    const int vkey0 = tid >> 4, vch = tid & 15;
    const unsigned vdst0 = (unsigned)((vch >> 2) * 4096 + vkey0 * 64 + (vch & 3) * 16);
    const unsigned kread = (unsigned)(r * 144 + hl * 16);
    const unsigned vread = (unsigned)(((lane >> 4) & 1) * 32 + (lane & 3) * 8 + (4 * hl + ((lane & 15) >> 2)) * 64);
#define KROW(t_) ((t_) < 4 ? kc0 + 64 * (t_) : kl0 + 64 * ((t_) - 4))
#pragma unroll 1
    for (int comp = 0; comp < 2; ++comp) {
        bf16x8 qf[4];
#pragma unroll
        for (int s = 0; s < 4; ++s) qf[s] = *(const bf16x8*)(QA + (size_t)qrow * 512 + h * 128 + comp * 64 + 16 * s + 8 * hl);
        f32x16 o[4];
#pragma unroll
        for (int d = 0; d < 4; ++d)
#pragma unroll
            for (int i = 0; i < 16; ++i) o[d][i] = 0.f;
        float lrun = 0.f;
        const bf16_t* kp = KA + (size_t)kkey * 512 + h * 128 + comp * 64 + kch * 8;
        const bf16_t* vp = VA + (size_t)vkey0 * 512 + h * 128 + vch * 8;
        u32x4 rk, rv0, rv1;
        {
            const int kr0 = KROW(0), kr1 = KROW(1), kr2 = KROW(2), kr3 = KROW(3);
            const u32x4 k0 = *(const u32x4*)(kp + (size_t)kr0 * 512), k1 = *(const u32x4*)(kp + (size_t)kr1 * 512), k2 = *(const u32x4*)(kp + (size_t)kr2 * 512);
            const u32x4 v0 = *(const u32x4*)(vp + (size_t)kr0 * 512), v1 = *(const u32x4*)(vp + (size_t)(kr0 + 32) * 512);
            const u32x4 v2 = *(const u32x4*)(vp + (size_t)kr1 * 512), v3 = *(const u32x4*)(vp + (size_t)(kr1 + 32) * 512);
            rk = *(const u32x4*)(kp + (size_t)kr3 * 512); rv0 = *(const u32x4*)(vp + (size_t)kr2 * 512); rv1 = *(const u32x4*)(vp + (size_t)(kr2 + 32) * 512);
            *(LAS u32x4*)(lds + AT3_K + kdst) = k0; *(LAS u32x4*)(lds + AT3_K + AT_KB + kdst) = k1; *(LAS u32x4*)(lds + AT3_K + 2 * AT_KB + kdst) = k2;
            *(LAS u32x4*)(lds + AT3_V + vdst0) = v0; *(LAS u32x4*)(lds + AT3_V + vdst0 + 2048) = v1;
            *(LAS u32x4*)(lds + AT3_V + AT_VB + vdst0) = v2; *(LAS u32x4*)(lds + AT3_V + AT_VB + vdst0 + 2048) = v3;
        }
        __syncthreads();
        f32x16 st[2];
#pragma unroll
        for (int kt = 0; kt < 2; ++kt) {
#pragma unroll
            for (int i = 0; i < 16; ++i) st[kt][i] = 0.f;
#pragma unroll
            for (int s = 0; s < 4; ++s) st[kt] = MFMA32(*(const LAS bf16x8*)(lds + AT3_K + kread + kt * 32 * 144 + s * 32), qf[s], st[kt]);
        }
        f32x16 negm;
        {
            float mx0 = st[0][0];
#pragma unroll
            for (int i = 1; i < 16; ++i) mx0 = fmaxf(mx0, st[0][i]);
#pragma unroll
            for (int i = 0; i < 16; ++i) mx0 = fmaxf(mx0, st[1][i]);
            { auto rr = __builtin_amdgcn_permlane32_swap(__float_as_uint(mx0), __float_as_uint(mx0), false, false); mx0 = fmaxf(__uint_as_float(rr[0]), __uint_as_float(rr[1])); }
#pragma unroll
            for (int i = 0; i < 16; ++i) { negm[i] = -mx0; st[0][i] -= mx0; st[1][i] -= mx0; }
        }
        const AttnIt geo{kp, vp, kc0, kl0, nT, kdst, vdst0, kread, vread};
        f32x16 sn[2];
#define KBUF(x_) ((unsigned)(AT3_K + (((x_) & 3) * AT_KB)))
#define VBUF(x_) ((unsigned)(AT3_V + (((x_) & 3) * AT_VB)))
#pragma unroll 1
        for (int t = 0; t < nT; t += 2) {
            attn_iter<FAKE, false>(t, geo, lds, KBUF(t + 1), KBUF(t + 3), VBUF(t), VBUF(t + 2), rk, rv0, rv1, st, sn, o, negm, lrun, qf);
            attn_iter<FAKE, true>(t + 1, geo, lds, KBUF(t + 2), KBUF(t + 4), VBUF(t + 1), VBUF(t + 3), rk, rv0, rv1, sn, st, o, negm, lrun, qf);
        }
#undef KBUF
#undef VBUF
        const float ltot = lrun + __shfl_xor(lrun, 32);
        const float inv = 1.f / ltot;
        const int tid2 = tidx(), lane2 = tid2 & 63, wid2 = tid2 >> 6, hl2 = lane2 >> 5;
        const int qrow2 = qrow0 + 32 * wid2 + (lane2 & 31);
        unsigned char* stash = a.ws + WS_M + (size_t)blockIdx.x * 65536 + wid2 * 8192 + lane2 * 16;
        if (comp == 0) {
#pragma unroll
            for (int d = 0; d < 4; ++d) {
                u32x4 w0, w1;
                w0.x = pk2(o[d][0] * inv, o[d][1] * inv); w0.y = pk2(o[d][2] * inv, o[d][3] * inv); w0.z = pk2(o[d][4] * inv, o[d][5] * inv); w0.w = pk2(o[d][6] * inv, o[d][7] * inv);
                w1.x = pk2(o[d][8] * inv, o[d][9] * inv); w1.y = pk2(o[d][10] * inv, o[d][11] * inv); w1.z = pk2(o[d][12] * inv, o[d][13] * inv); w1.w = pk2(o[d][14] * inv, o[d][15] * inv);
                *(u32x4*)(stash + (2 * d) * 1024) = w0; *(u32x4*)(stash + (2 * d + 1) * 1024) = w1;
            }
        } else {
            bf16_t* YA = FAKE ? (bf16_t*)(a.ws + WS_GPRE) : (bf16_t*)(a.ws + WS_YAB);
            int l2_ = l; asm volatile("" : "+v"(l2_));
            const float li = lam_init_of(l2_);
            float ss = 0.f;
#pragma unroll
            for (int d = 0; d < 4; ++d) {
                const u32x4 on0 = *(const u32x4*)(stash + (2 * d) * 1024), on1s = *(const u32x4*)(stash + (2 * d + 1) * 1024);
#pragma unroll
                for (int k = 0; k < 4; ++k) {
                    const unsigned wa = on0[k], wb = on1s[k];
                    const float a0 = __uint_as_float(wa << 16), a1 = __uint_as_float(wa & 0xffff0000u), b0 = __uint_as_float(wb << 16), b1 = __uint_as_float(wb & 0xffff0000u);
                    o[d][2 * k] = a0 - lam * o[d][2 * k] * inv; o[d][2 * k + 1] = a1 - lam * o[d][2 * k + 1] * inv;
                    o[d][8 + 2 * k] = b0 - lam * o[d][8 + 2 * k] * inv; o[d][8 + 2 * k + 1] = b1 - lam * o[d][8 + 2 * k + 1] * inv;
                    ss += o[d][2 * k] * o[d][2 * k] + o[d][2 * k + 1] * o[d][2 * k + 1] + o[d][8 + 2 * k] * o[d][8 + 2 * k] + o[d][8 + 2 * k + 1] * o[d][8 + 2 * k + 1];
                }
            }
            ss += __shfl_xor(ss, 32);
            const float rs = rsqrtf(ss * (1.f / 128.f) + EPS) * (1.f - li);
            const float* sg = a.in[12] + l * 128;
#pragma unroll
            for (int d = 0; d < 4; ++d)
#pragma unroll
                for (int ig = 0; ig < 4; ++ig) {
                    const int dv0 = 32 * d + 8 * ig + 4 * hl2;
                    const f32x4 g4 = *(const f32x4*)(sg + dv0);
                    u32x2 w; w.x = pk2(o[d][4 * ig] * rs * g4[0], o[d][4 * ig + 1] * rs * g4[1]); w.y = pk2(o[d][4 * ig + 2] * rs * g4[2], o[d][4 * ig + 3] * rs * g4[3]);
                    *(u32x2*)(YA + (size_t)qrow2 * 512 + h * 128 + dv0) = w;
                }
        }
    }
#undef KROW
}
template <int FAKE> DI void ph_attn(const Args& a, int l, LAS unsigned char* lds) {
    const int ln_ = tidx() & 63;
    const float s1 = wave_sum(a.in[8][l * 64 + ln_] * a.in[9][l * 64 + ln_]), s2 = wave_sum(a.in[10][l * 64 + ln_] * a.in[11][l * 64 + ln_]);
    int l3_ = l; asm volatile("" : "+v"(l3_));
    const float lam = expf(s1) - expf(s2) + lam_init_of(l3_);
    const int G = gridDim.x, bx = blockIdx.x;
    const int vcu = (G % 8 == 0) ? (bx % 8) * (G / 8) + bx / 8 : bx;
    for (int u = vcu; u < 256; u += G) {
        const int bh = u >> 4, qt = u & 15, b = bh >> 2, h = bh & 3;
        attn_unit<FAKE>(a, l, h, NCTX + b * SEQ + qt * 256, 68, b * CTX, NCTX + b * SEQ, lam, lds);
    }
    if (l < DEPTH - 1) {
        if (G >= 80) { if (bx >= 64 && bx < 80) { const int u = bx - 64, b = u >> 2, h = u & 3; attn_unit<FAKE>(a, l, h, b * CTX, 4, b * CTX, 0, lam, lds); } }
        else for (int u = vcu; u < 16; u += G) { const int b = u >> 2, h = u & 3; attn_unit<FAKE>(a, l, h, b * CTX, 4, b * CTX, 0, lam, lds); }
    }
}


constexpr int GP_WN = 0, GP_QD = 8192, GP_KDT = 16384, GP_QK = 24576, GP_U = 28672, GP_REC = 36864;
DI int swap23(int p) { return (p & ~12) | ((p & 4) << 1) | ((p & 8) >> 1); }
DI int chunk_index(int dir, int b, int h, int cc) { return ((dir * 4 + b) * 4 + h) * 68 + cc; }
constexpr int G1_XS = 71680, G1_XST = 832, G1_WS = 71680 + 68 * 832;
constexpr int G1_QS = 0, G1_KS = 17408, G1_VS = 34816  , G1_GS = 71680, G1_QKS = 88064, G1_AT = 104448  , G1_SM = LDS_MISC + 256;
DI float* g1_sm(unsigned char* lds, int dir, int kind) { return (float*)(lds + G1_SM) + (dir * 5 + kind) * 64; }

#ifndef G1REP1
#define G1REP1 1
#endif
#ifndef G1REP6
#define G1REP6 1
#endif
#ifndef G1REP7
#define G1REP7 1
#endif
DI void g1_task(const Args& a, int l, int b, int h, int cc, unsigned char* lds, int cut = 0) {
    const int tid = tidx(), lane = tid & 63, wid = tid >> 6, r = lane & 31, hl = lane >> 5;
    const int s0 = cc < 4 ? b * CTX : NCTX + b * SEQ, len = cc < 4 ? CTX : SEQ, t0 = cc < 4 ? cc * 64 : (cc - 4) * 64;
    const bf16_t* QKV = (const bf16_t*)(a.ws + WS_QKV);
    const float* cw = a.in[7] + (size_t)l * 5 * 1536;
    if (wid < 2) {
        const int dir = wid, row = s0 + t0 + lane;
        const float* AB = (const float*)(a.ws + WS_AB);
        const float nal = -expf(a.in[13][l * 8 + dir * 4 + h]), dtb = a.in[14][l * 8 + dir * 4 + h];
        const float g = nal * softplusf_(AB[(size_t)row * 16 + dir * 4 + h] + dtb);
        const float beta = sigmoidf_(AB[(size_t)row * 16 + 8 + dir * 4 + h]);
        float c = g;
        if (dir == 0) {
#pragma unroll
            for (int o = 1; o < 64; o <<= 1) { const float v = __shfl_up(c, o); if (lane >= o) c += v; }
        } else {
#pragma unroll
            for (int o = 1; o < 64; o <<= 1) { const float v = __shfl_down(c, o); if (lane + o < 64) c += v; }
        }
        const float glref = __shfl(c, dir == 0 ? 63 : 0);
        const float eg = __expf(c);
        g1_sm(lds, dir, 0)[lane] = c; g1_sm(lds, dir, 1)[lane] = beta; g1_sm(lds, dir, 2)[lane] = beta * eg; g1_sm(lds, dir, 3)[lane] = __expf(glref - c); g1_sm(lds, dir, 4)[lane] = eg;
        if (lane == 0) ((float*)(a.ws + WS_GL))[chunk_index(dir, b, h, cc)] = __expf(glref);
    }
#pragma unroll 1
    for (int rep1_ = 0; rep1_ < G1REP1; ++rep1_) {
    {
        unsigned char* xs = lds + G1_XS; float* wsm = (float*)(lds + G1_WS);
        u32x4 xv[7];
#pragma unroll
        for (int it = 0; it < 7; ++it) {
            const int p = tid + 512 * it; const int pc = p < 68 * 48 ? p : 68 * 48 - 1;
            const int rr = pc / 48, q = pc - rr * 48, part = q >> 4, c8 = q & 15;
            const int tt = t0 + rr - 2; const int ttc = tt < 0 ? 0 : (tt >= len ? len - 1 : tt);
            xv[it] = *(const u32x4*)(QKV + (size_t)(s0 + ttc) * 1536 + part * 512 + h * 128 + c8 * 8);
            if (tt != ttc) xv[it] = (u32x4){0u, 0u, 0u, 0u};
        }
#pragma unroll
        for (int it = 0; it < 7; ++it) {
            const int p = tid + 512 * it;
            if (p < 68 * 48) { const int rr = p / 48, q = p - rr * 48, part = q >> 4, c8 = q & 15; *(u32x4*)(xs + rr * G1_XST + part * 256 + c8 * 16) = xv[it]; }
        }
        if (tid < 480) { const int j = tid / 96, q = tid - j * 96, part = q >> 5, c4 = q & 31;
            *(f32x4*)(wsm + j * 384 + part * 128 + c4 * 4) = *(const f32x4*)(cw + j * 1536 + part * 512 + h * 128 + c4 * 4); }
    }
    __syncthreads();
    if (cut == 3) return;
    {
        const int i = tid >> 3, sub = tid & 7;
        const unsigned char* xs = lds + G1_XS; const float* wsm = (const float*)(lds + G1_WS);
#pragma unroll
        for (int part = 0; part < 3; ++part) {
            float val[16];
#pragma unroll
            for (int cg = 0; cg < 2; ++cg) {
                const int d = cg * 64 + sub * 8;
                float acc[8];
#pragma unroll
                for (int e = 0; e < 8; ++e) acc[e] = 0.f;
#pragma unroll
                for (int j = 0; j < 5; ++j) {
                    {
                        const u32x4 x = *(const u32x4*)(xs + (i + j) * G1_XST + part * 256 + d * 2);
                        const f32x4 w0 = *(const f32x4*)(wsm + j * 384 + part * 128 + d), w1 = *(const f32x4*)(wsm + j * 384 + part * 128 + d + 4);
                        acc[0] += w0[0] * __uint_as_float(x[0] << 16); acc[1] += w0[1] * __uint_as_float(x[0] & 0xffff0000u);
                        acc[2] += w0[2] * __uint_as_float(x[1] << 16); acc[3] += w0[3] * __uint_as_float(x[1] & 0xffff0000u);
                        acc[4] += w1[0] * __uint_as_float(x[2] << 16); acc[5] += w1[1] * __uint_as_float(x[2] & 0xffff0000u);
                        acc[6] += w1[2] * __uint_as_float(x[3] << 16); acc[7] += w1[3] * __uint_as_float(x[3] & 0xffff0000u);
                    }
                }
#pragma unroll
                for (int e = 0; e < 8; ++e) val[cg * 8 + e] = (cut == 5) ? acc[e] : siluf_(acc[e]);
            }
            float scale = 1.f;
            if (part < 2) {
                float ss = 0.f;
#pragma unroll
                for (int e = 0; e < 16; ++e) ss += val[e] * val[e];
                ss += __shfl_xor(ss, 1); ss += __shfl_xor(ss, 2); ss += __shfl_xor(ss, 4);
                scale = rsqrtf(ss + EPS) * (part == 0 ? 0.08838834764831845f : 1.f);
            }
#pragma unroll
            for (int cg = 0; cg < 2; ++cg) {
                const int d = cg * 64 + sub * 8;
                bf16_t hv[8];
#pragma unroll
                for (int e = 0; e < 8; ++e) hv[e] = f2bf(val[cg * 8 + e] * scale);
                if (cut != 4 || scale == 123456.789f) {
                    u32x4 w; w.x = hv[0] | ((unsigned)hv[1] << 16); w.y = hv[2] | ((unsigned)hv[3] << 16); w.z = hv[4] | ((unsigned)hv[5] << 16); w.w = hv[6] | ((unsigned)hv[7] << 16);
                    *(u32x4*)(lds + (part == 0 ? G1_QS : (part == 1 ? G1_KS : G1_VS)) + i * 272 + d * 2) = w;
                }
            }
        }
    }
    }
    __syncthreads();
    if (cut == 1 || cut == 4 || cut == 5) return;
    {
        const int which = wid >> 2, mi = (wid >> 1) & 1, ni = wid & 1;
        const unsigned char* Ab = lds + (which ? G1_QS : G1_KS) + (32 * mi + r) * 272 + hl * 16;
        const unsigned char* Bb = lds + G1_KS + (32 * ni + r) * 272 + hl * 16;
        f32x16 acc;
#pragma unroll
        for (int i = 0; i < 16; ++i) acc[i] = 0.f;
#pragma unroll
        for (int s = 0; s < 8; ++s) acc = MFMA32(*(const bf16x8*)(Ab + s * 32), *(const bf16x8*)(Bb + s * 32), acc);
        float* O = (float*)(lds + (which ? G1_QKS : G1_GS));
#pragma unroll
        for (int i = 0; i < 16; ++i) O[(32 * mi + crow(i, hl)) * 64 + 32 * ni + r] = acc[i];
    }
    __syncthreads();
    {
        const float* GS = (const float*)(lds + G1_GS);
#pragma unroll 4
        for (int x = tid; x < 2 * 4096; x += 512) {
            const int dir = x >> 12, i = (x >> 6) & 63, j = x & 63;
            const float* gc = g1_sm(lds, dir, 0);
            const bool before = dir == 0 ? (j < i) : (j > i);
            const float v = before ? g1_sm(lds, dir, 1)[i] * GS[i * 64 + j] * __expf(gc[i] - gc[j]) : 0.f;
            if (dir == 0) ((float*)(lds + G1_AT))[i * 68 + j] = v; else ((float*)(lds + G1_AT + 17408))[(63 - i) * 68 + (63 - j)] = v;
        }
    }
    __syncthreads();
    if (cut == 2) return;
    if (wid < 2) {
        float* T = (float*)(lds + G1_AT + wid * 17408);
        float t[64];
        f32x4 ra[2][16];
        t[0] = (lane == 0) ? 1.f : 0.f;
        ra[1][0] = *(const f32x4*)(T + 1 * 68);
#pragma unroll
        for (int i = 1; i < 64; ++i) {
            const int c = i & 1, nx = c ^ 1;
            if (i < 63) {
#pragma unroll
                for (int j4 = 0; j4 * 4 < i + 1; ++j4) ra[nx][j4] = *(const f32x4*)(T + (i + 1) * 68 + 4 * j4);
            }
            float ac[4] = {(lane == i) ? 1.f : 0.f, 0.f, 0.f, 0.f};
#pragma unroll
            for (int j4 = 0; j4 * 4 < i; ++j4) {
#pragma unroll
                for (int e = 0; e < 4; ++e) if (4 * j4 + e < i) ac[e] -= ra[c][j4][e] * t[4 * j4 + e];
            }
            t[i] = (ac[0] + ac[1]) + (ac[2] + ac[3]);
        }
#pragma unroll
        for (int i = 0; i < 64; ++i) T[i * 68 + lane] = t[i];
    } else {
        bf16_t* rec0e = (bf16_t*)(a.ws + WS_GPRE);
#pragma unroll
        for (int it2 = 0; it2 < 12; ++it2) {
            const int kind = it2 >> 1, x = (tid - 128) + 384 * (it2 & 1), dir = kind >= 3 ? 1 : 0, kk = kind - 3 * dir;
            if (x >= 512) continue;
            bf16_t* rec = rec0e + (size_t)chunk_index(dir, b, h, cc) * GP_REC;
            const float* gc = g1_sm(lds, dir, 0); const float* ekd = g1_sm(lds, dir, 3); const float* eg = g1_sm(lds, dir, 4);
            if (kk == 0) {
                const int c = x >> 3, g16 = x & 7;
                const u32x4 x0 = *(const u32x4*)(lds + G1_QS + c * 272 + g16 * 32), x1 = *(const u32x4*)(lds + G1_QS + c * 272 + g16 * 32 + 16);
                const unsigned pm[8] = {x0.x, x0.y, x1.x, x1.y, x0.z, x0.w, x1.z, x1.w};
                const float sc = eg[c];
                u32x4 o0, o1;
                o0.x = pk2(__uint_as_float(pm[0] << 16) * sc, __uint_as_float(pm[0] & 0xffff0000u) * sc); o0.y = pk2(__uint_as_float(pm[1] << 16) * sc, __uint_as_float(pm[1] & 0xffff0000u) * sc);
                o0.z = pk2(__uint_as_float(pm[2] << 16) * sc, __uint_as_float(pm[2] & 0xffff0000u) * sc); o0.w = pk2(__uint_as_float(pm[3] << 16) * sc, __uint_as_float(pm[3] & 0xffff0000u) * sc);
                o1.x = pk2(__uint_as_float(pm[4] << 16) * sc, __uint_as_float(pm[4] & 0xffff0000u) * sc); o1.y = pk2(__uint_as_float(pm[5] << 16) * sc, __uint_as_float(pm[5] & 0xffff0000u) * sc);
                o1.z = pk2(__uint_as_float(pm[6] << 16) * sc, __uint_as_float(pm[6] & 0xffff0000u) * sc); o1.w = pk2(__uint_as_float(pm[7] << 16) * sc, __uint_as_float(pm[7] & 0xffff0000u) * sc);
                u32x4* dp = (u32x4*)(rec + GP_QD + c * 128 + g16 * 16); dp[0] = o0; dp[1] = o1;
            } else if (kk == 1) {
                const int dk = x >> 2, g16 = x & 3;
                const bf16_t* kp = (const bf16_t*)(lds + G1_KS) + dk + (g16 * 16) * 136;
                unsigned ow[8];
#pragma unroll
                for (int q = 0; q < 8; ++q) {
                    const int p0 = 2 * q, p1 = 2 * q + 1; const int c0 = swap23(p0), c1 = swap23(p1);
                    ow[q] = pk2(bf2f(kp[c0 * 136]) * ekd[16 * g16 + c0], bf2f(kp[c1 * 136]) * ekd[16 * g16 + c1]);
                }
                u32x4* dp = (u32x4*)(rec + GP_KDT + dk * 64 + g16 * 16);
                dp[0] = (u32x4){ow[0], ow[1], ow[2], ow[3]}; dp[1] = (u32x4){ow[4], ow[5], ow[6], ow[7]};
            } else {
                const int i = x >> 3, sub = x & 7;
                const float* QKm = (const float*)(lds + G1_QKS) + i * 64;
                const float gi = gc[i];
                unsigned ow[4];
#pragma unroll
                for (int q = 0; q < 4; ++q) {
                    float v[2];
#pragma unroll
                    for (int e = 0; e < 2; ++e) {
                        const int jp = 8 * sub + 2 * q + e, j = (jp & ~15) + swap23(jp & 15);
                        const bool ok = dir == 0 ? (j <= i) : (j >= i);
                        v[e] = ok ? QKm[j] * __expf(gi - gc[j]) : 0.f;
                    }
                    ow[q] = pk2(v[0], v[1]);
                }
                *(u32x4*)(rec + GP_QK + i * 64 + 8 * sub) = (u32x4){ow[0], ow[1], ow[2], ow[3]};
            }
        }
    }
    __syncthreads();
    bf16_t* rec0 = (bf16_t*)(a.ws + WS_GPRE);
#pragma unroll 1
    for (int rep6_ = 0; rep6_ < G1REP6; ++rep6_) {
    {
        const int dir = wid >> 2, n = wid & 3;
        bf16_t* rec = rec0 + (size_t)chunk_index(dir, b, h, cc) * GP_REC;
        const float* T = (const float*)(lds + G1_AT + dir * 17408);
        f32x4 tq[2][4][2];
        f32x4 c1[4][2], c2[4][2];
        bf16x8 bv[4], bk[4];
#pragma unroll
        for (int s = 0; s < 4; ++s) {
            const float* p1 = g1_sm(lds, dir, 1) + 16 * s + 8 * hl; const float* p2 = g1_sm(lds, dir, 2) + 16 * s + 8 * hl;
            c1[s][0] = *(const f32x4*)p1; c1[s][1] = *(const f32x4*)(p1 + 4); c2[s][0] = *(const f32x4*)p2; c2[s][1] = *(const f32x4*)(p2 + 4);
            {
                const unsigned toff = (unsigned)((16 * s + 8 * hl + ((lane & 15) >> 2)) * 272 + (32 * n + 16 * ((lane >> 4) & 1)) * 2 + 8 * (lane & 3));
                const s16x4 v0 = tr_read((const LAS unsigned char*)lds + G1_VS + toff), v1 = tr_read((const LAS unsigned char*)lds + G1_VS + toff + 4 * 272);
                const s16x4 k0 = tr_read((const LAS unsigned char*)lds + G1_KS + toff), k1 = tr_read((const LAS unsigned char*)lds + G1_KS + toff + 4 * 272);
                bv[s] = (bf16x8){v0[0], v0[1], v0[2], v0[3], v1[0], v1[1], v1[2], v1[3]};
                bk[s] = (bf16x8){k0[0], k0[1], k0[2], k0[3], k1[0], k1[1], k1[2], k1[3]};
            }
#pragma unroll
            for (int m = 0; m < 2; ++m) {
                if (dir == 0) { const float* tp = T + (32 * m + r) * 68 + 16 * s + 8 * hl; tq[m][s][0] = *(const f32x4*)tp; tq[m][s][1] = *(const f32x4*)(tp + 4); }
                else { const float* tp = T + (63 - (32 * m + r)) * 68 + 56 - 16 * s - 8 * hl; const f32x4 x0 = *(const f32x4*)tp, x1 = *(const f32x4*)(tp + 4);
                       tq[m][s][0] = (f32x4){x1[3], x1[2], x1[1], x1[0]}; tq[m][s][1] = (f32x4){x0[3], x0[2], x0[1], x0[0]}; }
            }
        }
#pragma unroll
        for (int prod = 0; prod < 2; ++prod) {
#pragma unroll
            for (int m = 0; m < 2; ++m) {
                f32x16 acc;
#pragma unroll
                for (int i = 0; i < 16; ++i) acc[i] = 0.f;
#pragma unroll
                for (int s = 0; s < 4; ++s) {
                    const f32x4 ta = tq[m][s][0], tb = tq[m][s][1];
                    const f32x4 ca = prod == 0 ? c1[s][0] : c2[s][0], cb = prod == 0 ? c1[s][1] : c2[s][1];
                    u32x4 aw; aw.x = pk2(ta[0] * ca[0], ta[1] * ca[1]); aw.y = pk2(ta[2] * ca[2], ta[3] * ca[3]); aw.z = pk2(tb[0] * cb[0], tb[1] * cb[1]); aw.w = pk2(tb[2] * cb[2], tb[3] * cb[3]);
                    acc = MFMA32(__builtin_bit_cast(bf16x8, aw), prod == 0 ? bv[s] : bk[s], acc);
                }
                if (prod == 0) {
                    u32x4 w0, w1;
                    w0.x = pk2(acc[0], acc[1]); w0.y = pk2(acc[2], acc[3]); w0.z = pk2(acc[4], acc[5]); w0.w = pk2(acc[6], acc[7]);
                    w1.x = pk2(acc[8], acc[9]); w1.y = pk2(acc[10], acc[11]); w1.z = pk2(acc[12], acc[13]); w1.w = pk2(acc[14], acc[15]);
                    u32x4* up = (u32x4*)(rec + GP_U + ((m * 4 + n) * 64 + lane) * 16);
                    up[0] = w0; up[1] = w1;
                } else {
                    const int dkp = 32 * n + (r & 16) + swap23(r & 15);
#pragma unroll
                    for (int i = 0; i < 16; ++i) rec[GP_WN + (32 * m + crow(i, hl)) * 128 + dkp] = f2bf(-acc[i]);
                }
            }
        }
    }
    }
    __syncthreads();
}
DI void ph_g1(const Args& a, int l, unsigned char* lds, int cut = 0) {
#pragma unroll 1
    for (int task = blockIdx.x; task < 16 * 68; task += gridDim.x) {
        const int bh = task / 68, cc = task % 68;
        g1_task(a, l, bh >> 2, bh & 3, cc, lds, cut);
    }
}

#ifndef PROBE_SCAN_FAKE
#define PROBE_SCAN_FAKE 0
#endif
constexpr int SC_WN = 0, SC_QD = 16384, SC_KDT = 32768, SC_QK = 49152, SC_BUF = 57344, SC_GL = 2 * SC_BUF;
DI int scan_cc(int dir, int step) { return dir == 0 ? step : (step < 4 ? 3 - step : 71 - step); }
DI unsigned scan_src_off(int p) {
    if (p < 2048) { const int row = (p & 1023) >> 4, s16 = p & 15; return (unsigned)((p >> 10) * 16384 + row * 256 + ((s16 ^ (row & 15)) << 4)); }
    const int q = p - 2048, row = q >> 3, s8 = q & 7;
    return (unsigned)(32768 + row * 128 + ((s8 ^ ((row >> 1) & 7)) << 4));
}
#define SCAN_BAR() asm volatile("s_barrier" ::: "memory")
DI void scan_block(const Args& a, int l, int dir, int b, int h, unsigned char* lds, int fake = 0) {
    const int tid = tidx(), lane = tid & 63, wid = tid >> 6, r = lane & 31, hl = lane >> 5;
    const bf16_t* rec0 = (const bf16_t*)(a.ws + WS_GPRE);
    const float* GL = (const float*)(a.ws + WS_GL);
    const bool loader = wid >= 4;
    const int n = wid & 3, lw = __builtin_amdgcn_readfirstlane(wid) - 4;
    bf16_t* OD = (bf16_t*)(a.ws + (dir ? WS_OB : WS_OF));
    f32x16 st[4];
#pragma unroll
    for (int t = 0; t < 4; ++t)
#pragma unroll
        for (int i = 0; i < 16; ++i) st[t][i] = 0.f;
    u32x4 un[4]; float gln = 0.f;
    unsigned swq[8], skq[6];
    if (loader) {
#pragma unroll
        for (int j = 0; j < 8; ++j) swq[j] = scan_src_off((lw * 8 + j) * 64 + lane);
#pragma unroll
        for (int j = 0; j < 6; ++j) skq[j] = scan_src_off(2048 + (lw * 6 + j) * 64 + lane);
    }
#define DMA_WQ(chunk_, bufsel_) do { const int c_ = (chunk_) < 68 ? (chunk_) : 67; const unsigned char* src_ = (const unsigned char*)(rec0 + (size_t)chunk_index(dir, b, h, scan_cc(dir, c_)) * GP_REC); \
        LAS unsigned char* nb_ = (LAS unsigned char*)lds + (bufsel_) * SC_BUF; \
        _Pragma("unroll") for (int j = 0; j < 8; ++j) __builtin_amdgcn_global_load_lds((const unsigned*)(src_ + swq[j]), (LAS unsigned*)(nb_ + (lw * 8 + j) * 1024), 16, 0, 0); } while (0)
#define DMA_KQ(chunk_, bufsel_) do { const int c_ = (chunk_) < 68 ? (chunk_) : 67; const unsigned char* src_ = (const unsigned char*)(rec0 + (size_t)chunk_index(dir, b, h, scan_cc(dir, c_)) * GP_REC); \
        LAS unsigned char* nb_ = (LAS unsigned char*)lds + (bufsel_) * SC_BUF; \
        _Pragma("unroll") for (int j = 0; j < 6; ++j) __builtin_amdgcn_global_load_lds((const unsigned*)(src_ + skq[j]), (LAS unsigned*)(nb_ + 32768 + (lw * 6 + j) * 1024), 16, 0, 0); } while (0)
    if (loader) {
        DMA_WQ(0, 0); DMA_KQ(0, 0); DMA_WQ(1, 1);
        asm volatile("s_waitcnt vmcnt(8)" ::: "memory");
    } else {
        const int ci = chunk_index(dir, b, h, scan_cc(dir, 0));
        const bf16_t* rec = rec0 + (size_t)ci * GP_REC;
#pragma unroll
        for (int m = 0; m < 2; ++m) { const u32x4* up = (const u32x4*)(rec + GP_U + ((m * 4 + n) * 64 + lane) * 16); un[2 * m] = up[0]; un[2 * m + 1] = up[1]; }
        gln = GL[ci];
    }
    SCAN_BAR();
#pragma unroll 1
    for (int step = 0; step < 68; ++step) {
        const int cur = step & 1;
        if (loader) {
            if (fake != 1) {
                DMA_KQ(step + 1, cur ^ 1);
                asm volatile("s_waitcnt vmcnt(14)" ::: "memory");
                SCAN_BAR();
                DMA_WQ(step + 2, cur);
                asm volatile("s_waitcnt vmcnt(14)" ::: "memory");
                SCAN_BAR();
            } else { SCAN_BAR(); SCAN_BAR(); }
        } else {
            if (fake != 2) {
            const int cc = scan_cc(dir, step);
            const int row0 = cc < 4 ? b * CTX + cc * 64 : NCTX + b * SEQ + (cc - 4) * 64;
            const unsigned char* buf = lds + cur * SC_BUF;
            const float gl = gln;
            const unsigned char* pwn = buf + SC_WN + r * 256;
            const unsigned char* pqd = buf + SC_QD + r * 256;
            const unsigned char* pqk = buf + SC_QK + r * 128;
            const unsigned char* pkd = buf + SC_KDT + r * 128;
            const int x16 = r & 15, x8 = (r >> 1) & 7;
#define FR256(base, tile, blk) (*(const bf16x8*)((base) + (tile) * 32 * 256 + ((((blk) ^ x16)) << 4)))
#define FR128(base, tile, blk) (*(const bf16x8*)((base) + (tile) * 32 * 128 + ((((blk) ^ x8)) << 4)))
            bf16x8 fa[2][4];
#pragma unroll
            for (int m = 0; m < 2; ++m) { fa[0][m] = FR256(pwn, m, hl); fa[0][2 + m] = FR256(pqd, m, hl); }
            f32x16 vn[2];
#pragma unroll
            for (int m = 0; m < 2; ++m) {
                const u32x4 u0 = un[2 * m], u1 = un[2 * m + 1];
#pragma unroll
                for (int k = 0; k < 4; ++k) { vn[m][2 * k] = __uint_as_float(u0[k] << 16); vn[m][2 * k + 1] = __uint_as_float(u0[k] & 0xffff0000u); vn[m][8 + 2 * k] = __uint_as_float(u1[k] << 16); vn[m][8 + 2 * k + 1] = __uint_as_float(u1[k] & 0xffff0000u); }
            }
            if (step + 1 < 68) {
                const int ci1 = chunk_index(dir, b, h, scan_cc(dir, step + 1));
                const bf16_t* rec = rec0 + (size_t)ci1 * GP_REC;
#pragma unroll
                for (int m = 0; m < 2; ++m) { const u32x4* up = (const u32x4*)(rec + GP_U + ((m * 4 + n) * 64 + lane) * 16); un[2 * m] = up[0]; un[2 * m + 1] = up[1]; }
                gln = GL[ci1];
            }
            f32x16 o[2];
#pragma unroll
            for (int m = 0; m < 2; ++m)
#pragma unroll
                for (int i = 0; i < 16; ++i) o[m][i] = 0.f;
#pragma unroll
            for (int kk = 0; kk < 8; ++kk) {
                const int c = kk & 1, nx = c ^ 1;
                if (kk < 7) {
#pragma unroll
                    for (int m = 0; m < 2; ++m) { fa[nx][m] = FR256(pwn, m, 2 * (kk + 1) + hl); fa[nx][2 + m] = FR256(pqd, m, 2 * (kk + 1) + hl); }
                }
                const bf16x8 sbk = pack8(st[kk >> 1], kk & 1);
#pragma unroll
                for (int m = 0; m < 2; ++m) { vn[m] = MFMA32(fa[c][m], sbk, vn[m]); o[m] = MFMA32(fa[c][2 + m], sbk, o[m]); }
            }
            asm volatile("s_waitcnt lgkmcnt(0)" ::: "memory");
            SCAN_BAR();
            bf16x8 fb[2][3];
            fb[0][0] = FR128(pqk, 0, hl); fb[0][1] = FR128(pqk, 1, hl); fb[0][2] = FR128(pkd, 0, hl);
#pragma unroll
            for (int t = 0; t < 4; ++t)
#pragma unroll
                for (int i = 0; i < 16; ++i) st[t][i] *= gl;
#pragma unroll
            for (int h2 = 0; h2 < 8; ++h2) {
                const int kk = h2 >> 1, part = h2 & 1, c = h2 & 1, nx = c ^ 1;
                if (h2 < 7) {
                    const int k1 = (h2 + 1) >> 1;
                    if (part == 0) {
#pragma unroll
                        for (int t = 1; t < 4; ++t) fb[nx][t - 1] = FR128(pkd, t, 2 * k1 + hl);
                    } else { fb[nx][0] = FR128(pqk, 0, 2 * k1 + hl); fb[nx][1] = FR128(pqk, 1, 2 * k1 + hl); fb[nx][2] = FR128(pkd, 0, 2 * k1 + hl); }
                }
                const bf16x8 vbk = pack8(vn[kk >> 1], kk & 1);
                if (part == 0) { o[0] = MFMA32(fb[c][0], vbk, o[0]); o[1] = MFMA32(fb[c][1], vbk, o[1]); st[0] = MFMA32(fb[c][2], vbk, st[0]); }
                else { st[1] = MFMA32(fb[c][0], vbk, st[1]); st[2] = MFMA32(fb[c][1], vbk, st[2]); st[3] = MFMA32(fb[c][2], vbk, st[3]); }
            }
#undef FR256
#undef FR128
#pragma unroll
            for (int m = 0; m < 2; ++m)
#pragma unroll
                for (int i = 0; i < 16; ++i) OD[(size_t)(row0 + 32 * m + crow(i, hl)) * 512 + h * 128 + 32 * n + r] = f2bf(o[m][i]);
            asm volatile("s_waitcnt lgkmcnt(0)" ::: "memory");
            SCAN_BAR();
            } else { SCAN_BAR(); SCAN_BAR(); }
        }
    }
    if (loader) asm volatile("s_waitcnt vmcnt(0)" ::: "memory");
    __syncthreads();
#undef DMA_WQ
#undef DMA_KQ
}
#undef SCAN_BAR
DI void ph_scan(const Args& a, int l, unsigned char* lds) {
    const int x = blockIdx.x;
#if PROBE_SCAN_FAKE
    scan_block(a, l, x >> 4, (x >> 2) & 3, x & 3, lds, PROBE_SCAN_FAKE); __syncthreads();
#endif
    scan_block(a, l, x >> 4, (x >> 2) & 3, x & 3, lds);
}


__global__ void __launch_bounds__(256) nv_inproj(Args a) {
    const int l = a.layer;
    const int row = blockIdx.y, cd = blockIdx.x * 256 + threadIdx.x;
    const int cs = cd < 3584 ? cd : cd + 16;
    const float* w = a.in[6] + (size_t)l * 1024 * N_IN;
    const bf16_t* hr = (const bf16_t*)(a.ws + WS_H) + (size_t)row * 1024;
    const bool isrope = (cd < 1024) && (row >= NCTX);
    const int cs2 = cs ^ 16;
    float acc = 0.f, acc2 = 0.f;
    for (int k = 0; k < 1024; ++k) { const float h = bf2f(hr[k]); acc += h * w[(size_t)k * N_IN + cs]; if (isrope) acc2 += h * w[(size_t)k * N_IN + cs2]; }
    if (cd < 1024) {
        float v = acc;
        if (isrope) {
            const float* rope = (const float*)(a.ws + WS_ROPE);
            const int t = (row - NCTX) & 4095, d = cd & 63, axis = (d >> 5) & 1, half = (d >> 4) & 1, f = d & 15;
            const int pos = axis ? (t & 63) : (t >> 6);
            const float c = rope[(pos * 16 + f) * 2], s = rope[(pos * 16 + f) * 2 + 1];
            v = half == 0 ? acc * c - acc2 * s : acc * c + acc2 * s;
        }
        if (cd < 512) ((bf16_t*)(a.ws + WS_QA))[(size_t)row * 512 + cd] = f2bf(v * QSCALE);
        else ((bf16_t*)(a.ws + WS_KA))[(size_t)row * 512 + cd - 512] = f2bf(v);
    } else if (cd < 1536) ((bf16_t*)(a.ws + WS_VA))[(size_t)row * 512 + cd - 1024] = f2bf(acc);
    else if (cd < 3072) ((bf16_t*)(a.ws + WS_QKV))[(size_t)row * 1536 + cd - 1536] = f2bf(acc);
    else if (cd < 3584) ((bf16_t*)(a.ws + WS_Z))[(size_t)row * 512 + cd - 3072] = f2bf(acc);
    else ((bf16_t*)(a.ws + WS_SG))[(size_t)row * 2048 + cd - 3584] = f2bf(sigmoidf_(acc));
}

__global__ void __launch_bounds__(256) nv_attn(Args a) {
    const int row = blockIdx.x * 256 + threadIdx.x;
    const int h = blockIdx.y >> 2, comp = (blockIdx.y >> 1) & 1, dh = blockIdx.y & 1;
    const bf16_t* QA = (const bf16_t*)(a.ws + WS_QA); const bf16_t* KA = (const bf16_t*)(a.ws + WS_KA); const bf16_t* VA = (const bf16_t*)(a.ws + WS_VA);
    float* ON = (float*)(a.ws + WS_ON);
    const bool isctx = row < NCTX;
    const int b = isctx ? (row >> 8) : ((row - NCTX) >> 12);
    float q[64];
    { const bf16_t* qp = QA + (size_t)row * 512 + h * 128 + comp * 64;
#pragma unroll
      for (int i = 0; i < 64; ++i) q[i] = bf2f(qp[i]); }
    float acc[64];
#pragma unroll
    for (int i = 0; i < 64; ++i) acc[i] = 0.f;
    float m = -1e30f, lsum = 0.f;
    const int nkeys = isctx ? CTX : CTX + SEQ;
    for (int kk = 0; kk < nkeys; ++kk) {
        const int kr = kk < CTX ? b * CTX + kk : NCTX + b * SEQ + (kk - CTX);
        const bf16_t* kp = KA + (size_t)kr * 512 + h * 128 + comp * 64;
        float s = 0.f;
#pragma unroll
        for (int i = 0; i < 64; ++i) s += q[i] * bf2f(kp[i]);
        const float mn = fmaxf(m, s), corr = exp2f(m - mn), p = exp2f(s - mn);
        lsum = lsum * corr + p; m = mn;
        const bf16_t* vp = VA + (size_t)kr * 512 + h * 128 + dh * 64;
#pragma unroll
        for (int i = 0; i < 64; ++i) acc[i] = acc[i] * corr + p * bf2f(vp[i]);
    }
    const float inv = 1.f / lsum;
    float* op = ON + ((size_t)comp * TT + row) * 512 + h * 128 + dh * 64;
#pragma unroll
    for (int i = 0; i < 64; ++i) op[i] = acc[i] * inv;
}
DI float lam_of(const Args& a, int l) {
    float s1 = 0.f, s2 = 0.f;
    for (int i = 0; i < 64; ++i) { s1 += a.in[8][l * 64 + i] * a.in[9][l * 64 + i]; s2 += a.in[10][l * 64 + i] * a.in[11][l * 64 + i]; }
    return expf(s1) - expf(s2) + lam_init_of(l);
}
__global__ void __launch_bounds__(256) nv_attn_combine(Args a) {
    const int l = a.layer;
    const int idx = blockIdx.x * 256 + threadIdx.x; if (idx >= TT * 4) return;
    const int row = idx >> 2, h = idx & 3;
    const float lam = lam_of(a, l), li = lam_init_of(l);
    const float* ON = (const float*)(a.ws + WS_ON);
    const float* o0 = ON + (size_t)row * 512 + h * 128; const float* o1 = ON + ((size_t)TT + row) * 512 + h * 128;
    float ss = 0.f;
    for (int i = 0; i < 128; ++i) { const float o = o0[i] - lam * o1[i]; ss += o * o; }
    const float r = rsqrtf(ss * (1.f / 128.f) + EPS) * (1.f - li);
    bf16_t* ya = (bf16_t*)(a.ws + WS_YAB) + (size_t)row * 512 + h * 128;
    const float* sg = a.in[12] + l * 128;
    for (int i = 0; i < 128; ++i) ya[i] = f2bf((o0[i] - lam * o1[i]) * r * sg[i]);
}
__global__ void __launch_bounds__(256) nv_conv(Args a) {
    const int l = a.layer;
    const int row = blockIdx.y, ch = blockIdx.x * 256 + threadIdx.x;
    const bf16_t* QKV = (const bf16_t*)(a.ws + WS_QKV); float* CO = (float*)(a.ws + WS_CONVO);
    const float* cw = a.in[7] + l * 5 * 1536;
    int s0, len; if (row < NCTX) { s0 = (row >> 8) << 8; len = CTX; } else { s0 = NCTX + (((row - NCTX) >> 12) << 12); len = SEQ; }
    const int t = row - s0; float acc = 0.f;
    for (int j = 0; j < 5; ++j) { const int tt = t + j - 2; if (tt >= 0 && tt < len) acc += cw[j * 1536 + ch] * bf2f(QKV[(size_t)(s0 + tt) * 1536 + ch]); }
    CO[(size_t)row * 1536 + ch] = siluf_(acc);
}
__global__ void __launch_bounds__(256) nv_norm(Args a) {
    const int idx = blockIdx.x * 256 + threadIdx.x; if (idx >= TT * 8) return;
    const int row = idx >> 3, h = (idx >> 1) & 3, which = idx & 1;
    float* p = (float*)(a.ws + WS_CONVO) + (size_t)row * 1536 + which * 512 + h * 128;
    float ss = 0.f; for (int i = 0; i < 128; ++i) ss += p[i] * p[i];
    const float r = rsqrtf(ss + EPS) * (which == 0 ? 0.08838834764831845f : 1.f);
    for (int i = 0; i < 128; ++i) p[i] *= r;
}
__global__ void __launch_bounds__(128) nv_scan(Args a) {
    const int l = a.layer;
    const int dir = blockIdx.x >> 4, b = (blockIdx.x >> 2) & 3, h = blockIdx.x & 3, e = threadIdx.x;
    __shared__ float sq[128], sk[128];
    const float* CO = (const float*)(a.ws + WS_CONVO); const float* AB = (const float*)(a.ws + WS_AB);
    bf16_t* OD = (bf16_t*)(a.ws + (dir ? WS_OB : WS_OF));
    const float nal = -expf(a.in[13][l * 8 + dir * 4 + h]), dtb = a.in[14][l * 8 + dir * 4 + h];
    float s[128];
#pragma unroll
    for (int d = 0; d < 128; ++d) s[d] = 0.f;
    for (int step = 0; step < CTX + SEQ; ++step) {
        int row;
        if (step < CTX) { const int t = dir ? (CTX - 1 - step) : step; row = b * CTX + t; }
        else { const int t = dir ? (SEQ - 1 - (step - CTX)) : (step - CTX); row = NCTX + b * SEQ + t; }
        __syncthreads();
        sq[e] = CO[(size_t)row * 1536 + h * 128 + e]; sk[e] = CO[(size_t)row * 1536 + 512 + h * 128 + e];
        const float v = CO[(size_t)row * 1536 + 1024 + h * 128 + e];
        __syncthreads();
        const float g = nal * softplusf_(AB[(size_t)row * 16 + dir * 4 + h] + dtb);
        const float av = expf(g), beta = sigmoidf_(AB[(size_t)row * 16 + 8 + dir * 4 + h]);
        float r = 0.f, qs = 0.f, qk = 0.f;
#pragma unroll
        for (int d = 0; d < 128; ++d) { r += sk[d] * s[d]; qs += sq[d] * s[d]; qk += sq[d] * sk[d]; }
        const float vn = beta * (v - av * r);
        const float o = av * qs + qk * vn;
#pragma unroll
        for (int d = 0; d < 128; ++d) s[d] = av * s[d] + sk[d] * vn;
        OD[(size_t)row * 512 + h * 128 + e] = f2bf(o);
    }
}
__global__ void __launch_bounds__(256) nv_merge1(Args a) {
    const int l = a.layer;
    const int row = blockIdx.y, c = blockIdx.x * 256 + threadIdx.x;
    const bf16_t* YA = (const bf16_t*)(a.ws + WS_YAB) + (size_t)row * 512; const bf16_t* YB = (const bf16_t*)(a.ws + WS_YAB) + ((size_t)TT + row) * 512;
    const float* wpa = a.in[16] + (size_t)l * 512 * 1024; const float* wpb = a.in[17] + (size_t)l * 512 * 1024;
    float pa = 0.f, pb = 0.f;
    for (int k = 0; k < 512; ++k) { pa += bf2f(YA[k]) * wpa[(size_t)k * 1024 + c]; pb += bf2f(YB[k]) * wpb[(size_t)k * 1024 + c]; }
    const bf16_t* SG = (const bf16_t*)(a.ws + WS_SG) + (size_t)row * 2048;
    ((bf16_t*)(a.ws + WS_M))[(size_t)row * 1024 + c] = f2bf(bf2f(SG[c]) * pa + bf2f(SG[1024 + c]) * pb);
}
__global__ void __launch_bounds__(256) nv_wo(Args a) {
    const int l = a.layer;
    const int row = blockIdx.y, c = blockIdx.x * 256 + threadIdx.x;
    const bf16_t* M = (const bf16_t*)(a.ws + WS_M) + (size_t)row * 1024; const float* wo = a.in[18] + (size_t)l * 1024 * 1024;
    float acc = 0.f;
    for (int k = 0; k < 1024; ++k) acc += bf2f(M[k]) * wo[(size_t)k * 1024 + c];
    float* X = (float*)(a.ws + WS_X) + (size_t)row * 1024 + c;
    const float* m = (const float*)(a.ws + WS_MODS) + (size_t)(l * 5 + mod_set(row)) * 6144;
    *X = ALPHA * *X + m[2 * 1024 + c] * acc;
}
__global__ void __launch_bounds__(256) nv_moe1(Args a) {
    const int l = a.layer;
    const int as = blockIdx.y, j = blockIdx.x * 256 + threadIdx.x;
    const int row = as >> 1; if (l == DEPTH - 1 && row < NCTX) return;
    const int e = ((const int*)(a.ws + WS_ROUTE_E))[as];
    const bf16_t* hr = (const bf16_t*)(a.ws + WS_H) + (size_t)row * 1024;
    const float* w1 = a.in[23] + ((size_t)l * 16 + e) * 1024 * 512; const float* w3 = a.in[24] + ((size_t)l * 16 + e) * 1024 * 512;
    float g = 0.f, u = 0.f;
    for (int k = 0; k < 1024; ++k) { const float hv = bf2f(hr[k]); g += hv * w1[(size_t)k * 512 + j]; u += hv * w3[(size_t)k * 512 + j]; }
    ((bf16_t*)(a.ws + WS_ACT))[(size_t)as * 512 + j] = f2bf(siluf_(g) * u);
}
__global__ void __launch_bounds__(256) nv_moe2(Args a) {
    const int l = a.layer;
    const int as = blockIdx.y, c = blockIdx.x * 256 + threadIdx.x;
    const int row = as >> 1; if (l == DEPTH - 1 && row < NCTX) return;
    const int e = ((const int*)(a.ws + WS_ROUTE_E))[as];
    const bf16_t* ar = (const bf16_t*)(a.ws + WS_ACT) + (size_t)as * 512;
    const float* w2 = a.in[25] + ((size_t)l * 16 + e) * 512 * 1024;
    float acc = 0.f;
    for (int k = 0; k < 512; ++k) acc += bf2f(ar[k]) * w2[(size_t)k * 1024 + c];
    ((bf16_t*)(a.ws + WS_YS))[(size_t)as * 1024 + c] = f2bf(acc);
}


enum Op { OP_MODS = 0, OP_CONVERT, OP_PREP0, OP_INPROJ, OP_ATTN_G1, OP_SCAN, OP_YB, OP_MERGE1, OP_WO, OP_LN1, OP_SLOT, OP_UP, OP_DOWN, OP_COMBINE, OP_NONE };
constexpr int NSTEP_PRE = 2, NSTEP_LAYER = 11, NSTEPS = NSTEP_PRE + NSTEP_LAYER * DEPTH;
__host__ __device__ inline void decode_step(int step, int& op, int& l) {
    if (step < NSTEP_PRE) { l = 0; op = step == 0 ? OP_MODS : OP_PREP0; return; }
    const int s = step - NSTEP_PRE; l = s / NSTEP_LAYER; op = OP_INPROJ + s % NSTEP_LAYER;
}

#ifndef PROBE_XBAR
#define PROBE_XBAR 0
#endif
#ifndef PROBE_WO2
#define PROBE_WO2 0
#endif
#ifndef PROBE_LN12
#define PROBE_LN12 0
#endif
#ifndef PROBE_CMB2
#define PROBE_CMB2 0
#endif
#ifndef PROBE_ATT2
#define PROBE_ATT2 0
#endif
#ifndef PROBE_G12
#define PROBE_G12 0
#endif
#ifndef PROBE_OP
#define PROBE_OP -1
#endif
#ifndef PROBE_N
#define PROBE_N 1
#endif
#ifndef PROBE_PAD
#define PROBE_PAD 7
#endif
#ifndef ONLY_OP
#define ONLY_OP -1
#endif
#define EN(o) (ONLY_OP < 0 || ONLY_OP == (o))
__global__ void __launch_bounds__(512, 2) mk(Args a_in) {
    extern __shared__ __attribute__((aligned(16))) unsigned char lds[];
    const int tid = threadIdx.x;
    volatile LAS unsigned* MISC = (volatile LAS unsigned*)((LAS unsigned char*)lds + LDS_MISC);
    if (tid < 64) MISC[tid] = 0u;
    __syncthreads();
    XcdBarrier bar; bar.bar = (unsigned*)(a_in.ws + WS_CTL) + 4096; bar.x = 0; bar.st = nullptr;
    if (a_in.hi - a_in.lo > 1) bar = xcd_barrier_post((unsigned*)(a_in.ws + WS_CTL) + 4096, MISC + 8);
    const int G = gridDim.x;
#pragma unroll 1
    for (int step = a_in.lo; step < a_in.hi; ++step) {
        int op, l; decode_step(step, op, l);
        if ((op == OP_WO || op == OP_DOWN || op == OP_LN1) && (a_in.hi - a_in.lo > 1)) continue;
        Args a = a_in;
        { unsigned z; asm volatile("s_mov_b32 %0, 0" : "=s"(z)); a.ws = a_in.ws + z; a.out = a_in.out + z;
#pragma unroll
          for (int i = 0; i < 28; ++i) a.in[i] = a_in.in[i] + z; }
#if PROBE_OP >= 0
        const int nrep_ = (op == PROBE_OP) ? 1 + PROBE_N : 1;
#pragma unroll 1
        for (int rep_ = 0; rep_ < nrep_; ++rep_) {
        const int padm_ = (rep_ > 0) ? PROBE_PAD : 7;
        if (rep_ > 0) xcd_barrier(bar);
#else
        const int padm_ = 7;
        {
#endif
        const int vcu_ = (G == 256 && XCD_RELABEL) ? (((int)blockIdx.x & 7) * 32 + ((int)blockIdx.x >> 3)) : (int)blockIdx.x;
        if (EN(OP_MODS) && op == OP_MODS) {
            ph_mods(a, lds);
            { const int t_ = tidx(); convert_run(a, 0, -1, blockIdx.x * 8 + (t_ >> 6), G * 8, (float*)(lds + 40960 + (t_ >> 6) * 8704), t_ & 63); }
            __syncthreads();
        }
        else if (EN(OP_PREP0) && op == OP_PREP0) ph_prep0(a, lds);
        else if (EN(OP_INPROJ) && op == OP_INPROJ) {
            pg8::Gemm g{(const bf16_t*)(a.ws + WS_H), (const bf16_t*)(a.ws + WS_WIN), TT, NPROJ, 1024};
            pg8::StaticOrder S; S.init(TT, NPROJ, G, (int)blockIdx.x);
            EpiInproj E{a.ws};
            pg8::gemm_phase<EpiInproj, pg8::StaticOrder, true, true>((LAS unsigned char*)lds, g, S, E);
        }
        else if (EN(OP_ATTN_G1) && op == OP_ATTN_G1) {
            if (a_in.pad & padm_ & 1) {
#if PROBE_ATT2
                ph_attn<PROBE_ATT2>(a, l, (LAS unsigned char*)lds); __syncthreads();
#endif
                ph_attn<0>(a, l, (LAS unsigned char*)lds);
            }
            if (a_in.pad & padm_ & 2) {
#if PROBE_G12
                ph_g1(a, l, lds, PROBE_G12 - 1); __syncthreads();
#endif
                ph_g1(a, l, lds);
            }
        }
        else if (EN(OP_SCAN) && op == OP_SCAN) {
            const int t_ = tidx(), w_ = t_ >> 6;
            const bool scanner = (a_in.pad & 4) && blockIdx.x < 32;
            const bool do_conv_ = (padm_ & 8) || (padm_ == 7);
            if (scanner) { if (padm_ & 4) ph_scan(a, l, lds); }
            else {
                const int nscan = (a_in.pad & 4) ? 32 : 0;
                const int rank = ((int)blockIdx.x - nscan) * 8 + w_;
                if (do_conv_) convert_run(a, l + 1, l, rank, (G - nscan) * 8, (float*)(lds + w_ * 16384), t_ & 63);
                if (nscan && padm_ == 7) {
                    __syncthreads();
                    pg8::Gemm g{(const bf16_t*)(a.ws + WS_YAB), (const bf16_t*)(a.ws + WS_WPAB), 2 * TT, 2048, 512};
                    SchedMergeA S{G - nscan, (int)blockIdx.x - nscan, l == DEPTH - 1 ? 4 : 0, a.ws, l};
                    EpiMerge1 E{a.ws};
                    pg8::gemm_phase<EpiMerge1, SchedMergeA, true, true>((LAS unsigned char*)lds, g, S, E);
                }
            }
            __syncthreads();
        }
        else if (EN(OP_YB) && op == OP_YB) ph_yb(a, l);
        else if (EN(OP_MERGE1) && op == OP_MERGE1) {
            {
                pg8::Gemm g{(const bf16_t*)(a.ws + WS_YAB), (const bf16_t*)(a.ws + WS_WPAB), 2 * TT, 2048, 512};
                SchedMerge1 S{G, vcu_, l == DEPTH - 1 ? 4 : 0, a.ws, l};
                EpiMerge1 E{a.ws};
                pg8::gemm_phase<EpiMerge1, SchedMerge1, true, true>((LAS unsigned char*)lds, g, S, E);
            }
            {
                pg8::Gemm g{(const bf16_t*)(a.ws + WS_M), (const bf16_t*)(a.ws + WS_WO), TT, 1024, 1024};
                SchedWoWait S{G, vcu_, l == DEPTH - 1 ? 4 : 0, a.ws, l};
                EpiWo E{a.ws, l, 0};
                pg8::gemm_phase<EpiWo, SchedWoWait, true, true>((LAS unsigned char*)lds, g, S, E);
            }
            if (a_in.hi - a_in.lo > 1) { __syncthreads(); ph_ln1_router(a, l, lds); }
        }
        else if (EN(OP_LN1) && op == OP_LN1) {
#if PROBE_LN12
            ph_ln1_router(a, l, lds, PROBE_LN12); __syncthreads();
#endif
            ph_ln1_router(a, l, lds);
        }
        else if (EN(OP_SLOT) && op == OP_SLOT) ph_slot(a, l, lds);
        else if (EN(OP_UP) && op == OP_UP) {
            const int* meta = (const int*)(a.ws + WS_META);
            const int ntl = meta[META_NT];
            {
                pg8::Gemm g{(const bf16_t*)(a.ws + WS_H), (const bf16_t*)(a.ws + WS_W13), NSLOT, 16384, 1024};
                SchedMoe S{G, vcu_, ntl, meta + META_TE, a.ws, l, 1};
                EpiUp E{a.ws};
                pg8::gemm_phase<EpiUp, SchedMoe, true, true>((LAS unsigned char*)lds, g, S, E);
            }
            {
                pg8::Gemm g{(const bf16_t*)(a.ws + WS_ACT), (const bf16_t*)(a.ws + WS_W2), NSLOT, 16384, 512};
                SchedMoe S{G, vcu_, ntl, meta + META_TE, a.ws, l, 2};
                EpiDown E{a.ws};
                pg8::gemm_phase<EpiDown, SchedMoe, true, true>((LAS unsigned char*)lds, g, S, E);
            }
        }
        else if (EN(OP_COMBINE) && op == OP_COMBINE) {
#if PROBE_CMB2
            ph_combine_ln2(a, l, lds, 1); __syncthreads();
#endif
            ph_combine_ln2(a, l, lds);
        }
        }
        if (step + 1 < a_in.hi) { xcd_barrier(bar);
#if PROBE_XBAR
            for (int xb_ = 0; xb_ < PROBE_XBAR; ++xb_) xcd_barrier(bar);
#endif
        }
    }
}


#ifndef FAST_MASK
#define FAST_MASK 0xffffffffu
#endif
#ifndef MK_SINGLE
#define MK_SINGLE 1
#endif
#ifndef FAST_ATTN
#define FAST_ATTN 1
#endif
#ifndef FAST_G1
#define FAST_G1 1
#endif
#ifndef FAST_SCAN
#define FAST_SCAN 1
#endif
static bool op_fast(int op) {
    if (op == OP_ATTN_G1) return false;
    if (op == OP_SCAN) return FAST_SCAN != 0;
    return (FAST_MASK >> op) & 1u;
}
extern "C" void kernel_launch(void* const* d_in, const int* in_sizes, int n_in, void* d_out, int out_size, void* d_ws, size_t ws_size, hipStream_t stream) {
    if (n_in != 28 || ws_size < WS_END) { fprintf(stderr, "kernel_launch: unexpected n_in %d / ws_size %zu (need %zu)\n", n_in, ws_size, (size_t)WS_END); return; }
    Args a{};
    for (int i = 0; i < 28; ++i) a.in[i] = (const float*)d_in[i];
    a.out = (float*)d_out; a.ws = (unsigned char*)d_ws;
    static bool attr_done = false;
    if (!attr_done) {
        if (hipFuncSetAttribute((const void*)mk, hipFuncAttributeMaxDynamicSharedMemorySize, LDS_BYTES) != hipSuccess) fprintf(stderr, "hipFuncSetAttribute failed\n");
        attr_done = true;
    }
    hipMemsetAsync((char*)d_ws + WS_CTL, 0, 1 * MiB, stream);
#if MK_SINGLE
    a.lo = 0; a.hi = NSTEPS; a.pad = 7;
    hipLaunchKernelGGL(mk, dim3(256), dim3(512), LDS_BYTES, stream, a);
#else
    for (int step = 0; step < NSTEPS; ++step) {
        int op, l; decode_step(step, op, l);
        a.layer = l;
        if (op == OP_ATTN_G1) {
            if (FAST_ATTN || FAST_G1) { a.lo = step; a.hi = step + 1; a.pad = (FAST_ATTN ? 1 : 0) | (FAST_G1 ? 2 : 0); hipLaunchKernelGGL(mk, dim3(256), dim3(512), LDS_BYTES, stream, a); a.pad = 0; a.lo = 0; a.hi = 0; }
            if (!FAST_ATTN) {
                hipLaunchKernelGGL(nv_attn, dim3(TT / 256, 16), dim3(256), 0, stream, a);
                hipLaunchKernelGGL(nv_attn_combine, dim3(TT * 4 / 256), dim3(256), 0, stream, a);
            }
            if (!FAST_G1) {
                hipLaunchKernelGGL(nv_conv, dim3(1536 / 256, TT), dim3(256), 0, stream, a);
                hipLaunchKernelGGL(nv_norm, dim3(TT * 8 / 256), dim3(256), 0, stream, a);
            }
            continue;
        }
        if (op == OP_SCAN) {
            a.lo = step; a.hi = step + 1; a.pad = FAST_SCAN ? 4 : 0; hipLaunchKernelGGL(mk, dim3(256), dim3(512), LDS_BYTES, stream, a); a.pad = 0; a.lo = 0; a.hi = 0;
            if (!FAST_SCAN) hipLaunchKernelGGL(nv_scan, dim3(32), dim3(128), 0, stream, a);
            continue;
        }
        if (op_fast(op)) { a.lo = step; a.hi = step + 1; hipLaunchKernelGGL(mk, dim3(256), dim3(512), LDS_BYTES, stream, a); continue; }
        a.lo = 0; a.hi = 0;
        switch (op) {
        case OP_INPROJ: hipLaunchKernelGGL(nv_inproj, dim3(NPROJ / 256, TT), dim3(256), 0, stream, a); break;
        case OP_MERGE1: hipLaunchKernelGGL(nv_merge1, dim3(4, TT), dim3(256), 0, stream, a); break;
        case OP_WO: hipLaunchKernelGGL(nv_wo, dim3(4, TT), dim3(256), 0, stream, a); break;
        case OP_SLOT: break;
        case OP_UP: hipLaunchKernelGGL(nv_moe1, dim3(2, NASSIGN), dim3(256), 0, stream, a); break;
        case OP_DOWN: hipLaunchKernelGGL(nv_moe2, dim3(4, NASSIGN), dim3(256), 0, stream, a); break;
        default: fprintf(stderr, "no naive kernel for op %d\n", op); break;
        }
    }
#endif
}
```
